# Optimizing an MI355X kernel written in HIP

```python
import math
import jax, jax.numpy as jnp
from jax import lax
import numpy as np


D_MODEL = 2048
BATCH = 2
SEQ = 8192
DEPTH = 4

F32 = jnp.float32
EPS = 1e-6

HG_HEADS = 6
HG_DK = 128
HG_DV = 128
HG_WIDTH = HG_HEADS * HG_DV
HG_CHUNK = 64

RET_HEADS = 6
RET_DK = 64
RET_DV = 128
RET_WIDTH = RET_HEADS * RET_DV
RET_CHUNK = 128
ROPE_BASE = 10000.0

DIL_SLOTS = 4
DIL_HD = 128
DIL_GROUPS = ((128, 1), (512, 4), (2048, 16))
DIL_WIDTH = DIL_SLOTS * DIL_HD
DIL_HEADS = DIL_SLOTS * len(DIL_GROUPS)

MIX_WIDTH = HG_WIDTH + RET_WIDTH + DIL_WIDTH
D_FF = 4 * D_MODEL
REL_BUCKETS = 32
REL_MAX_DIST = 1024

IN_SPLITS = (HG_HEADS * HG_DK, HG_WIDTH, HG_HEADS * HG_DK, HG_HEADS * HG_DK, HG_WIDTH,
             RET_HEADS * RET_DK, RET_HEADS * RET_DK, RET_WIDTH, RET_WIDTH) + (DIL_WIDTH,) * (3 * len(DIL_GROUPS))
IN_WIDTH = sum(IN_SPLITS)

kernel_name = 'hybrid_hgrn2_retnet_dilated_encoder'


def rms_norm(x, g):
    xf = x.astype(F32)
    y = xf * lax.rsqrt(jnp.mean(xf * xf, axis=-1, keepdims=True) + EPS)
    return (y * g.astype(F32)).astype(x.dtype)


def head_rms(t, gain):
    return t * lax.rsqrt(jnp.mean(t * t, axis=-1, keepdims=True) + EPS) * gain.astype(F32)


def to_heads(t, n_heads):
    B, S, W = t.shape
    return t.astype(F32).reshape(B, S, n_heads, W // n_heads).transpose(0, 2, 1, 3)


def rope(t):
    S, d = t.shape[1], t.shape[-1]
    half = d // 2
    inv = ROPE_BASE ** (-jnp.arange(half, dtype=F32) / half)
    ang = jnp.arange(S, dtype=F32)[:, None] * inv[None, :]
    cos = jnp.cos(ang)[None, :, None, :]
    sin = jnp.sin(ang)[None, :, None, :]
    t1, t2 = t[..., :half], t[..., half:]
    return jnp.concatenate([t1 * cos - t2 * sin, t1 * sin + t2 * cos], axis=-1)


def hgrn2_chunk_scan(q, k, v, log_f):
    B, H, S, DK = q.shape
    DV = v.shape[-1]
    C = HG_CHUNK
    nc = S // C

    def chunks(t):
        return t.reshape(B, H, nc, C, t.shape[-1]).transpose(2, 0, 1, 3, 4)

    mask = jnp.tril(jnp.ones((C, C), dtype=bool))[:, :, None]

    def step(state, inp):
        qc, kc, vc, lc = inp
        b = jnp.cumsum(lc, axis=2)
        diff = b[:, :, :, None, :] - b[:, :, None, :, :]
        decay = jnp.exp(jnp.where(mask, diff, -jnp.inf))
        attn = jnp.einsum('bhik,bhjk,bhijk->bhij', qc, kc, decay)
        out = (jnp.einsum('bhij,bhjv->bhiv', attn, vc)
               + jnp.einsum('bhik,bhkv->bhiv', qc * jnp.exp(b), state))
        b_last = b[:, :, -1:, :]
        state = (jnp.exp(b_last)[:, :, 0, :, None] * state
                 + jnp.einsum('bhjk,bhjv->bhkv', kc * jnp.exp(b_last - b), vc))
        return state, out

    state0 = jnp.zeros((B, H, DK, DV), F32)
    _, out = lax.scan(step, state0, (chunks(q), chunks(k), chunks(v), chunks(log_f)))
    return out.transpose(1, 2, 0, 3, 4).reshape(B, H, S, DV)


def hgrn2_mixer(q, i_in, z_fwd, z_bwd, gate, lb_fwd, lb_bwd, norm_g):
    B, S, _ = q.shape
    qh = to_heads(q, HG_HEADS)
    vh = to_heads(i_in, HG_HEADS)

    def one_direction(z, lb, reverse):
        lbh = lb.astype(F32).reshape(HG_HEADS, 1, HG_DK)
        f = lbh + (1.0 - lbh) * jax.nn.sigmoid(to_heads(z, HG_HEADS))
        k = 1.0 - f
        lf = jnp.log(f)
        if reverse:
            fl = lambda t: jnp.flip(t, axis=2)
            return fl(hgrn2_chunk_scan(fl(qh), fl(k), fl(vh), fl(lf)))
        return hgrn2_chunk_scan(qh, k, vh, lf)

    o = one_direction(z_fwd, lb_fwd, False) + one_direction(z_bwd, lb_bwd, True)
    o = o.transpose(0, 2, 1, 3)
    o = o * lax.rsqrt(jnp.mean(o * o, axis=-1, keepdims=True) + EPS)
    o = o.reshape(B, S, HG_WIDTH) * norm_g.astype(F32)
    return o * jax.nn.silu(gate.astype(F32))


def retention_chunk(q, k, v, log_gamma):
    B, H, S, DK = q.shape
    DV = v.shape[-1]
    C = RET_CHUNK
    nc = S // C
    qc = q.reshape(B, H, nc, C, DK)
    kc = k.reshape(B, H, nc, C, DK)
    vc = v.reshape(B, H, nc, C, DV)
    idx = jnp.arange(C, dtype=F32)
    lg = log_gamma[:, None]
    rel = idx[:, None] - idx[None, :]
    decay = jnp.where(rel >= 0, jnp.exp(lg[:, :, None] * jnp.maximum(rel, 0.0)), 0.0)
    scores = jnp.einsum('bhnid,bhnjd->bhnij', qc, kc) * decay[None, :, None]
    intra = jnp.einsum('bhnij,bhnje->bhnie', scores, vc)
    zeta = jnp.exp(lg * (C - 1 - idx))
    xi = jnp.exp(lg * (idx + 1))
    kv = jnp.einsum('bhnjd,hj,bhnje->nbhde', kc, zeta, vc)
    chunk_decay = jnp.exp(log_gamma * C)[None, :, None, None]

    def step(state, kv_n):
        return chunk_decay * state + kv_n, state

    _, prev = lax.scan(step, jnp.zeros((B, H, DK, DV), F32), kv)
    cross = jnp.einsum('bhnid,hi,nbhde->bhnie', qc, xi, prev)
    return (intra + cross).reshape(B, H, S, DV)


def retention_mixer(q, k, v, gate, norm_g):
    B, S, _ = q.shape
    qh = rope(q.astype(F32).reshape(B, S, RET_HEADS, RET_DK)).transpose(0, 2, 1, 3)
    kh = rope(k.astype(F32).reshape(B, S, RET_HEADS, RET_DK)).transpose(0, 2, 1, 3) * RET_DK ** -0.5
    vh = to_heads(v, RET_HEADS)
    hidx = jnp.arange(RET_HEADS, dtype=F32)
    log_g_fwd = jnp.log1p(-jnp.exp2(-5.0 - hidx))
    log_g_bwd = log_g_fwd[::-1]
    fl = lambda t: jnp.flip(t, axis=2)
    o = retention_chunk(qh, kh, vh, log_g_fwd) + fl(retention_chunk(fl(qh), fl(kh), fl(vh), log_g_bwd))
    o = o.transpose(0, 2, 1, 3)
    mu = jnp.mean(o, axis=-1, keepdims=True)
    var = jnp.mean(jnp.square(o - mu), axis=-1, keepdims=True)
    o = ((o - mu) * lax.rsqrt(var + EPS)).reshape(B, S, RET_WIDTH) * norm_g.astype(F32)
    return o * jax.nn.silu(gate.astype(F32))


def t5_bucket(rel):
    nb = REL_BUCKETS // 2
    max_exact = nb // 2
    sign_off = jnp.where(rel > 0, nb, 0)
    n = jnp.abs(rel)
    nf = jnp.maximum(n, 1).astype(F32)
    large = max_exact + (jnp.log(nf / max_exact) / math.log(REL_MAX_DIST / max_exact)
                         * (nb - max_exact)).astype(jnp.int32)
    large = jnp.minimum(large, nb - 1)
    return sign_off + jnp.where(n < max_exact, n, large)


def dilated_local_attention(q, k, v, bias_table, dil, half):
    B, H, S, D = q.shape
    L = S // dil
    nb = -(-L // half)
    Lp = nb * half

    def to_res(t):
        return t.reshape(B, H, L, dil, D).transpose(0, 1, 3, 2, 4)

    qr, kr, vr = to_res(q), to_res(k), to_res(v)
    qb = jnp.pad(qr, ((0, 0), (0, 0), (0, 0), (0, Lp - L), (0, 0))).reshape(B, H, dil, nb, half, D)

    def band(t):
        tp = jnp.pad(t, ((0, 0), (0, 0), (0, 0), (half, Lp - L + half), (0, 0)))
        tp = tp.reshape(B, H, dil, nb + 2, half, D)
        return jnp.concatenate([tp[:, :, :, :-2], tp[:, :, :, 1:-1], tp[:, :, :, 2:]], axis=4)

    kb, vb = band(kr), band(vr)
    ii = jnp.arange(half)[:, None]
    jj = jnp.arange(3 * half)[None, :]
    rel = jj - half - ii
    bias = bias_table.astype(F32)[t5_bucket(rel * dil)].transpose(2, 0, 1)
    key_idx = jnp.arange(nb)[:, None, None] * half + jj[None] - half
    valid = (jnp.abs(rel) <= half)[None] & (key_idx >= 0) & (key_idx < L)
    s = jnp.einsum('bhrnqd,bhrnkd->bhrnqk', qb, kb) + bias[None, :, None, None]
    s = jnp.where(valid, s, -jnp.inf)
    m = jnp.max(s, axis=-1, keepdims=True)
    p = jnp.exp(s - m)
    den = jnp.sum(p, axis=-1)
    o = jnp.einsum('bhrnqk,bhrnkd->bhrnqd', p, vb) / den[..., None]
    lse = m[..., 0] + jnp.log(den)
    o = o.reshape(B, H, dil, Lp, D)[:, :, :, :L].transpose(0, 1, 3, 2, 4).reshape(B, H, S, D)
    lse = lse.reshape(B, H, dil, Lp)[..., :L].transpose(0, 1, 3, 2).reshape(B, H, S)
    return o, lse


def dilated_mixer(parts, rel_bias, q_gain, k_gain):
    B, S, _ = parts[0].shape
    outs, lses = [], []
    for g, (window, dil) in enumerate(DIL_GROUPS):
        half = window // (2 * dil)
        q = head_rms(parts[3 * g].astype(F32).reshape(B, S, DIL_SLOTS, DIL_HD), q_gain) * DIL_HD ** -0.5
        k = head_rms(parts[3 * g + 1].astype(F32).reshape(B, S, DIL_SLOTS, DIL_HD), k_gain)
        v = parts[3 * g + 2].astype(F32).reshape(B, S, DIL_SLOTS, DIL_HD)
        tbl = rel_bias[:, g * DIL_SLOTS:(g + 1) * DIL_SLOTS]
        o, lse = dilated_local_attention(q.transpose(0, 2, 1, 3), k.transpose(0, 2, 1, 3),
                                         v.transpose(0, 2, 1, 3), tbl, dil, half)
        outs.append(o)
        lses.append(lse)
    w = jax.nn.softmax(jnp.stack(lses, axis=0), axis=0)
    o = jnp.sum(w[..., None] * jnp.stack(outs, axis=0), axis=0)
    return o.transpose(0, 2, 1, 3).reshape(B, S, DIL_WIDTH)


def setup_inputs(seed: int = 0) -> dict:
    key = jax.random.key(seed)
    ks = jax.random.split(key, 14)

    def nrm(k, shape, scale):
        return jax.random.normal(k, shape, F32) * scale

    return {
        'x': nrm(ks[0], (BATCH, SEQ, D_MODEL), 1.0),
        'w_in': nrm(ks[1], (DEPTH, D_MODEL, IN_WIDTH), D_MODEL ** -0.5),
        'w_out': nrm(ks[2], (DEPTH, MIX_WIDTH, D_MODEL), MIX_WIDTH ** -0.5),
        'w_up': nrm(ks[3], (DEPTH, D_MODEL, D_FF), D_MODEL ** -0.5),
        'w_down': nrm(ks[4], (DEPTH, D_FF, D_MODEL), D_FF ** -0.5),
        'norm_mix': 1.0 + nrm(ks[5], (DEPTH, D_MODEL), 0.02),
        'norm_mlp': 1.0 + nrm(ks[6], (DEPTH, D_MODEL), 0.02),
        'hg_lb_fwd': nrm(ks[7], (DEPTH, HG_HEADS * HG_DK), 0.5),
        'hg_lb_bwd': nrm(ks[8], (DEPTH, HG_HEADS * HG_DK), 0.5),
        'hg_norm': 1.0 + nrm(ks[9], (DEPTH, HG_WIDTH), 0.02),
        'ret_norm': 1.0 + nrm(ks[10], (DEPTH, RET_WIDTH), 0.02),
        'q_norm': 1.0 + nrm(ks[11], (DEPTH, DIL_HD), 0.02),
        'k_norm': 1.0 + nrm(ks[12], (DEPTH, DIL_HD), 0.02),
        'rel_bias': nrm(ks[13], (REL_BUCKETS, DIL_HEADS), 0.1),
    }


def reference(x, w_in, w_out, w_up, w_down, norm_mix, norm_mlp, hg_lb_fwd, hg_lb_bwd,
              hg_norm, ret_norm, q_norm, k_norm, rel_bias):
    lb_fwd_all = jnp.cumsum(jax.nn.softmax(hg_lb_fwd.astype(F32), axis=0), axis=0)
    lb_bwd_all = jnp.cumsum(jax.nn.softmax(hg_lb_bwd.astype(F32), axis=0), axis=0)
    offsets = np.cumsum(IN_SPLITS)[:-1].tolist()
    for l in range(DEPTH):
        h = rms_norm(x, norm_mix[l]) @ w_in[l]
        p = jnp.split(h, offsets, axis=-1)
        y_a = hgrn2_mixer(p[0], p[1], p[2], p[3], p[4],
                          lb_fwd_all[l] - lb_fwd_all[0], lb_bwd_all[l] - lb_bwd_all[0], hg_norm[l])
        y_b = retention_mixer(p[5], p[6], p[7], p[8], ret_norm[l])
        y_c = dilated_mixer(p[9:], rel_bias, q_norm[l], k_norm[l])
        y = jnp.concatenate([y_a, y_b, y_c], axis=-1).astype(x.dtype)
        x = x + y @ w_out[l]
        hm = rms_norm(x, norm_mlp[l])
        x = x + jnp.square(jax.nn.relu(hm @ w_up[l])) @ w_down[l]
    return x
```

```cpp
#include <hip/hip_runtime.h>
#include <cstdio>
#include <cstdint>
namespace pg8 {
#define PG8_LAS __attribute__((address_space(3)))
typedef unsigned short bf16_t;
typedef short bf16x8 __attribute__((ext_vector_type(8)));
typedef float f32x4 __attribute__((ext_vector_type(4)));
typedef unsigned u32x4 __attribute__((ext_vector_type(4)));
constexpr int BM = 256, BK = 64, HALF = 128, HTB = HALF * BK * 2  , STAGE_BYTES = 8 * HTB, NXCD = 8, WGM = 8;

__host__ __device__ __forceinline__ int lds_byte(int r, int c) { const int st = (r >> 4) * 2 + (c >> 5), rr = r & 15, cc = c & 31, ob = rr * 64 + cc * 2; return st * 1024 + (ob ^ (((ob >> 9) & 1) << 5)); }
__host__ __device__ __forceinline__ void stage_rc(int b, int& R, int& C) { const int st = b / 1024, sb = b % 1024, swz = sb ^ (((sb >> 9) & 1) << 5); R = (st >> 1) * 16 + swz / 64; C = (st & 1) * 32 + (swz % 64) / 2; }
__host__ __device__ __forceinline__ int perm32(int rho) { const int n = rho >> 4, i = rho & 15; return 8 * (i >> 2) + 4 * n + (i & 3); }

struct Unit { int pm, pn; };
struct Gemm { const bf16_t* A; const bf16_t* Bt; int M, N, K; };

struct StaticOrder {
    int nM, nN, nwg, G, c;
    __host__ __device__ void init(int M, int N, int G_, int c_) { nM = M / BM; nN = N / BM; nwg = nM * nN; G = G_; c = c_; }
    __host__ __device__ bool next(int i, Unit& u) const {
        const long L = (long)i * G + c; if (L >= nwg) return false;
        int wgid = (int)L; { const int q = nwg / NXCD, r = nwg % NXCD, xcd = wgid % NXCD, off = wgid / NXCD; wgid = (xcd < r ? xcd * (q + 1) : r * (q + 1) + (xcd - r) * q) + off; }
        const int nig = WGM * nN, gid = wgid / nig, fm = gid * WGM, gsz = (nM - fm) < WGM ? (nM - fm) : WGM;
        u.pm = fm + ((wgid % nig) % gsz); u.pn = (wgid % nig) / gsz; return true;
    }
    __device__ __forceinline__ void a_ready(const Unit&) const {}
    __device__ __forceinline__ void done(const Unit&) const {}
};

typedef float f32x2 __attribute__((ext_vector_type(2))); typedef __bf16 bf16x2_t __attribute__((ext_vector_type(2)));
__device__ __forceinline__ unsigned cvt_pk_bf16(float lo, float hi) { f32x2 v = {lo, hi}; bf16x2_t b = __builtin_convertvector(v, bf16x2_t); return __builtin_bit_cast(unsigned, b); }

template <int ACT> struct EpiScaleBf16 {
    static constexpr bool PERM = true, AFTER_DRAIN = false;
    bf16_t* O; int ldc; const float* ss;
    __device__ __forceinline__ void operator()(const f32x4 (&acc)[2][2][4][2], const Unit& u, int wr, int wc, int fr, int fq) const {
        const int row0 = u.pm * BM + wr * 64 + fr; const int col0 = u.pn * BM + wc * 32 + 8 * fq;
#pragma unroll
        for (int ai = 0; ai < 2; ++ai)
#pragma unroll
            for (int m = 0; m < 4; ++m) { const int row = row0 + ai * HALF + m * 16;
                const f32x4 p0 = *(const f32x4*)(ss + (size_t)row * 32 + fq * 8), p1 = *(const f32x4*)(ss + (size_t)row * 32 + fq * 8 + 4);
                float sq = ((p0[0] + p0[1]) + (p0[2] + p0[3])) + ((p1[0] + p1[1]) + (p1[2] + p1[3])); sq += __shfl_xor(sq, 16); sq += __shfl_xor(sq, 32);
                const float sc = 1.0f / sqrtf(sq * (1.0f / 2048.0f) + 1e-6f);
                bf16_t* rowp = O + (size_t)row * ldc + col0;
#pragma unroll
                for (int bj = 0; bj < 2; ++bj) { f32x4 v0 = acc[ai][bj][m][0] * sc, v1 = acc[ai][bj][m][1] * sc;
                    if (ACT == 1) {
#pragma unroll
                        for (int e = 0; e < 4; ++e) { float a = v0[e] > 0.f ? v0[e] : 0.f; v0[e] = a * a; float b = v1[e] > 0.f ? v1[e] : 0.f; v1[e] = b * b; } }
                    u32x4 w; w.x = cvt_pk_bf16(v0[0], v0[1]); w.y = cvt_pk_bf16(v0[2], v0[3]); w.z = cvt_pk_bf16(v1[0], v1[1]); w.w = cvt_pk_bf16(v1[2], v1[3]);
                    *(u32x4*)(rowp + bj * HALF) = w; } }
    }
};
struct EpiResid {
    static constexpr bool PERM = false, AFTER_DRAIN = false;
    const float* xin; float* xout; bf16_t* xb; float* ssn;
    __device__ __forceinline__ void operator()(const f32x4 (&acc)[2][2][4][2], const Unit& u, int wr, int wc, int fr, int fq) const {
        typedef unsigned u32x2v __attribute__((ext_vector_type(2)));
        const int col0 = u.pn * BM + wc * 32 + 4 * fq;
#pragma unroll
        for (int ai = 0; ai < 2; ++ai)
#pragma unroll
            for (int m = 0; m < 4; ++m) { const int row = u.pm * BM + ai * HALF + wr * 64 + m * 16 + fr; const size_t off = (size_t)row * 2048 + col0; float sq = 0.f;
#pragma unroll
                for (int bj = 0; bj < 2; ++bj)
#pragma unroll
                    for (int n = 0; n < 2; ++n) { const size_t o2 = off + bj * HALF + n * 16; const f32x4 xo = *(const f32x4*)(xin + o2); const f32x4 xn = xo + acc[ai][bj][m][n];
                        *(f32x4*)(xout + o2) = xn; u32x2v w; w.x = cvt_pk_bf16(xn[0], xn[1]); w.y = cvt_pk_bf16(xn[2], xn[3]); *(u32x2v*)(xb + o2) = w;
                        sq += (xn[0] * xn[0] + xn[1] * xn[1]) + (xn[2] * xn[2] + xn[3] * xn[3]); }
                sq += __shfl_xor(sq, 16); sq += __shfl_xor(sq, 32);
                if (fq == 0) ssn[(size_t)row * 32 + u.pn * 4 + wc] = sq; }
    }
};
template <class Epi, class Sched, bool ALIGN_EPI = false, bool SP2 = false>
__device__ __forceinline__ void gemm_phase(PG8_LAS unsigned char* lds, const Gemm g, const Sched& S, const Epi& E) {
    int tid_ = threadIdx.x; asm volatile("" : "+v"(tid_));
    const int tid = tid_, wid = __builtin_amdgcn_readfirstlane(tid >> 6), lane = tid & 63, wr = wid >> 2, wc = wid & 3, fr = lane & 15, fq = lane >> 4;
    const int K = g.K, nt = K / BK;
    unsigned voffA[2], voffB[2];
#pragma unroll
    for (int i = 0; i < 2; ++i) { int R, C; stage_rc(tid * 16 + i * 8192, R, C); const int Rb = Epi::PERM ? ((R & ~31) + perm32(R & 31)) : R;
        voffA[i] = (unsigned)(R * K + C) * 2u; voffB[i] = (unsigned)(Rb * K + C) * 2u; }
    const size_t kstep = (size_t)(BK * 2);
    const size_t hstep = (size_t)HALF * K * 2;
    const size_t tstep = 2 * hstep;
    const unsigned ldsw = (unsigned)wid * 1024u;
    const int aoff = lds_byte(wr * 64 + fr, fq * 8), boff = lds_byte(wc * 32 + fr, fq * 8);
#define PG8_SA(b, h) (((b) * 2 + (h)) * HTB)
#define PG8_SB(b, h) ((4 + (b) * 2 + (h)) * HTB)
#define PG8_STAGE(bufoff, gbase, voff) do { _Pragma("unroll") for (int _i = 0; _i < 2; ++_i) \
        __builtin_amdgcn_global_load_lds((const unsigned*)((const char*)(gbase) + (voff)[_i]), (PG8_LAS unsigned*)(lds + (bufoff) + ldsw + _i * 8192), 16, 0, 0); } while (0)
#define PG8_LDA(dst, b, h) do { _Pragma("unroll") for (int m = 0; m < 4; ++m) _Pragma("unroll") for (int k = 0; k < 2; ++k) dst[m][k] = *(const PG8_LAS bf16x8*)(lds + PG8_SA(b, h) + aoff + m * 2048 + k * 1024); } while (0)
#define PG8_LDB(dst, b, h) do { _Pragma("unroll") for (int n = 0; n < 2; ++n) _Pragma("unroll") for (int k = 0; k < 2; ++k) dst[n][k] = *(const PG8_LAS bf16x8*)(lds + PG8_SB(b, h) + boff + n * 2048 + k * 1024); } while (0)
#define PG8_MMA(ai, bj, At, Bt) do { __builtin_amdgcn_s_setprio(1); _Pragma("unroll") for (int m = 0; m < 4; ++m) _Pragma("unroll") for (int n = 0; n < 2; ++n) _Pragma("unroll") for (int k = 0; k < 2; ++k) \
        acc[ai][bj][m][n] = __builtin_amdgcn_mfma_f32_16x16x32_bf16(Bt[n][k], At[m][k], acc[ai][bj][m][n], 0, 0, 0); __builtin_amdgcn_s_setprio(0); } while (0)
#define PG8_WAIT_V(n) asm volatile("s_waitcnt vmcnt(" #n ")" ::: "memory")
#define PG8_WAIT_L(n) asm volatile("s_waitcnt lgkmcnt(" #n ")" ::: "memory")
#define PG8_BAR __builtin_amdgcn_s_barrier()
#define PG8_SCHED __builtin_amdgcn_sched_barrier(0)
    Unit cur, nxt; int ui = 0;
    if (!S.next(0, cur)) return;
    f32x4 acc[2][2][4][2];
#pragma unroll
    for (int a = 0; a < 2; ++a)
#pragma unroll
        for (int b = 0; b < 2; ++b)
#pragma unroll
            for (int m = 0; m < 4; ++m)
#pragma unroll
                for (int n = 0; n < 2; ++n) acc[a][b][m][n] = (f32x4){0.f, 0.f, 0.f, 0.f};
    bf16x8 At[4][2], B0[2][2], B1[2][2];
    const char* cA = (const char*)g.A + (size_t)cur.pm * tstep; const char* cB = (const char*)g.Bt + (size_t)cur.pn * tstep;
    S.a_ready(cur);
    if constexpr (SP2) {
        PG8_STAGE(PG8_SB(0, 0), cB, voffB); PG8_STAGE(PG8_SB(0, 1), cB + hstep, voffB); PG8_STAGE(PG8_SA(0, 0), cA, voffA); PG8_STAGE(PG8_SA(0, 1), cA + hstep, voffA);
        if (wr == 1) PG8_BAR;
        PG8_WAIT_V(2); PG8_BAR;
        PG8_STAGE(PG8_SB(1, 0), cB + kstep, voffB); PG8_STAGE(PG8_SA(1, 0), cA + kstep, voffA); PG8_STAGE(PG8_SB(1, 1), cB + hstep + kstep, voffB);
        PG8_WAIT_V(6); PG8_BAR;
    } else {
        PG8_STAGE(PG8_SB(0, 0), cB, voffB); PG8_STAGE(PG8_SA(0, 0), cA, voffA); PG8_STAGE(PG8_SB(0, 1), cB + hstep, voffB); PG8_STAGE(PG8_SA(0, 1), cA + hstep, voffA);
        if (wr == 1) PG8_BAR;
        PG8_WAIT_V(4); PG8_BAR;
        PG8_STAGE(PG8_SB(1, 0), cB + kstep, voffB); PG8_STAGE(PG8_SA(1, 0), cA + kstep, voffA); PG8_STAGE(PG8_SB(1, 1), cB + hstep + kstep, voffB);
        PG8_WAIT_V(6); PG8_BAR;
    }
    for (;;) {
        const bool has_next = S.next(ui + 1, nxt);
        const char* nA = has_next ? (const char*)g.A + (size_t)nxt.pm * tstep : cA; const char* nB = has_next ? (const char*)g.Bt + (size_t)nxt.pn * tstep : cB;
        for (int t = 0; t < nt; t += 2) {
            const bool last = (t == nt - 2);
            const char* a1 = cA + (size_t)(t + 1) * kstep;
            const char* a2 = last ? nA : cA + (size_t)(t + 2) * kstep; const char* b2 = last ? nB : cB + (size_t)(t + 2) * kstep;
            const char* a3 = a2 + kstep; const char* b3 = b2 + kstep;
            if (last && has_next) S.a_ready(nxt);
            if constexpr (SP2) {
            PG8_LDB(B0, 0, 0); PG8_LDB(B1, 0, 1); PG8_SCHED; PG8_LDA(At, 0, 0); PG8_STAGE(PG8_SA(1, 1), a1 + hstep, voffA);
            PG8_WAIT_V(8); PG8_WAIT_L(0); PG8_BAR; PG8_MMA(0, 0, At, B0); PG8_MMA(0, 1, At, B1); PG8_BAR; PG8_SCHED;
            PG8_LDA(At, 0, 1); PG8_STAGE(PG8_SB(0, 0), b2, voffB); PG8_STAGE(PG8_SB(0, 1), b2 + hstep, voffB); PG8_STAGE(PG8_SA(0, 0), a2, voffA);
            PG8_WAIT_V(8); PG8_WAIT_L(0); PG8_BAR; PG8_MMA(1, 0, At, B0); PG8_MMA(1, 1, At, B1); PG8_BAR; PG8_SCHED;
            PG8_LDB(B0, 1, 0); PG8_LDB(B1, 1, 1); PG8_SCHED; PG8_LDA(At, 1, 0); PG8_STAGE(PG8_SA(0, 1), a2 + hstep, voffA);
            PG8_WAIT_V(8); PG8_WAIT_L(0); PG8_BAR; PG8_MMA(0, 0, At, B0); PG8_MMA(0, 1, At, B1); PG8_BAR; PG8_SCHED;
            PG8_LDA(At, 1, 1); PG8_STAGE(PG8_SB(1, 0), b3, voffB); PG8_STAGE(PG8_SB(1, 1), b3 + hstep, voffB); PG8_STAGE(PG8_SA(1, 0), a3, voffA);
            PG8_WAIT_V(8); PG8_WAIT_L(0); PG8_BAR; PG8_MMA(1, 0, At, B0); PG8_MMA(1, 1, At, B1); PG8_BAR; PG8_SCHED;
            } else {
            PG8_LDB(B0, 0, 0); PG8_SCHED; PG8_LDA(At, 0, 0); PG8_STAGE(PG8_SA(1, 1), a1 + hstep, voffA);
            PG8_WAIT_L(8); PG8_BAR; PG8_WAIT_L(0); PG8_MMA(0, 0, At, B0); PG8_BAR; PG8_SCHED;
            PG8_LDB(B1, 0, 1); PG8_STAGE(PG8_SB(0, 0), b2, voffB);
            PG8_BAR; PG8_WAIT_L(0); PG8_MMA(0, 1, At, B1); PG8_BAR;
            PG8_LDA(At, 0, 1); PG8_STAGE(PG8_SA(0, 0), a2, voffA);
            PG8_BAR; PG8_WAIT_L(0); PG8_MMA(1, 0, At, B0); PG8_BAR; PG8_SCHED;
            PG8_STAGE(PG8_SB(0, 1), b2 + hstep, voffB);
            PG8_WAIT_V(6); PG8_BAR; PG8_MMA(1, 1, At, B1); PG8_BAR;
            PG8_LDB(B0, 1, 0); PG8_SCHED; PG8_LDA(At, 1, 0); PG8_STAGE(PG8_SA(0, 1), a2 + hstep, voffA);
            PG8_WAIT_L(8); PG8_BAR; PG8_WAIT_L(0); PG8_MMA(0, 0, At, B0); PG8_BAR; PG8_SCHED;
            PG8_LDB(B1, 1, 1); PG8_STAGE(PG8_SB(1, 0), b3, voffB);
            PG8_BAR; PG8_WAIT_L(0); PG8_MMA(0, 1, At, B1); PG8_BAR;
            PG8_LDA(At, 1, 1); PG8_STAGE(PG8_SA(1, 0), a3, voffA);
            PG8_BAR; PG8_WAIT_L(0); PG8_MMA(1, 0, At, B0); PG8_BAR; PG8_SCHED;
            PG8_STAGE(PG8_SB(1, 1), b3 + hstep, voffB);
            PG8_WAIT_V(6); PG8_BAR; PG8_MMA(1, 1, At, B1); PG8_BAR;
            }
        }
        if constexpr (ALIGN_EPI) { if (wr == 0) PG8_BAR; }
        if constexpr (!Epi::AFTER_DRAIN) { E(acc, cur, wr, wc, fr, fq); S.done(cur); }
        if (!has_next) break;
#pragma unroll
        for (int a = 0; a < 2; ++a)
#pragma unroll
            for (int b = 0; b < 2; ++b)
#pragma unroll
                for (int m = 0; m < 4; ++m)
#pragma unroll
                    for (int n = 0; n < 2; ++n) acc[a][b][m][n] = (f32x4){0.f, 0.f, 0.f, 0.f};
        cur = nxt; cA = nA; cB = nB; ++ui;
        if constexpr (ALIGN_EPI) { if (wr == 1) PG8_BAR; }
    }
    PG8_WAIT_V(0);
    if constexpr (!ALIGN_EPI) { if (wr == 0) PG8_BAR; }
    PG8_BAR;
    if constexpr (Epi::AFTER_DRAIN) { E.fused(acc, cur, wr, wc, fr, fq, lds, wid, lane); S.done(cur); }
#undef PG8_SA
#undef PG8_SB
#undef PG8_STAGE
#undef PG8_LDA
#undef PG8_LDB
#undef PG8_MMA
#undef PG8_WAIT_V
#undef PG8_WAIT_L
#undef PG8_BAR
#undef PG8_SCHED
}
}
constexpr int NWAVES = 8, NTHR = 512;
constexpr int BATCH = 2, SEQ = 8192, M = BATCH * SEQ, D = 2048, DEPTH = 4, INW = 10752, FF = 8192;
constexpr int C_HGQ = 0, C_HGV = 768, C_ZF = 1536, C_ZB = 2304, C_HGG = 3072, C_RQ = 3840, C_RK = 4224, C_RV = 4608, C_RG = 5376, C_DIL = 6144;
constexpr int CH = 64, NCH = SEQ / CH;
constexpr float EPS = 1e-6f;
constexpr int NPHASE = 1 + 7 * DEPTH;

constexpr size_t MiB = 1u << 20;
constexpr size_t WS_CTL = 0, CTL_ZERO_BYTES = 1 * MiB;
constexpr size_t WS_PART = 10 * MiB;
constexpr size_t WS_ROPE = 2 * MiB;
constexpr size_t WS_TAB = 4 * MiB;
constexpr size_t WS_LSE = 5 * MiB;
constexpr size_t WS_DHG = 6 * MiB;
constexpr size_t WS_DRT = 8 * MiB;
constexpr size_t WS_WIN = 16 * MiB, WS_WOUT = 184 * MiB, WS_WUP = 216 * MiB, WS_WDN = 344 * MiB;
constexpr size_t WS_XB = 472 * MiB;
constexpr size_t WS_Y = 536 * MiB;
constexpr size_t WS_H = 600 * MiB;
constexpr size_t WS_SHG = 936 * MiB;
constexpr size_t WS_SRT = 1032 * MiB;
constexpr size_t WS_END = 1080 * MiB;
constexpr int CW_BAR = 4096;

constexpr int PH_BYTES = 155648;
constexpr int LDSCTL_OFF = PH_BYTES, MISC_OFF = LDSCTL_OFF + 320;
constexpr int LDS_BYTES = PH_BYTES + 1024;

#define GAS __attribute__((address_space(1)))
#define LAS __attribute__((address_space(3)))
typedef unsigned short bf16;
typedef unsigned v4u __attribute__((ext_vector_type(4)));
typedef unsigned v2u __attribute__((ext_vector_type(2)));
typedef float f32x4 __attribute__((ext_vector_type(4)));
typedef short bf16x8 __attribute__((ext_vector_type(8)));
typedef LAS unsigned char* lptr;
#define LDS_WAIT() asm volatile("s_waitcnt lgkmcnt(0)" ::: "memory")
#define VM_WAIT() asm volatile("s_waitcnt vmcnt(0)" ::: "memory")
__device__ __forceinline__ float bf2f(unsigned h) { return __uint_as_float(h << 16); }
__device__ __forceinline__ unsigned pk2(float lo, float hi) { return pg8::cvt_pk_bf16(lo, hi); }
__device__ __forceinline__ unsigned short f2bf(float f) { return (unsigned short)(pk2(f, 0.f) & 0xffffu); }
__device__ __forceinline__ bf16x8 ldsfrag(lptr base, int row, int stride_b, int kel) { return *(const LAS bf16x8*)(base + row * stride_b + kel * 2); }
#define MFMA16(a, b, c) __builtin_amdgcn_mfma_f32_16x16x32_bf16((a), (b), (c), 0, 0, 0)
__device__ __forceinline__ float wave_sum(float v) {
#pragma unroll
    for (int o = 1; o < 64; o <<= 1) v += __shfl_xor(v, o);
    return v;
}
typedef GAS unsigned gu32;
#define XB_TMO      128
#define XB_XCNT(j)  (256  + 64 * (j))
#define XB_XSUB(j)  (1280 + 64 * (j))
#define XB_XGEN(j)  (2304 + 64 * (j))
#define XB_TOP      3328
#define XB_TOPGEN   3392
#define XCD_BAR_WORDS 3456
#define XB_SPIN_CAP (1u << 18)

__device__ __forceinline__ unsigned xb_ld(unsigned* p)              { return __hip_atomic_load(p, __ATOMIC_RELAXED, __HIP_MEMORY_SCOPE_AGENT); }
__device__ __forceinline__ unsigned xb_add(unsigned* p, unsigned v) { return __hip_atomic_fetch_add(p, v, __ATOMIC_RELAXED, __HIP_MEMORY_SCOPE_AGENT); }
__device__ __forceinline__ unsigned xb_xcc_id() { return (unsigned)__builtin_amdgcn_s_getreg((3 << 11) | 20) & 0xFu; }
#define XB_SPIN(cond, bar) do { unsigned _sp = 0; while (cond) { __builtin_amdgcn_s_sleep(1); \
    if ((++_sp & 255u) == 0u) { if (xb_ld(&(bar)[XB_TMO])) break; if (_sp > XB_SPIN_CAP) { atomicAdd(&(bar)[XB_TMO], 1u); break; } } } } while (0)

struct XcdBarrier {
    unsigned* bar; unsigned x;
    volatile LAS unsigned* st;
};

__device__ __forceinline__ XcdBarrier xcd_barrier_post(unsigned* bar, volatile LAS unsigned* st) {
    XcdBarrier b; b.bar = bar; b.x = xb_xcc_id(); b.st = st;
    if (threadIdx.x == 0) (void)xb_add(&bar[XB_XCNT(b.x)], 1u);
    return b;
}
__device__ __forceinline__ void xcd_barrier_complete(unsigned* bar, unsigned x, unsigned& nloc, unsigned& nx) {
    const unsigned G = gridDim.x * gridDim.y * gridDim.z;
    unsigned sum, cnt, mine, sp = 0u;
    for (;;) {
        sum = 0u; cnt = 0u; mine = 0u;
#pragma unroll
        for (unsigned j = 0; j < 16; ++j) { const unsigned c = xb_ld(&bar[XB_XCNT(j)]); sum += c; cnt += (c > 0u) ? 1u : 0u; mine = (j == x) ? c : mine; }
        if (sum == G) break;
        __builtin_amdgcn_s_sleep(1);
        if ((++sp & 255u) == 0u) { if (xb_ld(&bar[XB_TMO])) break; if (sp > XB_SPIN_CAP) { atomicAdd(&bar[XB_TMO], 1u); break; } }
    }
    nloc = mine > 0u ? mine : 1u; nx = cnt > 0u ? cnt : 1u;
}

__device__ __forceinline__ void xcd_barrier(const XcdBarrier& b) {
    asm volatile("s_waitcnt vmcnt(0)" ::: "memory");
    __syncthreads();
    if (threadIdx.x == 0) {
        unsigned* bar = b.bar;
        __builtin_amdgcn_s_waitcnt(0);
        unsigned nloc = b.st[0], nx = b.st[1];
        if (nloc == 0u) { xcd_barrier_complete(bar, b.x, nloc, nx); b.st[0] = nloc; b.st[1] = nx; }
        const unsigned old = xb_add(&bar[XB_XSUB(b.x)], 1u);
        const unsigned gen = old / nloc;
        if (old + 1u == (gen + 1u) * nloc) {
            __builtin_amdgcn_fence(__ATOMIC_RELEASE, "agent");
            asm volatile("s_waitcnt vmcnt(0)" ::: "memory");
            const unsigned og = xb_add(&bar[XB_TOP], 1u);
            const unsigned tg = og / nx;
            if (og + 1u == (tg + 1u) * nx) xb_add(&bar[XB_TOPGEN], 1u);
            else XB_SPIN(xb_ld(&bar[XB_TOPGEN]) == tg, bar);
            __builtin_amdgcn_fence(__ATOMIC_ACQUIRE, "agent");
            xb_add(&bar[XB_XGEN(b.x)], 1u);
            asm volatile("s_waitcnt vmcnt(0)" ::: "memory");
        } else {
            XB_SPIN(xb_ld(&bar[XB_XGEN(b.x)]) == gen, bar);
            __builtin_amdgcn_fence(__ATOMIC_ACQUIRE, "agent");
            asm volatile("s_waitcnt vmcnt(0)" ::: "memory");
        }
    }
    __syncthreads();
}
__device__ __forceinline__ void transpose_item(const float* W, const float* g, int K, int N, bf16* WT, LAS float* scr, int item, int lane) {
    const int nblk = N / 32, kb = item / nblk, nb = item % nblk, k0 = 64 * kb, n0 = 32 * nb;
#pragma unroll 8
    for (int i = 0; i < 32; ++i) { const int kk = 2 * i + (lane >> 5); float w = W[(size_t)(k0 + kk) * N + n0 + (lane & 31)]; if (g) w *= g[k0 + kk]; scr[kk * 33 + (lane & 31)] = w; }
    LDS_WAIT(); asm volatile("" ::: "memory");
    const int c = lane & 7;
#pragma unroll
    for (int j = 0; j < 4; ++j) { const int n = (lane >> 3) + 8 * j; const LAS float* s = scr + (8 * c) * 33 + n;
        v4u o; o.x = pk2(s[0 * 33], s[1 * 33]); o.y = pk2(s[2 * 33], s[3 * 33]); o.z = pk2(s[4 * 33], s[5 * 33]); o.w = pk2(s[6 * 33], s[7 * 33]);
        *(v4u*)(WT + (size_t)(n0 + n) * K + k0 + 8 * c) = o; }
    LDS_WAIT(); asm volatile("" ::: "memory");
}
__device__ __forceinline__ void sincos_d(double a, float& s, float& c) {
    const double kq = __builtin_rint(a * 0.6366197723675814); const double r = a - kq * 1.5707963267948966; const int q = ((int)kq) & 3; const double r2 = r * r;
    double sp = 1.0 / 6227020800.0; sp = sp * r2 - 1.0 / 39916800.0; sp = sp * r2 + 1.0 / 362880.0; sp = sp * r2 - 1.0 / 5040.0; sp = sp * r2 + 1.0 / 120.0; sp = sp * r2 - 1.0 / 6.0; sp = sp * r2 + 1.0; sp *= r;
    double cp = -1.0 / 87178291200.0; cp = cp * r2 + 1.0 / 479001600.0; cp = cp * r2 - 1.0 / 3628800.0; cp = cp * r2 + 1.0 / 40320.0; cp = cp * r2 - 1.0 / 720.0; cp = cp * r2 + 1.0 / 24.0; cp = cp * r2 - 0.5; cp = cp * r2 + 1.0;
    const double ss = (q == 0) ? sp : (q == 1) ? cp : (q == 2) ? -sp : -cp; const double cc = (q == 0) ? cp : (q == 1) ? -sp : (q == 2) ? -cp : sp;
    s = (float)ss; c = (float)cc;
}
__device__ __forceinline__ int t5_bucket(int rel) {
    const int n = rel < 0 ? -rel : rel; int b;
    if (n < 8) b = n; else { b = 8 + (n >= 15) + (n >= 27) + (n >= 50) + (n >= 91) + (n >= 166) + (n >= 305) + (n >= 559); }
    return b + (rel > 0 ? 16 : 0);
}

struct Args { const float* in[14]; float* out; unsigned char* ws; int ph_lo, ph_hi; };
typedef const __attribute__((address_space(4))) Args* kargp;
struct Ctx {
    lptr lds; int tid, lane, wave, G, bid; kargp ka; unsigned char* ws;
    __device__ __forceinline__ const float* in(int i) const { return ka->in[i]; }
    __device__ __forceinline__ float* out() const { return ka->out; }
};
__device__ __forceinline__ Ctx mkctx(lptr lds) {
    Ctx X; int tid = threadIdx.x; asm volatile("" : "+v"(tid));
    kargp ka = (kargp)__builtin_amdgcn_kernarg_segment_ptr(); asm volatile("" : "+s"(ka));
    X.lds = lds; X.tid = tid; X.lane = tid & 63; X.wave = __builtin_amdgcn_readfirstlane(tid >> 6); X.G = gridDim.x; X.bid = blockIdx.x; X.ka = ka; X.ws = ka->ws; return X;
}

__device__ __forceinline__ void prologue(const Ctx& X) {
    const int gw = X.bid * NWAVES + X.wave, NGW = X.G * NWAVES;
    LAS float* scr = (LAS float*)(X.lds + X.wave * 16384);
    constexpr int I_IN = (D / 64) * (INW / 32), I_OUT = (D / 64) * (D / 32), I_UP = (D / 64) * (FF / 32), I_DN = (FF / 64) * (D / 32), I_L = I_IN + I_OUT + I_UP + I_DN;
    for (int it = gw; it < DEPTH * I_L; it += NGW) {
        const int l = it / I_L; int r = it % I_L;
        if (r < I_IN) { transpose_item(X.in(1) + (size_t)l * D * INW, X.in(5) + l * D, D, INW, (bf16*)(X.ws + WS_WIN) + (size_t)l * INW * D, scr, r, X.lane); continue; } r -= I_IN;
        if (r < I_OUT) { transpose_item(X.in(2) + (size_t)l * D * D, nullptr, D, D, (bf16*)(X.ws + WS_WOUT) + (size_t)l * D * D, scr, r, X.lane); continue; } r -= I_OUT;
        if (r < I_UP) { transpose_item(X.in(3) + (size_t)l * D * FF, X.in(6) + l * D, D, FF, (bf16*)(X.ws + WS_WUP) + (size_t)l * FF * D, scr, r, X.lane); continue; } r -= I_UP;
        transpose_item(X.in(4) + (size_t)l * FF * D, nullptr, FF, D, (bf16*)(X.ws + WS_WDN) + (size_t)l * D * FF, scr, r, X.lane);
    }
    float* ss0 = (float*)(X.ws + WS_PART); bf16* xb = (bf16*)(X.ws + WS_XB);
    for (int m = gw; m < M; m += NGW) {
        const f32x4* xr = (const f32x4*)(X.in(0) + (size_t)m * D) + X.lane; f32x4 v[8]; float s = 0.f;
#pragma unroll
        for (int j = 0; j < 8; ++j) { v[j] = xr[64 * j]; s += (v[j].x * v[j].x + v[j].y * v[j].y) + (v[j].z * v[j].z + v[j].w * v[j].w); }
        s = wave_sum(s); if (X.lane < 32) ss0[(size_t)m * 32 + X.lane] = X.lane == 0 ? s : 0.f;
        v2u* o8 = (v2u*)(xb + (size_t)m * D) + X.lane;
#pragma unroll
        for (int j = 0; j < 8; ++j) { v2u w; w.x = pk2(v[j].x, v[j].y); w.y = pk2(v[j].z, v[j].w); o8[64 * j] = w; }
    }
    const int gt = X.bid * NTHR + X.tid, NGT = X.G * NTHR;
    float* rc = (float*)(X.ws + WS_ROPE); float* rs = rc + SEQ * 32;
    for (int i = gt; i < SEQ * 32; i += NGT) { const int pos = i >> 5, f = i & 31; double inv = 1.0; for (int e = 0; e < f; ++e) inv *= 0.7498942093324558; const float ang = (float)pos * (float)inv; float s, c; sincos_d((double)ang, s, c); rc[i] = c; rs[i] = s; }
    float* LB = (float*)(X.ws + WS_TAB); float* BT = LB + 2 * 4 * 768;
    for (int i = gt; i < 2 * 768; i += NGT) { const int dir = i / 768, c = i % 768; const float* src = dir ? X.in(8) : X.in(7);
        const float a0 = src[c], a1 = src[768 + c], a2 = src[2 * 768 + c], a3 = src[3 * 768 + c]; const float mx = fmaxf(fmaxf(a0, a1), fmaxf(a2, a3));
        const float e0 = __expf(a0 - mx), e1 = __expf(a1 - mx), e2 = __expf(a2 - mx), e3 = __expf(a3 - mx); const float inv = 1.0f / (e0 + e1 + e2 + e3);
        float* o = LB + dir * 4 * 768 + c; o[0] = 0.f; o[768] = e1 * inv; o[2 * 768] = (e1 + e2) * inv; o[3 * 768] = (e1 + e2 + e3) * inv; }
    for (int i = gt; i < 3 * 4 * 132; i += NGT) { const int g = i / (4 * 132), sl = (i / 132) % 4, rr = i % 132; const int dil = g == 0 ? 1 : (g == 1 ? 4 : 16);
        BT[i] = rr < 129 ? X.in(13)[t5_bucket((rr - 64) * dil) * 12 + g * 4 + sl] : 0.f; }
}

template <int DK, bool RET, int DIR>
__device__ __forceinline__ void gla_prep(const bf16* Hc  , int head, int n, const float* lbt, float lg, const float* rc, const float* rs, LAS float* seg, int k, int rq, bool active,
                                         float (&c)[16], float (&qv)[16], float (&kv)[16], float& tot) {
    if (active) {
        float run = 0.f;
        if (!RET) {
            const int zcol = (DIR ? C_ZB : C_ZF) + head * 128 + k, qcol = C_HGQ + head * 128 + k; const float lb = lbt[head * 128 + k];
#pragma unroll
            for (int i = 0; i < 16; ++i) { const int ii = DIR ? 15 - i : i; const bf16* hr = Hc + (size_t)(16 * rq + ii) * INW;
                const float z = bf2f(hr[zcol]); const float f = lb + (1.0f - lb) / (1.0f + __expf(-z)); run += __logf(f); c[ii] = run; kv[ii] = 1.0f - f; qv[ii] = bf2f(hr[qcol]); }
        } else {
            const int k2 = k & 31, qcol = C_RQ + head * 64, kcol = C_RK + head * 64;
#pragma unroll
            for (int i = 0; i < 16; ++i) { const int ii = DIR ? 15 - i : i; const int r = 16 * rq + ii; const bf16* hr = Hc + (size_t)r * INW; const int pos = n * CH + r;
                const float cs = rc[pos * 32 + k2], sn = rs[pos * 32 + k2];
                const float q1 = bf2f(hr[qcol + k2]), q2 = bf2f(hr[qcol + 32 + k2]), k1 = bf2f(hr[kcol + k2]), kk2 = bf2f(hr[kcol + 32 + k2]);
                qv[ii] = (k < 32) ? (q1 * cs - q2 * sn) : (q1 * sn + q2 * cs); kv[ii] = 0.125f * ((k < 32) ? (k1 * cs - kk2 * sn) : (k1 * sn + kk2 * cs));
                run += lg; c[ii] = run; }
        }
        tot = run; seg[rq * DK + k] = run;
    }
}
#define SEGT(j) seg[((DIR) ? 3 - (j) : (j)) * DK + k]

constexpr int L1_VT = 0, L1_KC = 128 * 144;
template <int DK, bool RET, int DIR>
__device__ __forceinline__ void gla_local_dir(const Ctx& X, const bf16* Hc, int b, int head, int n, const float* lbt, float lg, const float* rc, const float* rs, bf16* St, float* dd) {
    const lptr VT = X.lds + L1_VT, KC = X.lds + L1_KC; LAS float* seg = (LAS float*)(X.lds + L1_KC + 128 * 144);
    const int k = X.tid % DK, rq = X.tid / DK; const bool active = X.tid < 4 * DK;
    const int chain = (b * 6 + head) * 2 + DIR;
    float c[16], qv[16], kv[16], tot = 0.f;
    gla_prep<DK, RET, DIR>(Hc, head, n, lbt, lg, rc, rs, seg, k, rq, active, c, qv, kv, tot);
    __syncthreads();
    if (active) {
        const int sq = DIR ? 3 - rq : rq; float post = 0.f;
#pragma unroll
        for (int j = 1; j < 4; ++j) if (j > sq) post += SEGT(j);
        v4u w0, w1; float e[16];
#pragma unroll
        for (int ii = 0; ii < 16; ++ii) e[ii] = kv[ii] * __expf(tot - c[ii] + post);
        w0.x = pk2(e[0], e[1]); w0.y = pk2(e[2], e[3]); w0.z = pk2(e[4], e[5]); w0.w = pk2(e[6], e[7]); w1.x = pk2(e[8], e[9]); w1.y = pk2(e[10], e[11]); w1.z = pk2(e[12], e[13]); w1.w = pk2(e[14], e[15]);
        *(LAS v4u*)(KC + k * 144 + rq * 32) = w0; *(LAS v4u*)(KC + k * 144 + rq * 32 + 16) = w1;
        if (rq == 0) dd[((size_t)chain * NCH + n) * DK + k] = __expf(seg[k] + seg[DK + k] + seg[2 * DK + k] + seg[3 * DK + k]);
    }
    __syncthreads();
    {
        const int fr = X.lane & 15, fq = X.lane >> 4; const int rt = RET ? (X.wave & 3) : X.wave; const int ct0 = RET ? (X.wave >> 2) * 4 : 0; constexpr int NCT = RET ? 4 : 8;
        f32x4 acc[NCT];
#pragma unroll
        for (int t = 0; t < NCT; ++t) acc[t] = (f32x4){0.f, 0.f, 0.f, 0.f};
#pragma unroll
        for (int ks = 0; ks < 2; ++ks) { const bf16x8 a = ldsfrag(KC, 16 * rt + fr, 144, 32 * ks + 8 * fq);
#pragma unroll
            for (int t = 0; t < NCT; ++t) { const bf16x8 bb = ldsfrag(VT, 16 * (ct0 + t) + fr, 144, 32 * ks + 8 * fq); acc[t] = MFMA16(a, bb, acc[t]); } }
        bf16* Sp = St + ((size_t)chain * NCH + n) * 128 * DK;
#pragma unroll
        for (int t = 0; t < NCT; ++t) { v2u w; w.x = pk2(acc[t][0], acc[t][1]); w.y = pk2(acc[t][2], acc[t][3]); *(v2u*)(Sp + (size_t)(16 * (ct0 + t) + fr) * DK + 16 * rt + 4 * fq) = w; }
    }
    __syncthreads();
}
__device__ __forceinline__ void stage_vt(const Ctx& X, const bf16* Hc, int vcol, lptr VT) {
#pragma unroll
    for (int p = 0; p < 2; ++p) { const int idx = X.tid + NTHR * p, r = idx >> 4, c8 = idx & 15; const v4u w = *(const v4u*)(Hc + (size_t)r * INW + vcol + 8 * c8);
        LAS unsigned short* d = (LAS unsigned short*)(VT + (8 * c8) * 144 + r * 2);
        d[0] = (unsigned short)w.x; d[72] = (unsigned short)(w.x >> 16); d[144] = (unsigned short)w.y; d[216] = (unsigned short)(w.y >> 16);
        d[288] = (unsigned short)w.z; d[360] = (unsigned short)(w.z >> 16); d[432] = (unsigned short)w.w; d[504] = (unsigned short)(w.w >> 16); }
}
template <int DK, bool RET>
__device__ __forceinline__ void gla_local_item(const Ctx& X, const bf16* H, int l, int b, int head, int n) {
    const bf16* Hc = H + (size_t)(b * SEQ + n * CH) * INW;
    const float* LB = (const float*)(X.ws + WS_TAB); const float* rc = (const float*)(X.ws + WS_ROPE); const float* rs = rc + SEQ * 32;
    bf16* St = (bf16*)(X.ws + (RET ? WS_SRT : WS_SHG)); float* dd = (float*)(X.ws + (RET ? WS_DRT : WS_DHG));
    stage_vt(X, Hc, (RET ? C_RV : C_HGV) + head * 128, X.lds + L1_VT);
    const float lg0 = log1pf(-exp2f(-5.0f - (float)head)), lg1 = log1pf(-exp2f(-5.0f - (float)(5 - head)));
    gla_local_dir<DK, RET, 0>(X, Hc, b, head, n, LB + (0 * 4 + l) * 768, lg0, rc, rs, St, dd);
    gla_local_dir<DK, RET, 1>(X, Hc, b, head, n, LB + (1 * 4 + l) * 768, lg1, rc, rs, St, dd);
}

template <int DK> struct L3 { static constexpr int SQ = (DK + 8) * 2, QD = 0, KD = 160 * SQ, KH = KD + 64 * SQ, VT = KH + 64 * SQ, AM = VT + 128 * 144, SEG = AM + 64 * 144, RED = SEG + 4 * DK * 4, END = RED + 1024; };
__device__ __forceinline__ int qdbase(int d) { return 64 * d - 8 * d * (d - 1); }
template <int DK, bool RET, int DIR>
__device__ __forceinline__ void gla_out_dir(const Ctx& X, const bf16* Hc, int b, int head, int n, const float* lbt, float lg, const float* rc, const float* rs, const bf16* St, f32x4 (&o)[4]) {
    typedef L3<DK> L; constexpr int SQ = L::SQ;
    const lptr QD = X.lds + L::QD, KD = X.lds + L::KD, KH = X.lds + L::KH, VT = X.lds + L::VT, AM = X.lds + L::AM; LAS float* seg = (LAS float*)(X.lds + L::SEG);
    const int k = X.tid % DK, rq = X.tid / DK; const bool active = X.tid < 4 * DK;
    const int chain = (b * 6 + head) * 2 + DIR;
    {
        float c[16], qv[16], kv[16], tot = 0.f;
        gla_prep<DK, RET, DIR>(Hc, head, n, lbt, lg, rc, rs, seg, k, rq, active, c, qv, kv, tot);
        __syncthreads();
        if (active) {
            const int sq = DIR ? 3 - rq : rq;
            const float t1 = sq >= 1 ? SEGT(sq - 1) : 0.f, t2 = sq >= 2 ? SEGT(sq - 2) : 0.f, t3 = sq >= 3 ? SEGT(sq - 3) : 0.f;
#pragma unroll
            for (int ii = 0; ii < 16; ++ii) { const int r = 16 * rq + ii; const float ci = c[ii], q = qv[ii], kk = kv[ii];
                *(LAS unsigned short*)(KD + r * SQ + k * 2) = f2bf(kk * __expf(fminf(-ci, 80.f)));
                *(LAS unsigned short*)(KH + r * SQ + k * 2) = f2bf(kk * __expf(tot - ci));
                *(LAS unsigned short*)(QD + (DIR ? r : r) * SQ + k * 2) = f2bf(q * __expf(ci));
                if (sq >= 1) *(LAS unsigned short*)(QD + (qdbase(1) + (DIR ? r : r - 16)) * SQ + k * 2) = f2bf(q * __expf(ci + t1));
                if (sq >= 2) *(LAS unsigned short*)(QD + (qdbase(2) + (DIR ? r : r - 32)) * SQ + k * 2) = f2bf(q * __expf(ci + t1 + t2));
                if (sq >= 3) *(LAS unsigned short*)(QD + (qdbase(3) + (DIR ? r : r - 48)) * SQ + k * 2) = f2bf(q * __expf(ci + t1 + t2 + t3)); }
        }
    }
    __syncthreads();
    const int fr = X.lane & 15, fq = X.lane >> 4;
#pragma unroll
    for (int bi = 0; bi < 2; ++bi) { const int blk = 2 * X.wave + bi, I = blk >> 2, J = blk & 3; const int sI = DIR ? 3 - I : I, sJ = DIR ? 3 - J : J;
        v2u w; w.x = 0u; w.y = 0u;
        if (sJ <= sI) { const int dd = sI - sJ, d = dd == 0 ? 0 : dd - 1; const int r = 16 * I + fr; const int qrow = qdbase(d) + (DIR ? r : r - 16 * d); const lptr KS = dd == 0 ? KD : KH;
            f32x4 acc = (f32x4){0.f, 0.f, 0.f, 0.f};
#pragma unroll
            for (int ks = 0; ks < DK / 32; ++ks) { const bf16x8 a = ldsfrag(KS, 16 * J + fr, SQ, 32 * ks + 8 * fq); const bf16x8 bb = ldsfrag(QD, qrow, SQ, 32 * ks + 8 * fq); acc = MFMA16(a, bb, acc); }
            if (dd == 0) {
#pragma unroll
                for (int j = 0; j < 4; ++j) { const int jl = 4 * fq + j; const bool keep = DIR ? (jl >= fr) : (jl <= fr); if (!keep) acc[j] = 0.f; } }
            w.x = pk2(acc[0], acc[1]); w.y = pk2(acc[2], acc[3]); }
        *(LAS v2u*)(AM + (16 * I + fr) * 144 + (16 * J + 4 * fq) * 2) = w; }
    __syncthreads();
    {
        const int tb = X.wave & 3, vh = X.wave >> 2, stb = DIR ? 3 - tb : tb; const int r = 16 * tb + fr;
#pragma unroll
        for (int ks = 0; ks < 2; ++ks) { const bf16x8 bb = ldsfrag(AM, r, 144, 32 * ks + 8 * fq);
#pragma unroll
            for (int vt = 0; vt < 4; ++vt) { const bf16x8 a = ldsfrag(VT, 64 * vh + 16 * vt + fr, 144, 32 * ks + 8 * fq); o[vt] = MFMA16(a, bb, o[vt]); } }
        const int qrow = qdbase(stb) + (DIR ? r : r - 16 * stb);
        const bf16* Sp = St + ((size_t)chain * NCH + n) * 128 * DK;
#pragma unroll
        for (int ks = 0; ks < DK / 32; ++ks) { const bf16x8 bb = ldsfrag(QD, qrow, SQ, 32 * ks + 8 * fq);
#pragma unroll
            for (int vt = 0; vt < 4; ++vt) { const bf16x8 a = *(const bf16x8*)(Sp + (size_t)(64 * vh + 16 * vt + fr) * DK + 32 * ks + 8 * fq); o[vt] = MFMA16(a, bb, o[vt]); } }
    }
    __syncthreads();
}
template <int DK, bool RET>
__device__ __forceinline__ void gla_out_item(const Ctx& X, const bf16* H, bf16* Y, int l, int b, int head, int n) {
    typedef L3<DK> L;
    const bf16* Hc = H + (size_t)(b * SEQ + n * CH) * INW;
    const float* LB = (const float*)(X.ws + WS_TAB); const float* rc = (const float*)(X.ws + WS_ROPE); const float* rs = rc + SEQ * 32;
    const bf16* St = (const bf16*)(X.ws + (RET ? WS_SRT : WS_SHG));
    stage_vt(X, Hc, (RET ? C_RV : C_HGV) + head * 128, X.lds + L::VT);
    const float lg0 = log1pf(-exp2f(-5.0f - (float)head)), lg1 = log1pf(-exp2f(-5.0f - (float)(5 - head)));
    f32x4 o[4];
#pragma unroll
    for (int t = 0; t < 4; ++t) o[t] = (f32x4){0.f, 0.f, 0.f, 0.f};
    gla_out_dir<DK, RET, 0>(X, Hc, b, head, n, LB + (0 * 4 + l) * 768, lg0, rc, rs, St, o);
    gla_out_dir<DK, RET, 1>(X, Hc, b, head, n, LB + (1 * 4 + l) * 768, lg1, rc, rs, St, o);
    LAS float* red = (LAS float*)(X.lds + L::RED);
    const int fr = X.lane & 15, fq = X.lane >> 4, tb = X.wave & 3, vh = X.wave >> 2;
    float mu = 0.f;
    if (RET) {
        float s = 0.f;
#pragma unroll
        for (int t = 0; t < 4; ++t) s += (o[t][0] + o[t][1]) + (o[t][2] + o[t][3]);
        s += __shfl_xor(s, 16); s += __shfl_xor(s, 32);
        if (fq == 0) red[128 + X.wave * 16 + fr] = s;
        __syncthreads();
        mu = (red[128 + X.wave * 16 + fr] + red[128 + (X.wave ^ 4) * 16 + fr]) * (1.0f / 128.0f);
    }
    float s2 = 0.f;
#pragma unroll
    for (int t = 0; t < 4; ++t)
#pragma unroll
        for (int j = 0; j < 4; ++j) { const float dlt = o[t][j] - mu; s2 += dlt * dlt; }
    s2 += __shfl_xor(s2, 16); s2 += __shfl_xor(s2, 32);
    if (fq == 0) red[X.wave * 16 + fr] = s2;
    __syncthreads();
    const float rstd = 1.0f / sqrtf((red[X.wave * 16 + fr] + red[(X.wave ^ 4) * 16 + fr]) * (1.0f / 128.0f) + EPS);
    const float* gn = X.in(RET ? 10 : 9) + l * 768 + head * 128;
    const size_t m = (size_t)(b * SEQ + n * CH + 16 * tb + fr);
    const int gcol = (RET ? C_RG : C_HGG) + head * 128, ycol = (RET ? 768 : 0) + head * 128;
#pragma unroll
    for (int t = 0; t < 4; ++t) { const int v = 64 * vh + 16 * t + 4 * fq; const f32x4 g4 = *(const f32x4*)(gn + v); const v2u gw = *(const v2u*)(H + m * INW + gcol + v);
        const float g0 = bf2f(gw.x & 0xffffu), g1 = bf2f(gw.x >> 16), g2 = bf2f(gw.y & 0xffffu), g3 = bf2f(gw.y >> 16);
        const float y0 = (o[t][0] - mu) * rstd * g4.x * (g0 / (1.0f + __expf(-g0))), y1 = (o[t][1] - mu) * rstd * g4.y * (g1 / (1.0f + __expf(-g1)));
        const float y2 = (o[t][2] - mu) * rstd * g4.z * (g2 / (1.0f + __expf(-g2))), y3 = (o[t][3] - mu) * rstd * g4.w * (g3 / (1.0f + __expf(-g3)));
        v2u w; w.x = pk2(y0, y1); w.y = pk2(y2, y3); *(v2u*)(Y + m * D + ycol + v) = w; }
    __syncthreads();
}

__device__ __forceinline__ void scan_phase(const Ctx& X) {
    constexpr int T_HG = 24 * 2048, T_RT = 24 * 1024;
    for (int task = X.bid * NTHR + X.tid; task < T_HG + T_RT; task += X.G * NTHR) {
        bf16* p; const float* dp; int cstride, dstride, dir;
        if (task < T_HG) { const int chain = task / 2048, e = task % 2048; p = (bf16*)(X.ws + WS_SHG) + (size_t)chain * NCH * 16384 + e * 8; dp = (const float*)(X.ws + WS_DHG) + (size_t)chain * NCH * 128 + (e & 15) * 8; cstride = 16384; dstride = 128; dir = chain & 1; }
        else { const int t2 = task - T_HG, chain = t2 / 1024, e = t2 % 1024; p = (bf16*)(X.ws + WS_SRT) + (size_t)chain * NCH * 8192 + e * 8; dp = (const float*)(X.ws + WS_DRT) + (size_t)chain * NCH * 64 + (e & 7) * 8; cstride = 8192; dstride = 64; dir = chain & 1; }
        float S[8];
#pragma unroll
        for (int i = 0; i < 8; ++i) S[i] = 0.f;
        for (int s0 = 0; s0 < NCH; s0 += 8) {
            v4u u[8]; f32x4 d0[8], d1[8];
#pragma unroll
            for (int j = 0; j < 8; ++j) { const int n = dir ? NCH - 1 - (s0 + j) : s0 + j; u[j] = *(const v4u*)(p + (size_t)n * cstride); d0[j] = *(const f32x4*)(dp + (size_t)n * dstride); d1[j] = *(const f32x4*)(dp + (size_t)n * dstride + 4); }
#pragma unroll
            for (int j = 0; j < 8; ++j) { const int n = dir ? NCH - 1 - (s0 + j) : s0 + j;
                v4u w; w.x = pk2(S[0], S[1]); w.y = pk2(S[2], S[3]); w.z = pk2(S[4], S[5]); w.w = pk2(S[6], S[7]); *(v4u*)(p + (size_t)n * cstride) = w;
                S[0] = d0[j].x * S[0] + bf2f(u[j].x & 0xffffu); S[1] = d0[j].y * S[1] + bf2f(u[j].x >> 16); S[2] = d0[j].z * S[2] + bf2f(u[j].y & 0xffffu); S[3] = d0[j].w * S[3] + bf2f(u[j].y >> 16);
                S[4] = d1[j].x * S[4] + bf2f(u[j].z & 0xffffu); S[5] = d1[j].y * S[5] + bf2f(u[j].z >> 16); S[6] = d1[j].z * S[6] + bf2f(u[j].w & 0xffffu); S[7] = d1[j].w * S[7] + bf2f(u[j].w >> 16); }
        }
    }
}
constexpr int DA_KN = 0, DA_VT = 192 * 272, DA_P = DA_VT + 128 * 400, DA_BIAS = DA_P + 64 * 400, DA_MX = DA_BIAS + 544, DA_LX = DA_MX + 512, DA_END = DA_LX + 512;
static_assert(DA_END <= PH_BYTES, "dilated-attention LDS map");
__device__ __forceinline__ void dil_item(const Ctx& X, bf16* H, int l, int idx) {
    const int b = idx / 1536, rem = idx % 1536, g = rem / 512, rem2 = rem % 512, slot = rem2 / 128, rb = rem2 % 128;
    const int dil = g == 0 ? 1 : (g == 1 ? 4 : 16), nbper = 128 / dil, rho = rb / nbper, nb = rb % nbper, Ls = SEQ / dil;
    const int qcol = C_DIL + (3 * g) * 512 + slot * 128, kcol = qcol + 512, vcol = qcol + 1024;
    const lptr KN = X.lds + DA_KN, VT = X.lds + DA_VT, P = X.lds + DA_P; LAS float* bias = (LAS float*)(X.lds + DA_BIAS); LAS float* mx = (LAS float*)(X.lds + DA_MX); LAS float* lx = (LAS float*)(X.lds + DA_LX);
    const float* qg = X.in(11) + l * 128; const float* kg = X.in(12) + l * 128;
    const bf16* Hb = H + (size_t)b * SEQ * INW;
#pragma unroll
    for (int p = 0; p < 6; ++p) { const int row = (X.tid >> 4) + 32 * p, c8 = X.tid & 15; const int kj = 64 * nb - 64 + row; const bool ok = kj >= 0 && kj < Ls;
        v4u kw = (v4u){0u, 0u, 0u, 0u}, vw = (v4u){0u, 0u, 0u, 0u};
        if (ok) { const bf16* hr = Hb + (size_t)(kj * dil + rho) * INW; kw = *(const v4u*)(hr + kcol + 8 * c8); vw = *(const v4u*)(hr + vcol + 8 * c8); }
        float f[8]; f[0] = bf2f(kw.x & 0xffffu); f[1] = bf2f(kw.x >> 16); f[2] = bf2f(kw.y & 0xffffu); f[3] = bf2f(kw.y >> 16); f[4] = bf2f(kw.z & 0xffffu); f[5] = bf2f(kw.z >> 16); f[6] = bf2f(kw.w & 0xffffu); f[7] = bf2f(kw.w >> 16);
        float s = 0.f;
#pragma unroll
        for (int e = 0; e < 8; ++e) s += f[e] * f[e];
        s += __shfl_xor(s, 1); s += __shfl_xor(s, 2); s += __shfl_xor(s, 4); s += __shfl_xor(s, 8);
        const float sc = 1.0f / sqrtf(s * (1.0f / 128.0f) + EPS); const f32x4 g0 = *(const f32x4*)(kg + 8 * c8), g1 = *(const f32x4*)(kg + 8 * c8 + 4);
        v4u o; o.x = pk2(f[0] * sc * g0.x, f[1] * sc * g0.y); o.y = pk2(f[2] * sc * g0.z, f[3] * sc * g0.w); o.z = pk2(f[4] * sc * g1.x, f[5] * sc * g1.y); o.w = pk2(f[6] * sc * g1.z, f[7] * sc * g1.w);
        *(LAS v4u*)(KN + row * 272 + c8 * 16) = o;
        LAS unsigned short* d = (LAS unsigned short*)(VT + (8 * c8) * 400 + row * 2);
        d[0] = (unsigned short)vw.x; d[200] = (unsigned short)(vw.x >> 16); d[400] = (unsigned short)vw.y; d[600] = (unsigned short)(vw.y >> 16);
        d[800] = (unsigned short)vw.z; d[1000] = (unsigned short)(vw.z >> 16); d[1200] = (unsigned short)vw.w; d[1400] = (unsigned short)(vw.w >> 16); }
    if (X.tid < 132) bias[X.tid] = ((const float*)(X.ws + WS_TAB) + 2 * 4 * 768)[(g * 4 + slot) * 132 + X.tid];
    const int fr = X.lane & 15, fq = X.lane >> 4, qb = X.wave & 3, kh = X.wave >> 2; const int qi = 16 * qb + fr;
    const size_t qtok = (size_t)((64 * nb + qi) * dil + rho);
    bf16x8 qf[4];
    {
        v4u qw[4]; float s = 0.f;
#pragma unroll
        for (int ks = 0; ks < 4; ++ks) { qw[ks] = *(const v4u*)(Hb + qtok * INW + qcol + 32 * ks + 8 * fq);
            const float a0 = bf2f(qw[ks].x & 0xffffu), a1 = bf2f(qw[ks].x >> 16), a2 = bf2f(qw[ks].y & 0xffffu), a3 = bf2f(qw[ks].y >> 16), a4 = bf2f(qw[ks].z & 0xffffu), a5 = bf2f(qw[ks].z >> 16), a6 = bf2f(qw[ks].w & 0xffffu), a7 = bf2f(qw[ks].w >> 16);
            s += (a0 * a0 + a1 * a1) + (a2 * a2 + a3 * a3) + (a4 * a4 + a5 * a5) + (a6 * a6 + a7 * a7); }
        s += __shfl_xor(s, 16); s += __shfl_xor(s, 32);
        const float sc = 0.08838834764831845f / sqrtf(s * (1.0f / 128.0f) + EPS);
#pragma unroll
        for (int ks = 0; ks < 4; ++ks) { const f32x4 g0 = *(const f32x4*)(qg + 32 * ks + 8 * fq), g1 = *(const f32x4*)(qg + 32 * ks + 8 * fq + 4);
            v4u o; o.x = pk2(bf2f(qw[ks].x & 0xffffu) * sc * g0.x, bf2f(qw[ks].x >> 16) * sc * g0.y); o.y = pk2(bf2f(qw[ks].y & 0xffffu) * sc * g0.z, bf2f(qw[ks].y >> 16) * sc * g0.w);
            o.z = pk2(bf2f(qw[ks].z & 0xffffu) * sc * g1.x, bf2f(qw[ks].z >> 16) * sc * g1.y); o.w = pk2(bf2f(qw[ks].w & 0xffffu) * sc * g1.z, bf2f(qw[ks].w >> 16) * sc * g1.w);
            qf[ks] = __builtin_bit_cast(bf16x8, o); }
    }
    __syncthreads();
    f32x4 sc[6]; float mloc = -1e30f;
#pragma unroll
    for (int t = 0; t < 6; ++t) { f32x4 acc = (f32x4){0.f, 0.f, 0.f, 0.f};
#pragma unroll
        for (int ks = 0; ks < 4; ++ks) { const bf16x8 a = ldsfrag(KN, 96 * kh + 16 * t + fr, 272, 32 * ks + 8 * fq); acc = MFMA16(a, qf[ks], acc); }
#pragma unroll
        for (int j = 0; j < 4; ++j) { const int jj = 96 * kh + 16 * t + 4 * fq + j, rel = jj - 64 - qi, kj = 64 * nb - 64 + jj; const bool ok = rel >= -64 && rel <= 64 && kj >= 0 && kj < Ls;
            const float v = ok ? acc[j] + bias[ok ? rel + 64 : 0] : -1e30f; acc[j] = v; mloc = fmaxf(mloc, v); }
        sc[t] = acc; }
    mloc = fmaxf(mloc, __shfl_xor(mloc, 16)); mloc = fmaxf(mloc, __shfl_xor(mloc, 32));
    if (fq == 0) mx[kh * 64 + qi] = mloc;
    __syncthreads();
    const float mrow = fmaxf(mx[qi], mx[64 + qi]); float lloc = 0.f;
#pragma unroll
    for (int t = 0; t < 6; ++t) { float p[4];
#pragma unroll
        for (int j = 0; j < 4; ++j) { p[j] = sc[t][j] > -1e29f ? __expf(sc[t][j] - mrow) : 0.f; lloc += p[j]; }
        v2u w; w.x = pk2(p[0], p[1]); w.y = pk2(p[2], p[3]); *(LAS v2u*)(P + qi * 400 + (96 * kh + 16 * t + 4 * fq) * 2) = w; }
    lloc += __shfl_xor(lloc, 16); lloc += __shfl_xor(lloc, 32);
    if (fq == 0) lx[kh * 64 + qi] = lloc;
    __syncthreads();
    const int dh = kh; const float lrow = lx[qi] + lx[64 + qi]; const float inv = 1.0f / lrow;
    f32x4 oo[4];
#pragma unroll
    for (int t = 0; t < 4; ++t) oo[t] = (f32x4){0.f, 0.f, 0.f, 0.f};
#pragma unroll
    for (int ks = 0; ks < 6; ++ks) { const bf16x8 bb = ldsfrag(P, qi, 400, 32 * ks + 8 * fq);
#pragma unroll
        for (int t = 0; t < 4; ++t) { const bf16x8 a = ldsfrag(VT, 64 * dh + 16 * t + fr, 400, 32 * ks + 8 * fq); oo[t] = MFMA16(a, bb, oo[t]); } }
#pragma unroll
    for (int t = 0; t < 4; ++t) { v2u w; w.x = pk2(oo[t][0] * inv, oo[t][1] * inv); w.y = pk2(oo[t][2] * inv, oo[t][3] * inv); *(v2u*)(H + ((size_t)b * SEQ + qtok) * INW + qcol + 64 * dh + 16 * t + 4 * fq) = w; }
    if (dh == 0 && fq == 0) ((float*)(X.ws + WS_LSE))[((size_t)g * M + (size_t)b * SEQ + qtok) * 4 + slot] = mrow + __logf(lrow);
    __syncthreads();
}
__device__ __forceinline__ void dil_merge_item(const Ctx& X, const bf16* H, bf16* Y, int it) {
    const float* LSE = (const float*)(X.ws + WS_LSE);
#pragma unroll
    for (int p = 0; p < 8; ++p) { const int idx = X.tid + NTHR * p; const int tk = idx >> 6, slot = (idx >> 4) & 3, c8 = idx & 15; const size_t m = (size_t)it * 64 + tk;
        const float l0 = LSE[(0 * (size_t)M + m) * 4 + slot], l1 = LSE[(1 * (size_t)M + m) * 4 + slot], l2 = LSE[(2 * (size_t)M + m) * 4 + slot]; const float mxl = fmaxf(l0, fmaxf(l1, l2));
        const float e0 = __expf(l0 - mxl), e1 = __expf(l1 - mxl), e2 = __expf(l2 - mxl), inv = 1.0f / (e0 + e1 + e2); const float w[3] = {e0 * inv, e1 * inv, e2 * inv};
        float acc[8];
#pragma unroll
        for (int e = 0; e < 8; ++e) acc[e] = 0.f;
#pragma unroll
        for (int g = 0; g < 3; ++g) { const v4u ow = *(const v4u*)(H + m * INW + C_DIL + (3 * g) * 512 + slot * 128 + 8 * c8);
            acc[0] += w[g] * bf2f(ow.x & 0xffffu); acc[1] += w[g] * bf2f(ow.x >> 16); acc[2] += w[g] * bf2f(ow.y & 0xffffu); acc[3] += w[g] * bf2f(ow.y >> 16);
            acc[4] += w[g] * bf2f(ow.z & 0xffffu); acc[5] += w[g] * bf2f(ow.z >> 16); acc[6] += w[g] * bf2f(ow.w & 0xffffu); acc[7] += w[g] * bf2f(ow.w >> 16); }
        v4u o; o.x = pk2(acc[0], acc[1]); o.y = pk2(acc[2], acc[3]); o.z = pk2(acc[4], acc[5]); o.w = pk2(acc[6], acc[7]);
        *(v4u*)(Y + m * D + 1536 + slot * 128 + 8 * c8) = o; }
}

#ifndef MK_N_LAUNCHES
#define MK_N_LAUNCHES 1
#endif
__global__ void __launch_bounds__(NTHR, 2) mega_fwd(Args args) {
    extern __shared__ __attribute__((aligned(16))) unsigned char lds_raw[];
    const lptr lds = (lptr)lds_raw;
    volatile LAS unsigned* MISC = (volatile LAS unsigned*)(lds + MISC_OFF);
    for (int u = threadIdx.x; u < (LDS_BYTES - LDSCTL_OFF) / 4; u += NTHR) ((LAS unsigned*)(lds + LDSCTL_OFF))[u] = 0u;
    __syncthreads();
    XcdBarrier bar; bar.bar = (unsigned*)(args.ws + WS_CTL) + CW_BAR; bar.x = 0; bar.st = nullptr;
    if (MK_N_LAUNCHES == 1) bar = xcd_barrier_post((unsigned*)(args.ws + WS_CTL) + CW_BAR, MISC + 8);
    const int lo = args.ph_lo, hi = args.ph_hi;
#define IN(k) (lo <= (k) && (k) < hi)
#define SEAM(k) do { if (IN(k) && IN((k) + 1)) xcd_barrier(bar); } while (0)
#define PHASE_CTX() const Ctx X = mkctx(lds); bf16* const XB = (bf16*)(X.ws + WS_XB); bf16* const Y = (bf16*)(X.ws + WS_Y); bf16* const H = (bf16*)(X.ws + WS_H); float* const ss_mix = (float*)(X.ws + WS_PART); \
        float* const ss_mix_next = ss_mix; float* const ss_mlp = ss_mix + (size_t)M * 32; (void)XB; (void)Y; (void)H; (void)ss_mix; (void)ss_mix_next; (void)ss_mlp;

    #ifndef NO_PRO
    if (IN(0)) { const Ctx X = mkctx(lds); prologue(X); }
#endif
    SEAM(0);
    for (int l = 0; l < DEPTH; ++l) {
        const int pb = 1 + 7 * l;
#if !defined(NO_GEMM) && !defined(NO_GA)
        if (IN(pb + 0)) { PHASE_CTX(); pg8::Gemm g{XB, (const bf16*)(X.ws + WS_WIN) + (size_t)l * INW * D, M, INW, D}; pg8::StaticOrder S; S.init(M, INW, X.G, X.bid);
            pg8::EpiScaleBf16<0> E{H, INW, ss_mix}; pg8::gemm_phase<pg8::EpiScaleBf16<0>, pg8::StaticOrder, true, true>(X.lds, g, S, E); }
#endif
        SEAM(pb + 0);
#ifndef NO_MIX1
        if (IN(pb + 1)) {
#ifndef NO_DA
            { PHASE_CTX(); for (int it = X.bid; it < 3072; it += X.G) dil_item(X, H, l, it); }
#endif
#ifndef NO_HG1
            { PHASE_CTX(); for (int r = X.bid; r < 1536; r += X.G) gla_local_item<128, false>(X, H, l, r / 768, (r / 128) % 6, r % 128); }
#endif
#ifndef NO_RT1
            { PHASE_CTX(); for (int r = X.bid; r < 1536; r += X.G) gla_local_item<64, true>(X, H, l, r / 768, (r / 128) % 6, r % 128); }
#endif
        }
#endif
        SEAM(pb + 1);
#ifndef NO_SCAN
        if (IN(pb + 2)) { const Ctx X = mkctx(lds); scan_phase(X); }
#endif
        SEAM(pb + 2);
#ifndef NO_MIX2
        if (IN(pb + 3)) {
#ifndef NO_HG2
            { PHASE_CTX(); for (int r = X.bid; r < 1536; r += X.G) gla_out_item<128, false>(X, H, Y, l, r / 768, (r / 128) % 6, r % 128); }
#endif
#ifndef NO_RT2
            { PHASE_CTX(); for (int r = X.bid; r < 1536; r += X.G) gla_out_item<64, true>(X, H, Y, l, r / 768, (r / 128) % 6, r % 128); }
#endif
#ifndef NO_DM
            { PHASE_CTX(); for (int it = X.bid; it < 256; it += X.G) dil_merge_item(X, H, Y, it); }
#endif
        }
#endif
        SEAM(pb + 3);
#if !defined(NO_GEMM) && !defined(NO_GE)
        if (IN(pb + 4)) { PHASE_CTX(); pg8::Gemm g{Y, (const bf16*)(X.ws + WS_WOUT) + (size_t)l * D * D, M, D, D}; pg8::StaticOrder S; S.init(M, D, X.G, X.bid);
            pg8::EpiResid E{l == 0 ? X.in(0) : X.out(), X.out(), XB, ss_mlp}; pg8::gemm_phase<pg8::EpiResid, pg8::StaticOrder, true, true>(X.lds, g, S, E); }
#endif
        SEAM(pb + 4);
#if !defined(NO_GEMM) && !defined(NO_GF)
        if (IN(pb + 5)) { PHASE_CTX(); pg8::Gemm g{XB, (const bf16*)(X.ws + WS_WUP) + (size_t)l * FF * D, M, FF, D}; pg8::StaticOrder S; S.init(M, FF, X.G, X.bid);
            pg8::EpiScaleBf16<1> E{H, FF, ss_mlp}; pg8::gemm_phase<pg8::EpiScaleBf16<1>, pg8::StaticOrder, true, true>(X.lds, g, S, E); }
#endif
        SEAM(pb + 5);
#if !defined(NO_GEMM) && !defined(NO_GG)
        if (IN(pb + 6)) { PHASE_CTX(); pg8::Gemm g{H, (const bf16*)(X.ws + WS_WDN) + (size_t)l * D * FF, M, D, FF}; pg8::StaticOrder S; S.init(M, D, X.G, X.bid);
            pg8::EpiResid E{X.out(), X.out(), XB, ss_mix_next}; pg8::gemm_phase<pg8::EpiResid, pg8::StaticOrder, true, true>(X.lds, g, S, E); }
#endif
        SEAM(pb + 6);
    }
#undef IN
#undef SEAM
}

extern "C" void kernel_launch(void* const* d_in, const int* in_sizes, int n_in, void* d_out, int out_size, void* d_ws, size_t ws_size, hipStream_t stream) {
    static int grid = 0;
    if (grid == 0) {
        if (n_in != 14 || in_sizes[0] != M * D || out_size != M * D || ws_size < WS_END) { fprintf(stderr, "kernel_launch: unexpected problem (n_in %d, in0 %d, out %d, ws %zu < %zu); nothing launched\n", n_in, n_in > 0 ? in_sizes[0] : -1, out_size, ws_size, (size_t)WS_END); grid = -1; return; }
        int dev = 0, cus = 0, per_cu = 0;
        if (hipGetDevice(&dev) != hipSuccess || hipDeviceGetAttribute(&cus, hipDeviceAttributeMultiprocessorCount, dev) != hipSuccess) { grid = -1; return; }
        if (hipFuncSetAttribute((const void*)mega_fwd, hipFuncAttributeMaxDynamicSharedMemorySize, LDS_BYTES) != hipSuccess) { fprintf(stderr, "kernel_launch: hipFuncSetAttribute failed\n"); grid = -1; return; }
        if (hipOccupancyMaxActiveBlocksPerMultiprocessor(&per_cu, (const void*)mega_fwd, NTHR, LDS_BYTES) != hipSuccess || per_cu < 1) fprintf(stderr, "kernel_launch: occupancy query reports %d workgroups per CU\n", per_cu);
        (void)hipGetLastError();
        grid = cus;
    }
    if (grid < 0) return;
    (void)hipMemsetAsync((char*)d_ws + WS_CTL, 0, CTL_ZERO_BYTES, stream);
    Args a{};
    for (int i = 0; i < 14; ++i) a.in[i] = (const float*)d_in[i];
    a.out = (float*)d_out; a.ws = (unsigned char*)d_ws;
    if (MK_N_LAUNCHES == 1) { a.ph_lo = 0; a.ph_hi = NPHASE; hipLaunchKernelGGL(mega_fwd, dim3(grid), dim3(NTHR), LDS_BYTES, stream, a); }
    else for (int p = 0; p < NPHASE; ++p) { a.ph_lo = p; a.ph_hi = p + 1; hipLaunchKernelGGL(mega_fwd, dim3(grid), dim3(NTHR), LDS_BYTES, stream, a); }
}
```

```cpp
#include <hip/hip_runtime.h>
#include <cstdio>
#include <cstdint>
namespace pg8 {
#define PG8_LAS __attribute__((address_space(3)))
typedef unsigned short bf16_t;
typedef short bf16x8 __attribute__((ext_vector_type(8)));
typedef float f32x4 __attribute__((ext_vector_type(4)));
typedef unsigned u32x4 __attribute__((ext_vector_type(4)));
constexpr int BM = 256, BK = 64, HALF = 128, HTB = HALF * BK * 2  , STAGE_BYTES = 8 * HTB, NXCD = 8, WGM = 4;

__host__ __device__ __forceinline__ int lds_byte(int r, int c) { const int st = (r >> 4) * 2 + (c >> 5), rr = r & 15, cc = c & 31, ob = rr * 64 + cc * 2; return st * 1024 + (ob ^ (((ob >> 9) & 1) << 5)); }
__host__ __device__ __forceinline__ void stage_rc(int b, int& R, int& C) { const int st = b / 1024, sb = b % 1024, swz = sb ^ (((sb >> 9) & 1) << 5); R = (st >> 1) * 16 + swz / 64; C = (st & 1) * 32 + (swz % 64) / 2; }
__host__ __device__ __forceinline__ int perm32(int rho) { const int n = rho >> 4, i = rho & 15; return 8 * (i >> 2) + 4 * n + (i & 3); }

struct Unit { int pm, pn; };
struct Gemm { const bf16_t* A; const bf16_t* Bt; int M, N, K; };

struct StaticOrder {
    int nM, nN, nwg, G, c;
    __host__ __device__ void init(int M, int N, int G_, int c_) { nM = M / BM; nN = N / BM; nwg = nM * nN; G = G_; c = c_; }
    __host__ __device__ bool next(int i, Unit& u) const {
        const long L = (long)i * G + c; if (L >= nwg) return false;
        int wgid = (int)L; { const int q = nwg / NXCD, r = nwg % NXCD, xcd = wgid % NXCD, off = wgid / NXCD; wgid = (xcd < r ? xcd * (q + 1) : r * (q + 1) + (xcd - r) * q) + off; }
        const int nig = WGM * nN, gid = wgid / nig, fm = gid * WGM, gsz = (nM - fm) < WGM ? (nM - fm) : WGM;
        u.pm = fm + ((wgid % nig) % gsz); u.pn = (wgid % nig) / gsz; return true;
    }
    __device__ __forceinline__ void a_ready(const Unit&) const {}
    __device__ __forceinline__ void done(const Unit&) const {}
};

typedef float f32x2 __attribute__((ext_vector_type(2))); typedef __bf16 bf16x2_t __attribute__((ext_vector_type(2)));
__device__ __forceinline__ unsigned cvt_pk_bf16(float lo, float hi) { f32x2 v = {lo, hi}; bf16x2_t b = __builtin_convertvector(v, bf16x2_t); return __builtin_bit_cast(unsigned, b); }

template <int ACT, bool BLK = false> struct EpiScaleBf16 {
    static constexpr bool PERM = true, AFTER_DRAIN = false, HAS_PREP = true;
    bf16_t* O; int ldc; const float* ss; PG8_LAS float* rtab;
    __device__ __forceinline__ void prep(const Unit& u, int tid, int buf) const {
        if (tid < BM) { const float* p = ss + (size_t)(u.pm * BM + tid) * 32; float sq = 0.f;
#pragma unroll
            for (int i = 0; i < 8; ++i) { const f32x4 v = *(const f32x4*)(p + 4 * i); sq += (v[0] + v[1]) + (v[2] + v[3]); }
            rtab[buf * BM + tid] = __builtin_amdgcn_rsqf(sq * (1.0f / 2048.0f) + 1e-6f); }
    }
    __device__ __forceinline__ void operator()(const f32x4 (&acc)[2][2][4][2], const Unit& u, int wr, int wc, int fr, int fq, int buf) const {
        const int row0 = u.pm * BM + wr * 64 + fr; const int col0 = u.pn * BM + wc * 32 + 8 * fq;
#pragma unroll
        for (int ai = 0; ai < 2; ++ai)
#pragma unroll
            for (int m = 0; m < 4; ++m) { const int row = row0 + ai * HALF + m * 16;
                const float sc = rtab[buf * BM + wr * 64 + fr + ai * HALF + m * 16];
                bf16_t* rowp = BLK ? O + ((size_t)(2 * u.pn) * ldc + row) * 128 + wc * 32 + 8 * fq : O + (size_t)row * ldc + col0;
#pragma unroll
                for (int bj = 0; bj < 2; ++bj) { f32x4 v0 = acc[ai][bj][m][0] * sc, v1 = acc[ai][bj][m][1] * sc;
                    if (ACT == 1) {
#pragma unroll
                        for (int e = 0; e < 4; ++e) { float a = v0[e] > 0.f ? v0[e] : 0.f; v0[e] = a * a; float b = v1[e] > 0.f ? v1[e] : 0.f; v1[e] = b * b; } }
                    u32x4 w; w.x = cvt_pk_bf16(v0[0], v0[1]); w.y = cvt_pk_bf16(v0[2], v0[3]); w.z = cvt_pk_bf16(v1[0], v1[1]); w.w = cvt_pk_bf16(v1[2], v1[3]);
                    *(u32x4*)(rowp + (BLK ? (size_t)bj * ldc * 128 : (size_t)bj * HALF)) = w; } }
    }
};
template <bool FINAL> struct EpiResid {
    static constexpr bool PERM = true, AFTER_DRAIN = false, HAS_PREP = false;
    bf16_t* xb; float* out; float* ssn;
    __device__ __forceinline__ void operator()(const f32x4 (&acc)[2][2][4][2], const Unit& u, int wr, int wc, int fr, int fq) const {
        const int col0 = u.pn * BM + wc * 32 + 8 * fq;
#pragma unroll
        for (int ai = 0; ai < 2; ++ai)
#pragma unroll
            for (int m = 0; m < 4; ++m) { const int row = u.pm * BM + ai * HALF + wr * 64 + m * 16 + fr; const size_t off = (size_t)row * 2048 + col0; float sq = 0.f;
#pragma unroll
                for (int bj = 0; bj < 2; ++bj) { const size_t o2 = off + bj * HALF; const u32x4 xw = *(const u32x4*)(xb + o2);
                    f32x4 x0, x1; x0[0] = __uint_as_float(xw.x << 16); x0[1] = __uint_as_float(xw.x & 0xffff0000u); x0[2] = __uint_as_float(xw.y << 16); x0[3] = __uint_as_float(xw.y & 0xffff0000u);
                    x1[0] = __uint_as_float(xw.z << 16); x1[1] = __uint_as_float(xw.z & 0xffff0000u); x1[2] = __uint_as_float(xw.w << 16); x1[3] = __uint_as_float(xw.w & 0xffff0000u);
                    x0 = x0 + acc[ai][bj][m][0]; x1 = x1 + acc[ai][bj][m][1];
                    if (FINAL) { *(f32x4*)(out + o2) = x0; *(f32x4*)(out + o2 + 4) = x1; }
                    else { u32x4 w; w.x = cvt_pk_bf16(x0[0], x0[1]); w.y = cvt_pk_bf16(x0[2], x0[3]); w.z = cvt_pk_bf16(x1[0], x1[1]); w.w = cvt_pk_bf16(x1[2], x1[3]); *(u32x4*)(xb + o2) = w; }
                    sq += ((x0[0] * x0[0] + x0[1] * x0[1]) + (x0[2] * x0[2] + x0[3] * x0[3])) + ((x1[0] * x1[0] + x1[1] * x1[1]) + (x1[2] * x1[2] + x1[3] * x1[3])); }
                sq += __shfl_xor(sq, 16); sq += __shfl_xor(sq, 32);
                if (!FINAL && fq == 0) ssn[(size_t)row * 32 + u.pn * 4 + wc] = sq; }
    }
};
template <class Epi, class Sched, bool ALIGN_EPI = false, bool SP2 = false>
__device__ __forceinline__ void gemm_phase(PG8_LAS unsigned char* lds, const Gemm g, const Sched& S, const Epi& E) {
    int tid_ = threadIdx.x; asm volatile("" : "+v"(tid_));
    const int tid = tid_, wid = __builtin_amdgcn_readfirstlane(tid >> 6), lane = tid & 63, wr = wid >> 2, wc = wid & 3, fr = lane & 15, fq = lane >> 4;
    const int K = g.K, nt = K / BK;
    unsigned voffA[2], voffB[2];
#pragma unroll
    for (int i = 0; i < 2; ++i) { int R, C; stage_rc(tid * 16 + i * 8192, R, C); const int Rb = Epi::PERM ? ((R & ~31) + perm32(R & 31)) : R;
        voffA[i] = (unsigned)(R * K + C) * 2u; voffB[i] = (unsigned)(Rb * K + C) * 2u; }
    const size_t kstep = (size_t)(BK * 2);
    const size_t hstep = (size_t)HALF * K * 2;
    const size_t tstep = 2 * hstep;
    const unsigned ldsw = (unsigned)wid * 1024u;
    const int aoff = lds_byte(wr * 64 + fr, fq * 8), boff = lds_byte(wc * 32 + fr, fq * 8);
#define PG8_SA(b, h) (((b) * 2 + (h)) * HTB)
#define PG8_SB(b, h) ((4 + (b) * 2 + (h)) * HTB)
#define PG8_STAGE(bufoff, gbase, voff) do { _Pragma("unroll") for (int _i = 0; _i < 2; ++_i) \
        __builtin_amdgcn_global_load_lds((const unsigned*)((const char*)(gbase) + (voff)[_i]), (PG8_LAS unsigned*)(lds + (bufoff) + ldsw + _i * 8192), 16, 0, 0); } while (0)
#define PG8_LDA(dst, b, h) do { _Pragma("unroll") for (int m = 0; m < 4; ++m) _Pragma("unroll") for (int k = 0; k < 2; ++k) dst[m][k] = *(const PG8_LAS bf16x8*)(lds + PG8_SA(b, h) + aoff + m * 2048 + k * 1024); } while (0)
#define PG8_LDB(dst, b, h) do { _Pragma("unroll") for (int n = 0; n < 2; ++n) _Pragma("unroll") for (int k = 0; k < 2; ++k) dst[n][k] = *(const PG8_LAS bf16x8*)(lds + PG8_SB(b, h) + boff + n * 2048 + k * 1024); } while (0)
#define PG8_MMA(ai, bj, At, Bt) do { __builtin_amdgcn_s_setprio(1); _Pragma("unroll") for (int m = 0; m < 4; ++m) _Pragma("unroll") for (int n = 0; n < 2; ++n) _Pragma("unroll") for (int k = 0; k < 2; ++k) \
        acc[ai][bj][m][n] = __builtin_amdgcn_mfma_f32_16x16x32_bf16(Bt[n][k], At[m][k], acc[ai][bj][m][n], 0, 0, 0); __builtin_amdgcn_s_setprio(0); } while (0)
#define PG8_WAIT_V(n) asm volatile("s_waitcnt vmcnt(" #n ")" ::: "memory")
#define PG8_WAIT_L(n) asm volatile("s_waitcnt lgkmcnt(" #n ")" ::: "memory")
#define PG8_BAR __builtin_amdgcn_s_barrier()
#define PG8_SCHED __builtin_amdgcn_sched_barrier(0)
    Unit cur, nxt; int ui = 0;
    if (!S.next(0, cur)) return;
    f32x4 acc[2][2][4][2];
#pragma unroll
    for (int a = 0; a < 2; ++a)
#pragma unroll
        for (int b = 0; b < 2; ++b)
#pragma unroll
            for (int m = 0; m < 4; ++m)
#pragma unroll
                for (int n = 0; n < 2; ++n) acc[a][b][m][n] = (f32x4){0.f, 0.f, 0.f, 0.f};
    bf16x8 At[4][2], B0[2][2], B1[2][2];
    const char* cA = (const char*)g.A + (size_t)cur.pm * tstep; const char* cB = (const char*)g.Bt + (size_t)cur.pn * tstep;
    S.a_ready(cur);
    int prep_pm = cur.pm, prep_gen = 0; if constexpr (Epi::HAS_PREP) E.prep(cur, tid, 0);
    if constexpr (SP2) {
        PG8_STAGE(PG8_SB(0, 0), cB, voffB); PG8_STAGE(PG8_SB(0, 1), cB + hstep, voffB); PG8_STAGE(PG8_SA(0, 0), cA, voffA); PG8_STAGE(PG8_SA(0, 1), cA + hstep, voffA);
        if (wr == 1) PG8_BAR;
        PG8_WAIT_V(2); PG8_BAR;
        PG8_STAGE(PG8_SB(1, 0), cB + kstep, voffB); PG8_STAGE(PG8_SA(1, 0), cA + kstep, voffA); PG8_STAGE(PG8_SB(1, 1), cB + hstep + kstep, voffB);
        PG8_WAIT_V(6); PG8_BAR;
    } else {
        PG8_STAGE(PG8_SB(0, 0), cB, voffB); PG8_STAGE(PG8_SA(0, 0), cA, voffA); PG8_STAGE(PG8_SB(0, 1), cB + hstep, voffB); PG8_STAGE(PG8_SA(0, 1), cA + hstep, voffA);
        if (wr == 1) PG8_BAR;
        PG8_WAIT_V(4); PG8_BAR;
        PG8_STAGE(PG8_SB(1, 0), cB + kstep, voffB); PG8_STAGE(PG8_SA(1, 0), cA + kstep, voffA); PG8_STAGE(PG8_SB(1, 1), cB + hstep + kstep, voffB);
        PG8_WAIT_V(6); PG8_BAR;
    }
    for (;;) {
        const bool has_next = S.next(ui + 1, nxt);
        const char* nA = has_next ? (const char*)g.A + (size_t)nxt.pm * tstep : cA; const char* nB = has_next ? (const char*)g.Bt + (size_t)nxt.pn * tstep : cB;
        for (int t = 0; t < nt; t += 2) {
            const bool last = (t == nt - 2);
            const char* a1 = cA + (size_t)(t + 1) * kstep;
            const char* a2 = last ? nA : cA + (size_t)(t + 2) * kstep; const char* b2 = last ? nB : cB + (size_t)(t + 2) * kstep;
            const char* a3 = a2 + kstep; const char* b3 = b2 + kstep;
            if (last && has_next) S.a_ready(nxt);
            if constexpr (SP2) {
            PG8_LDB(B0, 0, 0); PG8_LDB(B1, 0, 1); PG8_SCHED; PG8_LDA(At, 0, 0); PG8_STAGE(PG8_SA(1, 1), a1 + hstep, voffA);
            PG8_WAIT_V(8); PG8_WAIT_L(0); PG8_BAR; PG8_MMA(0, 0, At, B0); PG8_MMA(0, 1, At, B1); PG8_BAR; PG8_SCHED;
            PG8_LDA(At, 0, 1); PG8_STAGE(PG8_SB(0, 0), b2, voffB); PG8_STAGE(PG8_SB(0, 1), b2 + hstep, voffB); PG8_STAGE(PG8_SA(0, 0), a2, voffA);
            PG8_WAIT_V(8); PG8_WAIT_L(0); PG8_BAR; PG8_MMA(1, 0, At, B0); PG8_MMA(1, 1, At, B1); PG8_BAR; PG8_SCHED;
            PG8_LDB(B0, 1, 0); PG8_LDB(B1, 1, 1); PG8_SCHED; PG8_LDA(At, 1, 0); PG8_STAGE(PG8_SA(0, 1), a2 + hstep, voffA);
            PG8_WAIT_V(8); PG8_WAIT_L(0); PG8_BAR; PG8_MMA(0, 0, At, B0); PG8_MMA(0, 1, At, B1); PG8_BAR; PG8_SCHED;
            PG8_LDA(At, 1, 1); PG8_STAGE(PG8_SB(1, 0), b3, voffB); PG8_STAGE(PG8_SB(1, 1), b3 + hstep, voffB); PG8_STAGE(PG8_SA(1, 0), a3, voffA);
            PG8_WAIT_V(8); PG8_WAIT_L(0); PG8_BAR; PG8_MMA(1, 0, At, B0); PG8_MMA(1, 1, At, B1); PG8_BAR; PG8_SCHED;
            } else {
            PG8_LDB(B0, 0, 0); PG8_SCHED; PG8_LDA(At, 0, 0); PG8_STAGE(PG8_SA(1, 1), a1 + hstep, voffA);
            PG8_WAIT_L(8); PG8_BAR; PG8_WAIT_L(0); PG8_MMA(0, 0, At, B0); PG8_BAR; PG8_SCHED;
            PG8_LDB(B1, 0, 1); PG8_STAGE(PG8_SB(0, 0), b2, voffB);
            PG8_BAR; PG8_WAIT_L(0); PG8_MMA(0, 1, At, B1); PG8_BAR;
            PG8_LDA(At, 0, 1); PG8_STAGE(PG8_SA(0, 0), a2, voffA);
            PG8_BAR; PG8_WAIT_L(0); PG8_MMA(1, 0, At, B0); PG8_BAR; PG8_SCHED;
            PG8_STAGE(PG8_SB(0, 1), b2 + hstep, voffB);
            PG8_WAIT_V(6); PG8_BAR; PG8_MMA(1, 1, At, B1); PG8_BAR;
            PG8_LDB(B0, 1, 0); PG8_SCHED; PG8_LDA(At, 1, 0); PG8_STAGE(PG8_SA(0, 1), a2 + hstep, voffA);
            PG8_WAIT_L(8); PG8_BAR; PG8_WAIT_L(0); PG8_MMA(0, 0, At, B0); PG8_BAR; PG8_SCHED;
            PG8_LDB(B1, 1, 1); PG8_STAGE(PG8_SB(1, 0), b3, voffB);
            PG8_BAR; PG8_WAIT_L(0); PG8_MMA(0, 1, At, B1); PG8_BAR;
            PG8_LDA(At, 1, 1); PG8_STAGE(PG8_SA(1, 0), a3, voffA);
            PG8_BAR; PG8_WAIT_L(0); PG8_MMA(1, 0, At, B0); PG8_BAR; PG8_SCHED;
            PG8_STAGE(PG8_SB(1, 1), b3 + hstep, voffB);
            PG8_WAIT_V(6); PG8_BAR; PG8_MMA(1, 1, At, B1); PG8_BAR;
            }
        }
        if constexpr (ALIGN_EPI) { if (wr == 0) PG8_BAR; }
        if constexpr (!Epi::AFTER_DRAIN) { if constexpr (Epi::HAS_PREP) E(acc, cur, wr, wc, fr, fq, prep_gen & 1); else E(acc, cur, wr, wc, fr, fq); S.done(cur); }
        if (!has_next) break;
#pragma unroll
        for (int a = 0; a < 2; ++a)
#pragma unroll
            for (int b = 0; b < 2; ++b)
#pragma unroll
                for (int m = 0; m < 4; ++m)
#pragma unroll
                    for (int n = 0; n < 2; ++n) acc[a][b][m][n] = (f32x4){0.f, 0.f, 0.f, 0.f};
        cur = nxt; cA = nA; cB = nB; ++ui;
        if constexpr (Epi::HAS_PREP) { if (cur.pm != prep_pm) { ++prep_gen; E.prep(cur, tid, prep_gen & 1); prep_pm = cur.pm; } }
        if constexpr (ALIGN_EPI) { if (wr == 1) PG8_BAR; }
    }
    PG8_WAIT_V(0);
    if constexpr (!ALIGN_EPI) { if (wr == 0) PG8_BAR; }
    PG8_BAR;
    if constexpr (Epi::AFTER_DRAIN) { E.fused(acc, cur, wr, wc, fr, fq, lds, wid, lane); S.done(cur); }
#undef PG8_SA
#undef PG8_SB
#undef PG8_STAGE
#undef PG8_LDA
#undef PG8_LDB
#undef PG8_MMA
#undef PG8_WAIT_V
#undef PG8_WAIT_L
#undef PG8_BAR
#undef PG8_SCHED
}
}
constexpr int NWAVES = 8, NTHR = 512;
constexpr int BATCH = 2, SEQ = 8192, M = BATCH * SEQ, D = 2048, DEPTH = 4, INW = 10752, FF = 8192;
constexpr int C_HGQ = 0, C_HGV = 768, C_ZF = 1536, C_ZB = 2304, C_HGG = 3072, C_RQ = 3840, C_RK = 4224, C_RV = 4608, C_RG = 5376, C_DIL = 6144;
constexpr int CH = 64, NCH = SEQ / CH;
constexpr float EPS = 1e-6f;
constexpr int NPHASE = 1 + 7 * DEPTH;

constexpr size_t MiB = 1u << 20;
constexpr size_t WS_CTL = 0, CTL_ZERO_BYTES = 1 * MiB;
constexpr size_t WS_PART = 10 * MiB;
constexpr size_t WS_ROPE = 2 * MiB;
constexpr size_t WS_TAB = 4 * MiB;
constexpr size_t WS_LSE = 5 * MiB;
constexpr size_t WS_DHG = 6 * MiB;
constexpr size_t WS_DRT = 8 * MiB;
constexpr size_t WS_WIN = 16 * MiB, WS_WOUT = 184 * MiB, WS_WUP = 216 * MiB, WS_WDN = 344 * MiB;
constexpr size_t WS_XB = 472 * MiB;
constexpr size_t WS_Y = 536 * MiB;
constexpr size_t WS_H = 600 * MiB;
constexpr size_t WS_SHG = 936 * MiB;
constexpr size_t WS_SRT = 1032 * MiB;
constexpr size_t WS_END = 1080 * MiB;
constexpr int CW_BAR = 4096;

constexpr int PH_BYTES = 155648;
constexpr int LDSCTL_OFF = PH_BYTES, MISC_OFF = LDSCTL_OFF + 320;
constexpr int LDS_BYTES = PH_BYTES + 1024;

#define GAS __attribute__((address_space(1)))
#define LAS __attribute__((address_space(3)))
typedef unsigned short bf16;
typedef unsigned v4u __attribute__((ext_vector_type(4)));
typedef unsigned v2u __attribute__((ext_vector_type(2)));
typedef float f32x4 __attribute__((ext_vector_type(4)));
typedef short bf16x8 __attribute__((ext_vector_type(8)));
typedef LAS unsigned char* lptr;
#define LDS_WAIT() asm volatile("s_waitcnt lgkmcnt(0)" ::: "memory")
#define VM_WAIT() asm volatile("s_waitcnt vmcnt(0)" ::: "memory")
#ifndef PROBE_MASK
#define PROBE_MASK 0
#endif
#define SP_BEGIN() unsigned long long sp0_ = 0; if (PROBE_MASK >> 16) sp0_ = __builtin_amdgcn_s_memrealtime();
#define SP_END(bit) do { if (PROBE_MASK >> 16) { const unsigned long long t1_ = __builtin_amdgcn_s_memrealtime(); if (PROBE_MASK & (1 << (bit))) { const unsigned long long dt_ = t1_ - sp0_; while (__builtin_amdgcn_s_memrealtime() - t1_ < dt_) __builtin_amdgcn_s_sleep(2); } sp0_ = __builtin_amdgcn_s_memrealtime(); } } while (0)
#define BAR_LDS() do { asm volatile("s_waitcnt lgkmcnt(0)" ::: "memory"); __builtin_amdgcn_s_barrier(); asm volatile("" ::: "memory"); } while (0)
__device__ __forceinline__ float bf2f(unsigned h) { return __uint_as_float(h << 16); }
__device__ __forceinline__ unsigned pk2(float lo, float hi) { return pg8::cvt_pk_bf16(lo, hi); }
__device__ __forceinline__ unsigned short f2bf(float f) { return (unsigned short)(pk2(f, 0.f) & 0xffffu); }
__device__ __forceinline__ bf16x8 ldsfrag(lptr base, int row, int stride_b, int kel) { return *(const LAS bf16x8*)(base + row * stride_b + kel * 2); }
#define MFMA16(a, b, c) __builtin_amdgcn_mfma_f32_16x16x32_bf16((a), (b), (c), 0, 0, 0)
template <class T> __device__ __forceinline__ T* hptr(T* H, size_t m, int col) { return H + ((size_t)(col >> 7) * M + m) * 128 + (col & 127); }
__device__ __forceinline__ float wave_sum(float v) {
#pragma unroll
    for (int o = 1; o < 64; o <<= 1) v += __shfl_xor(v, o);
    return v;
}
typedef GAS unsigned gu32;
#define XB_TMO      128
#define XB_XCNT(j)  (256  + 64 * (j))
#define XB_XSUB(j)  (1280 + 64 * (j))
#define XB_XGEN(j)  (2304 + 64 * (j))
#define XB_TOP      3328
#define XB_TOPGEN   3392
#define XCD_BAR_WORDS 3456
#define XB_SPIN_CAP (1u << 18)

__device__ __forceinline__ unsigned xb_ld(unsigned* p)              { return __hip_atomic_load(p, __ATOMIC_RELAXED, __HIP_MEMORY_SCOPE_AGENT); }
__device__ __forceinline__ unsigned xb_add(unsigned* p, unsigned v) { return __hip_atomic_fetch_add(p, v, __ATOMIC_RELAXED, __HIP_MEMORY_SCOPE_AGENT); }
__device__ __forceinline__ unsigned xb_xcc_id() { return (unsigned)__builtin_amdgcn_s_getreg((3 << 11) | 20) & 0xFu; }
#define XB_SPIN(cond, bar) do { unsigned _sp = 0; while (cond) { __builtin_amdgcn_s_sleep(1); \
    if ((++_sp & 255u) == 0u) { if (xb_ld(&(bar)[XB_TMO])) break; if (_sp > XB_SPIN_CAP) { atomicAdd(&(bar)[XB_TMO], 1u); break; } } } } while (0)

struct XcdBarrier {
    unsigned* bar; unsigned x;
    volatile LAS unsigned* st;
};

__device__ __forceinline__ XcdBarrier xcd_barrier_post(unsigned* bar, volatile LAS unsigned* st) {
    XcdBarrier b; b.bar = bar; b.x = xb_xcc_id(); b.st = st;
    if (threadIdx.x == 0) (void)xb_add(&bar[XB_XCNT(b.x)], 1u);
    return b;
}
__device__ __forceinline__ void xcd_barrier_complete(unsigned* bar, unsigned x, unsigned& nloc, unsigned& nx) {
    const unsigned G = gridDim.x * gridDim.y * gridDim.z;
    unsigned sum, cnt, mine, sp = 0u;
    for (;;) {
        sum = 0u; cnt = 0u; mine = 0u;
#pragma unroll
        for (unsigned j = 0; j < 16; ++j) { const unsigned c = xb_ld(&bar[XB_XCNT(j)]); sum += c; cnt += (c > 0u) ? 1u : 0u; mine = (j == x) ? c : mine; }
        if (sum == G) break;
        __builtin_amdgcn_s_sleep(1);
        if ((++sp & 255u) == 0u) { if (xb_ld(&bar[XB_TMO])) break; if (sp > XB_SPIN_CAP) { atomicAdd(&bar[XB_TMO], 1u); break; } }
    }
    nloc = mine > 0u ? mine : 1u; nx = cnt > 0u ? cnt : 1u;
}

__device__ __forceinline__ void xcd_barrier(const XcdBarrier& b) {
    asm volatile("s_waitcnt vmcnt(0)" ::: "memory");
    __syncthreads();
    if (threadIdx.x == 0) {
        unsigned* bar = b.bar;
        __builtin_amdgcn_s_waitcnt(0);
        unsigned nloc = b.st[0], nx = b.st[1];
        if (nloc == 0u) { xcd_barrier_complete(bar, b.x, nloc, nx); b.st[0] = nloc; b.st[1] = nx; }
        const unsigned old = xb_add(&bar[XB_XSUB(b.x)], 1u);
        const unsigned gen = old / nloc;
        if (old + 1u == (gen + 1u) * nloc) {
            __builtin_amdgcn_fence(__ATOMIC_RELEASE, "agent");
            asm volatile("s_waitcnt vmcnt(0)" ::: "memory");
            const unsigned og = xb_add(&bar[XB_TOP], 1u);
            const unsigned tg = og / nx;
            if (og + 1u == (tg + 1u) * nx) xb_add(&bar[XB_TOPGEN], 1u);
            else XB_SPIN(xb_ld(&bar[XB_TOPGEN]) == tg, bar);
            __builtin_amdgcn_fence(__ATOMIC_ACQUIRE, "agent");
            xb_add(&bar[XB_XGEN(b.x)], 1u);
            asm volatile("s_waitcnt vmcnt(0)" ::: "memory");
        } else {
            XB_SPIN(xb_ld(&bar[XB_XGEN(b.x)]) == gen, bar);
            __builtin_amdgcn_fence(__ATOMIC_ACQUIRE, "agent");
            asm volatile("s_waitcnt vmcnt(0)" ::: "memory");
        }
    }
    __syncthreads();
}
constexpr int TR_SCR = 64 * 65 * 4;
__device__ __forceinline__ void transpose_item(const float* W, const float* g, int K, int N, bf16* WT, LAS float* scr, int item, int lane) {
    const int nblk = N / 64, kb = item / nblk, nb = item % nblk, k0 = 64 * kb, n0 = 64 * nb;
    const int n4 = lane & 15, kr = lane >> 4;
    f32x4 w[16];
#pragma unroll
    for (int i = 0; i < 16; ++i) w[i] = *(const f32x4*)(W + (size_t)(k0 + 4 * i + kr) * N + n0 + 4 * n4);
    if (g) {
#pragma unroll
        for (int i = 0; i < 16; ++i) w[i] = w[i] * g[k0 + 4 * i + kr]; }
#pragma unroll
    for (int i = 0; i < 16; ++i) { LAS float* d = scr + (4 * i + kr) * 65 + 4 * n4; d[0] = w[i].x; d[1] = w[i].y; d[2] = w[i].z; d[3] = w[i].w; }
    LDS_WAIT(); asm volatile("" ::: "memory");
    const int c = lane & 7;
#pragma unroll
    for (int j = 0; j < 8; ++j) { const int n = (lane >> 3) + 8 * j; const LAS float* s = scr + (8 * c) * 65 + n;
        v4u o; o.x = pk2(s[0 * 65], s[1 * 65]); o.y = pk2(s[2 * 65], s[3 * 65]); o.z = pk2(s[4 * 65], s[5 * 65]); o.w = pk2(s[6 * 65], s[7 * 65]);
        *(v4u*)(WT + (size_t)(n0 + n) * K + k0 + 8 * c) = o; }
    LDS_WAIT(); asm volatile("" ::: "memory");
}
__device__ __forceinline__ void sincos_d(double a, float& s, float& c) {
    const double kq = __builtin_rint(a * 0.6366197723675814); const double r = a - kq * 1.5707963267948966; const int q = ((int)kq) & 3; const double r2 = r * r;
    double sp = 1.0 / 6227020800.0; sp = sp * r2 - 1.0 / 39916800.0; sp = sp * r2 + 1.0 / 362880.0; sp = sp * r2 - 1.0 / 5040.0; sp = sp * r2 + 1.0 / 120.0; sp = sp * r2 - 1.0 / 6.0; sp = sp * r2 + 1.0; sp *= r;
    double cp = -1.0 / 87178291200.0; cp = cp * r2 + 1.0 / 479001600.0; cp = cp * r2 - 1.0 / 3628800.0; cp = cp * r2 + 1.0 / 40320.0; cp = cp * r2 - 1.0 / 720.0; cp = cp * r2 + 1.0 / 24.0; cp = cp * r2 - 0.5; cp = cp * r2 + 1.0;
    const double ss = (q == 0) ? sp : (q == 1) ? cp : (q == 2) ? -sp : -cp; const double cc = (q == 0) ? cp : (q == 1) ? -sp : (q == 2) ? -cp : sp;
    s = (float)ss; c = (float)cc;
}
__device__ __forceinline__ int t5_bucket(int rel) {
    const int n = rel < 0 ? -rel : rel; int b;
    if (n < 8) b = n; else { b = 8 + (n >= 15) + (n >= 27) + (n >= 50) + (n >= 91) + (n >= 166) + (n >= 305) + (n >= 559); }
    return b + (rel > 0 ? 16 : 0);
}

struct Args { const float* in[14]; float* out; unsigned char* ws; int ph_lo, ph_hi; };
typedef const __attribute__((address_space(4))) Args* kargp;
struct Ctx {
    lptr lds; int tid, lane, wave, G, bid; kargp ka; unsigned char* ws;
    __device__ __forceinline__ const float* in(int i) const { return ka->in[i]; }
    __device__ __forceinline__ float* out() const { return ka->out; }
};
__device__ __forceinline__ Ctx mkctx(lptr lds) {
    Ctx X; int tid = threadIdx.x; asm volatile("" : "+v"(tid));
    kargp ka = (kargp)__builtin_amdgcn_kernarg_segment_ptr(); asm volatile("" : "+s"(ka));
    X.lds = lds; X.tid = tid; X.lane = tid & 63; X.wave = __builtin_amdgcn_readfirstlane(tid >> 6); X.G = gridDim.x; X.bid = blockIdx.x; X.ka = ka; X.ws = ka->ws; return X;
}

constexpr int I_IN = (D / 64) * (INW / 64), I_OUT = (D / 64) * (D / 64), I_UP = (D / 64) * (FF / 64), I_DN = (FF / 64) * (D / 64), I_L = I_IN + I_OUT + I_UP + I_DN;
constexpr int TAILQ = 8192;
__device__ __forceinline__ void convert_item(const Ctx& X, int l, int r, LAS float* scr) {
    if (r < I_IN) { transpose_item(X.in(1) + (size_t)l * D * INW, X.in(5) + l * D, D, INW, (bf16*)(X.ws + WS_WIN) + (size_t)l * INW * D, scr, r, X.lane); return; } r -= I_IN;
    if (r < I_OUT) { transpose_item(X.in(2) + (size_t)l * D * D, nullptr, D, D, (bf16*)(X.ws + WS_WOUT) + (size_t)l * D * D, scr, r, X.lane); return; } r -= I_OUT;
    if (r < I_UP) { transpose_item(X.in(3) + (size_t)l * D * FF, X.in(6) + l * D, D, FF, (bf16*)(X.ws + WS_WUP) + (size_t)l * FF * D, scr, r, X.lane); return; } r -= I_UP;
    transpose_item(X.in(4) + (size_t)l * FF * D, nullptr, FF, D, (bf16*)(X.ws + WS_WDN) + (size_t)l * D * FF, scr, r, X.lane);
}
__device__ __forceinline__ void prologue(const Ctx& X) {
    const int gw = X.bid * NWAVES + X.wave, NGW = X.G * NWAVES;
    LAS float* scr = (LAS float*)(X.lds + X.wave * TR_SCR);
    static_assert(8 * TR_SCR <= PH_BYTES, "transpose scratch");
    const int tq = X.G == 256 ? TAILQ : 0, per = I_L - tq;
    for (int it = gw; it < I_L + (DEPTH - 1) * per; it += NGW) {
        if (it < I_L) convert_item(X, 0, it, scr);
        else { const int j = it - I_L; convert_item(X, 1 + j / per, tq + j % per, scr); }
    }
    float* ss0 = (float*)(X.ws + WS_PART); bf16* xb = (bf16*)(X.ws + WS_XB);
    for (int m = gw; m < M; m += NGW) {
        const f32x4* xr = (const f32x4*)(X.in(0) + (size_t)m * D) + X.lane; f32x4 v[8]; float s = 0.f;
#pragma unroll
        for (int j = 0; j < 8; ++j) { v[j] = xr[64 * j]; s += (v[j].x * v[j].x + v[j].y * v[j].y) + (v[j].z * v[j].z + v[j].w * v[j].w); }
        s = wave_sum(s); if (X.lane < 32) ss0[(size_t)m * 32 + X.lane] = X.lane == 0 ? s : 0.f;
        v2u* o8 = (v2u*)(xb + (size_t)m * D) + X.lane;
#pragma unroll
        for (int j = 0; j < 8; ++j) { v2u w; w.x = pk2(v[j].x, v[j].y); w.y = pk2(v[j].z, v[j].w); o8[64 * j] = w; }
    }
    const int gt = X.bid * NTHR + X.tid, NGT = X.G * NTHR;
    float* rc = (float*)(X.ws + WS_ROPE); float* rs = rc + SEQ * 32;
    for (int i = gt; i < SEQ * 32; i += NGT) { const int pos = i >> 5, f = i & 31; double inv = 1.0; for (int e = 0; e < f; ++e) inv *= 0.7498942093324558; const float ang = (float)pos * (float)inv; float s, c; sincos_d((double)ang, s, c); rc[i] = c; rs[i] = s; }
    float* LB = (float*)(X.ws + WS_TAB); float* BT = LB + 2 * 4 * 768;
    for (int i = gt; i < 2 * 768; i += NGT) { const int dir = i / 768, c = i % 768; const float* src = dir ? X.in(8) : X.in(7);
        const float a0 = src[c], a1 = src[768 + c], a2 = src[2 * 768 + c], a3 = src[3 * 768 + c]; const float mx = fmaxf(fmaxf(a0, a1), fmaxf(a2, a3));
        const float e0 = __expf(a0 - mx), e1 = __expf(a1 - mx), e2 = __expf(a2 - mx), e3 = __expf(a3 - mx); const float inv = 1.0f / (e0 + e1 + e2 + e3);
        float* o = LB + dir * 4 * 768 + c; o[0] = 0.f; o[768] = e1 * inv; o[2 * 768] = (e1 + e2) * inv; o[3 * 768] = (e1 + e2 + e3) * inv; }
    for (int i = gt; i < 3 * 4 * 132; i += NGT) { const int g = i / (4 * 132), sl = (i / 132) % 4, rr = i % 132; const int dil = g == 0 ? 1 : (g == 1 ? 4 : 16);
        BT[i] = rr < 129 ? 1.4426950408889634f * X.in(13)[t5_bucket((rr - 64) * dil) * 12 + g * 4 + sl] : 0.f; }
}

template <int NC> struct RawRegs { v4u w[NC / 64]; };
template <int NC> __device__ __forceinline__ void raw_load(const Ctx& X, const bf16* H, size_t m0, int col, RawRegs<NC>& R) {
#pragma unroll
    for (int p = 0; p < NC / 64; ++p) { const int idx = X.tid + NTHR * p, r = idx / (NC / 8), c8 = idx % (NC / 8); R.w[p] = *(const v4u*)hptr(H, m0 + r, col + 8 * c8); }
}
template <int NC> __device__ __forceinline__ void raw_store(const Ctx& X, lptr dst, const RawRegs<NC>& R) {
#pragma unroll
    for (int p = 0; p < NC / 64; ++p) { const int idx = X.tid + NTHR * p; *(LAS v4u*)(dst + idx * 16) = R.w[p]; }
}
__device__ __forceinline__ void vt_store(const Ctx& X, lptr VT, const RawRegs<128>& R) {
#pragma unroll
    for (int p = 0; p < 2; ++p) { const int idx = X.tid + NTHR * p, r = idx >> 4, c8 = idx & 15; const v4u w = R.w[p];
        LAS unsigned short* d = (LAS unsigned short*)(VT + (8 * c8) * 144 + (r ^ (8 * (c8 & 7))) * 2);
        d[0] = (unsigned short)w.x; d[72] = (unsigned short)(w.x >> 16); d[144] = (unsigned short)w.y; d[216] = (unsigned short)(w.y >> 16);
        d[288] = (unsigned short)w.z; d[360] = (unsigned short)(w.z >> 16); d[432] = (unsigned short)w.w; d[504] = (unsigned short)(w.w >> 16); }
}
__device__ __forceinline__ bf16x8 vtfrag(lptr VT, int row, int stride_b, int kel) { return *(const LAS bf16x8*)(VT + row * stride_b + (kel ^ (8 * ((row >> 3) & 7))) * 2); }
typedef float f32x2v __attribute__((ext_vector_type(2)));
__device__ __forceinline__ f32x2v bfpair(unsigned w) { f32x2v r; r.x = __uint_as_float(w << 16); r.y = __uint_as_float(w & 0xffff0000u); return r; }
__device__ __forceinline__ f32x2v rcp2(f32x2v v) { f32x2v r; r.x = __builtin_amdgcn_rcpf(v.x); r.y = __builtin_amdgcn_rcpf(v.y); return r; }
template <int DIR, bool NEEDQ>
__device__ __forceinline__ void gla_prep(lptr rawz, lptr rawq, f32x2v lb, LAS float* seg, int kp, int rg, f32x2v (&c)[8], f32x2v (&qv)[8], f32x2v (&kv)[8]) {
    f32x2v run = (f32x2v){1.f, 1.f}; const f32x2v oml = 1.0f - lb;
#pragma unroll
    for (int i = 0; i < 8; ++i) { const int ii = DIR ? 7 - i : i; const int r = 8 * rg + ii;
        const f32x2v z = bfpair(*(const LAS unsigned*)(rawz + (r * 128 + 2 * kp) * 2)); f32x2v e; e.x = __expf(-z.x); e.y = __expf(-z.y);
        const f32x2v f = lb + oml * rcp2(e + 1.0f); run = run * f; kv[ii] = 1.0f - f; c[ii] = run;
        if (NEEDQ) qv[ii] = bfpair(*(const LAS unsigned*)(rawq + (r * 128 + 2 * kp) * 2)); }
    *(LAS f32x2v*)(seg + rg * 128 + 2 * kp) = run;
}
#define SEGT(j) (*(const LAS f32x2v*)(seg + ((DIR) ? 7 - (j) : (j)) * 128 + 2 * kp))

constexpr int L1_VT = 0, L1_KC = 128 * 144, L1_SEG = 2 * 128 * 144, L1_RAW = L1_SEG + 4096, L1_END = L1_RAW + 32768;
template <int DK, bool RET, int DIR>
__device__ __forceinline__ void gla_local_dir(const Ctx& X, int chain, int n, f32x2v lb, bf16* St, float* dd) {
    static_assert(DK == 128 && !RET, "HGRN2 only (retention has its own path)");
    const lptr VT = X.lds + L1_VT, KC = X.lds + L1_KC; LAS float* seg = (LAS float*)(X.lds + L1_SEG);
    const lptr rawz = X.lds + L1_RAW + (DIR ? 16384 : 0);
    int t_ = X.tid; asm volatile("" : "+v"(t_));
    const int kp = t_ & 63, rg = __builtin_amdgcn_readfirstlane(t_ >> 6);
    f32x2v c[8], qv[8], kv[8];
    gla_prep<DIR, false>(rawz, rawz, lb, seg, kp, rg, c, qv, kv);
    BAR_LDS();
    {
        const int sg = DIR ? 7 - rg : rg;
        f32x2v base = (f32x2v){1.f, 1.f}, all = (f32x2v){1.f, 1.f};
#pragma unroll
        for (int j = 0; j < 8; ++j) { const f32x2v T = SEGT(j); all = all * T; if (j >= sg) base = base * T; }
        f32x2v e[8];
#pragma unroll
        for (int ii = 0; ii < 8; ++ii) { f32x2v cc = c[ii]; cc.x = fmaxf(cc.x, 1e-37f); cc.y = fmaxf(cc.y, 1e-37f); e[ii] = kv[ii] * base * rcp2(cc); }
        v4u w0, w1;
        w0.x = pk2(e[0].x, e[1].x); w0.y = pk2(e[2].x, e[3].x); w0.z = pk2(e[4].x, e[5].x); w0.w = pk2(e[6].x, e[7].x);
        w1.x = pk2(e[0].y, e[1].y); w1.y = pk2(e[2].y, e[3].y); w1.z = pk2(e[4].y, e[5].y); w1.w = pk2(e[6].y, e[7].y);
        *(LAS v4u*)(KC + (2 * kp) * 144 + rg * 16) = w0; *(LAS v4u*)(KC + (2 * kp + 1) * 144 + rg * 16) = w1;
        if (rg == 0) *(f32x2v*)(dd + ((size_t)chain * NCH + n) * DK + 2 * kp) = all;
    }
    BAR_LDS();
    {
        const int fr = X.lane & 15, fq = X.lane >> 4; const int rt = X.wave; constexpr int NCT = 8;
        f32x4 acc[NCT];
#pragma unroll
        for (int t = 0; t < NCT; ++t) acc[t] = (f32x4){0.f, 0.f, 0.f, 0.f};
#pragma unroll
        for (int ks = 0; ks < 2; ++ks) { const bf16x8 a = ldsfrag(KC, 16 * rt + fr, 144, 32 * ks + 8 * fq);
#pragma unroll
            for (int t = 0; t < NCT; ++t) { const bf16x8 bb = vtfrag(VT, 16 * t + fr, 144, 32 * ks + 8 * fq); acc[t] = MFMA16(a, bb, acc[t]); } }
        bf16* Sp = St + ((size_t)chain * NCH + n) * 128 * DK;
        const lptr UT = X.lds + L1_END;
#pragma unroll
        for (int t = 0; t < NCT; ++t) { v2u w; w.x = pk2(acc[t][0], acc[t][1]); w.y = pk2(acc[t][2], acc[t][3]); *(LAS v2u*)(UT + (16 * t + fr) * 272 + (16 * rt + 4 * fq) * 2) = w; }
        BAR_LDS();
#pragma unroll
        for (int p = 0; p < 4; ++p) { const int idx = X.tid + NTHR * p, row = idx >> 4, c8 = idx & 15; *(v4u*)(Sp + (size_t)row * DK + 8 * c8) = *(const LAS v4u*)(UT + row * 272 + c8 * 16); }
    }
    BAR_LDS();
}
template <bool RET> struct LocRegs { RawRegs<128> rv, rzf, rzb; RawRegs<64> rq, rk; f32x4 c4, s4; };
template <bool RET> __device__ __forceinline__ void loc_load(const Ctx& X, const bf16* H, int r, LocRegs<RET>& R) {
    const int b = r / 768, head = (r / 128) % 6, n = r % 128; const size_t m0 = (size_t)(b * SEQ + n * CH);
    raw_load<128>(X, H, m0, (RET ? C_RV : C_HGV) + head * 128, R.rv);
    if (!RET) { raw_load<128>(X, H, m0, C_ZF + head * 128, R.rzf); raw_load<128>(X, H, m0, C_ZB + head * 128, R.rzb); }
    else { raw_load<64>(X, H, m0, C_RQ + head * 64, R.rq); raw_load<64>(X, H, m0, C_RK + head * 64, R.rk);
        const float* rc = (const float*)(X.ws + WS_ROPE) + (size_t)n * CH * 32; R.c4 = *(const f32x4*)(rc + X.tid * 4); R.s4 = *(const f32x4*)(rc + SEQ * 32 + X.tid * 4); }
}
template <int DK, bool RET>
__device__ __forceinline__ void gla_local_item(const Ctx& X, bf16* H, int l, int r, LocRegs<RET>& R, bool has_next) {
    static_assert(DK == 128 && !RET, "HGRN2 only (retention has its own path)");
    const int b = r / 768, head = (r / 128) % 6, n = r % 128;
    const float* LB = (const float*)(X.ws + WS_TAB);
    bf16* St = (bf16*)(X.ws + WS_SHG); float* dd = (float*)(X.ws + WS_DHG);
    const int kp = X.tid & 63;
    f32x2v lb0 = *(const f32x2v*)(LB + (0 * 4 + l) * 768 + head * 128 + 2 * kp), lb1 = *(const f32x2v*)(LB + (1 * 4 + l) * 768 + head * 128 + 2 * kp);
    vt_store(X, X.lds + L1_VT, R.rv); raw_store<128>(X, X.lds + L1_RAW, R.rzf); raw_store<128>(X, X.lds + L1_RAW + 16384, R.rzb);
    asm volatile("" : "+v"(lb0), "+v"(lb1)); __builtin_amdgcn_sched_barrier(0);
    if (has_next) loc_load<RET>(X, H, r + X.G, R);
    __builtin_amdgcn_sched_barrier(0);
    BAR_LDS();
    const int chain = (b * 6 + head) * 2;
    gla_local_dir<DK, RET, 0>(X, chain, n, lb0, St, dd);
    gla_local_dir<DK, RET, 1>(X, chain + 1, n, lb1, St, dd);
}

template <int DK, bool RET> struct L3 { static constexpr int SQ = (DK + 8) * 2, Q0 = 0, Q1 = 64 * SQ, KD = 96 * SQ, KH = 160 * SQ, VT = 192 * SQ, AM = VT + 128 * 144, SEG = AM + 64 * 144, RED = SEG + 4096, RAW = RED + 1024,
    END = RAW + (RET ? 16384 : 49152); };
static_assert(L3<128, false>::END <= PH_BYTES && L1_END <= PH_BYTES, "mixer LDS maps");
template <int DK, bool RET, int DIR>
__device__ __forceinline__ void gla_out_dir(const Ctx& X, int chain, int n, f32x2v lb, const bf16* St, f32x4 (&o)[4], const bf16* H, size_t m0, int zbcol) {
    static_assert(DK == 128 && !RET, "HGRN2 only (retention has its own path)");
    typedef L3<DK, RET> L; constexpr int SQ = L::SQ;
    const lptr Q0 = X.lds + L::Q0, Q1 = X.lds + L::Q1, KD = X.lds + L::KD, KH = X.lds + L::KH, VT = X.lds + L::VT, AM = X.lds + L::AM; LAS float* seg = (LAS float*)(X.lds + L::SEG);
    const lptr rawz = X.lds + L::RAW + (DIR ? 16384 : 0), rawq = X.lds + L::RAW + 32768;
    int t_ = X.tid; asm volatile("" : "+v"(t_));
    const int kp = t_ & 63, rg = __builtin_amdgcn_readfirstlane(t_ >> 6);
    const int fr = X.lane & 15, fq = X.lane >> 4;
    const int tb = X.wave & 3, vh = X.wave >> 2;
    SP_BEGIN()
    bf16x8 sf[DK / 32][4];
    const bf16* Sp = St + ((size_t)chain * NCH + n) * 128 * DK;
#pragma unroll
    for (int ks = 0; ks < 2; ++ks)
#pragma unroll
        for (int vt = 0; vt < 4; ++vt) sf[ks][vt] = *(const bf16x8*)(Sp + (size_t)(64 * vh + 16 * vt + fr) * DK + 32 * ks + 8 * fq);
    {
        f32x2v c[8], qv[8], kv[8];
        gla_prep<DIR, true>(rawz, rawq, lb, seg, kp, rg, c, qv, kv);
        BAR_LDS(); SP_END(21);
#pragma unroll
        for (int ks = 2; ks < 4; ++ks)
#pragma unroll
            for (int vt = 0; vt < 4; ++vt) sf[ks][vt] = *(const bf16x8*)(Sp + (size_t)(64 * vh + 16 * vt + fr) * DK + 32 * ks + 8 * fq);
        {
            const int sg = DIR ? 7 - rg : rg, ss = sg >> 2, hq = sg & 3;
            const f32x2v T0 = SEGT(0), T1 = SEGT(1), T2 = SEGT(2), T3 = SEGT(3), sub0 = (T0 * T1) * (T2 * T3);
            f32x2v pq = (f32x2v){1.f, 1.f};
#pragma unroll
            for (int j = 0; j < 3; ++j) if (j < hq) pq = pq * SEGT(4 * ss + j);
#pragma unroll
            for (int ii = 0; ii < 8; ++ii) { const int r = 8 * rg + ii; f32x2v cp = c[ii] * pq;
                const f32x2v q0 = qv[ii] * cp; cp.x = fmaxf(cp.x, 1e-37f); cp.y = fmaxf(cp.y, 1e-37f); const f32x2v kd = kv[ii] * rcp2(cp);
                *(LAS unsigned*)(KD + r * SQ + kp * 4) = pk2(kd.x, kd.y);
                *(LAS unsigned*)(Q0 + r * SQ + kp * 4) = pk2(q0.x, q0.y);
                if (ss) { const f32x2v q1 = q0 * sub0; *(LAS unsigned*)(Q1 + (DIR ? r : r - 32) * SQ + kp * 4) = pk2(q1.x, q1.y); }
                else { const f32x2v kh = kd * sub0; *(LAS unsigned*)(KH + (DIR ? r - 32 : r) * SQ + kp * 4) = pk2(kh.x, kh.y); }
                if (ii & 1) __builtin_amdgcn_sched_barrier(0); }
        }
    }
    BAR_LDS(); SP_END(22);
    RawRegs<128> zbr; if (!RET && DIR == 0) raw_load<128>(X, H, m0, zbcol, zbr);
#pragma unroll
    for (int bi = 0; bi < 2; ++bi) { const int blk = 2 * X.wave + bi, I = blk >> 2, J = blk & 3; const int sI = DIR ? 3 - I : I, sJ = DIR ? 3 - J : J;
        v2u w; w.x = 0u; w.y = 0u;
        if (sJ <= sI) { const bool same = (sI >> 1) == (sJ >> 1); const lptr KS = same ? KD : KH; const int krow = same ? 16 * J + fr : (DIR ? 16 * J + fr - 32 : 16 * J + fr);
            f32x4 acc = (f32x4){0.f, 0.f, 0.f, 0.f};
#pragma unroll
            for (int ks = 0; ks < DK / 32; ++ks) { const bf16x8 a = ldsfrag(KS, krow, SQ, 32 * ks + 8 * fq); const bf16x8 bb = ldsfrag(Q0, 16 * I + fr, SQ, 32 * ks + 8 * fq); acc = MFMA16(a, bb, acc); }
            if (sI == sJ) {
#pragma unroll
                for (int j = 0; j < 4; ++j) { const int jl = 4 * fq + j; const bool keep = DIR ? (jl >= fr) : (jl <= fr); if (!keep) acc[j] = 0.f; } }
            w.x = pk2(acc[0], acc[1]); w.y = pk2(acc[2], acc[3]); }
        *(LAS v2u*)(AM + (16 * I + fr) * 144 + (16 * J + 4 * fq) * 2) = w; }
    BAR_LDS(); SP_END(23);
    {
        const int stb = DIR ? 3 - tb : tb; const int r = 16 * tb + fr;
#pragma unroll
        for (int ks = 0; ks < 2; ++ks) { const bf16x8 bb = ldsfrag(AM, r, 144, 32 * ks + 8 * fq);
#pragma unroll
            for (int vt = 0; vt < 4; ++vt) { const bf16x8 a = vtfrag(VT, 64 * vh + 16 * vt + fr, 144, 32 * ks + 8 * fq); o[vt] = MFMA16(a, bb, o[vt]); } }
        const lptr QI = (stb >> 1) ? Q1 : Q0; const int qrow = (stb >> 1) ? (DIR ? r : r - 32) : r;
#pragma unroll
        for (int ks = 0; ks < DK / 32; ++ks) { const bf16x8 bb = ldsfrag(QI, qrow, SQ, 32 * ks + 8 * fq);
#pragma unroll
            for (int vt = 0; vt < 4; ++vt) o[vt] = MFMA16(sf[ks][vt], bb, o[vt]); }
    }
    if (!RET && DIR == 0) raw_store<128>(X, X.lds + L::RAW + 16384, zbr);
    BAR_LDS(); SP_END(24);
}
template <bool RET> struct OutRegs { RawRegs<128> rv, rzf, rzb, rq; RawRegs<64> rq6, rk6; v2u gw[4]; };
template <bool RET> __device__ __forceinline__ void out_load(const Ctx& X, const bf16* H, int r, OutRegs<RET>& R) {
    const int b = r / 768, head = (r / 128) % 6, n = r % 128; const size_t m0 = (size_t)(b * SEQ + n * CH);
    const int fr = X.lane & 15, fq = X.lane >> 4, tb = X.wave & 3, vh = X.wave >> 2; const size_t m = m0 + 16 * tb + fr; const int gcol = (RET ? C_RG : C_HGG) + head * 128;
    raw_load<128>(X, H, m0, (RET ? C_RV : C_HGV) + head * 128, R.rv);
    if (!RET) { raw_load<128>(X, H, m0, C_ZF + head * 128, R.rzf); raw_load<128>(X, H, m0, C_HGQ + head * 128, R.rq); }
    else { raw_load<64>(X, H, m0, C_RQ + head * 64, R.rq6); raw_load<64>(X, H, m0, C_RK + head * 64, R.rk6); }
#pragma unroll
    for (int t = 0; t < 4; ++t) if (RET) R.gw[t] = *(const v2u*)hptr(H, m, gcol + 64 * vh + 16 * t + 4 * fq);
}
template <int DK, bool RET>
__device__ __forceinline__ void gla_out_item(const Ctx& X, const bf16* H, bf16* Y, int l, int r, OutRegs<RET>& R, bool has_next) {
    typedef L3<DK, RET> L;
    const int b = r / 768, head = (r / 128) % 6, n = r % 128;
    const float* LB = (const float*)(X.ws + WS_TAB);
    const bf16* St = (const bf16*)(X.ws + (RET ? WS_SRT : WS_SHG));
    const int fr = X.lane & 15, fq = X.lane >> 4, tb = X.wave & 3, vh = X.wave >> 2;
    const size_t m = (size_t)(b * SEQ + n * CH + 16 * tb + fr);
    const int ycol = (RET ? 768 : 0) + head * 128;
    SP_BEGIN()
    const int kp = X.tid & 63; f32x2v lb0 = (f32x2v){0.f, 0.f}, lb1 = lb0;
    v2u gw[4];
    if (!RET) {
        lb0 = *(const f32x2v*)(LB + (0 * 4 + l) * 768 + head * 128 + 2 * kp); lb1 = *(const f32x2v*)(LB + (1 * 4 + l) * 768 + head * 128 + 2 * kp);
        vt_store(X, X.lds + L::VT, R.rv); raw_store<128>(X, X.lds + L::RAW, R.rzf); raw_store<128>(X, X.lds + L::RAW + 32768, R.rq);
    } else {
        vt_store(X, X.lds + L::VT, R.rv); raw_store<64>(X, X.lds + L::RAW, R.rq6); raw_store<64>(X, X.lds + L::RAW + 8192, R.rk6);
    }
    asm volatile("" : "+v"(lb0), "+v"(lb1)); __builtin_amdgcn_sched_barrier(0);
    if (has_next) out_load<RET>(X, H, r + X.G, R);
    __builtin_amdgcn_sched_barrier(0);
    BAR_LDS(); SP_END(20);
    const int chain = (b * 6 + head) * 2;
    f32x4 o[4];
#pragma unroll
    for (int t = 0; t < 4; ++t) o[t] = (f32x4){0.f, 0.f, 0.f, 0.f};
    const size_t m0 = (size_t)(b * SEQ + n * CH);
    gla_out_dir<DK, RET, 0>(X, chain, n, lb0, St, o, H, m0, C_ZB + head * 128);
#pragma unroll
    for (int t = 0; t < 4; ++t) gw[t] = *(const v2u*)hptr(H, m, C_HGG + head * 128 + 64 * vh + 16 * t + 4 * fq);
    gla_out_dir<DK, RET, 1>(X, chain + 1, n, lb1, St, o, H, m0, 0);
    LAS float* red = (LAS float*)(X.lds + L::RED);
    float mu = 0.f;
    if (RET) {
        float s = 0.f;
#pragma unroll
        for (int t = 0; t < 4; ++t) s += (o[t][0] + o[t][1]) + (o[t][2] + o[t][3]);
        s += __shfl_xor(s, 16); s += __shfl_xor(s, 32);
        if (fq == 0) red[128 + X.wave * 16 + fr] = s;
        BAR_LDS();
        mu = (red[128 + X.wave * 16 + fr] + red[128 + (X.wave ^ 4) * 16 + fr]) * (1.0f / 128.0f);
    }
    float s2 = 0.f;
#pragma unroll
    for (int t = 0; t < 4; ++t)
#pragma unroll
        for (int j = 0; j < 4; ++j) { const float dlt = o[t][j] - mu; s2 += dlt * dlt; }
    s2 += __shfl_xor(s2, 16); s2 += __shfl_xor(s2, 32);
    if (fq == 0) red[X.wave * 16 + fr] = s2;
    BAR_LDS();
    const float rstd = __builtin_amdgcn_rsqf((red[X.wave * 16 + fr] + red[(X.wave ^ 4) * 16 + fr]) * (1.0f / 128.0f) + EPS);
    const float* gn = X.in(RET ? 10 : 9) + l * 768 + head * 128;
#pragma unroll
    for (int t = 0; t < 4; ++t) { const int v = 64 * vh + 16 * t + 4 * fq; const f32x4 g4 = *(const f32x4*)(gn + v);
        const float g0 = bf2f(gw[t].x & 0xffffu), g1 = bf2f(gw[t].x >> 16), g2 = bf2f(gw[t].y & 0xffffu), g3 = bf2f(gw[t].y >> 16);
        const float y0 = (o[t][0] - mu) * rstd * g4.x * (g0 * __builtin_amdgcn_rcpf(1.0f + __expf(-g0))), y1 = (o[t][1] - mu) * rstd * g4.y * (g1 * __builtin_amdgcn_rcpf(1.0f + __expf(-g1)));
        const float y2 = (o[t][2] - mu) * rstd * g4.z * (g2 * __builtin_amdgcn_rcpf(1.0f + __expf(-g2))), y3 = (o[t][3] - mu) * rstd * g4.w * (g3 * __builtin_amdgcn_rcpf(1.0f + __expf(-g3)));
        v2u w; w.x = pk2(y0, y1); w.y = pk2(y2, y3); *(LAS v2u*)(X.lds + L::Q0 + (16 * tb + fr) * 272 + v * 2) = w; }
    BAR_LDS();
    { const size_t mrow = (size_t)(b * SEQ + n * CH); int t_ = X.tid; asm volatile("" : "+v"(t_));
#pragma unroll
        for (int p = 0; p < 2; ++p) { const int idx = t_ + NTHR * p, row = idx >> 4, c8 = idx & 15; *(v4u*)(Y + (mrow + row) * D + ycol + 8 * c8) = *(const LAS v4u*)(X.lds + L::Q0 + row * 272 + c8 * 16); } }
    BAR_LDS();
}

constexpr int R1_VT = 0, R1_KC0 = 128 * 144, R1_KC1 = R1_KC0 + 64 * 144, R1_RAW = R1_KC1 + 64 * 144, R1_END = R1_RAW + 32768;
__device__ __forceinline__ void ret_local_item(const Ctx& X, bf16* H, int r, LocRegs<true>& R, bool has_next) {
    const int b = r / 768, head = (r / 128) % 6, n = r % 128; const size_t m0 = (size_t)(b * SEQ + n * CH);
    bf16* St = (bf16*)(X.ws + WS_SRT); float* dd = (float*)(X.ws + WS_DRT);
    const lptr VT = X.lds + R1_VT, KC0 = X.lds + R1_KC0, KC1 = X.lds + R1_KC1, rawq = X.lds + R1_RAW, rawk = X.lds + R1_RAW + 8192; LAS float* cs = (LAS float*)(X.lds + R1_RAW + 16384); LAS float* sn = (LAS float*)(X.lds + R1_RAW + 24576);
    const float l2f = __log2f(1.0f - exp2f(-5.0f - (float)head)), l2b = __log2f(1.0f - exp2f(-5.0f - (float)(5 - head)));
    const int chain = (b * 6 + head) * 2;
    vt_store(X, VT, R.rv); raw_store<64>(X, rawq, R.rq); raw_store<64>(X, rawk, R.rk); *(LAS f32x4*)(cs + X.tid * 4) = R.c4; *(LAS f32x4*)(sn + X.tid * 4) = R.s4;
    __builtin_amdgcn_sched_barrier(0);
    if (has_next) loc_load<true>(X, H, r + X.G, R);
    __builtin_amdgcn_sched_barrier(0);
    BAR_LDS();
    const int k = X.tid & 63, rq = X.tid >> 6, k2 = k & 31; const bool active = X.tid < 256; float qr[16], kr[16];
    if (active) {
#pragma unroll
        for (int ii = 0; ii < 16; ++ii) { const int rr = 16 * rq + ii; const float c_ = cs[rr * 32 + k2], s_ = sn[rr * 32 + k2];
            const float q1 = bf2f(*(const LAS unsigned short*)(rawq + (rr * 64 + k2) * 2)), q2 = bf2f(*(const LAS unsigned short*)(rawq + (rr * 64 + 32 + k2) * 2));
            const float k1 = bf2f(*(const LAS unsigned short*)(rawk + (rr * 64 + k2) * 2)), k2v = bf2f(*(const LAS unsigned short*)(rawk + (rr * 64 + 32 + k2) * 2));
            qr[ii] = (k < 32) ? (q1 * c_ - q2 * s_) : (q1 * s_ + q2 * c_); kr[ii] = 0.125f * ((k < 32) ? (k1 * c_ - k2v * s_) : (k1 * s_ + k2v * c_)); } }
    BAR_LDS();
    if (active) {
        float ef[16], eb[16];
#pragma unroll
        for (int ii = 0; ii < 16; ++ii) { const int rr = 16 * rq + ii; *(LAS unsigned short*)(rawq + (rr * 64 + k) * 2) = f2bf(qr[ii]); *(LAS unsigned short*)(rawk + (rr * 64 + k) * 2) = f2bf(kr[ii]);
            ef[ii] = kr[ii] * __builtin_amdgcn_exp2f((float)(63 - rr) * l2f); eb[ii] = kr[ii] * __builtin_amdgcn_exp2f((float)rr * l2b); }
        v4u w0, w1;
        w0.x = pk2(ef[0], ef[1]); w0.y = pk2(ef[2], ef[3]); w0.z = pk2(ef[4], ef[5]); w0.w = pk2(ef[6], ef[7]); w1.x = pk2(ef[8], ef[9]); w1.y = pk2(ef[10], ef[11]); w1.z = pk2(ef[12], ef[13]); w1.w = pk2(ef[14], ef[15]);
        *(LAS v4u*)(KC0 + k * 144 + rq * 32) = w0; *(LAS v4u*)(KC0 + k * 144 + rq * 32 + 16) = w1;
        w0.x = pk2(eb[0], eb[1]); w0.y = pk2(eb[2], eb[3]); w0.z = pk2(eb[4], eb[5]); w0.w = pk2(eb[6], eb[7]); w1.x = pk2(eb[8], eb[9]); w1.y = pk2(eb[10], eb[11]); w1.z = pk2(eb[12], eb[13]); w1.w = pk2(eb[14], eb[15]);
        *(LAS v4u*)(KC1 + k * 144 + rq * 32) = w0; *(LAS v4u*)(KC1 + k * 144 + rq * 32 + 16) = w1;
        if (rq == 0) { dd[((size_t)chain * NCH + n) * 64 + k] = __builtin_amdgcn_exp2f(64.0f * l2f); dd[((size_t)(chain + 1) * NCH + n) * 64 + k] = __builtin_amdgcn_exp2f(64.0f * l2b); }
    }
    BAR_LDS();
    { const int rr = X.tid >> 3, c8 = X.tid & 7; *(v4u*)hptr(H, m0 + rr, C_RQ + head * 64 + 8 * c8) = *(const LAS v4u*)(rawq + X.tid * 16); *(v4u*)hptr(H, m0 + rr, C_RK + head * 64 + 8 * c8) = *(const LAS v4u*)(rawk + X.tid * 16); }
    {
        const int fr = X.lane & 15, fq = X.lane >> 4, rt = X.wave & 3, ct0 = (X.wave >> 2) * 4;
#pragma unroll
        for (int dir = 0; dir < 2; ++dir) { const lptr KC = dir ? KC1 : KC0; f32x4 acc[4];
#pragma unroll
            for (int t = 0; t < 4; ++t) acc[t] = (f32x4){0.f, 0.f, 0.f, 0.f};
#pragma unroll
            for (int ks = 0; ks < 2; ++ks) { const bf16x8 a = ldsfrag(KC, 16 * rt + fr, 144, 32 * ks + 8 * fq);
#pragma unroll
                for (int t = 0; t < 4; ++t) { const bf16x8 bb = vtfrag(VT, 16 * (ct0 + t) + fr, 144, 32 * ks + 8 * fq); acc[t] = MFMA16(a, bb, acc[t]); } }
            const lptr UT = X.lds + R1_END + dir * 128 * 144;
#pragma unroll
            for (int t = 0; t < 4; ++t) { v2u w; w.x = pk2(acc[t][0], acc[t][1]); w.y = pk2(acc[t][2], acc[t][3]); *(LAS v2u*)(UT + (16 * (ct0 + t) + fr) * 144 + (16 * rt + 4 * fq) * 2) = w; } }
    }
    BAR_LDS();
#pragma unroll
    for (int dir = 0; dir < 2; ++dir) { bf16* Sp = St + ((size_t)(chain + dir) * NCH + n) * 128 * 64; const lptr UT = X.lds + R1_END + dir * 128 * 144;
#pragma unroll
        for (int p = 0; p < 2; ++p) { const int idx = X.tid + NTHR * p, row = idx >> 3, c8 = idx & 7; *(v4u*)(Sp + (size_t)row * 64 + 8 * c8) = *(const LAS v4u*)(UT + row * 144 + c8 * 16); } }
    BAR_LDS();
}
constexpr int R3_Q = 0, R3_K = 64 * 144, R3_VT = 2 * 64 * 144, R3_AM = R3_VT + 128 * 144, R3_RED = R3_AM + 64 * 144, R3_END = R3_RED + 1024;
__device__ __forceinline__ void ret_out_item(const Ctx& X, const bf16* H, bf16* Y, int l, int r, OutRegs<true>& R, bool has_next) {
    const int b = r / 768, head = (r / 128) % 6, n = r % 128;
    const bf16* St = (const bf16*)(X.ws + WS_SRT);
    const lptr Q = X.lds + R3_Q, K = X.lds + R3_K, VT = X.lds + R3_VT, AM = X.lds + R3_AM; LAS float* red = (LAS float*)(X.lds + R3_RED);
    const int fr = X.lane & 15, fq = X.lane >> 4, tb = X.wave & 3, vh = X.wave >> 2;
    const size_t m = (size_t)(b * SEQ + n * CH + 16 * tb + fr); const int ycol = 768 + head * 128;
    const float l2f = __log2f(1.0f - exp2f(-5.0f - (float)head)), l2b = __log2f(1.0f - exp2f(-5.0f - (float)(5 - head)));
    const int chain = (b * 6 + head) * 2;
    v2u gw[4];
#pragma unroll
    for (int t = 0; t < 4; ++t) gw[t] = R.gw[t];
    vt_store(X, VT, R.rv);
    { const int rr = X.tid >> 3, c8 = X.tid & 7; *(LAS v4u*)(Q + rr * 144 + c8 * 16) = R.rq6.w[0]; *(LAS v4u*)(K + rr * 144 + c8 * 16) = R.rk6.w[0]; }
    asm volatile("" : "+v"(gw[0]), "+v"(gw[1]), "+v"(gw[2]), "+v"(gw[3])); __builtin_amdgcn_sched_barrier(0);
    if (has_next) out_load<true>(X, H, r + X.G, R);
    bf16x8 sff[2][4], sfb[2][4];
    { const bf16* Sf = St + ((size_t)chain * NCH + n) * 128 * 64; const bf16* Sb = St + ((size_t)(chain + 1) * NCH + n) * 128 * 64;
#pragma unroll
        for (int ks = 0; ks < 2; ++ks)
#pragma unroll
            for (int vt = 0; vt < 4; ++vt) { const size_t o_ = (size_t)(64 * vh + 16 * vt + fr) * 64 + 32 * ks + 8 * fq; sff[ks][vt] = *(const bf16x8*)(Sf + o_); sfb[ks][vt] = *(const bf16x8*)(Sb + o_); } }
    __builtin_amdgcn_sched_barrier(0);
    BAR_LDS();
#pragma unroll
    for (int bi = 0; bi < 2; ++bi) { const int blk = 2 * X.wave + bi, I = blk >> 2, J = blk & 3;
        f32x4 acc = (f32x4){0.f, 0.f, 0.f, 0.f};
#pragma unroll
        for (int ks = 0; ks < 2; ++ks) { const bf16x8 a = ldsfrag(K, 16 * J + fr, 144, 32 * ks + 8 * fq); const bf16x8 bb = ldsfrag(Q, 16 * I + fr, 144, 32 * ks + 8 * fq); acc = MFMA16(a, bb, acc); }
#pragma unroll
        for (int j = 0; j < 4; ++j) { const int d = (16 * I + fr) - (16 * J + 4 * fq + j); const float dec = d > 0 ? __builtin_amdgcn_exp2f((float)d * l2f) : (d < 0 ? __builtin_amdgcn_exp2f((float)(-d) * l2b) : 2.0f); acc[j] *= dec; }
        v2u w; w.x = pk2(acc[0], acc[1]); w.y = pk2(acc[2], acc[3]); *(LAS v2u*)(AM + (16 * I + fr) * 144 + (16 * J + 4 * fq) * 2) = w; }
    BAR_LDS();
    f32x4 o[4], of[4], ob[4];
#pragma unroll
    for (int t = 0; t < 4; ++t) { o[t] = (f32x4){0.f, 0.f, 0.f, 0.f}; of[t] = o[t]; ob[t] = o[t]; }
    { const int rr = 16 * tb + fr;
#pragma unroll
        for (int ks = 0; ks < 2; ++ks) { const bf16x8 bb = ldsfrag(AM, rr, 144, 32 * ks + 8 * fq); const bf16x8 bq = ldsfrag(Q, rr, 144, 32 * ks + 8 * fq);
#pragma unroll
            for (int vt = 0; vt < 4; ++vt) { const bf16x8 a = vtfrag(VT, 64 * vh + 16 * vt + fr, 144, 32 * ks + 8 * fq); o[vt] = MFMA16(a, bb, o[vt]); of[vt] = MFMA16(sff[ks][vt], bq, of[vt]); ob[vt] = MFMA16(sfb[ks][vt], bq, ob[vt]); } }
        const float cf = __builtin_amdgcn_exp2f((float)(rr + 1) * l2f), cb = __builtin_amdgcn_exp2f((float)(64 - rr) * l2b);
#pragma unroll
        for (int t = 0; t < 4; ++t) o[t] = o[t] + of[t] * cf + ob[t] * cb; }
    float s = 0.f;
#pragma unroll
    for (int t = 0; t < 4; ++t) s += (o[t][0] + o[t][1]) + (o[t][2] + o[t][3]);
    s += __shfl_xor(s, 16); s += __shfl_xor(s, 32);
    if (fq == 0) red[128 + X.wave * 16 + fr] = s;
    BAR_LDS();
    const float mu = (red[128 + X.wave * 16 + fr] + red[128 + (X.wave ^ 4) * 16 + fr]) * (1.0f / 128.0f);
    float s2 = 0.f;
#pragma unroll
    for (int t = 0; t < 4; ++t)
#pragma unroll
        for (int j = 0; j < 4; ++j) { const float dlt = o[t][j] - mu; s2 += dlt * dlt; }
    s2 += __shfl_xor(s2, 16); s2 += __shfl_xor(s2, 32);
    if (fq == 0) red[X.wave * 16 + fr] = s2;
    BAR_LDS();
    const float rstd = __builtin_amdgcn_rsqf((red[X.wave * 16 + fr] + red[(X.wave ^ 4) * 16 + fr]) * (1.0f / 128.0f) + EPS);
    const float* gn = X.in(10) + l * 768 + head * 128;
#pragma unroll
    for (int t = 0; t < 4; ++t) { const int v = 64 * vh + 16 * t + 4 * fq; const f32x4 g4 = *(const f32x4*)(gn + v);
        const float g0 = bf2f(gw[t].x & 0xffffu), g1 = bf2f(gw[t].x >> 16), g2 = bf2f(gw[t].y & 0xffffu), g3 = bf2f(gw[t].y >> 16);
        const float y0 = (o[t][0] - mu) * rstd * g4.x * (g0 * __builtin_amdgcn_rcpf(1.0f + __expf(-g0))), y1 = (o[t][1] - mu) * rstd * g4.y * (g1 * __builtin_amdgcn_rcpf(1.0f + __expf(-g1)));
        const float y2 = (o[t][2] - mu) * rstd * g4.z * (g2 * __builtin_amdgcn_rcpf(1.0f + __expf(-g2))), y3 = (o[t][3] - mu) * rstd * g4.w * (g3 * __builtin_amdgcn_rcpf(1.0f + __expf(-g3)));
        v2u w; w.x = pk2(y0, y1); w.y = pk2(y2, y3); *(LAS v2u*)(VT + (16 * tb + fr) * 272 + v * 2) = w; }
    BAR_LDS();
    { const size_t mrow = (size_t)(b * SEQ + n * CH);
#pragma unroll
        for (int p = 0; p < 2; ++p) { const int idx = X.tid + NTHR * p, row = idx >> 4, c8 = idx & 15; *(v4u*)(Y + (mrow + row) * D + ycol + 8 * c8) = *(const LAS v4u*)(VT + row * 272 + c8 * 16); } }
    BAR_LDS();
}

struct ScanBatch { v4u u[4]; f32x4 d0[4], d1[4]; };
__device__ __forceinline__ void scan_load(ScanBatch& B, const bf16* p, const float* dp, int cstride, int dstride, int dir, int s0) {
#pragma unroll
    for (int j = 0; j < 4; ++j) { const int n = dir ? NCH - 1 - (s0 + j) : s0 + j; B.u[j] = *(const v4u*)(p + (size_t)n * cstride); B.d0[j] = *(const f32x4*)(dp + (size_t)n * dstride); B.d1[j] = *(const f32x4*)(dp + (size_t)n * dstride + 4); }
}
__device__ __forceinline__ void scan_step(const ScanBatch& B, float (&S)[8], bf16* p, int cstride, int dir, int s0) {
#pragma unroll
    for (int j = 0; j < 4; ++j) { const int n = dir ? NCH - 1 - (s0 + j) : s0 + j;
        v4u w; w.x = pk2(S[0], S[1]); w.y = pk2(S[2], S[3]); w.z = pk2(S[4], S[5]); w.w = pk2(S[6], S[7]); *(v4u*)(p + (size_t)n * cstride) = w;
        S[0] = B.d0[j].x * S[0] + bf2f(B.u[j].x & 0xffffu); S[1] = B.d0[j].y * S[1] + bf2f(B.u[j].x >> 16); S[2] = B.d0[j].z * S[2] + bf2f(B.u[j].y & 0xffffu); S[3] = B.d0[j].w * S[3] + bf2f(B.u[j].y >> 16);
        S[4] = B.d1[j].x * S[4] + bf2f(B.u[j].z & 0xffffu); S[5] = B.d1[j].y * S[5] + bf2f(B.u[j].z >> 16); S[6] = B.d1[j].z * S[6] + bf2f(B.u[j].w & 0xffffu); S[7] = B.d1[j].w * S[7] + bf2f(B.u[j].w >> 16); }
}
__device__ __forceinline__ void scan_phase(const Ctx& X) {
    constexpr int T_HG = 24 * 2048, T_RT = 24 * 1024;
    for (int task = X.bid * NTHR + X.tid; task < T_HG + T_RT; task += X.G * NTHR) {
        bf16* p; const float* dp; int cstride, dstride, dir;
        if (task < T_HG) { const int chain = task / 2048, e = task % 2048; p = (bf16*)(X.ws + WS_SHG) + (size_t)chain * NCH * 16384 + e * 8; dp = (const float*)(X.ws + WS_DHG) + (size_t)chain * NCH * 128 + (e & 15) * 8; cstride = 16384; dstride = 128; dir = chain & 1; }
        else { const int t2 = task - T_HG, chain = t2 / 1024, e = t2 % 1024; p = (bf16*)(X.ws + WS_SRT) + (size_t)chain * NCH * 8192 + e * 8; dp = (const float*)(X.ws + WS_DRT) + (size_t)chain * NCH * 64 + (e & 7) * 8; cstride = 8192; dstride = 64; dir = chain & 1; }
        float S[8];
#pragma unroll
        for (int i = 0; i < 8; ++i) S[i] = 0.f;
        ScanBatch A, B;
        scan_load(A, p, dp, cstride, dstride, dir, 0);
        for (int s0 = 0; s0 < NCH; s0 += 8) {
            scan_load(B, p, dp, cstride, dstride, dir, s0 + 4);
            scan_step(A, S, p, cstride, dir, s0);
            if (s0 + 8 < NCH) scan_load(A, p, dp, cstride, dstride, dir, s0 + 8);
            scan_step(B, S, p, cstride, dir, s0 + 4);
        }
    }
}

constexpr int DA_KN = 0, DA_VT = 192 * 272, DA_P = DA_VT + 128 * 400, DA_BIAS = DA_P + 64 * 400, DA_MX = DA_BIAS + 1024, DA_LX = DA_MX + 512, DA_END = DA_LX + 512;
static_assert(DA_END <= PH_BYTES, "dilated-attention LDS map");
struct DaBlk { v4u kw[2], vw[2]; };
struct DaRun { int b, g, slot, dil, rho, nb0, nbper, qcol; };
__device__ __forceinline__ DaRun da_decode(int run) {
    DaRun I; I.b = run / 384; const int rem = run % 384; I.g = rem / 128; const int rem2 = rem % 128; I.slot = rem2 / 32; const int rb = rem2 % 32;
    I.dil = I.g == 0 ? 1 : (I.g == 1 ? 4 : 16); I.nbper = 128 / I.dil; const int rpr = I.nbper / 4; I.rho = rb / rpr; I.nb0 = 4 * (rb % rpr); I.qcol = C_DIL + (3 * I.g) * 512 + I.slot * 128; return I;
}
__device__ __forceinline__ void da_blk_load(const Ctx& X, const bf16* H, const DaRun& I, int kb, DaBlk& R) {
    const bool ok = kb >= 0 && kb < I.nbper; const size_t mb = (size_t)I.b * SEQ; const int kcol = I.qcol + 512, vcol = I.qcol + 1024;
#pragma unroll
    for (int p = 0; p < 2; ++p) { const int r = (X.tid >> 4) + 32 * p, c8 = X.tid & 15; R.kw[p] = (v4u){0u, 0u, 0u, 0u}; R.vw[p] = (v4u){0u, 0u, 0u, 0u};
        if (ok) { const size_t mr = mb + (size_t)((64 * kb + r) * I.dil + I.rho); R.kw[p] = *(const v4u*)hptr(H, mr, kcol + 8 * c8); R.vw[p] = *(const v4u*)hptr(H, mr, vcol + 8 * c8); } }
}
__device__ __forceinline__ void da_blk_stage(const Ctx& X, const float* kg, int kb, const DaBlk& R) {
    const lptr KN = X.lds + DA_KN, VT = X.lds + DA_VT; const int slot = ((kb % 3) + 3) % 3;
#pragma unroll
    for (int p = 0; p < 2; ++p) { const int row = slot * 64 + (X.tid >> 4) + 32 * p, c8 = X.tid & 15; const v4u kw = R.kw[p], vw = R.vw[p];
        float f[8]; f[0] = bf2f(kw.x & 0xffffu); f[1] = bf2f(kw.x >> 16); f[2] = bf2f(kw.y & 0xffffu); f[3] = bf2f(kw.y >> 16); f[4] = bf2f(kw.z & 0xffffu); f[5] = bf2f(kw.z >> 16); f[6] = bf2f(kw.w & 0xffffu); f[7] = bf2f(kw.w >> 16);
        float s = 0.f;
#pragma unroll
        for (int e = 0; e < 8; ++e) s += f[e] * f[e];
        s += __shfl_xor(s, 1); s += __shfl_xor(s, 2); s += __shfl_xor(s, 4); s += __shfl_xor(s, 8);
        const float sc = __builtin_amdgcn_rsqf(s * (1.0f / 128.0f) + EPS); const f32x4 g0 = *(const f32x4*)(kg + 8 * c8), g1 = *(const f32x4*)(kg + 8 * c8 + 4);
        v4u o; o.x = pk2(f[0] * sc * g0.x, f[1] * sc * g0.y); o.y = pk2(f[2] * sc * g0.z, f[3] * sc * g0.w); o.z = pk2(f[4] * sc * g1.x, f[5] * sc * g1.y); o.w = pk2(f[6] * sc * g1.z, f[7] * sc * g1.w);
        *(LAS v4u*)(KN + row * 272 + c8 * 16) = o;
        LAS unsigned short* d = (LAS unsigned short*)(VT + (8 * c8) * 400 + (row ^ (8 * (c8 & 7))) * 2);
        d[0] = (unsigned short)vw.x; d[200] = (unsigned short)(vw.x >> 16); d[400] = (unsigned short)vw.y; d[600] = (unsigned short)(vw.y >> 16);
        d[800] = (unsigned short)vw.z; d[1000] = (unsigned short)(vw.z >> 16); d[1200] = (unsigned short)vw.w; d[1400] = (unsigned short)(vw.w >> 16); }
}
__device__ __forceinline__ void da_q_load(const Ctx& X, const bf16* H, const DaRun& I, int nb, v4u (&qw)[4]) {
    const int fr = X.lane & 15, fq = X.lane >> 4, qb = X.wave & 3; const size_t m = (size_t)I.b * SEQ + (size_t)((64 * nb + 16 * qb + fr) * I.dil + I.rho);
#pragma unroll
    for (int ks = 0; ks < 4; ++ks) qw[ks] = *(const v4u*)hptr(H, m, I.qcol + 32 * ks + 8 * fq);
}
__device__ __forceinline__ void dil_run(const Ctx& X, bf16* H, int l, int run) {
    const DaRun I = da_decode(run); const int b = I.b, g = I.g, slot = I.slot, dil = I.dil, rho = I.rho, qcol = I.qcol, Ls = SEQ / I.dil;
    const lptr KN = X.lds + DA_KN, VT = X.lds + DA_VT, P = X.lds + DA_P; LAS float* bias = (LAS float*)(X.lds + DA_BIAS); LAS float* mx = (LAS float*)(X.lds + DA_MX); LAS float* lx = (LAS float*)(X.lds + DA_LX);
    const float* qg = X.in(11) + l * 128; const float* kg = X.in(12) + l * 128; asm volatile("" : "+s"(qg), "+s"(kg));
    const int fr = X.lane & 15, fq = X.lane >> 4, qb = X.wave & 3, kh = X.wave >> 2; const int qi = 16 * qb + fr;
    SP_BEGIN()
    {
        DaBlk B0, B1, B2; da_blk_load(X, H, I, I.nb0 - 1, B0); da_blk_load(X, H, I, I.nb0, B1); da_blk_load(X, H, I, I.nb0 + 1, B2);
        if (X.tid < 256) bias[X.tid] = (X.tid >= 63 && X.tid <= 191) ? ((const float*)(X.ws + WS_TAB) + 2 * 4 * 768)[(g * 4 + slot) * 132 + X.tid - 63] : -1e30f;
        da_blk_stage(X, kg, I.nb0 - 1, B0); da_blk_stage(X, kg, I.nb0, B1); da_blk_stage(X, kg, I.nb0 + 1, B2);
    }
    v4u qw_[4]; da_q_load(X, H, I, I.nb0, qw_);
    for (int i = 0; i < 4; ++i) {
        const int nb = I.nb0 + i; const size_t qtok = (size_t)((64 * nb + qi) * dil + rho);
        bf16x8 qf[4];
        {
            float s = 0.f;
#pragma unroll
            for (int ks = 0; ks < 4; ++ks) { const v4u qw = qw_[ks];
                const float a0 = bf2f(qw.x & 0xffffu), a1 = bf2f(qw.x >> 16), a2 = bf2f(qw.y & 0xffffu), a3 = bf2f(qw.y >> 16), a4 = bf2f(qw.z & 0xffffu), a5 = bf2f(qw.z >> 16), a6 = bf2f(qw.w & 0xffffu), a7 = bf2f(qw.w >> 16);
                s += (a0 * a0 + a1 * a1) + (a2 * a2 + a3 * a3) + (a4 * a4 + a5 * a5) + (a6 * a6 + a7 * a7); }
            s += __shfl_xor(s, 16); s += __shfl_xor(s, 32);
            const float sc = (0.08838834764831845f * 1.4426950408889634f) * __builtin_amdgcn_rsqf(s * (1.0f / 128.0f) + EPS);
#pragma unroll
            for (int ks = 0; ks < 4; ++ks) { const v4u qw = qw_[ks]; const f32x4 g0 = *(const f32x4*)(qg + 32 * ks + 8 * fq), g1 = *(const f32x4*)(qg + 32 * ks + 8 * fq + 4);
                v4u o; o.x = pk2(bf2f(qw.x & 0xffffu) * sc * g0.x, bf2f(qw.x >> 16) * sc * g0.y); o.y = pk2(bf2f(qw.y & 0xffffu) * sc * g0.z, bf2f(qw.y >> 16) * sc * g0.w);
                o.z = pk2(bf2f(qw.z & 0xffffu) * sc * g1.x, bf2f(qw.z >> 16) * sc * g1.y); o.w = pk2(bf2f(qw.w & 0xffffu) * sc * g1.z, bf2f(qw.w >> 16) * sc * g1.w);
                qf[ks] = __builtin_bit_cast(bf16x8, o); }
        }
        asm volatile("" : "+v"(qf[0]), "+v"(qf[1]), "+v"(qf[2]), "+v"(qf[3]));
        __builtin_amdgcn_sched_barrier(0);
        DaBlk Bn; if (i < 3) { da_blk_load(X, H, I, nb + 2, Bn); da_q_load(X, H, I, nb + 1, qw_); }
        __builtin_amdgcn_sched_barrier(0);
        BAR_LDS(); SP_END(16);
        f32x4 sc[6]; float mloc = -1e30f;
        const LAS float* tb = bias + (96 * kh + 4 * fq - qi + 63);
        const bool edge_lo = nb == 0, edge_hi = nb == I.nbper - 1;
#pragma unroll
        for (int t = 0; t < 6; ++t) { f32x4 acc = (f32x4){0.f, 0.f, 0.f, 0.f}; const int rrow = (64 * nb + 128 + 96 * kh + 16 * t) % 192;
#pragma unroll
            for (int ks = 0; ks < 4; ++ks) { const bf16x8 a = ldsfrag(KN, rrow + fr, 272, 32 * ks + 8 * fq); acc = MFMA16(a, qf[ks], acc); }
#pragma unroll
            for (int j = 0; j < 4; ++j) acc[j] += tb[16 * t + j];
            if (edge_lo || edge_hi) {
#pragma unroll
                for (int j = 0; j < 4; ++j) { const int kj = 64 * nb - 64 + 96 * kh + 16 * t + 4 * fq + j; if (kj < 0 || kj >= Ls) acc[j] = -1e30f; } }
            mloc = fmaxf(fmaxf(mloc, fmaxf(acc[0], acc[1])), fmaxf(acc[2], acc[3]));
            sc[t] = acc; }
        mloc = fmaxf(mloc, __shfl_xor(mloc, 16)); mloc = fmaxf(mloc, __shfl_xor(mloc, 32));
        if (fq == 0) mx[kh * 64 + qi] = mloc;
        BAR_LDS(); SP_END(17);
        const float mrow = fmaxf(mx[qi], mx[64 + qi]); float lloc = 0.f;
#pragma unroll
        for (int t = 0; t < 6; ++t) { float p[4];
#pragma unroll
            for (int j = 0; j < 4; ++j) { p[j] = __builtin_amdgcn_exp2f(sc[t][j] - mrow); lloc += p[j]; }
            v2u w; w.x = pk2(p[0], p[1]); w.y = pk2(p[2], p[3]); *(LAS v2u*)(P + qi * 400 + (96 * kh + 16 * t + 4 * fq) * 2) = w; }
        lloc += __shfl_xor(lloc, 16); lloc += __shfl_xor(lloc, 32);
        if (fq == 0) lx[kh * 64 + qi] = lloc;
        BAR_LDS(); SP_END(18);
        const int dh = kh; const float lrow = lx[qi] + lx[64 + qi]; const float inv = __builtin_amdgcn_rcpf(lrow);
        f32x4 oo[4];
#pragma unroll
        for (int t = 0; t < 4; ++t) oo[t] = (f32x4){0.f, 0.f, 0.f, 0.f};
#pragma unroll
        for (int ks = 0; ks < 6; ++ks) { const bf16x8 bb = ldsfrag(P, qi, 400, 32 * ks + 8 * fq); const int rcol = (64 * nb + 128 + 32 * ks) % 192;
#pragma unroll
            for (int t = 0; t < 4; ++t) { const bf16x8 a = vtfrag(VT, 64 * dh + 16 * t + fr, 400, rcol + 8 * fq); oo[t] = MFMA16(a, bb, oo[t]); } }
        BAR_LDS();
#pragma unroll
        for (int t = 0; t < 4; ++t) { v2u w; w.x = pk2(oo[t][0] * inv, oo[t][1] * inv); w.y = pk2(oo[t][2] * inv, oo[t][3] * inv); *(LAS v2u*)(P + qi * 272 + (64 * dh + 16 * t + 4 * fq) * 2) = w; }
        if (dh == 0 && fq == 0) ((float*)(X.ws + WS_LSE))[((size_t)g * M + (size_t)b * SEQ + qtok) * 4 + slot] = 0.6931471805599453f * (mrow + __log2f(lrow));
        BAR_LDS(); SP_END(19);
#pragma unroll
        for (int p = 0; p < 2; ++p) { const int idx = X.tid + NTHR * p, row = idx >> 4, c8 = idx & 15; *(v4u*)hptr(H, (size_t)b * SEQ + (size_t)((64 * nb + row) * dil + rho), qcol + 8 * c8) = *(const LAS v4u*)(P + row * 272 + c8 * 16); }
        if (i < 3) da_blk_stage(X, kg, nb + 2, Bn);
    }
    BAR_LDS();
}
__device__ __forceinline__ void dil_merge_item(const Ctx& X, const bf16* H, bf16* Y, int it) {
    const float* LSE = (const float*)(X.ws + WS_LSE);
#pragma unroll
    for (int p = 0; p < 8; ++p) { const int idx = X.tid + NTHR * p; const int tk = idx >> 6, slot = (idx >> 4) & 3, c8 = idx & 15; const size_t m = (size_t)it * 64 + tk;
        const float l0 = LSE[(0 * (size_t)M + m) * 4 + slot], l1 = LSE[(1 * (size_t)M + m) * 4 + slot], l2 = LSE[(2 * (size_t)M + m) * 4 + slot]; const float mxl = fmaxf(l0, fmaxf(l1, l2));
        const float e0 = __expf(l0 - mxl), e1 = __expf(l1 - mxl), e2 = __expf(l2 - mxl), inv = __builtin_amdgcn_rcpf(e0 + e1 + e2); const float w[3] = {e0 * inv, e1 * inv, e2 * inv};
        float acc[8];
#pragma unroll
        for (int e = 0; e < 8; ++e) acc[e] = 0.f;
#pragma unroll
        for (int g = 0; g < 3; ++g) { const v4u ow = *(const v4u*)hptr(H, m, C_DIL + (3 * g) * 512 + slot * 128 + 8 * c8);
            acc[0] += w[g] * bf2f(ow.x & 0xffffu); acc[1] += w[g] * bf2f(ow.x >> 16); acc[2] += w[g] * bf2f(ow.y & 0xffffu); acc[3] += w[g] * bf2f(ow.y >> 16);
            acc[4] += w[g] * bf2f(ow.z & 0xffffu); acc[5] += w[g] * bf2f(ow.z >> 16); acc[6] += w[g] * bf2f(ow.w & 0xffffu); acc[7] += w[g] * bf2f(ow.w >> 16); }
        v4u o; o.x = pk2(acc[0], acc[1]); o.y = pk2(acc[2], acc[3]); o.z = pk2(acc[4], acc[5]); o.w = pk2(acc[6], acc[7]);
        *(v4u*)(Y + m * D + 1536 + slot * 128 + 8 * c8) = o; }
}

#ifndef MK_N_LAUNCHES
#define MK_N_LAUNCHES 1
#endif
__global__ void __launch_bounds__(NTHR, 2) mega_fwd(Args args) {
    extern __shared__ __attribute__((aligned(16))) unsigned char lds_raw[];
    const lptr lds = (lptr)lds_raw;
    volatile LAS unsigned* MISC = (volatile LAS unsigned*)(lds + MISC_OFF);
    for (int u = threadIdx.x; u < (LDS_BYTES - LDSCTL_OFF) / 4; u += NTHR) ((LAS unsigned*)(lds + LDSCTL_OFF))[u] = 0u;
    __syncthreads();
    XcdBarrier bar; bar.bar = (unsigned*)(args.ws + WS_CTL) + CW_BAR; bar.x = 0; bar.st = nullptr;
    if (MK_N_LAUNCHES == 1) bar = xcd_barrier_post((unsigned*)(args.ws + WS_CTL) + CW_BAR, MISC + 8);
    const int lo = args.ph_lo, hi = args.ph_hi;
#ifndef PROBE_K
#define PROBE_K 1
#endif
#define PB_BEGIN(bit) unsigned long long pt0_ = 0; if (PROBE_MASK & (1 << (bit))) pt0_ = __builtin_amdgcn_s_memrealtime();
#define PB_END(bit) if ((PROBE_MASK & (1 << 15)) && ((226 >> (bit)) & 1)) { const unsigned long long t1_ = __builtin_amdgcn_s_memrealtime(); while (__builtin_amdgcn_s_memrealtime() - t1_ < 10000ull) __builtin_amdgcn_s_sleep(8); } \
    if (PROBE_MASK & (1 << (bit))) { const unsigned long long t1_ = __builtin_amdgcn_s_memrealtime(), dt_ = (t1_ - pt0_) * PROBE_K; while (__builtin_amdgcn_s_memrealtime() - t1_ < dt_) __builtin_amdgcn_s_sleep(8); }
#define IN(k) (lo <= (k) && (k) < hi)
#define SEAM(k) do { if (IN(k) && IN((k) + 1)) { xcd_barrier(bar); if (PROBE_MASK & (1 << 14)) xcd_barrier(bar); } } while (0)
#define PHASE_CTX() const Ctx X = mkctx(lds); bf16* const XB = (bf16*)(X.ws + WS_XB); bf16* const Y = (bf16*)(X.ws + WS_Y); bf16* const H = (bf16*)(X.ws + WS_H); float* const ss_mix = (float*)(X.ws + WS_PART); \
        float* const ss_mix_next = ss_mix; float* const ss_mlp = ss_mix + (size_t)M * 32; (void)XB; (void)Y; (void)H; (void)ss_mix; (void)ss_mix_next; (void)ss_mlp;

    #ifndef NO_PRO
    if (IN(0)) { PB_BEGIN(0) const Ctx X = mkctx(lds); prologue(X); PB_END(0) }
#endif
    SEAM(0);
    for (int l = 0; l < DEPTH; ++l) {
        const int pb = 1 + 7 * l;
#if !defined(NO_GEMM) && !defined(NO_GA)
        if (IN(pb + 0)) { PB_BEGIN(1) PHASE_CTX(); pg8::Gemm g{XB, (const bf16*)(X.ws + WS_WIN) + (size_t)l * INW * D, M, INW, D}; pg8::StaticOrder S; S.init(M, INW, X.G, X.bid);
            pg8::EpiScaleBf16<0, true> E{H, M, ss_mix, (LAS float*)(X.lds + 131072)}; pg8::gemm_phase<pg8::EpiScaleBf16<0, true>, pg8::StaticOrder, true, true>(X.lds, g, S, E);
            if (X.G == 256 && X.bid >= 128 && l + 1 < DEPTH) {
                LAS float* scr = (LAS float*)(X.lds + X.wave * TR_SCR);
                for (int r = (X.bid - 128) * NWAVES + X.wave; r < TAILQ; r += 128 * NWAVES) convert_item(X, l + 1, r, scr); }
            PB_END(1) }
#endif
        SEAM(pb + 0);
#ifndef NO_MIX1
        if (IN(pb + 1)) { PB_BEGIN(2)
#ifndef NO_DA
            { PB_BEGIN(8) PHASE_CTX(); const int vcu = (X.G % 8 == 0) ? (X.bid % 8) * (X.G / 8) + X.bid / 8 : X.bid;
              for (int run = vcu; run < 768; run += X.G) dil_run(X, H, l, run); PB_END(8) }
#endif
#ifndef NO_HG1
            { PB_BEGIN(9) PHASE_CTX(); LocRegs<false> R; loc_load<false>(X, H, X.bid, R); for (int r = X.bid; r < 1536; r += X.G) gla_local_item<128, false>(X, H, l, r, R, r + X.G < 1536); PB_END(9) }
#endif
#ifndef NO_RT1
            { PB_BEGIN(10) PHASE_CTX(); LocRegs<true> R; loc_load<true>(X, H, X.bid, R); for (int r = X.bid; r < 1536; r += X.G) ret_local_item(X, H, r, R, r + X.G < 1536); PB_END(10) }
#endif
        PB_END(2) }
#endif
        SEAM(pb + 1);
#ifndef NO_SCAN
        if (IN(pb + 2)) { PB_BEGIN(3) const Ctx X = mkctx(lds); scan_phase(X); PB_END(3) }
#endif
        SEAM(pb + 2);
#ifndef NO_MIX2
        if (IN(pb + 3)) { PB_BEGIN(4)
#ifndef NO_HG2
            { PB_BEGIN(11) PHASE_CTX(); OutRegs<false> R; out_load<false>(X, H, X.bid, R); for (int r = X.bid; r < 1536; r += X.G) gla_out_item<128, false>(X, H, Y, l, r, R, r + X.G < 1536); PB_END(11) }
#endif
#ifndef NO_RT2
            { PB_BEGIN(12) PHASE_CTX(); OutRegs<true> R; out_load<true>(X, H, X.bid, R); for (int r = X.bid; r < 1536; r += X.G) ret_out_item(X, H, Y, l, r, R, r + X.G < 1536); PB_END(12) }
#endif
#ifndef NO_DM
            { PHASE_CTX(); for (int it = X.bid; it < 256; it += X.G) dil_merge_item(X, H, Y, it); }
#endif
        PB_END(4) }
#endif
        SEAM(pb + 3);
#if !defined(NO_GEMM) && !defined(NO_GE)
        if (IN(pb + 4)) { PB_BEGIN(5) PHASE_CTX(); pg8::Gemm g{Y, (const bf16*)(X.ws + WS_WOUT) + (size_t)l * D * D, M, D, D}; pg8::StaticOrder S; S.init(M, D, X.G, X.bid);
            pg8::EpiResid<false> E{XB, nullptr, ss_mlp}; pg8::gemm_phase<pg8::EpiResid<false>, pg8::StaticOrder, true, true>(X.lds, g, S, E); PB_END(5) }
#endif
        SEAM(pb + 4);
#if !defined(NO_GEMM) && !defined(NO_GF)
        if (IN(pb + 5)) { PB_BEGIN(6) PHASE_CTX(); pg8::Gemm g{XB, (const bf16*)(X.ws + WS_WUP) + (size_t)l * FF * D, M, FF, D}; pg8::StaticOrder S; S.init(M, FF, X.G, X.bid);
            pg8::EpiScaleBf16<1> E{H, FF, ss_mlp, (LAS float*)(X.lds + 131072)}; pg8::gemm_phase<pg8::EpiScaleBf16<1>, pg8::StaticOrder, true, true>(X.lds, g, S, E); PB_END(6) }
#endif
        SEAM(pb + 5);
#if !defined(NO_GEMM) && !defined(NO_GG)
        if (IN(pb + 6)) { PB_BEGIN(7) PHASE_CTX(); pg8::Gemm g{H, (const bf16*)(X.ws + WS_WDN) + (size_t)l * D * FF, M, D, FF}; pg8::StaticOrder S; S.init(M, D, X.G, X.bid);
            if (l < DEPTH - 1) { pg8::EpiResid<false> E{XB, nullptr, ss_mix_next}; pg8::gemm_phase<pg8::EpiResid<false>, pg8::StaticOrder, true, true>(X.lds, g, S, E); }
            else { pg8::EpiResid<true> E{XB, X.out(), nullptr}; pg8::gemm_phase<pg8::EpiResid<true>, pg8::StaticOrder, true, true>(X.lds, g, S, E); }
            PB_END(7) }
#endif
        SEAM(pb + 6);
    }
#undef IN
#undef SEAM
}

extern "C" void kernel_launch(void* const* d_in, const int* in_sizes, int n_in, void* d_out, int out_size, void* d_ws, size_t ws_size, hipStream_t stream) {
    static int grid = 0;
    if (grid == 0) {
        if (n_in != 14 || in_sizes[0] != M * D || out_size != M * D || ws_size < WS_END) { fprintf(stderr, "kernel_launch: unexpected problem (n_in %d, in0 %d, out %d, ws %zu < %zu); nothing launched\n", n_in, n_in > 0 ? in_sizes[0] : -1, out_size, ws_size, (size_t)WS_END); grid = -1; return; }
        int dev = 0, cus = 0, per_cu = 0;
        if (hipGetDevice(&dev) != hipSuccess || hipDeviceGetAttribute(&cus, hipDeviceAttributeMultiprocessorCount, dev) != hipSuccess) { grid = -1; return; }
        if (hipFuncSetAttribute((const void*)mega_fwd, hipFuncAttributeMaxDynamicSharedMemorySize, LDS_BYTES) != hipSuccess) { fprintf(stderr, "kernel_launch: hipFuncSetAttribute failed\n"); grid = -1; return; }
        if (hipOccupancyMaxActiveBlocksPerMultiprocessor(&per_cu, (const void*)mega_fwd, NTHR, LDS_BYTES) != hipSuccess || per_cu < 1) fprintf(stderr, "kernel_launch: occupancy query reports %d workgroups per CU\n", per_cu);
        (void)hipGetLastError();
        grid = cus;
    }
    if (grid < 0) return;
    (void)hipMemsetAsync((char*)d_ws + WS_CTL, 0, CTL_ZERO_BYTES, stream);
    Args a{};
    for (int i = 0; i < 14; ++i) a.in[i] = (const float*)d_in[i];
    a.out = (float*)d_out; a.ws = (unsigned char*)d_ws;
    if (MK_N_LAUNCHES == 1) { a.ph_lo = 0; a.ph_hi = NPHASE; hipLaunchKernelGGL(mega_fwd, dim3(grid), dim3(NTHR), LDS_BYTES, stream, a); }
    else for (int p = 0; p < NPHASE; ++p) { a.ph_lo = p; a.ph_hi = p + 1; hipLaunchKernelGGL(mega_fwd, dim3(grid), dim3(NTHR), LDS_BYTES, stream, a); }
}
```

```cpp
#include <hip/hip_runtime.h>
#include <cstdio>
#include <cstdint>
namespace pg8 {
#define PG8_LAS __attribute__((address_space(3)))
typedef unsigned short bf16_t;
typedef short bf16x8 __attribute__((ext_vector_type(8)));
typedef float f32x4 __attribute__((ext_vector_type(4)));
typedef unsigned u32x4 __attribute__((ext_vector_type(4)));
constexpr int BM = 256, BK = 64, HALF = 128, HTB = HALF * BK * 2  , STAGE_BYTES = 8 * HTB, NXCD = 8, WGM = 4;

__host__ __device__ __forceinline__ int lds_byte(int r, int c) { const int st = (r >> 4) * 2 + (c >> 5), rr = r & 15, cc = c & 31, ob = rr * 64 + cc * 2; return st * 1024 + (ob ^ (((ob >> 9) & 1) << 5)); }
__host__ __device__ __forceinline__ void stage_rc(int b, int& R, int& C) { const int st = b / 1024, sb = b % 1024, swz = sb ^ (((sb >> 9) & 1) << 5); R = (st >> 1) * 16 + swz / 64; C = (st & 1) * 32 + (swz % 64) / 2; }
__host__ __device__ __forceinline__ int perm32(int rho) { const int n = rho >> 4, i = rho & 15; return 8 * (i >> 2) + 4 * n + (i & 3); }

struct Unit { int pm, pn; };
struct Gemm { const bf16_t* A; const bf16_t* Bt; int M, N, K; };

struct StaticOrder {
    int nM, nN, nwg, G, c;
    __host__ __device__ void init(int M, int N, int G_, int c_) { nM = M / BM; nN = N / BM; nwg = nM * nN; G = G_; c = c_; }
    __host__ __device__ bool next(int i, Unit& u) const {
        const long L = (long)i * G + c; if (L >= nwg) return false;
        int wgid = (int)L; { const int q = nwg / NXCD, r = nwg % NXCD, xcd = wgid % NXCD, off = wgid / NXCD; wgid = (xcd < r ? xcd * (q + 1) : r * (q + 1) + (xcd - r) * q) + off; }
        const int nig = WGM * nN, gid = wgid / nig, fm = gid * WGM, gsz = (nM - fm) < WGM ? (nM - fm) : WGM;
        u.pm = fm + ((wgid % nig) % gsz); u.pn = (wgid % nig) / gsz; return true;
    }
    __device__ __forceinline__ void a_ready(const Unit&) const {}
    __device__ __forceinline__ void done(const Unit&) const {}
};

typedef float f32x2 __attribute__((ext_vector_type(2))); typedef __bf16 bf16x2_t __attribute__((ext_vector_type(2)));
__device__ __forceinline__ unsigned cvt_pk_bf16(float lo, float hi) { f32x2 v = {lo, hi}; bf16x2_t b = __builtin_convertvector(v, bf16x2_t); return __builtin_bit_cast(unsigned, b); }

template <int ACT, bool BLK = false> struct EpiScaleBf16 {
    static constexpr bool PERM = true, AFTER_DRAIN = false, HAS_PREP = true;
    bf16_t* O; int ldc; const float* ss; PG8_LAS float* rtab;
    __device__ __forceinline__ void prep(const Unit& u, int tid, int buf) const {
        if (tid < BM) { const float* p = ss + (size_t)(u.pm * BM + tid) * 32; float sq = 0.f;
#pragma unroll
            for (int i = 0; i < 8; ++i) { const f32x4 v = *(const f32x4*)(p + 4 * i); sq += (v[0] + v[1]) + (v[2] + v[3]); }
            rtab[buf * BM + tid] = __builtin_amdgcn_rsqf(sq * (1.0f / 2048.0f) + 1e-6f); }
    }
    __device__ __forceinline__ void operator()(const f32x4 (&acc)[2][2][4][2], const Unit& u, int wr, int wc, int fr, int fq, int buf) const {
        const int row0 = u.pm * BM + wr * 64 + fr; const int col0 = u.pn * BM + wc * 32 + 8 * fq;
#pragma unroll
        for (int ai = 0; ai < 2; ++ai)
#pragma unroll
            for (int m = 0; m < 4; ++m) { const int row = row0 + ai * HALF + m * 16;
                const float sc = rtab[buf * BM + wr * 64 + fr + ai * HALF + m * 16];
                bf16_t* rowp = BLK ? O + ((size_t)(2 * u.pn) * ldc + row) * 128 + wc * 32 + 8 * fq : O + (size_t)row * ldc + col0;
#pragma unroll
                for (int bj = 0; bj < 2; ++bj) { f32x4 v0 = acc[ai][bj][m][0] * sc, v1 = acc[ai][bj][m][1] * sc;
                    if (ACT == 1) {
#pragma unroll
                        for (int e = 0; e < 4; ++e) { float a = v0[e] > 0.f ? v0[e] : 0.f; v0[e] = a * a; float b = v1[e] > 0.f ? v1[e] : 0.f; v1[e] = b * b; } }
                    u32x4 w; w.x = cvt_pk_bf16(v0[0], v0[1]); w.y = cvt_pk_bf16(v0[2], v0[3]); w.z = cvt_pk_bf16(v1[0], v1[1]); w.w = cvt_pk_bf16(v1[2], v1[3]);
                    *(u32x4*)(rowp + (BLK ? (size_t)bj * ldc * 128 : (size_t)bj * HALF)) = w; } }
    }
};
template <bool FINAL> struct EpiResid {
    static constexpr bool PERM = true, AFTER_DRAIN = false, HAS_PREP = false;
    bf16_t* xb; float* out; float* ssn;
    __device__ __forceinline__ void operator()(const f32x4 (&acc)[2][2][4][2], const Unit& u, int wr, int wc, int fr, int fq) const {
        const int col0 = u.pn * BM + wc * 32 + 8 * fq;
#pragma unroll
        for (int ai = 0; ai < 2; ++ai)
#pragma unroll
            for (int m = 0; m < 4; ++m) { const int row = u.pm * BM + ai * HALF + wr * 64 + m * 16 + fr; const size_t off = (size_t)row * 2048 + col0; float sq = 0.f;
#pragma unroll
                for (int bj = 0; bj < 2; ++bj) { const size_t o2 = off + bj * HALF; const u32x4 xw = *(const u32x4*)(xb + o2);
                    f32x4 x0, x1; x0[0] = __uint_as_float(xw.x << 16); x0[1] = __uint_as_float(xw.x & 0xffff0000u); x0[2] = __uint_as_float(xw.y << 16); x0[3] = __uint_as_float(xw.y & 0xffff0000u);
                    x1[0] = __uint_as_float(xw.z << 16); x1[1] = __uint_as_float(xw.z & 0xffff0000u); x1[2] = __uint_as_float(xw.w << 16); x1[3] = __uint_as_float(xw.w & 0xffff0000u);
                    x0 = x0 + acc[ai][bj][m][0]; x1 = x1 + acc[ai][bj][m][1];
                    if (FINAL) { *(f32x4*)(out + o2) = x0; *(f32x4*)(out + o2 + 4) = x1; }
                    else { u32x4 w; w.x = cvt_pk_bf16(x0[0], x0[1]); w.y = cvt_pk_bf16(x0[2], x0[3]); w.z = cvt_pk_bf16(x1[0], x1[1]); w.w = cvt_pk_bf16(x1[2], x1[3]); *(u32x4*)(xb + o2) = w; }
                    sq += ((x0[0] * x0[0] + x0[1] * x0[1]) + (x0[2] * x0[2] + x0[3] * x0[3])) + ((x1[0] * x1[0] + x1[1] * x1[1]) + (x1[2] * x1[2] + x1[3] * x1[3])); }
                sq += __shfl_xor(sq, 16); sq += __shfl_xor(sq, 32);
                if (!FINAL && fq == 0) ssn[(size_t)row * 32 + u.pn * 4 + wc] = sq; }
    }
};
template <class Epi, class Sched, bool ALIGN_EPI = false, bool SP2 = false>
__device__ __forceinline__ void gemm_phase(PG8_LAS unsigned char* lds, const Gemm g, const Sched& S, const Epi& E) {
    int tid_ = threadIdx.x; asm volatile("" : "+v"(tid_));
    const int tid = tid_, wid = __builtin_amdgcn_readfirstlane(tid >> 6), lane = tid & 63, wr = wid >> 2, wc = wid & 3, fr = lane & 15, fq = lane >> 4;
    const int K = g.K, nt = K / BK;
    unsigned voffA[2], voffB[2];
#pragma unroll
    for (int i = 0; i < 2; ++i) { int R, C; stage_rc(tid * 16 + i * 8192, R, C); const int Rb = Epi::PERM ? ((R & ~31) + perm32(R & 31)) : R;
        voffA[i] = (unsigned)(R * K + C) * 2u; voffB[i] = (unsigned)(Rb * K + C) * 2u; }
    const size_t kstep = (size_t)(BK * 2);
    const size_t hstep = (size_t)HALF * K * 2;
    const size_t tstep = 2 * hstep;
    const unsigned ldsw = (unsigned)wid * 1024u;
    const int aoff = lds_byte(wr * 64 + fr, fq * 8), boff = lds_byte(wc * 32 + fr, fq * 8);
#define PG8_SA(b, h) (((b) * 2 + (h)) * HTB)
#define PG8_SB(b, h) ((4 + (b) * 2 + (h)) * HTB)
#define PG8_STAGE(bufoff, gbase, voff) do { _Pragma("unroll") for (int _i = 0; _i < 2; ++_i) \
        __builtin_amdgcn_global_load_lds((const unsigned*)((const char*)(gbase) + (voff)[_i]), (PG8_LAS unsigned*)(lds + (bufoff) + ldsw + _i * 8192), 16, 0, 0); } while (0)
#define PG8_LDA(dst, b, h) do { _Pragma("unroll") for (int m = 0; m < 4; ++m) _Pragma("unroll") for (int k = 0; k < 2; ++k) dst[m][k] = *(const PG8_LAS bf16x8*)(lds + PG8_SA(b, h) + aoff + m * 2048 + k * 1024); } while (0)
#define PG8_LDB(dst, b, h) do { _Pragma("unroll") for (int n = 0; n < 2; ++n) _Pragma("unroll") for (int k = 0; k < 2; ++k) dst[n][k] = *(const PG8_LAS bf16x8*)(lds + PG8_SB(b, h) + boff + n * 2048 + k * 1024); } while (0)
#define PG8_MMA(ai, bj, At, Bt) do { __builtin_amdgcn_s_setprio(1); _Pragma("unroll") for (int m = 0; m < 4; ++m) _Pragma("unroll") for (int n = 0; n < 2; ++n) _Pragma("unroll") for (int k = 0; k < 2; ++k) \
        acc[ai][bj][m][n] = __builtin_amdgcn_mfma_f32_16x16x32_bf16(Bt[n][k], At[m][k], acc[ai][bj][m][n], 0, 0, 0); __builtin_amdgcn_s_setprio(0); } while (0)
#define PG8_WAIT_V(n) asm volatile("s_waitcnt vmcnt(" #n ")" ::: "memory")
#define PG8_WAIT_L(n) asm volatile("s_waitcnt lgkmcnt(" #n ")" ::: "memory")
#define PG8_BAR __builtin_amdgcn_s_barrier()
#define PG8_SCHED __builtin_amdgcn_sched_barrier(0)
    Unit cur, nxt; int ui = 0;
    if (!S.next(0, cur)) return;
    f32x4 acc[2][2][4][2];
#pragma unroll
    for (int a = 0; a < 2; ++a)
#pragma unroll
        for (int b = 0; b < 2; ++b)
#pragma unroll
            for (int m = 0; m < 4; ++m)
#pragma unroll
                for (int n = 0; n < 2; ++n) acc[a][b][m][n] = (f32x4){0.f, 0.f, 0.f, 0.f};
    bf16x8 At[4][2], B0[2][2], B1[2][2];
    const char* cA = (const char*)g.A + (size_t)cur.pm * tstep; const char* cB = (const char*)g.Bt + (size_t)cur.pn * tstep;
    S.a_ready(cur);
    int prep_pm = cur.pm, prep_gen = 0; if constexpr (Epi::HAS_PREP) E.prep(cur, tid, 0);
    if constexpr (SP2) {
        PG8_STAGE(PG8_SB(0, 0), cB, voffB); PG8_STAGE(PG8_SB(0, 1), cB + hstep, voffB); PG8_STAGE(PG8_SA(0, 0), cA, voffA); PG8_STAGE(PG8_SA(0, 1), cA + hstep, voffA);
        if (wr == 1) PG8_BAR;
        PG8_WAIT_V(2); PG8_BAR;
        PG8_STAGE(PG8_SB(1, 0), cB + kstep, voffB); PG8_STAGE(PG8_SA(1, 0), cA + kstep, voffA); PG8_STAGE(PG8_SB(1, 1), cB + hstep + kstep, voffB);
        PG8_WAIT_V(6); PG8_BAR;
    } else {
        PG8_STAGE(PG8_SB(0, 0), cB, voffB); PG8_STAGE(PG8_SA(0, 0), cA, voffA); PG8_STAGE(PG8_SB(0, 1), cB + hstep, voffB); PG8_STAGE(PG8_SA(0, 1), cA + hstep, voffA);
        if (wr == 1) PG8_BAR;
        PG8_WAIT_V(4); PG8_BAR;
        PG8_STAGE(PG8_SB(1, 0), cB + kstep, voffB); PG8_STAGE(PG8_SA(1, 0), cA + kstep, voffA); PG8_STAGE(PG8_SB(1, 1), cB + hstep + kstep, voffB);
        PG8_WAIT_V(6); PG8_BAR;
    }
    for (;;) {
        const bool has_next = S.next(ui + 1, nxt);
        const char* nA = has_next ? (const char*)g.A + (size_t)nxt.pm * tstep : cA; const char* nB = has_next ? (const char*)g.Bt + (size_t)nxt.pn * tstep : cB;
        for (int t = 0; t < nt; t += 2) {
            const bool last = (t == nt - 2);
            const char* a1 = cA + (size_t)(t + 1) * kstep;
            const char* a2 = last ? nA : cA + (size_t)(t + 2) * kstep; const char* b2 = last ? nB : cB + (size_t)(t + 2) * kstep;
            const char* a3 = a2 + kstep; const char* b3 = b2 + kstep;
            if (last && has_next) S.a_ready(nxt);
            if constexpr (SP2) {
            PG8_LDB(B0, 0, 0); PG8_LDB(B1, 0, 1); PG8_SCHED; PG8_LDA(At, 0, 0); PG8_STAGE(PG8_SA(1, 1), a1 + hstep, voffA);
            PG8_WAIT_V(8); PG8_WAIT_L(0); PG8_BAR; PG8_MMA(0, 0, At, B0); PG8_MMA(0, 1, At, B1); PG8_BAR; PG8_SCHED;
            PG8_LDA(At, 0, 1); PG8_STAGE(PG8_SB(0, 0), b2, voffB); PG8_STAGE(PG8_SB(0, 1), b2 + hstep, voffB); PG8_STAGE(PG8_SA(0, 0), a2, voffA);
            PG8_WAIT_V(8); PG8_WAIT_L(0); PG8_BAR; PG8_MMA(1, 0, At, B0); PG8_MMA(1, 1, At, B1); PG8_BAR; PG8_SCHED;
            PG8_LDB(B0, 1, 0); PG8_LDB(B1, 1, 1); PG8_SCHED; PG8_LDA(At, 1, 0); PG8_STAGE(PG8_SA(0, 1), a2 + hstep, voffA);
            PG8_WAIT_V(8); PG8_WAIT_L(0); PG8_BAR; PG8_MMA(0, 0, At, B0); PG8_MMA(0, 1, At, B1); PG8_BAR; PG8_SCHED;
            PG8_LDA(At, 1, 1); PG8_STAGE(PG8_SB(1, 0), b3, voffB); PG8_STAGE(PG8_SB(1, 1), b3 + hstep, voffB); PG8_STAGE(PG8_SA(1, 0), a3, voffA);
            PG8_WAIT_V(8); PG8_WAIT_L(0); PG8_BAR; PG8_MMA(1, 0, At, B0); PG8_MMA(1, 1, At, B1); PG8_BAR; PG8_SCHED;
            } else {
            PG8_LDB(B0, 0, 0); PG8_SCHED; PG8_LDA(At, 0, 0); PG8_STAGE(PG8_SA(1, 1), a1 + hstep, voffA);
            PG8_WAIT_L(8); PG8_BAR; PG8_WAIT_L(0); PG8_MMA(0, 0, At, B0); PG8_BAR; PG8_SCHED;
            PG8_LDB(B1, 0, 1); PG8_STAGE(PG8_SB(0, 0), b2, voffB);
            PG8_BAR; PG8_WAIT_L(0); PG8_MMA(0, 1, At, B1); PG8_BAR;
            PG8_LDA(At, 0, 1); PG8_STAGE(PG8_SA(0, 0), a2, voffA);
            PG8_BAR; PG8_WAIT_L(0); PG8_MMA(1, 0, At, B0); PG8_BAR; PG8_SCHED;
            PG8_STAGE(PG8_SB(0, 1), b2 + hstep, voffB);
            PG8_WAIT_V(6); PG8_BAR; PG8_MMA(1, 1, At, B1); PG8_BAR;
            PG8_LDB(B0, 1, 0); PG8_SCHED; PG8_LDA(At, 1, 0); PG8_STAGE(PG8_SA(0, 1), a2 + hstep, voffA);
            PG8_WAIT_L(8); PG8_BAR; PG8_WAIT_L(0); PG8_MMA(0, 0, At, B0); PG8_BAR; PG8_SCHED;
            PG8_LDB(B1, 1, 1); PG8_STAGE(PG8_SB(1, 0), b3, voffB);
            PG8_BAR; PG8_WAIT_L(0); PG8_MMA(0, 1, At, B1); PG8_BAR;
            PG8_LDA(At, 1, 1); PG8_STAGE(PG8_SA(1, 0), a3, voffA);
            PG8_BAR; PG8_WAIT_L(0); PG8_MMA(1, 0, At, B0); PG8_BAR; PG8_SCHED;
            PG8_STAGE(PG8_SB(1, 1), b3 + hstep, voffB);
            PG8_WAIT_V(6); PG8_BAR; PG8_MMA(1, 1, At, B1); PG8_BAR;
            }
        }
        if constexpr (ALIGN_EPI) { if (wr == 0) PG8_BAR; }
        if constexpr (!Epi::AFTER_DRAIN) { if constexpr (Epi::HAS_PREP) E(acc, cur, wr, wc, fr, fq, prep_gen & 1); else E(acc, cur, wr, wc, fr, fq); S.done(cur); }
        if (!has_next) break;
#pragma unroll
        for (int a = 0; a < 2; ++a)
#pragma unroll
            for (int b = 0; b < 2; ++b)
#pragma unroll
                for (int m = 0; m < 4; ++m)
#pragma unroll
                    for (int n = 0; n < 2; ++n) acc[a][b][m][n] = (f32x4){0.f, 0.f, 0.f, 0.f};
        cur = nxt; cA = nA; cB = nB; ++ui;
        if constexpr (Epi::HAS_PREP) { if (cur.pm != prep_pm) { ++prep_gen; E.prep(cur, tid, prep_gen & 1); prep_pm = cur.pm; } }
        if constexpr (ALIGN_EPI) { if (wr == 1) PG8_BAR; }
    }
    PG8_WAIT_V(0);
    if constexpr (!ALIGN_EPI) { if (wr == 0) PG8_BAR; }
    PG8_BAR;
    if constexpr (Epi::AFTER_DRAIN) { E.fused(acc, cur, wr, wc, fr, fq, lds, wid, lane); S.done(cur); }
#undef PG8_SA
#undef PG8_SB
#undef PG8_STAGE
#undef PG8_LDA
#undef PG8_LDB
#undef PG8_MMA
#undef PG8_WAIT_V
#undef PG8_WAIT_L
#undef PG8_BAR
#undef PG8_SCHED
}
}
constexpr int NWAVES = 8, NTHR = 512;
constexpr int BATCH = 2, SEQ = 8192, M = BATCH * SEQ, D = 2048, DEPTH = 4, INW = 10752, FF = 8192;
constexpr int C_HGQ = 0, C_HGV = 768, C_ZF = 1536, C_ZB = 2304, C_HGG = 3072, C_RQ = 3840, C_RK = 4224, C_RV = 4608, C_RG = 5376, C_DIL = 6144;
constexpr int CH = 64, NCH = SEQ / CH;
constexpr float EPS = 1e-6f;
constexpr int NPHASE = 1 + 7 * DEPTH;

constexpr size_t MiB = 1u << 20;
constexpr size_t WS_CTL = 0, CTL_ZERO_BYTES = 1 * MiB;
constexpr size_t WS_PART = 10 * MiB;
constexpr size_t WS_ROPE = 2 * MiB;
constexpr size_t WS_TAB = 4 * MiB;
constexpr size_t WS_LSE = 5 * MiB;
constexpr size_t WS_DHG = 6 * MiB;
constexpr size_t WS_DRT = 8 * MiB;
constexpr size_t WS_WIN = 16 * MiB, WS_WOUT = 184 * MiB, WS_WUP = 216 * MiB, WS_WDN = 344 * MiB;
constexpr size_t WS_XB = 472 * MiB;
constexpr size_t WS_Y = 536 * MiB;
constexpr size_t WS_H = 600 * MiB;
constexpr size_t WS_SHG = 936 * MiB;
constexpr size_t WS_SRT = 1032 * MiB;
constexpr size_t WS_END = 1080 * MiB;
constexpr int CW_BAR = 4096;

constexpr int PH_BYTES = 155648;
constexpr int LDSCTL_OFF = PH_BYTES, MISC_OFF = LDSCTL_OFF + 320;
constexpr int LDS_BYTES = PH_BYTES + 1024;

#define GAS __attribute__((address_space(1)))
#define LAS __attribute__((address_space(3)))
typedef unsigned short bf16;
typedef unsigned v4u __attribute__((ext_vector_type(4)));
typedef unsigned v2u __attribute__((ext_vector_type(2)));
typedef float f32x4 __attribute__((ext_vector_type(4)));
typedef short bf16x8 __attribute__((ext_vector_type(8)));
typedef LAS unsigned char* lptr;
#define LDS_WAIT() asm volatile("s_waitcnt lgkmcnt(0)" ::: "memory")
#define VM_WAIT() asm volatile("s_waitcnt vmcnt(0)" ::: "memory")
#ifndef PROBE_MASK
#define PROBE_MASK 0
#endif
#define SP_BEGIN() unsigned long long sp0_ = 0; if (PROBE_MASK >> 16) sp0_ = __builtin_amdgcn_s_memrealtime();
#define SP_END(bit) do { if (PROBE_MASK >> 16) { const unsigned long long t1_ = __builtin_amdgcn_s_memrealtime(); if (PROBE_MASK & (1 << (bit))) { const unsigned long long dt_ = t1_ - sp0_; while (__builtin_amdgcn_s_memrealtime() - t1_ < dt_) __builtin_amdgcn_s_sleep(2); } sp0_ = __builtin_amdgcn_s_memrealtime(); } } while (0)
#define BAR_LDS() do { asm volatile("s_waitcnt lgkmcnt(0)" ::: "memory"); __builtin_amdgcn_s_barrier(); asm volatile("" ::: "memory"); } while (0)
__device__ __forceinline__ float bf2f(unsigned h) { return __uint_as_float(h << 16); }
__device__ __forceinline__ unsigned pk2(float lo, float hi) { return pg8::cvt_pk_bf16(lo, hi); }
__device__ __forceinline__ unsigned short f2bf(float f) { return (unsigned short)(pk2(f, 0.f) & 0xffffu); }
__device__ __forceinline__ bf16x8 ldsfrag(lptr base, int row, int stride_b, int kel) { return *(const LAS bf16x8*)(base + row * stride_b + kel * 2); }
#define MFMA16(a, b, c) __builtin_amdgcn_mfma_f32_16x16x32_bf16((a), (b), (c), 0, 0, 0)
template <class T> __device__ __forceinline__ T* hptr(T* H, size_t m, int col) { return H + ((size_t)(col >> 7) * M + m) * 128 + (col & 127); }
__device__ __forceinline__ float wave_sum(float v) {
#pragma unroll
    for (int o = 1; o < 64; o <<= 1) v += __shfl_xor(v, o);
    return v;
}
typedef GAS unsigned gu32;
#define XB_TMO      128
#define XB_XCNT(j)  (256  + 64 * (j))
#define XB_XSUB(j)  (1280 + 64 * (j))
#define XB_XGEN(j)  (2304 + 64 * (j))
#define XB_TOP      3328
#define XB_TOPGEN   3392
#define XCD_BAR_WORDS 3456
#define XB_SPIN_CAP (1u << 18)

__device__ __forceinline__ unsigned xb_ld(unsigned* p)              { return __hip_atomic_load(p, __ATOMIC_RELAXED, __HIP_MEMORY_SCOPE_AGENT); }
__device__ __forceinline__ unsigned xb_add(unsigned* p, unsigned v) { return __hip_atomic_fetch_add(p, v, __ATOMIC_RELAXED, __HIP_MEMORY_SCOPE_AGENT); }
__device__ __forceinline__ unsigned xb_xcc_id() { return (unsigned)__builtin_amdgcn_s_getreg((3 << 11) | 20) & 0xFu; }
#define XB_SPIN(cond, bar) do { unsigned _sp = 0; while (cond) { __builtin_amdgcn_s_sleep(1); \
    if ((++_sp & 255u) == 0u) { if (xb_ld(&(bar)[XB_TMO])) break; if (_sp > XB_SPIN_CAP) { atomicAdd(&(bar)[XB_TMO], 1u); break; } } } } while (0)

struct XcdBarrier {
    unsigned* bar; unsigned x;
    volatile LAS unsigned* st;
};

__device__ __forceinline__ XcdBarrier xcd_barrier_post(unsigned* bar, volatile LAS unsigned* st) {
    XcdBarrier b; b.bar = bar; b.x = xb_xcc_id(); b.st = st;
    if (threadIdx.x == 0) (void)xb_add(&bar[XB_XCNT(b.x)], 1u);
    return b;
}
__device__ __forceinline__ void xcd_barrier_complete(unsigned* bar, unsigned x, unsigned& nloc, unsigned& nx) {
    const unsigned G = gridDim.x * gridDim.y * gridDim.z;
    unsigned sum, cnt, mine, sp = 0u;
    for (;;) {
        sum = 0u; cnt = 0u; mine = 0u;
#pragma unroll
        for (unsigned j = 0; j < 16; ++j) { const unsigned c = xb_ld(&bar[XB_XCNT(j)]); sum += c; cnt += (c > 0u) ? 1u : 0u; mine = (j == x) ? c : mine; }
        if (sum == G) break;
        __builtin_amdgcn_s_sleep(1);
        if ((++sp & 255u) == 0u) { if (xb_ld(&bar[XB_TMO])) break; if (sp > XB_SPIN_CAP) { atomicAdd(&bar[XB_TMO], 1u); break; } }
    }
    nloc = mine > 0u ? mine : 1u; nx = cnt > 0u ? cnt : 1u;
}

__device__ __forceinline__ void xcd_barrier(const XcdBarrier& b) {
    asm volatile("s_waitcnt vmcnt(0)" ::: "memory");
    __syncthreads();
    if (threadIdx.x == 0) {
        unsigned* bar = b.bar;
        __builtin_amdgcn_s_waitcnt(0);
        unsigned nloc = b.st[0], nx = b.st[1];
        if (nloc == 0u) { xcd_barrier_complete(bar, b.x, nloc, nx); b.st[0] = nloc; b.st[1] = nx; }
        const unsigned old = xb_add(&bar[XB_XSUB(b.x)], 1u);
        const unsigned gen = old / nloc;
        if (old + 1u == (gen + 1u) * nloc) {
            __builtin_amdgcn_fence(__ATOMIC_RELEASE, "agent");
            asm volatile("s_waitcnt vmcnt(0)" ::: "memory");
            const unsigned og = xb_add(&bar[XB_TOP], 1u);
            const unsigned tg = og / nx;
            if (og + 1u == (tg + 1u) * nx) xb_add(&bar[XB_TOPGEN], 1u);
            else XB_SPIN(xb_ld(&bar[XB_TOPGEN]) == tg, bar);
            __builtin_amdgcn_fence(__ATOMIC_ACQUIRE, "agent");
            xb_add(&bar[XB_XGEN(b.x)], 1u);
            asm volatile("s_waitcnt vmcnt(0)" ::: "memory");
        } else {
            XB_SPIN(xb_ld(&bar[XB_XGEN(b.x)]) == gen, bar);
            __builtin_amdgcn_fence(__ATOMIC_ACQUIRE, "agent");
            asm volatile("s_waitcnt vmcnt(0)" ::: "memory");
        }
    }
    __syncthreads();
}
constexpr int TR_SCR = 64 * 65 * 4;
__device__ __forceinline__ void transpose_item(const float* W, const float* g, int K, int N, bf16* WT, LAS float* scr, int item, int lane) {
    const int nblk = N / 64, kb = item / nblk, nb = item % nblk, k0 = 64 * kb, n0 = 64 * nb;
    const int n4 = lane & 15, kr = lane >> 4;
    f32x4 w[16];
#pragma unroll
    for (int i = 0; i < 16; ++i) w[i] = *(const f32x4*)(W + (size_t)(k0 + 4 * i + kr) * N + n0 + 4 * n4);
    if (g) {
#pragma unroll
        for (int i = 0; i < 16; ++i) w[i] = w[i] * g[k0 + 4 * i + kr]; }
#pragma unroll
    for (int i = 0; i < 16; ++i) { LAS float* d = scr + (4 * i + kr) * 65 + 4 * n4; d[0] = w[i].x; d[1] = w[i].y; d[2] = w[i].z; d[3] = w[i].w; }
    LDS_WAIT(); asm volatile("" ::: "memory");
    const int c = lane & 7;
#pragma unroll
    for (int j = 0; j < 8; ++j) { const int n = (lane >> 3) + 8 * j; const LAS float* s = scr + (8 * c) * 65 + n;
        v4u o; o.x = pk2(s[0 * 65], s[1 * 65]); o.y = pk2(s[2 * 65], s[3 * 65]); o.z = pk2(s[4 * 65], s[5 * 65]); o.w = pk2(s[6 * 65], s[7 * 65]);
        *(v4u*)(WT + (size_t)(n0 + n) * K + k0 + 8 * c) = o; }
    LDS_WAIT(); asm volatile("" ::: "memory");
}
__device__ __forceinline__ void sincos_d(double a, float& s, float& c) {
    const double kq = __builtin_rint(a * 0.6366197723675814); const double r = a - kq * 1.5707963267948966; const int q = ((int)kq) & 3; const double r2 = r * r;
    double sp = 1.0 / 6227020800.0; sp = sp * r2 - 1.0 / 39916800.0; sp = sp * r2 + 1.0 / 362880.0; sp = sp * r2 - 1.0 / 5040.0; sp = sp * r2 + 1.0 / 120.0; sp = sp * r2 - 1.0 / 6.0; sp = sp * r2 + 1.0; sp *= r;
    double cp = -1.0 / 87178291200.0; cp = cp * r2 + 1.0 / 479001600.0; cp = cp * r2 - 1.0 / 3628800.0; cp = cp * r2 + 1.0 / 40320.0; cp = cp * r2 - 1.0 / 720.0; cp = cp * r2 + 1.0 / 24.0; cp = cp * r2 - 0.5; cp = cp * r2 + 1.0;
    const double ss = (q == 0) ? sp : (q == 1) ? cp : (q == 2) ? -sp : -cp; const double cc = (q == 0) ? cp : (q == 1) ? -sp : (q == 2) ? -cp : sp;
    s = (float)ss; c = (float)cc;
}
__device__ __forceinline__ int t5_bucket(int rel) {
    const int n = rel < 0 ? -rel : rel; int b;
    if (n < 8) b = n; else { b = 8 + (n >= 15) + (n >= 27) + (n >= 50) + (n >= 91) + (n >= 166) + (n >= 305) + (n >= 559); }
    return b + (rel > 0 ? 16 : 0);
}

struct Args { const float* in[14]; float* out; unsigned char* ws; int ph_lo, ph_hi; };
typedef const __attribute__((address_space(4))) Args* kargp;
struct Ctx {
    lptr lds; int tid, lane, wave, G, bid; kargp ka; unsigned char* ws;
    __device__ __forceinline__ const float* in(int i) const { return ka->in[i]; }
    __device__ __forceinline__ float* out() const { return ka->out; }
};
__device__ __forceinline__ Ctx mkctx(lptr lds) {
    Ctx X; int tid = threadIdx.x; asm volatile("" : "+v"(tid));
    kargp ka = (kargp)__builtin_amdgcn_kernarg_segment_ptr(); asm volatile("" : "+s"(ka));
    X.lds = lds; X.tid = tid; X.lane = tid & 63; X.wave = __builtin_amdgcn_readfirstlane(tid >> 6); X.G = gridDim.x; X.bid = blockIdx.x; X.ka = ka; X.ws = ka->ws; return X;
}

constexpr int I_IN = (D / 64) * (INW / 64), I_OUT = (D / 64) * (D / 64), I_UP = (D / 64) * (FF / 64), I_DN = (FF / 64) * (D / 64), I_L = I_IN + I_OUT + I_UP + I_DN;
constexpr int TAILQ = 8192;
__device__ __forceinline__ void convert_item(const Ctx& X, int l, int r, LAS float* scr) {
    if (r < I_IN) { transpose_item(X.in(1) + (size_t)l * D * INW, X.in(5) + l * D, D, INW, (bf16*)(X.ws + WS_WIN) + (size_t)l * INW * D, scr, r, X.lane); return; } r -= I_IN;
    if (r < I_OUT) { transpose_item(X.in(2) + (size_t)l * D * D, nullptr, D, D, (bf16*)(X.ws + WS_WOUT) + (size_t)l * D * D, scr, r, X.lane); return; } r -= I_OUT;
    if (r < I_UP) { transpose_item(X.in(3) + (size_t)l * D * FF, X.in(6) + l * D, D, FF, (bf16*)(X.ws + WS_WUP) + (size_t)l * FF * D, scr, r, X.lane); return; } r -= I_UP;
    transpose_item(X.in(4) + (size_t)l * FF * D, nullptr, FF, D, (bf16*)(X.ws + WS_WDN) + (size_t)l * D * FF, scr, r, X.lane);
}
__device__ __forceinline__ void prologue(const Ctx& X) {
    const int gw = X.bid * NWAVES + X.wave, NGW = X.G * NWAVES;
    LAS float* scr = (LAS float*)(X.lds + X.wave * TR_SCR);
    static_assert(8 * TR_SCR <= PH_BYTES, "transpose scratch");
    const int tq = X.G == 256 ? TAILQ : 0, per = I_L - tq;
    for (int it = gw; it < I_L + (DEPTH - 1) * per; it += NGW) {
        if (it < I_L) convert_item(X, 0, it, scr);
        else { const int j = it - I_L; convert_item(X, 1 + j / per, tq + j % per, scr); }
    }
    float* ss0 = (float*)(X.ws + WS_PART); bf16* xb = (bf16*)(X.ws + WS_XB);
    for (int m = gw; m < M; m += NGW) {
        const f32x4* xr = (const f32x4*)(X.in(0) + (size_t)m * D) + X.lane; f32x4 v[8]; float s = 0.f;
#pragma unroll
        for (int j = 0; j < 8; ++j) { v[j] = xr[64 * j]; s += (v[j].x * v[j].x + v[j].y * v[j].y) + (v[j].z * v[j].z + v[j].w * v[j].w); }
        s = wave_sum(s); if (X.lane < 32) ss0[(size_t)m * 32 + X.lane] = X.lane == 0 ? s : 0.f;
        v2u* o8 = (v2u*)(xb + (size_t)m * D) + X.lane;
#pragma unroll
        for (int j = 0; j < 8; ++j) { v2u w; w.x = pk2(v[j].x, v[j].y); w.y = pk2(v[j].z, v[j].w); o8[64 * j] = w; }
    }
    const int gt = X.bid * NTHR + X.tid, NGT = X.G * NTHR;
    float* rc = (float*)(X.ws + WS_ROPE); float* rs = rc + SEQ * 32;
    for (int i = gt; i < SEQ * 32; i += NGT) { const int pos = i >> 5, f = i & 31; double inv = 1.0; for (int e = 0; e < f; ++e) inv *= 0.7498942093324558; const float ang = (float)pos * (float)inv; float s, c; sincos_d((double)ang, s, c); rc[i] = c; rs[i] = s; }
    float* LB = (float*)(X.ws + WS_TAB); float* BT = LB + 2 * 4 * 768;
    for (int i = gt; i < 2 * 768; i += NGT) { const int dir = i / 768, c = i % 768; const float* src = dir ? X.in(8) : X.in(7);
        const float a0 = src[c], a1 = src[768 + c], a2 = src[2 * 768 + c], a3 = src[3 * 768 + c]; const float mx = fmaxf(fmaxf(a0, a1), fmaxf(a2, a3));
        const float e0 = __expf(a0 - mx), e1 = __expf(a1 - mx), e2 = __expf(a2 - mx), e3 = __expf(a3 - mx); const float inv = 1.0f / (e0 + e1 + e2 + e3);
        float* o = LB + dir * 4 * 768 + c; o[0] = 0.f; o[768] = e1 * inv; o[2 * 768] = (e1 + e2) * inv; o[3 * 768] = (e1 + e2 + e3) * inv; }
    for (int i = gt; i < 3 * 4 * 132; i += NGT) { const int g = i / (4 * 132), sl = (i / 132) % 4, rr = i % 132; const int dil = g == 0 ? 1 : (g == 1 ? 4 : 16);
        BT[i] = rr < 129 ? 1.4426950408889634f * X.in(13)[t5_bucket((rr - 64) * dil) * 12 + g * 4 + sl] : 0.f; }
}

template <int NC> struct RawRegs { v4u w[NC / 64]; };
template <int NC> __device__ __forceinline__ void raw_load(const Ctx& X, const bf16* H, size_t m0, int col, RawRegs<NC>& R) {
#pragma unroll
    for (int p = 0; p < NC / 64; ++p) { const int idx = X.tid + NTHR * p, r = idx / (NC / 8), c8 = idx % (NC / 8); R.w[p] = *(const v4u*)hptr(H, m0 + r, col + 8 * c8); }
}
template <int NC> __device__ __forceinline__ void raw_store(const Ctx& X, lptr dst, const RawRegs<NC>& R) {
#pragma unroll
    for (int p = 0; p < NC / 64; ++p) { const int idx = X.tid + NTHR * p; *(LAS v4u*)(dst + idx * 16) = R.w[p]; }
}
__device__ __forceinline__ void vt_store(const Ctx& X, lptr VT, const RawRegs<128>& R) {
#pragma unroll
    for (int p = 0; p < 2; ++p) { const int idx = X.tid + NTHR * p, r = idx >> 4, c8 = idx & 15; const v4u w = R.w[p];
        LAS unsigned short* d = (LAS unsigned short*)(VT + (8 * c8) * 144 + (r ^ (8 * (c8 & 7))) * 2);
        d[0] = (unsigned short)w.x; d[72] = (unsigned short)(w.x >> 16); d[144] = (unsigned short)w.y; d[216] = (unsigned short)(w.y >> 16);
        d[288] = (unsigned short)w.z; d[360] = (unsigned short)(w.z >> 16); d[432] = (unsigned short)w.w; d[504] = (unsigned short)(w.w >> 16); }
}
__device__ __forceinline__ bf16x8 vtfrag(lptr VT, int row, int stride_b, int kel) { return *(const LAS bf16x8*)(VT + row * stride_b + (kel ^ (8 * ((row >> 3) & 7))) * 2); }
typedef float f32x2v __attribute__((ext_vector_type(2)));
__device__ __forceinline__ f32x2v bfpair(unsigned w) { f32x2v r; r.x = __uint_as_float(w << 16); r.y = __uint_as_float(w & 0xffff0000u); return r; }
__device__ __forceinline__ f32x2v rcp2(f32x2v v) { f32x2v r; r.x = __builtin_amdgcn_rcpf(v.x); r.y = __builtin_amdgcn_rcpf(v.y); return r; }
template <int DIR, bool NEEDQ>
__device__ __forceinline__ void gla_prep(lptr rawz, lptr rawq, f32x2v lb, LAS float* seg, int kp, int rg, f32x2v (&c)[8], f32x2v (&qv)[8], f32x2v (&kv)[8]) {
    f32x2v run = (f32x2v){1.f, 1.f}; const f32x2v oml = 1.0f - lb;
#pragma unroll
    for (int i = 0; i < 8; ++i) { const int ii = DIR ? 7 - i : i; const int r = 8 * rg + ii;
        const f32x2v z = bfpair(*(const LAS unsigned*)(rawz + (r * 128 + 2 * kp) * 2)); f32x2v e; e.x = __expf(-z.x); e.y = __expf(-z.y);
        const f32x2v f = lb + oml * rcp2(e + 1.0f); run = run * f; kv[ii] = 1.0f - f; c[ii] = run;
        if (NEEDQ) qv[ii] = bfpair(*(const LAS unsigned*)(rawq + (r * 128 + 2 * kp) * 2)); }
    *(LAS f32x2v*)(seg + rg * 128 + 2 * kp) = run;
}
#define SEGT(j) (*(const LAS f32x2v*)(seg + ((DIR) ? 7 - (j) : (j)) * 128 + 2 * kp))

constexpr int L1_VT = 0, L1_KC = 128 * 144, L1_SEG = 2 * 128 * 144, L1_RAW = L1_SEG + 4096, L1_END = L1_RAW + 32768;
template <int DK, bool RET, int DIR>
__device__ __forceinline__ void gla_local_dir(const Ctx& X, int chain, int n, f32x2v lb, bf16* St, float* dd) {
    static_assert(DK == 128 && !RET, "HGRN2 only (retention has its own path)");
    const lptr VT = X.lds + L1_VT, KC = X.lds + L1_KC; LAS float* seg = (LAS float*)(X.lds + L1_SEG);
    const lptr rawz = X.lds + L1_RAW + (DIR ? 16384 : 0);
    int t_ = X.tid; asm volatile("" : "+v"(t_));
    const int kp = t_ & 63, rg = __builtin_amdgcn_readfirstlane(t_ >> 6);
    f32x2v c[8], qv[8], kv[8];
    gla_prep<DIR, false>(rawz, rawz, lb, seg, kp, rg, c, qv, kv);
    BAR_LDS();
    {
        const int sg = DIR ? 7 - rg : rg;
        f32x2v base = (f32x2v){1.f, 1.f}, all = (f32x2v){1.f, 1.f};
#pragma unroll
        for (int j = 0; j < 8; ++j) { const f32x2v T = SEGT(j); all = all * T; if (j >= sg) base = base * T; }
        f32x2v e[8];
#pragma unroll
        for (int ii = 0; ii < 8; ++ii) { f32x2v cc = c[ii]; cc.x = fmaxf(cc.x, 1e-37f); cc.y = fmaxf(cc.y, 1e-37f); e[ii] = kv[ii] * base * rcp2(cc); }
        v4u w0, w1;
        w0.x = pk2(e[0].x, e[1].x); w0.y = pk2(e[2].x, e[3].x); w0.z = pk2(e[4].x, e[5].x); w0.w = pk2(e[6].x, e[7].x);
        w1.x = pk2(e[0].y, e[1].y); w1.y = pk2(e[2].y, e[3].y); w1.z = pk2(e[4].y, e[5].y); w1.w = pk2(e[6].y, e[7].y);
        *(LAS v4u*)(KC + (2 * kp) * 144 + rg * 16) = w0; *(LAS v4u*)(KC + (2 * kp + 1) * 144 + rg * 16) = w1;
        if (rg == 0) *(f32x2v*)(dd + ((size_t)chain * NCH + n) * DK + 2 * kp) = all;
    }
    BAR_LDS();
    {
        const int fr = X.lane & 15, fq = X.lane >> 4; const int rt = X.wave; constexpr int NCT = 8;
        f32x4 acc[NCT];
#pragma unroll
        for (int t = 0; t < NCT; ++t) acc[t] = (f32x4){0.f, 0.f, 0.f, 0.f};
#pragma unroll
        for (int ks = 0; ks < 2; ++ks) { const bf16x8 a = ldsfrag(KC, 16 * rt + fr, 144, 32 * ks + 8 * fq);
#pragma unroll
            for (int t = 0; t < NCT; ++t) { const bf16x8 bb = vtfrag(VT, 16 * t + fr, 144, 32 * ks + 8 * fq); acc[t] = MFMA16(a, bb, acc[t]); } }
        bf16* Sp = St + ((size_t)chain * NCH + n) * 128 * DK;
        const lptr UT = X.lds + L1_END;
#pragma unroll
        for (int t = 0; t < NCT; ++t) { v2u w; w.x = pk2(acc[t][0], acc[t][1]); w.y = pk2(acc[t][2], acc[t][3]); *(LAS v2u*)(UT + (16 * t + fr) * 272 + (16 * rt + 4 * fq) * 2) = w; }
        BAR_LDS();
#pragma unroll
        for (int p = 0; p < 4; ++p) { const int idx = X.tid + NTHR * p, row = idx >> 4, c8 = idx & 15; *(v4u*)(Sp + (size_t)row * DK + 8 * c8) = *(const LAS v4u*)(UT + row * 272 + c8 * 16); }
    }
    BAR_LDS();
}
template <bool RET> struct LocRegs { RawRegs<128> rv, rzf, rzb; RawRegs<64> rq, rk; f32x4 c4, s4; };
template <bool RET> __device__ __forceinline__ void loc_load(const Ctx& X, const bf16* H, int r, LocRegs<RET>& R) {
    const int b = r / 768, head = (r / 128) % 6, n = r % 128; const size_t m0 = (size_t)(b * SEQ + n * CH);
    raw_load<128>(X, H, m0, (RET ? C_RV : C_HGV) + head * 128, R.rv);
    if (!RET) { raw_load<128>(X, H, m0, C_ZF + head * 128, R.rzf); raw_load<128>(X, H, m0, C_ZB + head * 128, R.rzb); }
    else { raw_load<64>(X, H, m0, C_RQ + head * 64, R.rq); raw_load<64>(X, H, m0, C_RK + head * 64, R.rk);
        const float* rc = (const float*)(X.ws + WS_ROPE) + (size_t)n * CH * 32; R.c4 = *(const f32x4*)(rc + X.tid * 4); R.s4 = *(const f32x4*)(rc + SEQ * 32 + X.tid * 4); }
}
template <int DK, bool RET>
__device__ __forceinline__ void gla_local_item(const Ctx& X, bf16* H, int l, int r, LocRegs<RET>& R, bool has_next) {
    static_assert(DK == 128 && !RET, "HGRN2 only (retention has its own path)");
    const int b = r / 768, head = (r / 128) % 6, n = r % 128;
    const float* LB = (const float*)(X.ws + WS_TAB);
    bf16* St = (bf16*)(X.ws + WS_SHG); float* dd = (float*)(X.ws + WS_DHG);
    const int kp = X.tid & 63;
    f32x2v lb0 = *(const f32x2v*)(LB + (0 * 4 + l) * 768 + head * 128 + 2 * kp), lb1 = *(const f32x2v*)(LB + (1 * 4 + l) * 768 + head * 128 + 2 * kp);
    vt_store(X, X.lds + L1_VT, R.rv); raw_store<128>(X, X.lds + L1_RAW, R.rzf); raw_store<128>(X, X.lds + L1_RAW + 16384, R.rzb);
    asm volatile("" : "+v"(lb0), "+v"(lb1)); __builtin_amdgcn_sched_barrier(0);
    if (has_next) loc_load<RET>(X, H, r + X.G, R);
    __builtin_amdgcn_sched_barrier(0);
    BAR_LDS();
    const int chain = (b * 6 + head) * 2;
    gla_local_dir<DK, RET, 0>(X, chain, n, lb0, St, dd);
    gla_local_dir<DK, RET, 1>(X, chain + 1, n, lb1, St, dd);
}

template <int DK, bool RET> struct L3 { static constexpr int SQ = (DK + 8) * 2, Q0 = 0, Q1 = 64 * SQ, KD = 96 * SQ, KH = 160 * SQ, VT = 192 * SQ, AM = VT + 128 * 144, SEG = AM + 64 * 144, RED = SEG + 4096, RAW = RED + 1024,
    END = RAW + (RET ? 16384 : 49152); };
static_assert(L3<128, false>::END <= PH_BYTES && L1_END <= PH_BYTES, "mixer LDS maps");
template <int DK, bool RET, int DIR>
__device__ __forceinline__ void gla_out_dir(const Ctx& X, int chain, int n, f32x2v lb, const bf16* St, f32x4 (&o)[4], const bf16* H, size_t m0, int zbcol) {
    static_assert(DK == 128 && !RET, "HGRN2 only (retention has its own path)");
    typedef L3<DK, RET> L; constexpr int SQ = L::SQ;
    const lptr Q0 = X.lds + L::Q0, Q1 = X.lds + L::Q1, KD = X.lds + L::KD, KH = X.lds + L::KH, VT = X.lds + L::VT, AM = X.lds + L::AM; LAS float* seg = (LAS float*)(X.lds + L::SEG);
    const lptr rawz = X.lds + L::RAW + (DIR ? 16384 : 0), rawq = X.lds + L::RAW + 32768;
    int t_ = X.tid; asm volatile("" : "+v"(t_));
    const int kp = t_ & 63, rg = __builtin_amdgcn_readfirstlane(t_ >> 6);
    const int fr = X.lane & 15, fq = X.lane >> 4;
    const int tb = X.wave & 3, vh = X.wave >> 2;
    SP_BEGIN()
    bf16x8 sf[DK / 32][4];
    const bf16* Sp = St + ((size_t)chain * NCH + n) * 128 * DK;
#pragma unroll
    for (int ks = 0; ks < 2; ++ks)
#pragma unroll
        for (int vt = 0; vt < 4; ++vt) sf[ks][vt] = *(const bf16x8*)(Sp + (size_t)(64 * vh + 16 * vt + fr) * DK + 32 * ks + 8 * fq);
    {
        f32x2v c[8], qv[8], kv[8];
        gla_prep<DIR, true>(rawz, rawq, lb, seg, kp, rg, c, qv, kv);
        BAR_LDS(); SP_END(21);
#pragma unroll
        for (int ks = 2; ks < 4; ++ks)
#pragma unroll
            for (int vt = 0; vt < 4; ++vt) sf[ks][vt] = *(const bf16x8*)(Sp + (size_t)(64 * vh + 16 * vt + fr) * DK + 32 * ks + 8 * fq);
        {
            const int sg = DIR ? 7 - rg : rg, ss = sg >> 2, hq = sg & 3;
            const f32x2v T0 = SEGT(0), T1 = SEGT(1), T2 = SEGT(2), T3 = SEGT(3), sub0 = (T0 * T1) * (T2 * T3);
            f32x2v pq = (f32x2v){1.f, 1.f};
#pragma unroll
            for (int j = 0; j < 3; ++j) if (j < hq) pq = pq * SEGT(4 * ss + j);
#pragma unroll
            for (int ii = 0; ii < 8; ++ii) { const int r = 8 * rg + ii; f32x2v cp = c[ii] * pq;
                const f32x2v q0 = qv[ii] * cp; cp.x = fmaxf(cp.x, 1e-37f); cp.y = fmaxf(cp.y, 1e-37f); const f32x2v kd = kv[ii] * rcp2(cp);
                *(LAS unsigned*)(KD + r * SQ + kp * 4) = pk2(kd.x, kd.y);
                *(LAS unsigned*)(Q0 + r * SQ + kp * 4) = pk2(q0.x, q0.y);
                if (ss) { const f32x2v q1 = q0 * sub0; *(LAS unsigned*)(Q1 + (DIR ? r : r - 32) * SQ + kp * 4) = pk2(q1.x, q1.y); }
                else { const f32x2v kh = kd * sub0; *(LAS unsigned*)(KH + (DIR ? r - 32 : r) * SQ + kp * 4) = pk2(kh.x, kh.y); }
                if (ii & 1) __builtin_amdgcn_sched_barrier(0); }
        }
    }
    BAR_LDS(); SP_END(22);
    RawRegs<128> zbr; if (!RET && DIR == 0) raw_load<128>(X, H, m0, zbcol, zbr);
#pragma unroll
    for (int bi = 0; bi < 2; ++bi) { const int blk = 2 * X.wave + bi, I = blk >> 2, J = blk & 3; const int sI = DIR ? 3 - I : I, sJ = DIR ? 3 - J : J;
        v2u w; w.x = 0u; w.y = 0u;
        if (sJ <= sI) { const bool same = (sI >> 1) == (sJ >> 1); const lptr KS = same ? KD : KH; const int krow = same ? 16 * J + fr : (DIR ? 16 * J + fr - 32 : 16 * J + fr);
            f32x4 acc = (f32x4){0.f, 0.f, 0.f, 0.f};
#pragma unroll
            for (int ks = 0; ks < DK / 32; ++ks) { const bf16x8 a = ldsfrag(KS, krow, SQ, 32 * ks + 8 * fq); const bf16x8 bb = ldsfrag(Q0, 16 * I + fr, SQ, 32 * ks + 8 * fq); acc = MFMA16(a, bb, acc); }
            if (sI == sJ) {
#pragma unroll
                for (int j = 0; j < 4; ++j) { const int jl = 4 * fq + j; const bool keep = DIR ? (jl >= fr) : (jl <= fr); if (!keep) acc[j] = 0.f; } }
            w.x = pk2(acc[0], acc[1]); w.y = pk2(acc[2], acc[3]); }
        *(LAS v2u*)(AM + (16 * I + fr) * 144 + (16 * J + 4 * fq) * 2) = w; }
    BAR_LDS(); SP_END(23);
    {
        const int stb = DIR ? 3 - tb : tb; const int r = 16 * tb + fr;
#pragma unroll
        for (int ks = 0; ks < 2; ++ks) { const bf16x8 bb = ldsfrag(AM, r, 144, 32 * ks + 8 * fq);
#pragma unroll
            for (int vt = 0; vt < 4; ++vt) { const bf16x8 a = vtfrag(VT, 64 * vh + 16 * vt + fr, 144, 32 * ks + 8 * fq); o[vt] = MFMA16(a, bb, o[vt]); } }
        const lptr QI = (stb >> 1) ? Q1 : Q0; const int qrow = (stb >> 1) ? (DIR ? r : r - 32) : r;
#pragma unroll
        for (int ks = 0; ks < DK / 32; ++ks) { const bf16x8 bb = ldsfrag(QI, qrow, SQ, 32 * ks + 8 * fq);
#pragma unroll
            for (int vt = 0; vt < 4; ++vt) o[vt] = MFMA16(sf[ks][vt], bb, o[vt]); }
    }
    if (!RET && DIR == 0) raw_store<128>(X, X.lds + L::RAW + 16384, zbr);
    BAR_LDS(); SP_END(24);
}
template <bool RET> struct OutRegs { RawRegs<128> rv, rzf, rzb, rq; RawRegs<64> rq6, rk6; v2u gw[4]; };
template <bool RET> __device__ __forceinline__ void out_load(const Ctx& X, const bf16* H, int r, OutRegs<RET>& R) {
    const int b = r / 768, head = (r / 128) % 6, n = r % 128; const size_t m0 = (size_t)(b * SEQ + n * CH);
    const int fr = X.lane & 15, fq = X.lane >> 4, tb = X.wave & 3, vh = X.wave >> 2; const size_t m = m0 + 16 * tb + fr; const int gcol = (RET ? C_RG : C_HGG) + head * 128;
    raw_load<128>(X, H, m0, (RET ? C_RV : C_HGV) + head * 128, R.rv);
    if (!RET) { raw_load<128>(X, H, m0, C_ZF + head * 128, R.rzf); raw_load<128>(X, H, m0, C_HGQ + head * 128, R.rq); }
    else { raw_load<64>(X, H, m0, C_RQ + head * 64, R.rq6); raw_load<64>(X, H, m0, C_RK + head * 64, R.rk6); }
#pragma unroll
    for (int t = 0; t < 4; ++t) if (RET) R.gw[t] = *(const v2u*)hptr(H, m, gcol + 64 * vh + 16 * t + 4 * fq);
}
template <int DK, bool RET>
__device__ __forceinline__ void gla_out_item(const Ctx& X, const bf16* H, bf16* Y, int l, int r, OutRegs<RET>& R, bool has_next) {
    typedef L3<DK, RET> L;
    const int b = r / 768, head = (r / 128) % 6, n = r % 128;
    const float* LB = (const float*)(X.ws + WS_TAB);
    const bf16* St = (const bf16*)(X.ws + (RET ? WS_SRT : WS_SHG));
    const int fr = X.lane & 15, fq = X.lane >> 4, tb = X.wave & 3, vh = X.wave >> 2;
    const size_t m = (size_t)(b * SEQ + n * CH + 16 * tb + fr);
    const int ycol = (RET ? 768 : 0) + head * 128;
    SP_BEGIN()
    const int kp = X.tid & 63; f32x2v lb0 = (f32x2v){0.f, 0.f}, lb1 = lb0;
    v2u gw[4];
    if (!RET) {
        lb0 = *(const f32x2v*)(LB + (0 * 4 + l) * 768 + head * 128 + 2 * kp); lb1 = *(const f32x2v*)(LB + (1 * 4 + l) * 768 + head * 128 + 2 * kp);
        vt_store(X, X.lds + L::VT, R.rv); raw_store<128>(X, X.lds + L::RAW, R.rzf); raw_store<128>(X, X.lds + L::RAW + 32768, R.rq);
    } else {
        vt_store(X, X.lds + L::VT, R.rv); raw_store<64>(X, X.lds + L::RAW, R.rq6); raw_store<64>(X, X.lds + L::RAW + 8192, R.rk6);
    }
    asm volatile("" : "+v"(lb0), "+v"(lb1)); __builtin_amdgcn_sched_barrier(0);
    if (has_next) out_load<RET>(X, H, r + X.G, R);
    __builtin_amdgcn_sched_barrier(0);
    BAR_LDS(); SP_END(20);
    const int chain = (b * 6 + head) * 2;
    f32x4 o[4];
#pragma unroll
    for (int t = 0; t < 4; ++t) o[t] = (f32x4){0.f, 0.f, 0.f, 0.f};
    const size_t m0 = (size_t)(b * SEQ + n * CH);
    gla_out_dir<DK, RET, 0>(X, chain, n, lb0, St, o, H, m0, C_ZB + head * 128);
#pragma unroll
    for (int t = 0; t < 4; ++t) gw[t] = *(const v2u*)hptr(H, m, C_HGG + head * 128 + 64 * vh + 16 * t + 4 * fq);
    gla_out_dir<DK, RET, 1>(X, chain + 1, n, lb1, St, o, H, m0, 0);
    LAS float* red = (LAS float*)(X.lds + L::RED);
    float mu = 0.f;
    if (RET) {
        float s = 0.f;
#pragma unroll
        for (int t = 0; t < 4; ++t) s += (o[t][0] + o[t][1]) + (o[t][2] + o[t][3]);
        s += __shfl_xor(s, 16); s += __shfl_xor(s, 32);
        if (fq == 0) red[128 + X.wave * 16 + fr] = s;
        BAR_LDS();
        mu = (red[128 + X.wave * 16 + fr] + red[128 + (X.wave ^ 4) * 16 + fr]) * (1.0f / 128.0f);
    }
    float s2 = 0.f;
#pragma unroll
    for (int t = 0; t < 4; ++t)
#pragma unroll
        for (int j = 0; j < 4; ++j) { const float dlt = o[t][j] - mu; s2 += dlt * dlt; }
    s2 += __shfl_xor(s2, 16); s2 += __shfl_xor(s2, 32);
    if (fq == 0) red[X.wave * 16 + fr] = s2;
    BAR_LDS();
    const float rstd = __builtin_amdgcn_rsqf((red[X.wave * 16 + fr] + red[(X.wave ^ 4) * 16 + fr]) * (1.0f / 128.0f) + EPS);
    const float* gn = X.in(RET ? 10 : 9) + l * 768 + head * 128;
#pragma unroll
    for (int t = 0; t < 4; ++t) { const int v = 64 * vh + 16 * t + 4 * fq; const f32x4 g4 = *(const f32x4*)(gn + v);
        const float g0 = bf2f(gw[t].x & 0xffffu), g1 = bf2f(gw[t].x >> 16), g2 = bf2f(gw[t].y & 0xffffu), g3 = bf2f(gw[t].y >> 16);
        const float y0 = (o[t][0] - mu) * rstd * g4.x * (g0 * __builtin_amdgcn_rcpf(1.0f + __expf(-g0))), y1 = (o[t][1] - mu) * rstd * g4.y * (g1 * __builtin_amdgcn_rcpf(1.0f + __expf(-g1)));
        const float y2 = (o[t][2] - mu) * rstd * g4.z * (g2 * __builtin_amdgcn_rcpf(1.0f + __expf(-g2))), y3 = (o[t][3] - mu) * rstd * g4.w * (g3 * __builtin_amdgcn_rcpf(1.0f + __expf(-g3)));
        v2u w; w.x = pk2(y0, y1); w.y = pk2(y2, y3); *(LAS v2u*)(X.lds + L::Q0 + (16 * tb + fr) * 272 + v * 2) = w; }
    BAR_LDS();
    { const size_t mrow = (size_t)(b * SEQ + n * CH); int t_ = X.tid; asm volatile("" : "+v"(t_));
#pragma unroll
        for (int p = 0; p < 2; ++p) { const int idx = t_ + NTHR * p, row = idx >> 4, c8 = idx & 15; *(v4u*)(Y + (mrow + row) * D + ycol + 8 * c8) = *(const LAS v4u*)(X.lds + L::Q0 + row * 272 + c8 * 16); } }
    BAR_LDS();
}

constexpr int RCH = 128, RNCH = SEQ / RCH;
constexpr int R1_VT = 0, R1_KC0 = 128 * 144, R1_KC1 = R1_KC0 + 64 * 144, R1_RAW = R1_KC1 + 64 * 144, R1_END = R1_RAW + 32768;
__device__ __forceinline__ void ret_local_item(const Ctx& X, bf16* H, int it, LocRegs<true>& R, bool has_next) {
    const int b = it / 384, head = (it / 64) % 6, n = it % 64;
    bf16* St = (bf16*)(X.ws + WS_SRT); float* dd = (float*)(X.ws + WS_DRT);
    const lptr VT = X.lds + R1_VT, KC0 = X.lds + R1_KC0, KC1 = X.lds + R1_KC1, rawq = X.lds + R1_RAW, rawk = X.lds + R1_RAW + 8192; LAS float* cs = (LAS float*)(X.lds + R1_RAW + 16384); LAS float* sn = (LAS float*)(X.lds + R1_RAW + 24576);
    const float l2f = __log2f(1.0f - exp2f(-5.0f - (float)head)), l2b = __log2f(1.0f - exp2f(-5.0f - (float)(5 - head)));
    const int chain = (b * 6 + head) * 2;
    const int fr = X.lane & 15, fq = X.lane >> 4, rt = X.wave & 3, ct0 = (X.wave >> 2) * 4;
    const int k = X.tid & 63, rq = X.tid >> 6, k2 = k & 31; const bool active = X.tid < 256;
    f32x4 accf[4], accb[4];
#pragma unroll
    for (int t = 0; t < 4; ++t) { accf[t] = (f32x4){0.f, 0.f, 0.f, 0.f}; accb[t] = accf[t]; }
#pragma unroll 1
    for (int h = 0; h < 2; ++h) {
        const int r = 2 * it + h; const size_t m0 = (size_t)(b * SEQ + (2 * n + h) * 64);
        vt_store(X, VT, R.rv); raw_store<64>(X, rawq, R.rq); raw_store<64>(X, rawk, R.rk); *(LAS f32x4*)(cs + X.tid * 4) = R.c4; *(LAS f32x4*)(sn + X.tid * 4) = R.s4;
        __builtin_amdgcn_sched_barrier(0);
        { const int nr = h == 0 ? r + 1 : 2 * (it + X.G); if (h == 0 || has_next) loc_load<true>(X, H, nr, R); }
        __builtin_amdgcn_sched_barrier(0);
        BAR_LDS();
        float qr[16], kr[16];
        if (active) {
#pragma unroll
            for (int ii = 0; ii < 16; ++ii) { const int rr = 16 * rq + ii; const float c_ = cs[rr * 32 + k2], s_ = sn[rr * 32 + k2];
                const float q1 = bf2f(*(const LAS unsigned short*)(rawq + (rr * 64 + k2) * 2)), q2 = bf2f(*(const LAS unsigned short*)(rawq + (rr * 64 + 32 + k2) * 2));
                const float k1 = bf2f(*(const LAS unsigned short*)(rawk + (rr * 64 + k2) * 2)), k2v = bf2f(*(const LAS unsigned short*)(rawk + (rr * 64 + 32 + k2) * 2));
                qr[ii] = (k < 32) ? (q1 * c_ - q2 * s_) : (q1 * s_ + q2 * c_); kr[ii] = 0.125f * ((k < 32) ? (k1 * c_ - k2v * s_) : (k1 * s_ + k2v * c_)); } }
        BAR_LDS();
        if (active) {
            float ef[16], eb[16];
#pragma unroll
            for (int ii = 0; ii < 16; ++ii) { const int rr = 16 * rq + ii, tt = 64 * h + rr; *(LAS unsigned short*)(rawq + (rr * 64 + k) * 2) = f2bf(qr[ii]); *(LAS unsigned short*)(rawk + (rr * 64 + k) * 2) = f2bf(kr[ii]);
                ef[ii] = kr[ii] * __builtin_amdgcn_exp2f((float)(RCH - 1 - tt) * l2f); eb[ii] = kr[ii] * __builtin_amdgcn_exp2f((float)tt * l2b); }
            v4u w0, w1;
            w0.x = pk2(ef[0], ef[1]); w0.y = pk2(ef[2], ef[3]); w0.z = pk2(ef[4], ef[5]); w0.w = pk2(ef[6], ef[7]); w1.x = pk2(ef[8], ef[9]); w1.y = pk2(ef[10], ef[11]); w1.z = pk2(ef[12], ef[13]); w1.w = pk2(ef[14], ef[15]);
            *(LAS v4u*)(KC0 + k * 144 + rq * 32) = w0; *(LAS v4u*)(KC0 + k * 144 + rq * 32 + 16) = w1;
            w0.x = pk2(eb[0], eb[1]); w0.y = pk2(eb[2], eb[3]); w0.z = pk2(eb[4], eb[5]); w0.w = pk2(eb[6], eb[7]); w1.x = pk2(eb[8], eb[9]); w1.y = pk2(eb[10], eb[11]); w1.z = pk2(eb[12], eb[13]); w1.w = pk2(eb[14], eb[15]);
            *(LAS v4u*)(KC1 + k * 144 + rq * 32) = w0; *(LAS v4u*)(KC1 + k * 144 + rq * 32 + 16) = w1;
        }
        BAR_LDS();
        { const int rr = X.tid >> 3, c8 = X.tid & 7; *(v4u*)hptr(H, m0 + rr, C_RQ + head * 64 + 8 * c8) = *(const LAS v4u*)(rawq + X.tid * 16); *(v4u*)hptr(H, m0 + rr, C_RK + head * 64 + 8 * c8) = *(const LAS v4u*)(rawk + X.tid * 16); }
#pragma unroll
        for (int ks = 0; ks < 2; ++ks) { const bf16x8 af = ldsfrag(KC0, 16 * rt + fr, 144, 32 * ks + 8 * fq), ab = ldsfrag(KC1, 16 * rt + fr, 144, 32 * ks + 8 * fq);
#pragma unroll
            for (int t = 0; t < 4; ++t) { const bf16x8 bb = vtfrag(VT, 16 * (ct0 + t) + fr, 144, 32 * ks + 8 * fq); accf[t] = MFMA16(af, bb, accf[t]); accb[t] = MFMA16(ab, bb, accb[t]); } }
        BAR_LDS();
    }
#pragma unroll
    for (int t = 0; t < 4; ++t) { v2u w; w.x = pk2(accf[t][0], accf[t][1]); w.y = pk2(accf[t][2], accf[t][3]); *(LAS v2u*)(X.lds + R1_END + (16 * (ct0 + t) + fr) * 144 + (16 * rt + 4 * fq) * 2) = w;
        w.x = pk2(accb[t][0], accb[t][1]); w.y = pk2(accb[t][2], accb[t][3]); *(LAS v2u*)(X.lds + R1_END + 128 * 144 + (16 * (ct0 + t) + fr) * 144 + (16 * rt + 4 * fq) * 2) = w; }
    if (X.tid < 64) { dd[((size_t)chain * RNCH + n) * 64 + X.tid] = __builtin_amdgcn_exp2f((float)RCH * l2f); dd[((size_t)(chain + 1) * RNCH + n) * 64 + X.tid] = __builtin_amdgcn_exp2f((float)RCH * l2b); }
    BAR_LDS();
#pragma unroll
    for (int dir = 0; dir < 2; ++dir) { bf16* Sp = St + ((size_t)(chain + dir) * RNCH + n) * 128 * 64; const lptr UT = X.lds + R1_END + dir * 128 * 144;
#pragma unroll
        for (int p = 0; p < 2; ++p) { const int idx = X.tid + NTHR * p, row = idx >> 3, c8 = idx & 7; *(v4u*)(Sp + (size_t)row * 64 + 8 * c8) = *(const LAS v4u*)(UT + row * 144 + c8 * 16); } }
    BAR_LDS();
}
struct RetOutRegs { v4u q[2], k[2], v[4]; };
__device__ __forceinline__ void ret_out_load(const Ctx& X, const bf16* H, int it, RetOutRegs& R) {
    const int b = it / 384, head = (it / 64) % 6, n = it % 64; const size_t m0 = (size_t)(b * SEQ + n * RCH);
    const int fr = X.lane & 15, fq = X.lane >> 4, tbq = X.wave & 3, vh = X.wave >> 2;
#pragma unroll
    for (int p = 0; p < 2; ++p) { const int idx = X.tid + NTHR * p, row = idx >> 3, c8 = idx & 7; R.q[p] = *(const v4u*)hptr(H, m0 + row, C_RQ + head * 64 + 8 * c8); R.k[p] = *(const v4u*)hptr(H, m0 + row, C_RK + head * 64 + 8 * c8); }
#pragma unroll
    for (int p = 0; p < 4; ++p) { const int idx = X.tid + NTHR * p, row = idx >> 4, c8 = idx & 15; R.v[p] = *(const v4u*)hptr(H, m0 + row, C_RV + head * 128 + 8 * c8); }
}
constexpr int R3_Q = 0, R3_K = 128 * 144, R3_VT = 2 * 128 * 144, R3_AM = R3_VT + 128 * 272, R3_RED = R3_AM + 128 * 272, R3_END = R3_RED + 4096;
static_assert(R3_END <= PH_BYTES && R1_END + 2 * 128 * 144 <= PH_BYTES, "retention LDS maps");
__device__ __forceinline__ void ret_out_item(const Ctx& X, const bf16* H, bf16* Y, int l, int it, RetOutRegs& R, bool has_next) {
    const int b = it / 384, head = (it / 64) % 6, n = it % 64; const size_t m0 = (size_t)(b * SEQ + n * RCH);
    const bf16* St = (const bf16*)(X.ws + WS_SRT);
    const lptr Q = X.lds + R3_Q, K = X.lds + R3_K, VT = X.lds + R3_VT, AM = X.lds + R3_AM; LAS float* red = (LAS float*)(X.lds + R3_RED);
    const int fr = X.lane & 15, fq = X.lane >> 4, tbq = X.wave & 3, vh = X.wave >> 2; const int ycol = 768 + head * 128;
    const float l2f = __log2f(1.0f - exp2f(-5.0f - (float)head)), l2b = __log2f(1.0f - exp2f(-5.0f - (float)(5 - head)));
    const int chain = (b * 6 + head) * 2;
#pragma unroll
    for (int p = 0; p < 2; ++p) { const int idx = X.tid + NTHR * p, row = idx >> 3, c8 = idx & 7; *(LAS v4u*)(Q + row * 144 + c8 * 16) = R.q[p]; *(LAS v4u*)(K + row * 144 + c8 * 16) = R.k[p]; }
#pragma unroll
    for (int p = 0; p < 4; ++p) { const int idx = X.tid + NTHR * p, row = idx >> 4, c8 = idx & 15; const v4u w = R.v[p];
        LAS unsigned short* d = (LAS unsigned short*)(VT + (8 * c8) * 272 + (row ^ (8 * (c8 & 7))) * 2);
        d[0] = (unsigned short)w.x; d[136] = (unsigned short)(w.x >> 16); d[272] = (unsigned short)w.y; d[408] = (unsigned short)(w.y >> 16);
        d[544] = (unsigned short)w.z; d[680] = (unsigned short)(w.z >> 16); d[816] = (unsigned short)w.w; d[952] = (unsigned short)(w.w >> 16); }
    __builtin_amdgcn_sched_barrier(0);
    if (has_next) ret_out_load(X, H, it + X.G, R);
    bf16x8 sff[2][4], sfb[2][4];
    { const bf16* Sf = St + ((size_t)chain * RNCH + n) * 128 * 64; const bf16* Sb = St + ((size_t)(chain + 1) * RNCH + n) * 128 * 64;
#pragma unroll
        for (int ks = 0; ks < 2; ++ks)
#pragma unroll
            for (int vt = 0; vt < 4; ++vt) { const size_t o_ = (size_t)(64 * vh + 16 * vt + fr) * 64 + 32 * ks + 8 * fq; sff[ks][vt] = *(const bf16x8*)(Sf + o_); sfb[ks][vt] = *(const bf16x8*)(Sb + o_); } }
    __builtin_amdgcn_sched_barrier(0);
    BAR_LDS();
#pragma unroll 1
    for (int J = 0; J < 8; ++J) { const int I = X.wave;
        f32x4 acc = (f32x4){0.f, 0.f, 0.f, 0.f};
#pragma unroll
        for (int ks = 0; ks < 2; ++ks) { const bf16x8 a = ldsfrag(K, 16 * J + fr, 144, 32 * ks + 8 * fq); const bf16x8 bb = ldsfrag(Q, 16 * I + fr, 144, 32 * ks + 8 * fq); acc = MFMA16(a, bb, acc); }
#pragma unroll
        for (int j = 0; j < 4; ++j) { const int d = (16 * I + fr) - (16 * J + 4 * fq + j); const float dec = d > 0 ? __builtin_amdgcn_exp2f((float)d * l2f) : (d < 0 ? __builtin_amdgcn_exp2f((float)(-d) * l2b) : 2.0f); acc[j] *= dec; }
        v2u w; w.x = pk2(acc[0], acc[1]); w.y = pk2(acc[2], acc[3]); *(LAS v2u*)(AM + (16 * I + fr) * 272 + (16 * J + 4 * fq) * 2) = w; }
    BAR_LDS();
    const float* gn = X.in(10) + l * 768 + head * 128;
    v2u gw[2][4];
#pragma unroll
    for (int ps = 0; ps < 2; ++ps)
#pragma unroll
        for (int t = 0; t < 4; ++t) gw[ps][t] = *(const v2u*)hptr(H, m0 + 16 * (tbq + 4 * ps) + fr, C_RG + head * 128 + 64 * vh + 16 * t + 4 * fq);
#pragma unroll
    for (int ps = 0; ps < 2; ++ps) { const int tok = 16 * (tbq + 4 * ps) + fr; f32x4 o[4];
#pragma unroll
        for (int t = 0; t < 4; ++t) o[t] = (f32x4){0.f, 0.f, 0.f, 0.f};
#pragma unroll
        for (int ks = 0; ks < 4; ++ks) { const bf16x8 bb = ldsfrag(AM, tok, 272, 32 * ks + 8 * fq);
#pragma unroll
            for (int vt = 0; vt < 4; ++vt) { const bf16x8 a = vtfrag(VT, 64 * vh + 16 * vt + fr, 272, 32 * ks + 8 * fq); o[vt] = MFMA16(a, bb, o[vt]); } }
        const bf16x8 bq0 = ldsfrag(Q, tok, 144, 8 * fq), bq1 = ldsfrag(Q, tok, 144, 32 + 8 * fq);
        const float cf = __builtin_amdgcn_exp2f((float)(tok + 1) * l2f), cb = __builtin_amdgcn_exp2f((float)(RCH - tok) * l2b);
        {
            f32x4 tf[4];
#pragma unroll
            for (int vt = 0; vt < 4; ++vt) { tf[vt] = MFMA16(sff[0][vt], bq0, ((f32x4){0.f, 0.f, 0.f, 0.f})); tf[vt] = MFMA16(sff[1][vt], bq1, tf[vt]); }
#pragma unroll
            for (int t = 0; t < 4; ++t) o[t] = o[t] + tf[t] * cf;
#pragma unroll
            for (int vt = 0; vt < 4; ++vt) { tf[vt] = MFMA16(sfb[0][vt], bq0, ((f32x4){0.f, 0.f, 0.f, 0.f})); tf[vt] = MFMA16(sfb[1][vt], bq1, tf[vt]); }
#pragma unroll
            for (int t = 0; t < 4; ++t) o[t] = o[t] + tf[t] * cb;
        }
        float s_ = 0.f;
#pragma unroll
        for (int t = 0; t < 4; ++t) s_ += (o[t][0] + o[t][1]) + (o[t][2] + o[t][3]);
        s_ += __shfl_xor(s_, 16); s_ += __shfl_xor(s_, 32);
        if (fq == 0) red[512 + (ps * 8 + X.wave) * 16 + fr] = s_;
        BAR_LDS();
        const float mu = (red[512 + (ps * 8 + X.wave) * 16 + fr] + red[512 + (ps * 8 + (X.wave ^ 4)) * 16 + fr]) * (1.0f / 128.0f); float s2 = 0.f;
#pragma unroll
        for (int t = 0; t < 4; ++t)
#pragma unroll
            for (int j = 0; j < 4; ++j) { const float dlt = o[t][j] - mu; s2 += dlt * dlt; }
        s2 += __shfl_xor(s2, 16); s2 += __shfl_xor(s2, 32);
        if (fq == 0) red[(ps * 8 + X.wave) * 16 + fr] = s2;
        BAR_LDS();
        const float rstd = __builtin_amdgcn_rsqf((red[(ps * 8 + X.wave) * 16 + fr] + red[(ps * 8 + (X.wave ^ 4)) * 16 + fr]) * (1.0f / 128.0f) + EPS);
#pragma unroll
        for (int t = 0; t < 4; ++t) { const int v = 64 * vh + 16 * t + 4 * fq; const f32x4 g4 = *(const f32x4*)(gn + v);
            const float g0 = bf2f(gw[ps][t].x & 0xffffu), g1 = bf2f(gw[ps][t].x >> 16), g2 = bf2f(gw[ps][t].y & 0xffffu), g3 = bf2f(gw[ps][t].y >> 16);
            const float y0 = (o[t][0] - mu) * rstd * g4.x * (g0 * __builtin_amdgcn_rcpf(1.0f + __expf(-g0))), y1 = (o[t][1] - mu) * rstd * g4.y * (g1 * __builtin_amdgcn_rcpf(1.0f + __expf(-g1)));
            const float y2 = (o[t][2] - mu) * rstd * g4.z * (g2 * __builtin_amdgcn_rcpf(1.0f + __expf(-g2))), y3 = (o[t][3] - mu) * rstd * g4.w * (g3 * __builtin_amdgcn_rcpf(1.0f + __expf(-g3)));
            v2u w; w.x = pk2(y0, y1); w.y = pk2(y2, y3); *(LAS v2u*)(AM + tok * 272 + v * 2) = w; } }
    BAR_LDS();
#pragma unroll
    for (int p = 0; p < 4; ++p) { const int idx = X.tid + NTHR * p, row = idx >> 4, c8 = idx & 15; *(v4u*)(Y + (m0 + row) * D + ycol + 8 * c8) = *(const LAS v4u*)(AM + row * 272 + c8 * 16); }
    BAR_LDS();
}

struct ScanBatch { v4u u[4]; f32x4 d0[4], d1[4]; };
__device__ __forceinline__ void scan_load(ScanBatch& B, const bf16* p, const float* dp, int cstride, int dstride, int dir, int s0, int nch) {
#pragma unroll
    for (int j = 0; j < 4; ++j) { const int n = dir ? nch - 1 - (s0 + j) : s0 + j; B.u[j] = *(const v4u*)(p + (size_t)n * cstride); B.d0[j] = *(const f32x4*)(dp + (size_t)n * dstride); B.d1[j] = *(const f32x4*)(dp + (size_t)n * dstride + 4); }
}
__device__ __forceinline__ void scan_step(const ScanBatch& B, float (&S)[8], bf16* p, int cstride, int dir, int s0, int nch) {
#pragma unroll
    for (int j = 0; j < 4; ++j) { const int n = dir ? nch - 1 - (s0 + j) : s0 + j;
        v4u w; w.x = pk2(S[0], S[1]); w.y = pk2(S[2], S[3]); w.z = pk2(S[4], S[5]); w.w = pk2(S[6], S[7]); *(v4u*)(p + (size_t)n * cstride) = w;
        S[0] = B.d0[j].x * S[0] + bf2f(B.u[j].x & 0xffffu); S[1] = B.d0[j].y * S[1] + bf2f(B.u[j].x >> 16); S[2] = B.d0[j].z * S[2] + bf2f(B.u[j].y & 0xffffu); S[3] = B.d0[j].w * S[3] + bf2f(B.u[j].y >> 16);
        S[4] = B.d1[j].x * S[4] + bf2f(B.u[j].z & 0xffffu); S[5] = B.d1[j].y * S[5] + bf2f(B.u[j].z >> 16); S[6] = B.d1[j].z * S[6] + bf2f(B.u[j].w & 0xffffu); S[7] = B.d1[j].w * S[7] + bf2f(B.u[j].w >> 16); }
}
__device__ __forceinline__ void scan_phase(const Ctx& X) {
    constexpr int T_HG = 24 * 2048, T_RT = 24 * 1024;
    for (int task = X.bid * NTHR + X.tid; task < T_HG + T_RT; task += X.G * NTHR) {
        bf16* p; const float* dp; int cstride, dstride, dir, nch;
        if (task < T_HG) { const int chain = task / 2048, e = task % 2048; p = (bf16*)(X.ws + WS_SHG) + (size_t)chain * NCH * 16384 + e * 8; dp = (const float*)(X.ws + WS_DHG) + (size_t)chain * NCH * 128 + (e & 15) * 8; cstride = 16384; dstride = 128; dir = chain & 1; nch = NCH; }
        else { const int t2 = task - T_HG, chain = t2 / 1024, e = t2 % 1024; p = (bf16*)(X.ws + WS_SRT) + (size_t)chain * RNCH * 8192 + e * 8; dp = (const float*)(X.ws + WS_DRT) + (size_t)chain * RNCH * 64 + (e & 7) * 8; cstride = 8192; dstride = 64; dir = chain & 1; nch = RNCH; }
        float S[8];
#pragma unroll
        for (int i = 0; i < 8; ++i) S[i] = 0.f;
        ScanBatch A, B;
        scan_load(A, p, dp, cstride, dstride, dir, 0, nch);
        for (int s0 = 0; s0 < nch; s0 += 8) {
            scan_load(B, p, dp, cstride, dstride, dir, s0 + 4, nch);
            scan_step(A, S, p, cstride, dir, s0, nch);
            if (s0 + 8 < nch) scan_load(A, p, dp, cstride, dstride, dir, s0 + 8, nch);
            scan_step(B, S, p, cstride, dir, s0 + 4, nch);
        }
    }
}

constexpr int DA_KN = 0, DA_VT = 192 * 272, DA_P = DA_VT + 128 * 400, DA_BIAS = DA_P + 64 * 400, DA_MX = DA_BIAS + 1024, DA_LX = DA_MX + 512, DA_END = DA_LX + 512;
static_assert(DA_END <= PH_BYTES, "dilated-attention LDS map");
struct DaBlk { v4u kw[2], vw[2]; };
struct DaRun { int b, g, slot, dil, rho, nb0, nbper, qcol; };
__device__ __forceinline__ DaRun da_decode(int run) {
    DaRun I; I.b = run / 384; const int rem = run % 384; I.g = rem / 128; const int rem2 = rem % 128; I.slot = rem2 / 32; const int rb = rem2 % 32;
    I.dil = I.g == 0 ? 1 : (I.g == 1 ? 4 : 16); I.nbper = 128 / I.dil; const int rpr = I.nbper / 4; I.rho = rb / rpr; I.nb0 = 4 * (rb % rpr); I.qcol = C_DIL + (3 * I.g) * 512 + I.slot * 128; return I;
}
__device__ __forceinline__ void da_blk_load(const Ctx& X, const bf16* H, const DaRun& I, int kb, DaBlk& R) {
    const bool ok = kb >= 0 && kb < I.nbper; const size_t mb = (size_t)I.b * SEQ; const int kcol = I.qcol + 512, vcol = I.qcol + 1024;
#pragma unroll
    for (int p = 0; p < 2; ++p) { const int r = (X.tid >> 4) + 32 * p, c8 = X.tid & 15; R.kw[p] = (v4u){0u, 0u, 0u, 0u}; R.vw[p] = (v4u){0u, 0u, 0u, 0u};
        if (ok) { const size_t mr = mb + (size_t)((64 * kb + r) * I.dil + I.rho); R.kw[p] = *(const v4u*)hptr(H, mr, kcol + 8 * c8); R.vw[p] = *(const v4u*)hptr(H, mr, vcol + 8 * c8); } }
}
__device__ __forceinline__ void da_blk_stage(const Ctx& X, const float* kg, int kb, const DaBlk& R) {
    const lptr KN = X.lds + DA_KN, VT = X.lds + DA_VT; const int slot = ((kb % 3) + 3) % 3;
#pragma unroll
    for (int p = 0; p < 2; ++p) { const int row = slot * 64 + (X.tid >> 4) + 32 * p, c8 = X.tid & 15; const v4u kw = R.kw[p], vw = R.vw[p];
        float f[8]; f[0] = bf2f(kw.x & 0xffffu); f[1] = bf2f(kw.x >> 16); f[2] = bf2f(kw.y & 0xffffu); f[3] = bf2f(kw.y >> 16); f[4] = bf2f(kw.z & 0xffffu); f[5] = bf2f(kw.z >> 16); f[6] = bf2f(kw.w & 0xffffu); f[7] = bf2f(kw.w >> 16);
        float s = 0.f;
#pragma unroll
        for (int e = 0; e < 8; ++e) s += f[e] * f[e];
        s += __shfl_xor(s, 1); s += __shfl_xor(s, 2); s += __shfl_xor(s, 4); s += __shfl_xor(s, 8);
        const float sc = __builtin_amdgcn_rsqf(s * (1.0f / 128.0f) + EPS); const f32x4 g0 = *(const f32x4*)(kg + 8 * c8), g1 = *(const f32x4*)(kg + 8 * c8 + 4);
        v4u o; o.x = pk2(f[0] * sc * g0.x, f[1] * sc * g0.y); o.y = pk2(f[2] * sc * g0.z, f[3] * sc * g0.w); o.z = pk2(f[4] * sc * g1.x, f[5] * sc * g1.y); o.w = pk2(f[6] * sc * g1.z, f[7] * sc * g1.w);
        *(LAS v4u*)(KN + row * 272 + c8 * 16) = o;
        LAS unsigned short* d = (LAS unsigned short*)(VT + (8 * c8) * 400 + (row ^ (8 * (c8 & 7))) * 2);
        d[0] = (unsigned short)vw.x; d[200] = (unsigned short)(vw.x >> 16); d[400] = (unsigned short)vw.y; d[600] = (unsigned short)(vw.y >> 16);
        d[800] = (unsigned short)vw.z; d[1000] = (unsigned short)(vw.z >> 16); d[1200] = (unsigned short)vw.w; d[1400] = (unsigned short)(vw.w >> 16); }
}
__device__ __forceinline__ void da_q_load(const Ctx& X, const bf16* H, const DaRun& I, int nb, v4u (&qw)[4]) {
    const int fr = X.lane & 15, fq = X.lane >> 4, qb = X.wave & 3; const size_t m = (size_t)I.b * SEQ + (size_t)((64 * nb + 16 * qb + fr) * I.dil + I.rho);
#pragma unroll
    for (int ks = 0; ks < 4; ++ks) qw[ks] = *(const v4u*)hptr(H, m, I.qcol + 32 * ks + 8 * fq);
}
__device__ __forceinline__ void dil_run(const Ctx& X, bf16* H, int l, int run) {
    const DaRun I = da_decode(run); const int b = I.b, g = I.g, slot = I.slot, dil = I.dil, rho = I.rho, qcol = I.qcol, Ls = SEQ / I.dil;
    const lptr KN = X.lds + DA_KN, VT = X.lds + DA_VT, P = X.lds + DA_P; LAS float* bias = (LAS float*)(X.lds + DA_BIAS); LAS float* mx = (LAS float*)(X.lds + DA_MX); LAS float* lx = (LAS float*)(X.lds + DA_LX);
    const float* qg = X.in(11) + l * 128; const float* kg = X.in(12) + l * 128; asm volatile("" : "+s"(qg), "+s"(kg));
    const int fr = X.lane & 15, fq = X.lane >> 4, qb = X.wave & 3, kh = X.wave >> 2; const int qi = 16 * qb + fr;
    SP_BEGIN()
    {
        DaBlk B0, B1, B2; da_blk_load(X, H, I, I.nb0 - 1, B0); da_blk_load(X, H, I, I.nb0, B1); da_blk_load(X, H, I, I.nb0 + 1, B2);
        if (X.tid < 256) bias[X.tid] = (X.tid >= 63 && X.tid <= 191) ? ((const float*)(X.ws + WS_TAB) + 2 * 4 * 768)[(g * 4 + slot) * 132 + X.tid - 63] : -1e30f;
        da_blk_stage(X, kg, I.nb0 - 1, B0); da_blk_stage(X, kg, I.nb0, B1); da_blk_stage(X, kg, I.nb0 + 1, B2);
    }
    v4u qw_[4]; da_q_load(X, H, I, I.nb0, qw_);
    for (int i = 0; i < 4; ++i) {
        const int nb = I.nb0 + i; const size_t qtok = (size_t)((64 * nb + qi) * dil + rho);
        bf16x8 qf[4];
        {
            float s = 0.f;
#pragma unroll
            for (int ks = 0; ks < 4; ++ks) { const v4u qw = qw_[ks];
                const float a0 = bf2f(qw.x & 0xffffu), a1 = bf2f(qw.x >> 16), a2 = bf2f(qw.y & 0xffffu), a3 = bf2f(qw.y >> 16), a4 = bf2f(qw.z & 0xffffu), a5 = bf2f(qw.z >> 16), a6 = bf2f(qw.w & 0xffffu), a7 = bf2f(qw.w >> 16);
                s += (a0 * a0 + a1 * a1) + (a2 * a2 + a3 * a3) + (a4 * a4 + a5 * a5) + (a6 * a6 + a7 * a7); }
            s += __shfl_xor(s, 16); s += __shfl_xor(s, 32);
            const float sc = (0.08838834764831845f * 1.4426950408889634f) * __builtin_amdgcn_rsqf(s * (1.0f / 128.0f) + EPS);
#pragma unroll
            for (int ks = 0; ks < 4; ++ks) { const v4u qw = qw_[ks]; const f32x4 g0 = *(const f32x4*)(qg + 32 * ks + 8 * fq), g1 = *(const f32x4*)(qg + 32 * ks + 8 * fq + 4);
                v4u o; o.x = pk2(bf2f(qw.x & 0xffffu) * sc * g0.x, bf2f(qw.x >> 16) * sc * g0.y); o.y = pk2(bf2f(qw.y & 0xffffu) * sc * g0.z, bf2f(qw.y >> 16) * sc * g0.w);
                o.z = pk2(bf2f(qw.z & 0xffffu) * sc * g1.x, bf2f(qw.z >> 16) * sc * g1.y); o.w = pk2(bf2f(qw.w & 0xffffu) * sc * g1.z, bf2f(qw.w >> 16) * sc * g1.w);
                qf[ks] = __builtin_bit_cast(bf16x8, o); }
        }
        asm volatile("" : "+v"(qf[0]), "+v"(qf[1]), "+v"(qf[2]), "+v"(qf[3]));
        __builtin_amdgcn_sched_barrier(0);
        DaBlk Bn; if (i < 3) { da_blk_load(X, H, I, nb + 2, Bn); da_q_load(X, H, I, nb + 1, qw_); }
        __builtin_amdgcn_sched_barrier(0);
        BAR_LDS(); SP_END(16);
        f32x4 sc[6]; float mloc = -1e30f;
        const LAS float* tb = bias + (96 * kh + 4 * fq - qi + 63);
        const bool edge_lo = nb == 0, edge_hi = nb == I.nbper - 1;
#pragma unroll
        for (int t = 0; t < 6; ++t) { f32x4 acc = (f32x4){0.f, 0.f, 0.f, 0.f}; const int rrow = (64 * nb + 128 + 96 * kh + 16 * t) % 192;
#pragma unroll
            for (int ks = 0; ks < 4; ++ks) { const bf16x8 a = ldsfrag(KN, rrow + fr, 272, 32 * ks + 8 * fq); acc = MFMA16(a, qf[ks], acc); }
#pragma unroll
            for (int j = 0; j < 4; ++j) acc[j] += tb[16 * t + j];
            if (edge_lo || edge_hi) {
#pragma unroll
                for (int j = 0; j < 4; ++j) { const int kj = 64 * nb - 64 + 96 * kh + 16 * t + 4 * fq + j; if (kj < 0 || kj >= Ls) acc[j] = -1e30f; } }
            mloc = fmaxf(fmaxf(mloc, fmaxf(acc[0], acc[1])), fmaxf(acc[2], acc[3]));
            sc[t] = acc; }
        mloc = fmaxf(mloc, __shfl_xor(mloc, 16)); mloc = fmaxf(mloc, __shfl_xor(mloc, 32));
        if (fq == 0) mx[kh * 64 + qi] = mloc;
        BAR_LDS(); SP_END(17);
        const float mrow = fmaxf(mx[qi], mx[64 + qi]); float lloc = 0.f;
#pragma unroll
        for (int t = 0; t < 6; ++t) { float p[4];
#pragma unroll
            for (int j = 0; j < 4; ++j) { p[j] = __builtin_amdgcn_exp2f(sc[t][j] - mrow); lloc += p[j]; }
            v2u w; w.x = pk2(p[0], p[1]); w.y = pk2(p[2], p[3]); *(LAS v2u*)(P + qi * 400 + (96 * kh + 16 * t + 4 * fq) * 2) = w; }
        lloc += __shfl_xor(lloc, 16); lloc += __shfl_xor(lloc, 32);
        if (fq == 0) lx[kh * 64 + qi] = lloc;
        BAR_LDS(); SP_END(18);
        const int dh = kh; const float lrow = lx[qi] + lx[64 + qi]; const float inv = __builtin_amdgcn_rcpf(lrow);
        f32x4 oo[4];
#pragma unroll
        for (int t = 0; t < 4; ++t) oo[t] = (f32x4){0.f, 0.f, 0.f, 0.f};
#pragma unroll
        for (int ks = 0; ks < 6; ++ks) { const bf16x8 bb = ldsfrag(P, qi, 400, 32 * ks + 8 * fq); const int rcol = (64 * nb + 128 + 32 * ks) % 192;
#pragma unroll
            for (int t = 0; t < 4; ++t) { const bf16x8 a = vtfrag(VT, 64 * dh + 16 * t + fr, 400, rcol + 8 * fq); oo[t] = MFMA16(a, bb, oo[t]); } }
        BAR_LDS();
#pragma unroll
        for (int t = 0; t < 4; ++t) { v2u w; w.x = pk2(oo[t][0] * inv, oo[t][1] * inv); w.y = pk2(oo[t][2] * inv, oo[t][3] * inv); *(LAS v2u*)(P + qi * 272 + (64 * dh + 16 * t + 4 * fq) * 2) = w; }
        if (dh == 0 && fq == 0) ((float*)(X.ws + WS_LSE))[((size_t)g * M + (size_t)b * SEQ + qtok) * 4 + slot] = 0.6931471805599453f * (mrow + __log2f(lrow));
        BAR_LDS(); SP_END(19);
#pragma unroll
        for (int p = 0; p < 2; ++p) { const int idx = X.tid + NTHR * p, row = idx >> 4, c8 = idx & 15; *(v4u*)hptr(H, (size_t)b * SEQ + (size_t)((64 * nb + row) * dil + rho), qcol + 8 * c8) = *(const LAS v4u*)(P + row * 272 + c8 * 16); }
        if (i < 3) da_blk_stage(X, kg, nb + 2, Bn);
    }
    BAR_LDS();
}
__device__ __forceinline__ void dil_merge_item(const Ctx& X, const bf16* H, bf16* Y, int it) {
    const float* LSE = (const float*)(X.ws + WS_LSE);
#pragma unroll
    for (int p = 0; p < 8; ++p) { const int idx = X.tid + NTHR * p; const int tk = idx >> 6, slot = (idx >> 4) & 3, c8 = idx & 15; const size_t m = (size_t)it * 64 + tk;
        const float l0 = LSE[(0 * (size_t)M + m) * 4 + slot], l1 = LSE[(1 * (size_t)M + m) * 4 + slot], l2 = LSE[(2 * (size_t)M + m) * 4 + slot]; const float mxl = fmaxf(l0, fmaxf(l1, l2));
        const float e0 = __expf(l0 - mxl), e1 = __expf(l1 - mxl), e2 = __expf(l2 - mxl), inv = __builtin_amdgcn_rcpf(e0 + e1 + e2); const float w[3] = {e0 * inv, e1 * inv, e2 * inv};
        float acc[8];
#pragma unroll
        for (int e = 0; e < 8; ++e) acc[e] = 0.f;
#pragma unroll
        for (int g = 0; g < 3; ++g) { const v4u ow = *(const v4u*)hptr(H, m, C_DIL + (3 * g) * 512 + slot * 128 + 8 * c8);
            acc[0] += w[g] * bf2f(ow.x & 0xffffu); acc[1] += w[g] * bf2f(ow.x >> 16); acc[2] += w[g] * bf2f(ow.y & 0xffffu); acc[3] += w[g] * bf2f(ow.y >> 16);
            acc[4] += w[g] * bf2f(ow.z & 0xffffu); acc[5] += w[g] * bf2f(ow.z >> 16); acc[6] += w[g] * bf2f(ow.w & 0xffffu); acc[7] += w[g] * bf2f(ow.w >> 16); }
        v4u o; o.x = pk2(acc[0], acc[1]); o.y = pk2(acc[2], acc[3]); o.z = pk2(acc[4], acc[5]); o.w = pk2(acc[6], acc[7]);
        *(v4u*)(Y + m * D + 1536 + slot * 128 + 8 * c8) = o; }
}

#ifndef MK_N_LAUNCHES
#define MK_N_LAUNCHES 1
#endif
__global__ void __launch_bounds__(NTHR, 2) mega_fwd(Args args) {
    extern __shared__ __attribute__((aligned(16))) unsigned char lds_raw[];
    const lptr lds = (lptr)lds_raw;
    volatile LAS unsigned* MISC = (volatile LAS unsigned*)(lds + MISC_OFF);
    for (int u = threadIdx.x; u < (LDS_BYTES - LDSCTL_OFF) / 4; u += NTHR) ((LAS unsigned*)(lds + LDSCTL_OFF))[u] = 0u;
    __syncthreads();
    XcdBarrier bar; bar.bar = (unsigned*)(args.ws + WS_CTL) + CW_BAR; bar.x = 0; bar.st = nullptr;
    if (MK_N_LAUNCHES == 1) bar = xcd_barrier_post((unsigned*)(args.ws + WS_CTL) + CW_BAR, MISC + 8);
    const int lo = args.ph_lo, hi = args.ph_hi;
#ifndef PROBE_K
#define PROBE_K 1
#endif
#define PB_BEGIN(bit) unsigned long long pt0_ = 0; if (PROBE_MASK & (1 << (bit))) pt0_ = __builtin_amdgcn_s_memrealtime();
#define PB_END(bit) if ((PROBE_MASK & (1 << 15)) && ((226 >> (bit)) & 1)) { const unsigned long long t1_ = __builtin_amdgcn_s_memrealtime(); while (__builtin_amdgcn_s_memrealtime() - t1_ < 10000ull) __builtin_amdgcn_s_sleep(8); } \
    if (PROBE_MASK & (1 << (bit))) { const unsigned long long t1_ = __builtin_amdgcn_s_memrealtime(), dt_ = (t1_ - pt0_) * PROBE_K; while (__builtin_amdgcn_s_memrealtime() - t1_ < dt_) __builtin_amdgcn_s_sleep(8); }
#define IN(k) (lo <= (k) && (k) < hi)
#define SEAM(k) do { if (IN(k) && IN((k) + 1)) { xcd_barrier(bar); if (PROBE_MASK & (1 << 14)) xcd_barrier(bar); } } while (0)
#define PHASE_CTX() const Ctx X = mkctx(lds); bf16* const XB = (bf16*)(X.ws + WS_XB); bf16* const Y = (bf16*)(X.ws + WS_Y); bf16* const H = (bf16*)(X.ws + WS_H); float* const ss_mix = (float*)(X.ws + WS_PART); \
        float* const ss_mix_next = ss_mix; float* const ss_mlp = ss_mix + (size_t)M * 32; (void)XB; (void)Y; (void)H; (void)ss_mix; (void)ss_mix_next; (void)ss_mlp;

    #ifndef NO_PRO
    if (IN(0)) { PB_BEGIN(0) const Ctx X = mkctx(lds); prologue(X); PB_END(0) }
#endif
    SEAM(0);
    for (int l = 0; l < DEPTH; ++l) {
        const int pb = 1 + 7 * l;
#if !defined(NO_GEMM) && !defined(NO_GA)
        if (IN(pb + 0)) { PB_BEGIN(1) PHASE_CTX(); pg8::Gemm g{XB, (const bf16*)(X.ws + WS_WIN) + (size_t)l * INW * D, M, INW, D}; pg8::StaticOrder S; S.init(M, INW, X.G, X.bid);
            pg8::EpiScaleBf16<0, true> E{H, M, ss_mix, (LAS float*)(X.lds + 131072)}; pg8::gemm_phase<pg8::EpiScaleBf16<0, true>, pg8::StaticOrder, true, true>(X.lds, g, S, E);
            if (X.G == 256 && X.bid >= 128 && l + 1 < DEPTH) {
                LAS float* scr = (LAS float*)(X.lds + X.wave * TR_SCR);
                for (int r = (X.bid - 128) * NWAVES + X.wave; r < TAILQ; r += 128 * NWAVES) convert_item(X, l + 1, r, scr); }
            PB_END(1) }
#endif
        SEAM(pb + 0);
#ifndef NO_MIX1
        if (IN(pb + 1)) { PB_BEGIN(2)
#ifndef NO_DA
            { PB_BEGIN(8) PHASE_CTX(); const int vcu = (X.G % 8 == 0) ? (X.bid % 8) * (X.G / 8) + X.bid / 8 : X.bid;
              for (int run = vcu; run < 768; run += X.G) dil_run(X, H, l, run); PB_END(8) }
#endif
#ifndef NO_HG1
            { PB_BEGIN(9) PHASE_CTX(); LocRegs<false> R; loc_load<false>(X, H, X.bid, R); for (int r = X.bid; r < 1536; r += X.G) gla_local_item<128, false>(X, H, l, r, R, r + X.G < 1536); PB_END(9) }
#endif
#ifndef NO_RT1
            { PB_BEGIN(10) PHASE_CTX(); LocRegs<true> R; loc_load<true>(X, H, 2 * X.bid, R); for (int it = X.bid; it < 768; it += X.G) ret_local_item(X, H, it, R, it + X.G < 768); PB_END(10) }
#endif
        PB_END(2) }
#endif
        SEAM(pb + 1);
#ifndef NO_SCAN
        if (IN(pb + 2)) { PB_BEGIN(3) const Ctx X = mkctx(lds); scan_phase(X); PB_END(3) }
#endif
        SEAM(pb + 2);
#ifndef NO_MIX2
        if (IN(pb + 3)) { PB_BEGIN(4)
#ifndef NO_HG2
            { PB_BEGIN(11) PHASE_CTX(); OutRegs<false> R; out_load<false>(X, H, X.bid, R); for (int r = X.bid; r < 1536; r += X.G) gla_out_item<128, false>(X, H, Y, l, r, R, r + X.G < 1536); PB_END(11) }
#endif
#ifndef NO_RT2
            { PB_BEGIN(12) PHASE_CTX(); RetOutRegs R; ret_out_load(X, H, X.bid, R); for (int it = X.bid; it < 768; it += X.G) ret_out_item(X, H, Y, l, it, R, it + X.G < 768); PB_END(12) }
#endif
#ifndef NO_DM
            { PHASE_CTX(); for (int it = X.bid; it < 256; it += X.G) dil_merge_item(X, H, Y, it); }
#endif
        PB_END(4) }
#endif
        SEAM(pb + 3);
#if !defined(NO_GEMM) && !defined(NO_GE)
        if (IN(pb + 4)) { PB_BEGIN(5) PHASE_CTX(); pg8::Gemm g{Y, (const bf16*)(X.ws + WS_WOUT) + (size_t)l * D * D, M, D, D}; pg8::StaticOrder S; S.init(M, D, X.G, X.bid);
            pg8::EpiResid<false> E{XB, nullptr, ss_mlp}; pg8::gemm_phase<pg8::EpiResid<false>, pg8::StaticOrder, true, true>(X.lds, g, S, E); PB_END(5) }
#endif
        SEAM(pb + 4);
#if !defined(NO_GEMM) && !defined(NO_GF)
        if (IN(pb + 5)) { PB_BEGIN(6) PHASE_CTX(); pg8::Gemm g{XB, (const bf16*)(X.ws + WS_WUP) + (size_t)l * FF * D, M, FF, D}; pg8::StaticOrder S; S.init(M, FF, X.G, X.bid);
            pg8::EpiScaleBf16<1> E{H, FF, ss_mlp, (LAS float*)(X.lds + 131072)}; pg8::gemm_phase<pg8::EpiScaleBf16<1>, pg8::StaticOrder, true, true>(X.lds, g, S, E); PB_END(6) }
#endif
        SEAM(pb + 5);
#if !defined(NO_GEMM) && !defined(NO_GG)
        if (IN(pb + 6)) { PB_BEGIN(7) PHASE_CTX(); pg8::Gemm g{H, (const bf16*)(X.ws + WS_WDN) + (size_t)l * D * FF, M, D, FF}; pg8::StaticOrder S; S.init(M, D, X.G, X.bid);
            if (l < DEPTH - 1) { pg8::EpiResid<false> E{XB, nullptr, ss_mix_next}; pg8::gemm_phase<pg8::EpiResid<false>, pg8::StaticOrder, true, true>(X.lds, g, S, E); }
            else { pg8::EpiResid<true> E{XB, X.out(), nullptr}; pg8::gemm_phase<pg8::EpiResid<true>, pg8::StaticOrder, true, true>(X.lds, g, S, E); }
            PB_END(7) }
#endif
        SEAM(pb + 6);
    }
#undef IN
#undef SEAM
}

extern "C" void kernel_launch(void* const* d_in, const int* in_sizes, int n_in, void* d_out, int out_size, void* d_ws, size_t ws_size, hipStream_t stream) {
    static int grid = 0;
    if (grid == 0) {
        if (n_in != 14 || in_sizes[0] != M * D || out_size != M * D || ws_size < WS_END) { fprintf(stderr, "kernel_launch: unexpected problem (n_in %d, in0 %d, out %d, ws %zu < %zu); nothing launched\n", n_in, n_in > 0 ? in_sizes[0] : -1, out_size, ws_size, (size_t)WS_END); grid = -1; return; }
        int dev = 0, cus = 0, per_cu = 0;
        if (hipGetDevice(&dev) != hipSuccess || hipDeviceGetAttribute(&cus, hipDeviceAttributeMultiprocessorCount, dev) != hipSuccess) { grid = -1; return; }
        if (hipFuncSetAttribute((const void*)mega_fwd, hipFuncAttributeMaxDynamicSharedMemorySize, LDS_BYTES) != hipSuccess) { fprintf(stderr, "kernel_launch: hipFuncSetAttribute failed\n"); grid = -1; return; }
        if (hipOccupancyMaxActiveBlocksPerMultiprocessor(&per_cu, (const void*)mega_fwd, NTHR, LDS_BYTES) != hipSuccess || per_cu < 1) fprintf(stderr, "kernel_launch: occupancy query reports %d workgroups per CU\n", per_cu);
        (void)hipGetLastError();
        grid = cus;
    }
    if (grid < 0) return;
    (void)hipMemsetAsync((char*)d_ws + WS_CTL, 0, CTL_ZERO_BYTES, stream);
    Args a{};
    for (int i = 0; i < 14; ++i) a.in[i] = (const float*)d_in[i];
    a.out = (float*)d_out; a.ws = (unsigned char*)d_ws;
    if (MK_N_LAUNCHES == 1) { a.ph_lo = 0; a.ph_hi = NPHASE; hipLaunchKernelGGL(mega_fwd, dim3(grid), dim3(NTHR), LDS_BYTES, stream, a); }
    else for (int p = 0; p < NPHASE; ++p) { a.ph_lo = p; a.ph_hi = p + 1; hipLaunchKernelGGL(mega_fwd, dim3(grid), dim3(NTHR), LDS_BYTES, stream, a); }
}
```

```cpp
#include <hip/hip_runtime.h>
#include <cstdio>
#include <cstdint>
namespace pg8 {
#define PG8_LAS __attribute__((address_space(3)))
typedef unsigned short bf16_t;
typedef short bf16x8 __attribute__((ext_vector_type(8)));
typedef float f32x4 __attribute__((ext_vector_type(4)));
typedef unsigned u32x4 __attribute__((ext_vector_type(4)));
constexpr int BM = 256, BK = 64, HALF = 128, HTB = HALF * BK * 2  , STAGE_BYTES = 8 * HTB, NXCD = 8, WGM = 4;

__host__ __device__ __forceinline__ int lds_byte(int r, int c) { const int st = (r >> 4) * 2 + (c >> 5), rr = r & 15, cc = c & 31, ob = rr * 64 + cc * 2; return st * 1024 + (ob ^ (((ob >> 9) & 1) << 5)); }
__host__ __device__ __forceinline__ void stage_rc(int b, int& R, int& C) { const int st = b / 1024, sb = b % 1024, swz = sb ^ (((sb >> 9) & 1) << 5); R = (st >> 1) * 16 + swz / 64; C = (st & 1) * 32 + (swz % 64) / 2; }
__host__ __device__ __forceinline__ int perm32(int rho) { const int n = rho >> 4, i = rho & 15; return 8 * (i >> 2) + 4 * n + (i & 3); }

struct Unit { int pm, pn; };
struct Gemm { const bf16_t* A; const bf16_t* Bt; int M, N, K; };

struct StaticOrder {
    int nM, nN, nwg, G, c;
    __host__ __device__ void init(int M, int N, int G_, int c_) { nM = M / BM; nN = N / BM; nwg = nM * nN; G = G_; c = c_; }
    __host__ __device__ bool next(int i, Unit& u) const {
        const long L = (long)i * G + c; if (L >= nwg) return false;
        int wgid = (int)L; { const int q = nwg / NXCD, r = nwg % NXCD, xcd = wgid % NXCD, off = wgid / NXCD; wgid = (xcd < r ? xcd * (q + 1) : r * (q + 1) + (xcd - r) * q) + off; }
        const int nig = WGM * nN, gid = wgid / nig, fm = gid * WGM, gsz = (nM - fm) < WGM ? (nM - fm) : WGM;
        u.pm = fm + ((wgid % nig) % gsz); u.pn = (wgid % nig) / gsz; return true;
    }
    __device__ __forceinline__ void a_ready(const Unit&) const {}
    __device__ __forceinline__ void done(const Unit&) const {}
};

typedef float f32x2 __attribute__((ext_vector_type(2))); typedef __bf16 bf16x2_t __attribute__((ext_vector_type(2)));
__device__ __forceinline__ unsigned cvt_pk_bf16(float lo, float hi) { f32x2 v = {lo, hi}; bf16x2_t b = __builtin_convertvector(v, bf16x2_t); return __builtin_bit_cast(unsigned, b); }

template <int ACT, bool BLK = false> struct EpiScaleBf16 {
    static constexpr bool PERM = true, AFTER_DRAIN = false, HAS_PREP = true;
    bf16_t* O; int ldc; const float* ss; PG8_LAS float* rtab;
    __device__ __forceinline__ void prep(const Unit& u, int tid, int buf) const {
        if (tid < BM) { const float* p = ss + (size_t)(u.pm * BM + tid) * 32; float sq = 0.f;
#pragma unroll
            for (int i = 0; i < 8; ++i) { const f32x4 v = *(const f32x4*)(p + 4 * i); sq += (v[0] + v[1]) + (v[2] + v[3]); }
            rtab[buf * BM + tid] = __builtin_amdgcn_rsqf(sq * (1.0f / 2048.0f) + 1e-6f); }
    }
    __device__ __forceinline__ void operator()(const f32x4 (&acc)[2][2][4][2], const Unit& u, int wr, int wc, int fr, int fq, int buf) const {
        const int row0 = u.pm * BM + wr * 64 + fr; const int col0 = u.pn * BM + wc * 32 + 8 * fq;
#pragma unroll
        for (int ai = 0; ai < 2; ++ai)
#pragma unroll
            for (int m = 0; m < 4; ++m) { const int row = row0 + ai * HALF + m * 16;
                const float sc = rtab[buf * BM + wr * 64 + fr + ai * HALF + m * 16];
                bf16_t* rowp = BLK ? O + ((size_t)(2 * u.pn) * ldc + row) * 128 + wc * 32 + 8 * fq : O + (size_t)row * ldc + col0;
#pragma unroll
                for (int bj = 0; bj < 2; ++bj) { f32x4 v0 = acc[ai][bj][m][0] * sc, v1 = acc[ai][bj][m][1] * sc;
                    if (ACT == 1) {
#pragma unroll
                        for (int e = 0; e < 4; ++e) { float a = v0[e] > 0.f ? v0[e] : 0.f; v0[e] = a * a; float b = v1[e] > 0.f ? v1[e] : 0.f; v1[e] = b * b; } }
                    u32x4 w; w.x = cvt_pk_bf16(v0[0], v0[1]); w.y = cvt_pk_bf16(v0[2], v0[3]); w.z = cvt_pk_bf16(v1[0], v1[1]); w.w = cvt_pk_bf16(v1[2], v1[3]);
                    *(u32x4*)(rowp + (BLK ? (size_t)bj * ldc * 128 : (size_t)bj * HALF)) = w; } }
    }
};
template <bool FINAL> struct EpiResid {
    static constexpr bool PERM = true, AFTER_DRAIN = false, HAS_PREP = false;
    bf16_t* xb; float* out; float* ssn;
    __device__ __forceinline__ void operator()(const f32x4 (&acc)[2][2][4][2], const Unit& u, int wr, int wc, int fr, int fq) const {
        const int col0 = u.pn * BM + wc * 32 + 8 * fq;
#pragma unroll
        for (int ai = 0; ai < 2; ++ai)
#pragma unroll
            for (int m = 0; m < 4; ++m) { const int row = u.pm * BM + ai * HALF + wr * 64 + m * 16 + fr; const size_t off = (size_t)row * 2048 + col0; float sq = 0.f;
#pragma unroll
                for (int bj = 0; bj < 2; ++bj) { const size_t o2 = off + bj * HALF; const u32x4 xw = *(const u32x4*)(xb + o2);
                    f32x4 x0, x1; x0[0] = __uint_as_float(xw.x << 16); x0[1] = __uint_as_float(xw.x & 0xffff0000u); x0[2] = __uint_as_float(xw.y << 16); x0[3] = __uint_as_float(xw.y & 0xffff0000u);
                    x1[0] = __uint_as_float(xw.z << 16); x1[1] = __uint_as_float(xw.z & 0xffff0000u); x1[2] = __uint_as_float(xw.w << 16); x1[3] = __uint_as_float(xw.w & 0xffff0000u);
                    x0 = x0 + acc[ai][bj][m][0]; x1 = x1 + acc[ai][bj][m][1];
                    if (FINAL) { *(f32x4*)(out + o2) = x0; *(f32x4*)(out + o2 + 4) = x1; }
                    else { u32x4 w; w.x = cvt_pk_bf16(x0[0], x0[1]); w.y = cvt_pk_bf16(x0[2], x0[3]); w.z = cvt_pk_bf16(x1[0], x1[1]); w.w = cvt_pk_bf16(x1[2], x1[3]); *(u32x4*)(xb + o2) = w; }
                    sq += ((x0[0] * x0[0] + x0[1] * x0[1]) + (x0[2] * x0[2] + x0[3] * x0[3])) + ((x1[0] * x1[0] + x1[1] * x1[1]) + (x1[2] * x1[2] + x1[3] * x1[3])); }
                sq += __shfl_xor(sq, 16); sq += __shfl_xor(sq, 32);
                if (!FINAL && fq == 0) ssn[(size_t)row * 32 + u.pn * 4 + wc] = sq; }
    }
};
template <class Epi, class Sched, bool ALIGN_EPI = false, bool SP2 = false>
__device__ __forceinline__ void gemm_phase(PG8_LAS unsigned char* lds, const Gemm g, const Sched& S, const Epi& E) {
    int tid_ = threadIdx.x; asm volatile("" : "+v"(tid_));
    const int tid = tid_, wid = __builtin_amdgcn_readfirstlane(tid >> 6), lane = tid & 63, wr = wid >> 2, wc = wid & 3, fr = lane & 15, fq = lane >> 4;
    const int K = g.K, nt = K / BK;
    unsigned voffA[2], voffB[2];
#pragma unroll
    for (int i = 0; i < 2; ++i) { int R, C; stage_rc(tid * 16 + i * 8192, R, C); const int Rb = Epi::PERM ? ((R & ~31) + perm32(R & 31)) : R;
        voffA[i] = (unsigned)(R * K + C) * 2u; voffB[i] = (unsigned)(Rb * K + C) * 2u; }
    const size_t kstep = (size_t)(BK * 2);
    const size_t hstep = (size_t)HALF * K * 2;
    const size_t tstep = 2 * hstep;
    const unsigned ldsw = (unsigned)wid * 1024u;
    const int aoff = lds_byte(wr * 64 + fr, fq * 8), boff = lds_byte(wc * 32 + fr, fq * 8);
#define PG8_SA(b, h) (((b) * 2 + (h)) * HTB)
#define PG8_SB(b, h) ((4 + (b) * 2 + (h)) * HTB)
#define PG8_STAGE(bufoff, gbase, voff) do { _Pragma("unroll") for (int _i = 0; _i < 2; ++_i) \
        __builtin_amdgcn_global_load_lds((const unsigned*)((const char*)(gbase) + (voff)[_i]), (PG8_LAS unsigned*)(lds + (bufoff) + ldsw + _i * 8192), 16, 0, 0); } while (0)
#define PG8_LDA(dst, b, h) do { _Pragma("unroll") for (int m = 0; m < 4; ++m) _Pragma("unroll") for (int k = 0; k < 2; ++k) dst[m][k] = *(const PG8_LAS bf16x8*)(lds + PG8_SA(b, h) + aoff + m * 2048 + k * 1024); } while (0)
#define PG8_LDB(dst, b, h) do { _Pragma("unroll") for (int n = 0; n < 2; ++n) _Pragma("unroll") for (int k = 0; k < 2; ++k) dst[n][k] = *(const PG8_LAS bf16x8*)(lds + PG8_SB(b, h) + boff + n * 2048 + k * 1024); } while (0)
#define PG8_MMA(ai, bj, At, Bt) do { __builtin_amdgcn_s_setprio(1); _Pragma("unroll") for (int m = 0; m < 4; ++m) _Pragma("unroll") for (int n = 0; n < 2; ++n) _Pragma("unroll") for (int k = 0; k < 2; ++k) \
        acc[ai][bj][m][n] = __builtin_amdgcn_mfma_f32_16x16x32_bf16(Bt[n][k], At[m][k], acc[ai][bj][m][n], 0, 0, 0); __builtin_amdgcn_s_setprio(0); } while (0)
#define PG8_WAIT_V(n) asm volatile("s_waitcnt vmcnt(" #n ")" ::: "memory")
#define PG8_WAIT_L(n) asm volatile("s_waitcnt lgkmcnt(" #n ")" ::: "memory")
#define PG8_BAR __builtin_amdgcn_s_barrier()
#define PG8_SCHED __builtin_amdgcn_sched_barrier(0)
    Unit cur, nxt; int ui = 0;
    if (!S.next(0, cur)) return;
    f32x4 acc[2][2][4][2];
#pragma unroll
    for (int a = 0; a < 2; ++a)
#pragma unroll
        for (int b = 0; b < 2; ++b)
#pragma unroll
            for (int m = 0; m < 4; ++m)
#pragma unroll
                for (int n = 0; n < 2; ++n) acc[a][b][m][n] = (f32x4){0.f, 0.f, 0.f, 0.f};
    bf16x8 At[4][2], B0[2][2], B1[2][2];
    const char* cA = (const char*)g.A + (size_t)cur.pm * tstep; const char* cB = (const char*)g.Bt + (size_t)cur.pn * tstep;
    S.a_ready(cur);
    int prep_pm = cur.pm, prep_gen = 0; if constexpr (Epi::HAS_PREP) E.prep(cur, tid, 0);
    if constexpr (SP2) {
        PG8_STAGE(PG8_SB(0, 0), cB, voffB); PG8_STAGE(PG8_SB(0, 1), cB + hstep, voffB); PG8_STAGE(PG8_SA(0, 0), cA, voffA); PG8_STAGE(PG8_SA(0, 1), cA + hstep, voffA);
        if (wr == 1) PG8_BAR;
        PG8_WAIT_V(2); PG8_BAR;
        PG8_STAGE(PG8_SB(1, 0), cB + kstep, voffB); PG8_STAGE(PG8_SA(1, 0), cA + kstep, voffA); PG8_STAGE(PG8_SB(1, 1), cB + hstep + kstep, voffB);
        PG8_WAIT_V(6); PG8_BAR;
    } else {
        PG8_STAGE(PG8_SB(0, 0), cB, voffB); PG8_STAGE(PG8_SA(0, 0), cA, voffA); PG8_STAGE(PG8_SB(0, 1), cB + hstep, voffB); PG8_STAGE(PG8_SA(0, 1), cA + hstep, voffA);
        if (wr == 1) PG8_BAR;
        PG8_WAIT_V(4); PG8_BAR;
        PG8_STAGE(PG8_SB(1, 0), cB + kstep, voffB); PG8_STAGE(PG8_SA(1, 0), cA + kstep, voffA); PG8_STAGE(PG8_SB(1, 1), cB + hstep + kstep, voffB);
        PG8_WAIT_V(6); PG8_BAR;
    }
    for (;;) {
        const bool has_next = S.next(ui + 1, nxt);
        const char* nA = has_next ? (const char*)g.A + (size_t)nxt.pm * tstep : cA; const char* nB = has_next ? (const char*)g.Bt + (size_t)nxt.pn * tstep : cB;
        for (int t = 0; t < nt; t += 2) {
            const bool last = (t == nt - 2);
            const char* a1 = cA + (size_t)(t + 1) * kstep;
            const char* a2 = last ? nA : cA + (size_t)(t + 2) * kstep; const char* b2 = last ? nB : cB + (size_t)(t + 2) * kstep;
            const char* a3 = a2 + kstep; const char* b3 = b2 + kstep;
            if (last && has_next) S.a_ready(nxt);
            if constexpr (SP2) {
            PG8_LDB(B0, 0, 0); PG8_LDB(B1, 0, 1); PG8_SCHED; PG8_LDA(At, 0, 0); PG8_STAGE(PG8_SA(1, 1), a1 + hstep, voffA);
            PG8_WAIT_V(8); PG8_WAIT_L(0); PG8_BAR; PG8_MMA(0, 0, At, B0); PG8_MMA(0, 1, At, B1); PG8_BAR; PG8_SCHED;
            PG8_LDA(At, 0, 1); PG8_STAGE(PG8_SB(0, 0), b2, voffB); PG8_STAGE(PG8_SB(0, 1), b2 + hstep, voffB); PG8_STAGE(PG8_SA(0, 0), a2, voffA);
            PG8_WAIT_V(8); PG8_WAIT_L(0); PG8_BAR; PG8_MMA(1, 0, At, B0); PG8_MMA(1, 1, At, B1); PG8_BAR; PG8_SCHED;
            PG8_LDB(B0, 1, 0); PG8_LDB(B1, 1, 1); PG8_SCHED; PG8_LDA(At, 1, 0); PG8_STAGE(PG8_SA(0, 1), a2 + hstep, voffA);
            PG8_WAIT_V(8); PG8_WAIT_L(0); PG8_BAR; PG8_MMA(0, 0, At, B0); PG8_MMA(0, 1, At, B1); PG8_BAR; PG8_SCHED;
            PG8_LDA(At, 1, 1); PG8_STAGE(PG8_SB(1, 0), b3, voffB); PG8_STAGE(PG8_SB(1, 1), b3 + hstep, voffB); PG8_STAGE(PG8_SA(1, 0), a3, voffA);
            PG8_WAIT_V(8); PG8_WAIT_L(0); PG8_BAR; PG8_MMA(1, 0, At, B0); PG8_MMA(1, 1, At, B1); PG8_BAR; PG8_SCHED;
            } else {
            PG8_LDB(B0, 0, 0); PG8_SCHED; PG8_LDA(At, 0, 0); PG8_STAGE(PG8_SA(1, 1), a1 + hstep, voffA);
            PG8_WAIT_L(8); PG8_BAR; PG8_WAIT_L(0); PG8_MMA(0, 0, At, B0); PG8_BAR; PG8_SCHED;
            PG8_LDB(B1, 0, 1); PG8_STAGE(PG8_SB(0, 0), b2, voffB);
            PG8_BAR; PG8_WAIT_L(0); PG8_MMA(0, 1, At, B1); PG8_BAR;
            PG8_LDA(At, 0, 1); PG8_STAGE(PG8_SA(0, 0), a2, voffA);
            PG8_BAR; PG8_WAIT_L(0); PG8_MMA(1, 0, At, B0); PG8_BAR; PG8_SCHED;
            PG8_STAGE(PG8_SB(0, 1), b2 + hstep, voffB);
            PG8_WAIT_V(6); PG8_BAR; PG8_MMA(1, 1, At, B1); PG8_BAR;
            PG8_LDB(B0, 1, 0); PG8_SCHED; PG8_LDA(At, 1, 0); PG8_STAGE(PG8_SA(0, 1), a2 + hstep, voffA);
            PG8_WAIT_L(8); PG8_BAR; PG8_WAIT_L(0); PG8_MMA(0, 0, At, B0); PG8_BAR; PG8_SCHED;
            PG8_LDB(B1, 1, 1); PG8_STAGE(PG8_SB(1, 0), b3, voffB);
            PG8_BAR; PG8_WAIT_L(0); PG8_MMA(0, 1, At, B1); PG8_BAR;
            PG8_LDA(At, 1, 1); PG8_STAGE(PG8_SA(1, 0), a3, voffA);
            PG8_BAR; PG8_WAIT_L(0); PG8_MMA(1, 0, At, B0); PG8_BAR; PG8_SCHED;
            PG8_STAGE(PG8_SB(1, 1), b3 + hstep, voffB);
            PG8_WAIT_V(6); PG8_BAR; PG8_MMA(1, 1, At, B1); PG8_BAR;
            }
        }
        if constexpr (ALIGN_EPI) { if (wr == 0) PG8_BAR; }
        if constexpr (!Epi::AFTER_DRAIN) { if constexpr (Epi::HAS_PREP) E(acc, cur, wr, wc, fr, fq, prep_gen & 1); else E(acc, cur, wr, wc, fr, fq); S.done(cur); }
        if (!has_next) break;
#pragma unroll
        for (int a = 0; a < 2; ++a)
#pragma unroll
            for (int b = 0; b < 2; ++b)
#pragma unroll
                for (int m = 0; m < 4; ++m)
#pragma unroll
                    for (int n = 0; n < 2; ++n) acc[a][b][m][n] = (f32x4){0.f, 0.f, 0.f, 0.f};
        cur = nxt; cA = nA; cB = nB; ++ui;
        if constexpr (Epi::HAS_PREP) { if (cur.pm != prep_pm) { ++prep_gen; E.prep(cur, tid, prep_gen & 1); prep_pm = cur.pm; } }
        if constexpr (ALIGN_EPI) { if (wr == 1) PG8_BAR; }
    }
    PG8_WAIT_V(0);
    if constexpr (!ALIGN_EPI) { if (wr == 0) PG8_BAR; }
    PG8_BAR;
    if constexpr (Epi::AFTER_DRAIN) { E.fused(acc, cur, wr, wc, fr, fq, lds, wid, lane); S.done(cur); }
#undef PG8_SA
#undef PG8_SB
#undef PG8_STAGE
#undef PG8_LDA
#undef PG8_LDB
#undef PG8_MMA
#undef PG8_WAIT_V
#undef PG8_WAIT_L
#undef PG8_BAR
#undef PG8_SCHED
}
}
constexpr int NWAVES = 8, NTHR = 512;
constexpr int BATCH = 2, SEQ = 8192, M = BATCH * SEQ, D = 2048, DEPTH = 4, INW = 10752, FF = 8192;
constexpr int C_HGQ = 0, C_HGV = 768, C_ZF = 1536, C_ZB = 2304, C_HGG = 3072, C_RQ = 3840, C_RK = 4224, C_RV = 4608, C_RG = 5376, C_DIL = 6144;
constexpr int CH = 64, NCH = SEQ / CH;
constexpr float EPS = 1e-6f;
constexpr int NPHASE = 1 + 7 * DEPTH;

constexpr size_t MiB = 1u << 20;
constexpr size_t WS_CTL = 0, CTL_ZERO_BYTES = 1 * MiB;
constexpr size_t WS_PART = 10 * MiB;
constexpr size_t WS_ROPE = 2 * MiB;
constexpr size_t WS_TAB = 4 * MiB;
constexpr size_t WS_LSE = 5 * MiB;
constexpr size_t WS_DHG = 6 * MiB;
constexpr size_t WS_DRT = 8 * MiB;
constexpr size_t WS_WIN = 16 * MiB, WS_WOUT = 184 * MiB, WS_WUP = 216 * MiB, WS_WDN = 344 * MiB;
constexpr size_t WS_XB = 472 * MiB;
constexpr size_t WS_Y = 536 * MiB;
constexpr size_t WS_H = 600 * MiB;
constexpr size_t WS_SHG = 936 * MiB;
constexpr size_t WS_SRT = 1032 * MiB;
constexpr size_t WS_END = 1080 * MiB;
constexpr int CW_BAR = 4096;

constexpr int PH_BYTES = 155648;
constexpr int LDSCTL_OFF = PH_BYTES, MISC_OFF = LDSCTL_OFF + 320;
constexpr int LDS_BYTES = PH_BYTES + 1024;

#define GAS __attribute__((address_space(1)))
#define LAS __attribute__((address_space(3)))
typedef unsigned short bf16;
typedef unsigned v4u __attribute__((ext_vector_type(4)));
typedef unsigned v2u __attribute__((ext_vector_type(2)));
typedef float f32x4 __attribute__((ext_vector_type(4)));
typedef short bf16x8 __attribute__((ext_vector_type(8)));
typedef LAS unsigned char* lptr;
#define LDS_WAIT() asm volatile("s_waitcnt lgkmcnt(0)" ::: "memory")
#define VM_WAIT() asm volatile("s_waitcnt vmcnt(0)" ::: "memory")
#ifndef PROBE_MASK
#define PROBE_MASK 0
#endif
#define SP_BEGIN() unsigned long long sp0_ = 0; if (PROBE_MASK >> 16) sp0_ = __builtin_amdgcn_s_memrealtime();
#define SP_END(bit) do { if (PROBE_MASK >> 16) { const unsigned long long t1_ = __builtin_amdgcn_s_memrealtime(); if (PROBE_MASK & (1 << (bit))) { const unsigned long long dt_ = t1_ - sp0_; while (__builtin_amdgcn_s_memrealtime() - t1_ < dt_) __builtin_amdgcn_s_sleep(2); } sp0_ = __builtin_amdgcn_s_memrealtime(); } } while (0)
#define BAR_LDS() do { asm volatile("s_waitcnt lgkmcnt(0)" ::: "memory"); __builtin_amdgcn_s_barrier(); asm volatile("" ::: "memory"); } while (0)
__device__ __forceinline__ float bf2f(unsigned h) { return __uint_as_float(h << 16); }
__device__ __forceinline__ unsigned pk2(float lo, float hi) { return pg8::cvt_pk_bf16(lo, hi); }
__device__ __forceinline__ unsigned short f2bf(float f) { return (unsigned short)(pk2(f, 0.f) & 0xffffu); }
__device__ __forceinline__ bf16x8 ldsfrag(lptr base, int row, int stride_b, int kel) { return *(const LAS bf16x8*)(base + row * stride_b + kel * 2); }
#define MFMA16(a, b, c) __builtin_amdgcn_mfma_f32_16x16x32_bf16((a), (b), (c), 0, 0, 0)
template <class T> __device__ __forceinline__ T* hptr(T* H, size_t m, int col) { return H + ((size_t)(col >> 7) * M + m) * 128 + (col & 127); }
__device__ __forceinline__ float wave_sum(float v) {
#pragma unroll
    for (int o = 1; o < 64; o <<= 1) v += __shfl_xor(v, o);
    return v;
}
typedef GAS unsigned gu32;
#define XB_TMO      128
#define XB_XCNT(j)  (256  + 64 * (j))
#define XB_XSUB(j)  (1280 + 64 * (j))
#define XB_XGEN(j)  (2304 + 64 * (j))
#define XB_TOP      3328
#define XB_TOPGEN   3392
#define XCD_BAR_WORDS 3456
#define XB_SPIN_CAP (1u << 18)

__device__ __forceinline__ unsigned xb_ld(unsigned* p)              { return __hip_atomic_load(p, __ATOMIC_RELAXED, __HIP_MEMORY_SCOPE_AGENT); }
__device__ __forceinline__ unsigned xb_add(unsigned* p, unsigned v) { return __hip_atomic_fetch_add(p, v, __ATOMIC_RELAXED, __HIP_MEMORY_SCOPE_AGENT); }
__device__ __forceinline__ unsigned xb_xcc_id() { return (unsigned)__builtin_amdgcn_s_getreg((3 << 11) | 20) & 0xFu; }
#define XB_SPIN(cond, bar) do { unsigned _sp = 0; while (cond) { __builtin_amdgcn_s_sleep(1); \
    if ((++_sp & 255u) == 0u) { if (xb_ld(&(bar)[XB_TMO])) break; if (_sp > XB_SPIN_CAP) { atomicAdd(&(bar)[XB_TMO], 1u); break; } } } } while (0)

struct XcdBarrier {
    unsigned* bar; unsigned x;
    volatile LAS unsigned* st;
};

__device__ __forceinline__ XcdBarrier xcd_barrier_post(unsigned* bar, volatile LAS unsigned* st) {
    XcdBarrier b; b.bar = bar; b.x = xb_xcc_id(); b.st = st;
    if (threadIdx.x == 0) (void)xb_add(&bar[XB_XCNT(b.x)], 1u);
    return b;
}
__device__ __forceinline__ void xcd_barrier_complete(unsigned* bar, unsigned x, unsigned& nloc, unsigned& nx) {
    const unsigned G = gridDim.x * gridDim.y * gridDim.z;
    unsigned sum, cnt, mine, sp = 0u;
    for (;;) {
        sum = 0u; cnt = 0u; mine = 0u;
#pragma unroll
        for (unsigned j = 0; j < 16; ++j) { const unsigned c = xb_ld(&bar[XB_XCNT(j)]); sum += c; cnt += (c > 0u) ? 1u : 0u; mine = (j == x) ? c : mine; }
        if (sum == G) break;
        __builtin_amdgcn_s_sleep(1);
        if ((++sp & 255u) == 0u) { if (xb_ld(&bar[XB_TMO])) break; if (sp > XB_SPIN_CAP) { atomicAdd(&bar[XB_TMO], 1u); break; } }
    }
    nloc = mine > 0u ? mine : 1u; nx = cnt > 0u ? cnt : 1u;
}

__device__ __forceinline__ void xcd_barrier(const XcdBarrier& b) {
    asm volatile("s_waitcnt vmcnt(0)" ::: "memory");
    __syncthreads();
    if (threadIdx.x == 0) {
        unsigned* bar = b.bar;
        __builtin_amdgcn_s_waitcnt(0);
        unsigned nloc = b.st[0], nx = b.st[1];
        if (nloc == 0u) { xcd_barrier_complete(bar, b.x, nloc, nx); b.st[0] = nloc; b.st[1] = nx; }
        const unsigned old = xb_add(&bar[XB_XSUB(b.x)], 1u);
        const unsigned gen = old / nloc;
        if (old + 1u == (gen + 1u) * nloc) {
            __builtin_amdgcn_fence(__ATOMIC_RELEASE, "agent");
            asm volatile("s_waitcnt vmcnt(0)" ::: "memory");
            const unsigned og = xb_add(&bar[XB_TOP], 1u);
            const unsigned tg = og / nx;
            if (og + 1u == (tg + 1u) * nx) xb_add(&bar[XB_TOPGEN], 1u);
            else XB_SPIN(xb_ld(&bar[XB_TOPGEN]) == tg, bar);
            __builtin_amdgcn_fence(__ATOMIC_ACQUIRE, "agent");
            xb_add(&bar[XB_XGEN(b.x)], 1u);
            asm volatile("s_waitcnt vmcnt(0)" ::: "memory");
        } else {
            XB_SPIN(xb_ld(&bar[XB_XGEN(b.x)]) == gen, bar);
            __builtin_amdgcn_fence(__ATOMIC_ACQUIRE, "agent");
            asm volatile("s_waitcnt vmcnt(0)" ::: "memory");
        }
    }
    __syncthreads();
}
constexpr int TR_SCR = 64 * 65 * 4;
__device__ __forceinline__ void transpose_item(const float* W, const float* g, int K, int N, bf16* WT, LAS float* scr, int item, int lane) {
    const int nblk = N / 64, kb = item / nblk, nb = item % nblk, k0 = 64 * kb, n0 = 64 * nb;
    const int n4 = lane & 15, kr = lane >> 4;
    f32x4 w[16];
#pragma unroll
    for (int i = 0; i < 16; ++i) w[i] = *(const f32x4*)(W + (size_t)(k0 + 4 * i + kr) * N + n0 + 4 * n4);
    if (g) {
#pragma unroll
        for (int i = 0; i < 16; ++i) w[i] = w[i] * g[k0 + 4 * i + kr]; }
#pragma unroll
    for (int i = 0; i < 16; ++i) { LAS float* d = scr + (4 * i + kr) * 65 + 4 * n4; d[0] = w[i].x; d[1] = w[i].y; d[2] = w[i].z; d[3] = w[i].w; }
    LDS_WAIT(); asm volatile("" ::: "memory");
    const int c = lane & 7;
#pragma unroll
    for (int j = 0; j < 8; ++j) { const int n = (lane >> 3) + 8 * j; const LAS float* s = scr + (8 * c) * 65 + n;
        v4u o; o.x = pk2(s[0 * 65], s[1 * 65]); o.y = pk2(s[2 * 65], s[3 * 65]); o.z = pk2(s[4 * 65], s[5 * 65]); o.w = pk2(s[6 * 65], s[7 * 65]);
        *(v4u*)(WT + (size_t)(n0 + n) * K + k0 + 8 * c) = o; }
    LDS_WAIT(); asm volatile("" ::: "memory");
}
__device__ __forceinline__ void sincos_d(double a, float& s, float& c) {
    const double kq = __builtin_rint(a * 0.6366197723675814); const double r = a - kq * 1.5707963267948966; const int q = ((int)kq) & 3; const double r2 = r * r;
    double sp = 1.0 / 6227020800.0; sp = sp * r2 - 1.0 / 39916800.0; sp = sp * r2 + 1.0 / 362880.0; sp = sp * r2 - 1.0 / 5040.0; sp = sp * r2 + 1.0 / 120.0; sp = sp * r2 - 1.0 / 6.0; sp = sp * r2 + 1.0; sp *= r;
    double cp = -1.0 / 87178291200.0; cp = cp * r2 + 1.0 / 479001600.0; cp = cp * r2 - 1.0 / 3628800.0; cp = cp * r2 + 1.0 / 40320.0; cp = cp * r2 - 1.0 / 720.0; cp = cp * r2 + 1.0 / 24.0; cp = cp * r2 - 0.5; cp = cp * r2 + 1.0;
    const double ss = (q == 0) ? sp : (q == 1) ? cp : (q == 2) ? -sp : -cp; const double cc = (q == 0) ? cp : (q == 1) ? -sp : (q == 2) ? -cp : sp;
    s = (float)ss; c = (float)cc;
}
__device__ __forceinline__ int t5_bucket(int rel) {
    const int n = rel < 0 ? -rel : rel; int b;
    if (n < 8) b = n; else { b = 8 + (n >= 15) + (n >= 27) + (n >= 50) + (n >= 91) + (n >= 166) + (n >= 305) + (n >= 559); }
    return b + (rel > 0 ? 16 : 0);
}

struct Args { const float* in[14]; float* out; unsigned char* ws; int ph_lo, ph_hi; };
typedef const __attribute__((address_space(4))) Args* kargp;
struct Ctx {
    lptr lds; int tid, lane, wave, G, bid; kargp ka; unsigned char* ws;
    __device__ __forceinline__ const float* in(int i) const { return ka->in[i]; }
    __device__ __forceinline__ float* out() const { return ka->out; }
};
__device__ __forceinline__ Ctx mkctx(lptr lds) {
    Ctx X; int tid = threadIdx.x; asm volatile("" : "+v"(tid));
    kargp ka = (kargp)__builtin_amdgcn_kernarg_segment_ptr(); asm volatile("" : "+s"(ka));
    X.lds = lds; X.tid = tid; X.lane = tid & 63; X.wave = __builtin_amdgcn_readfirstlane(tid >> 6); X.G = gridDim.x; X.bid = blockIdx.x; X.ka = ka; X.ws = ka->ws; return X;
}

constexpr int I_IN = (D / 64) * (INW / 64), I_OUT = (D / 64) * (D / 64), I_UP = (D / 64) * (FF / 64), I_DN = (FF / 64) * (D / 64), I_L = I_IN + I_OUT + I_UP + I_DN;
constexpr int TAILQ = 8192;
__device__ __forceinline__ void convert_item(const Ctx& X, int l, int r, LAS float* scr) {
    if (r < I_IN) { transpose_item(X.in(1) + (size_t)l * D * INW, X.in(5) + l * D, D, INW, (bf16*)(X.ws + WS_WIN) + (size_t)l * INW * D, scr, r, X.lane); return; } r -= I_IN;
    if (r < I_OUT) { transpose_item(X.in(2) + (size_t)l * D * D, nullptr, D, D, (bf16*)(X.ws + WS_WOUT) + (size_t)l * D * D, scr, r, X.lane); return; } r -= I_OUT;
    if (r < I_UP) { transpose_item(X.in(3) + (size_t)l * D * FF, X.in(6) + l * D, D, FF, (bf16*)(X.ws + WS_WUP) + (size_t)l * FF * D, scr, r, X.lane); return; } r -= I_UP;
    transpose_item(X.in(4) + (size_t)l * FF * D, nullptr, FF, D, (bf16*)(X.ws + WS_WDN) + (size_t)l * D * FF, scr, r, X.lane);
}
__device__ __forceinline__ void prologue(const Ctx& X) {
    const int gw = X.bid * NWAVES + X.wave, NGW = X.G * NWAVES;
    LAS float* scr = (LAS float*)(X.lds + X.wave * TR_SCR);
    static_assert(8 * TR_SCR <= PH_BYTES, "transpose scratch");
    const int tq = X.G == 256 ? TAILQ : 0, per = I_L - tq;
    for (int it = gw; it < I_L + (DEPTH - 1) * per; it += NGW) {
        if (it < I_L) convert_item(X, 0, it, scr);
        else { const int j = it - I_L; convert_item(X, 1 + j / per, tq + j % per, scr); }
    }
    float* ss0 = (float*)(X.ws + WS_PART); bf16* xb = (bf16*)(X.ws + WS_XB);
    for (int m = gw; m < M; m += NGW) {
        const f32x4* xr = (const f32x4*)(X.in(0) + (size_t)m * D) + X.lane; f32x4 v[8]; float s = 0.f;
#pragma unroll
        for (int j = 0; j < 8; ++j) { v[j] = xr[64 * j]; s += (v[j].x * v[j].x + v[j].y * v[j].y) + (v[j].z * v[j].z + v[j].w * v[j].w); }
        s = wave_sum(s); if (X.lane < 32) ss0[(size_t)m * 32 + X.lane] = X.lane == 0 ? s : 0.f;
        v2u* o8 = (v2u*)(xb + (size_t)m * D) + X.lane;
#pragma unroll
        for (int j = 0; j < 8; ++j) { v2u w; w.x = pk2(v[j].x, v[j].y); w.y = pk2(v[j].z, v[j].w); o8[64 * j] = w; }
    }
    const int gt = X.bid * NTHR + X.tid, NGT = X.G * NTHR;
    float* rc = (float*)(X.ws + WS_ROPE); float* rs = rc + SEQ * 32;
    for (int i = gt; i < SEQ * 32; i += NGT) { const int pos = i >> 5, f = i & 31; double inv = 1.0; for (int e = 0; e < f; ++e) inv *= 0.7498942093324558; const float ang = (float)pos * (float)inv; float s, c; sincos_d((double)ang, s, c); rc[i] = c; rs[i] = s; }
    float* LB = (float*)(X.ws + WS_TAB); float* BT = LB + 2 * 4 * 768;
    for (int i = gt; i < 2 * 768; i += NGT) { const int dir = i / 768, c = i % 768; const float* src = dir ? X.in(8) : X.in(7);
        const float a0 = src[c], a1 = src[768 + c], a2 = src[2 * 768 + c], a3 = src[3 * 768 + c]; const float mx = fmaxf(fmaxf(a0, a1), fmaxf(a2, a3));
        const float e0 = __expf(a0 - mx), e1 = __expf(a1 - mx), e2 = __expf(a2 - mx), e3 = __expf(a3 - mx); const float inv = 1.0f / (e0 + e1 + e2 + e3);
        float* o = LB + dir * 4 * 768 + c; o[0] = 0.f; o[768] = e1 * inv; o[2 * 768] = (e1 + e2) * inv; o[3 * 768] = (e1 + e2 + e3) * inv; }
    for (int i = gt; i < 3 * 4 * 132; i += NGT) { const int g = i / (4 * 132), sl = (i / 132) % 4, rr = i % 132; const int dil = g == 0 ? 1 : (g == 1 ? 4 : 16);
        BT[i] = rr < 129 ? 1.4426950408889634f * X.in(13)[t5_bucket((rr - 64) * dil) * 12 + g * 4 + sl] : 0.f; }
}

template <int NC> struct RawRegs { v4u w[NC / 64]; };
template <int NC> __device__ __forceinline__ void raw_load(const Ctx& X, const bf16* H, size_t m0, int col, RawRegs<NC>& R) {
#pragma unroll
    for (int p = 0; p < NC / 64; ++p) { const int idx = X.tid + NTHR * p, r = idx / (NC / 8), c8 = idx % (NC / 8); R.w[p] = *(const v4u*)hptr(H, m0 + r, col + 8 * c8); }
}
template <int NC> __device__ __forceinline__ void raw_store(const Ctx& X, lptr dst, const RawRegs<NC>& R) {
#pragma unroll
    for (int p = 0; p < NC / 64; ++p) { const int idx = X.tid + NTHR * p; *(LAS v4u*)(dst + idx * 16) = R.w[p]; }
}
__device__ __forceinline__ void vt_store(const Ctx& X, lptr VT, const RawRegs<128>& R) {
#pragma unroll
    for (int p = 0; p < 2; ++p) { const int idx = X.tid + NTHR * p, r = idx >> 4, c8 = idx & 15; const v4u w = R.w[p];
        LAS unsigned short* d = (LAS unsigned short*)(VT + (8 * c8) * 144 + (r ^ (8 * (c8 & 7))) * 2);
        d[0] = (unsigned short)w.x; d[72] = (unsigned short)(w.x >> 16); d[144] = (unsigned short)w.y; d[216] = (unsigned short)(w.y >> 16);
        d[288] = (unsigned short)w.z; d[360] = (unsigned short)(w.z >> 16); d[432] = (unsigned short)w.w; d[504] = (unsigned short)(w.w >> 16); }
}
__device__ __forceinline__ bf16x8 vtfrag(lptr VT, int row, int stride_b, int kel) { return *(const LAS bf16x8*)(VT + row * stride_b + (kel ^ (8 * ((row >> 3) & 7))) * 2); }
typedef float f32x2v __attribute__((ext_vector_type(2)));
__device__ __forceinline__ f32x2v bfpair(unsigned w) { f32x2v r; r.x = __uint_as_float(w << 16); r.y = __uint_as_float(w & 0xffff0000u); return r; }
__device__ __forceinline__ f32x2v rcp2(f32x2v v) { f32x2v r; r.x = __builtin_amdgcn_rcpf(v.x); r.y = __builtin_amdgcn_rcpf(v.y); return r; }
template <int DIR, bool NEEDQ>
__device__ __forceinline__ void gla_prep(lptr rawz, lptr rawq, f32x2v lb, LAS float* seg, int kp, int rg, f32x2v (&c)[8], f32x2v (&qv)[8], f32x2v (&kv)[8]) {
    f32x2v run = (f32x2v){1.f, 1.f}; const f32x2v oml = 1.0f - lb;
#pragma unroll
    for (int i = 0; i < 8; ++i) { const int ii = DIR ? 7 - i : i; const int r = 8 * rg + ii;
        const f32x2v z = bfpair(*(const LAS unsigned*)(rawz + (r * 128 + 2 * kp) * 2)); f32x2v e; e.x = __expf(-z.x); e.y = __expf(-z.y);
        const f32x2v f = lb + oml * rcp2(e + 1.0f); run = run * f; kv[ii] = 1.0f - f; c[ii] = run;
        if (NEEDQ) qv[ii] = bfpair(*(const LAS unsigned*)(rawq + (r * 128 + 2 * kp) * 2)); }
    *(LAS f32x2v*)(seg + rg * 128 + 2 * kp) = run;
}
#define SEGT(j) (*(const LAS f32x2v*)(seg + ((DIR) ? 7 - (j) : (j)) * 128 + 2 * kp))

constexpr int L1_VT = 0, L1_KC = 128 * 144, L1_SEG = 2 * 128 * 144, L1_RAW = L1_SEG + 4096, L1_END = L1_RAW + 32768;
template <int DK, bool RET, int DIR>
__device__ __forceinline__ void gla_local_dir(const Ctx& X, int chain, int n, f32x2v lb, bf16* St, float* dd) {
    static_assert(DK == 128 && !RET, "HGRN2 only (retention has its own path)");
    const lptr VT = X.lds + L1_VT, KC = X.lds + L1_KC; LAS float* seg = (LAS float*)(X.lds + L1_SEG);
    const lptr rawz = X.lds + L1_RAW + (DIR ? 16384 : 0);
    int t_ = X.tid; asm volatile("" : "+v"(t_));
    const int kp = t_ & 63, rg = __builtin_amdgcn_readfirstlane(t_ >> 6);
    f32x2v c[8], qv[8], kv[8];
    gla_prep<DIR, false>(rawz, rawz, lb, seg, kp, rg, c, qv, kv);
    BAR_LDS();
    {
        const int sg = DIR ? 7 - rg : rg;
        f32x2v base = (f32x2v){1.f, 1.f}, all = (f32x2v){1.f, 1.f};
#pragma unroll
        for (int j = 0; j < 8; ++j) { const f32x2v T = SEGT(j); all = all * T; if (j >= sg) base = base * T; }
        f32x2v e[8];
#pragma unroll
        for (int ii = 0; ii < 8; ++ii) { f32x2v cc = c[ii]; cc.x = fmaxf(cc.x, 1e-37f); cc.y = fmaxf(cc.y, 1e-37f); e[ii] = kv[ii] * base * rcp2(cc); }
        v4u w0, w1;
        w0.x = pk2(e[0].x, e[1].x); w0.y = pk2(e[2].x, e[3].x); w0.z = pk2(e[4].x, e[5].x); w0.w = pk2(e[6].x, e[7].x);
        w1.x = pk2(e[0].y, e[1].y); w1.y = pk2(e[2].y, e[3].y); w1.z = pk2(e[4].y, e[5].y); w1.w = pk2(e[6].y, e[7].y);
        *(LAS v4u*)(KC + (2 * kp) * 144 + rg * 16) = w0; *(LAS v4u*)(KC + (2 * kp + 1) * 144 + rg * 16) = w1;
        if (rg == 0) *(f32x2v*)(dd + ((size_t)chain * NCH + n) * DK + 2 * kp) = all;
    }
    BAR_LDS();
    {
        const int fr = X.lane & 15, fq = X.lane >> 4; const int rt = X.wave; constexpr int NCT = 8;
        f32x4 acc[NCT];
#pragma unroll
        for (int t = 0; t < NCT; ++t) acc[t] = (f32x4){0.f, 0.f, 0.f, 0.f};
#pragma unroll
        for (int ks = 0; ks < 2; ++ks) { const bf16x8 a = ldsfrag(KC, 16 * rt + fr, 144, 32 * ks + 8 * fq);
#pragma unroll
            for (int t = 0; t < NCT; ++t) { const bf16x8 bb = vtfrag(VT, 16 * t + fr, 144, 32 * ks + 8 * fq); acc[t] = MFMA16(a, bb, acc[t]); } }
        bf16* Sp = St + ((size_t)chain * NCH + n) * 128 * DK;
        const lptr UT = X.lds + L1_END;
#pragma unroll
        for (int t = 0; t < NCT; ++t) { v2u w; w.x = pk2(acc[t][0], acc[t][1]); w.y = pk2(acc[t][2], acc[t][3]); *(LAS v2u*)(UT + (16 * t + fr) * 272 + (16 * rt + 4 * fq) * 2) = w; }
        BAR_LDS();
#pragma unroll
        for (int p = 0; p < 4; ++p) { const int idx = X.tid + NTHR * p, row = idx >> 4, c8 = idx & 15; *(v4u*)(Sp + (size_t)row * DK + 8 * c8) = *(const LAS v4u*)(UT + row * 272 + c8 * 16); }
    }
    BAR_LDS();
}
template <bool RET> struct LocRegs { RawRegs<128> rv, rzf, rzb; RawRegs<64> rq, rk; f32x4 c4, s4; };
template <bool RET> __device__ __forceinline__ void loc_load(const Ctx& X, const bf16* H, int r, LocRegs<RET>& R) {
    const int b = r / 768, head = (r / 128) % 6, n = r % 128; const size_t m0 = (size_t)(b * SEQ + n * CH);
    raw_load<128>(X, H, m0, (RET ? C_RV : C_HGV) + head * 128, R.rv);
    if (!RET) { raw_load<128>(X, H, m0, C_ZF + head * 128, R.rzf); raw_load<128>(X, H, m0, C_ZB + head * 128, R.rzb); }
    else { raw_load<64>(X, H, m0, C_RQ + head * 64, R.rq); raw_load<64>(X, H, m0, C_RK + head * 64, R.rk);
        const float* rc = (const float*)(X.ws + WS_ROPE) + (size_t)n * CH * 32; R.c4 = *(const f32x4*)(rc + X.tid * 4); R.s4 = *(const f32x4*)(rc + SEQ * 32 + X.tid * 4); }
}
template <int DK, bool RET>
__device__ __forceinline__ void gla_local_item(const Ctx& X, bf16* H, int l, int r, LocRegs<RET>& R, bool has_next) {
    static_assert(DK == 128 && !RET, "HGRN2 only (retention has its own path)");
    const int b = r / 768, head = (r / 128) % 6, n = r % 128;
    const float* LB = (const float*)(X.ws + WS_TAB);
    bf16* St = (bf16*)(X.ws + WS_SHG); float* dd = (float*)(X.ws + WS_DHG);
    const int kp = X.tid & 63;
    f32x2v lb0 = *(const f32x2v*)(LB + (0 * 4 + l) * 768 + head * 128 + 2 * kp), lb1 = *(const f32x2v*)(LB + (1 * 4 + l) * 768 + head * 128 + 2 * kp);
    vt_store(X, X.lds + L1_VT, R.rv); raw_store<128>(X, X.lds + L1_RAW, R.rzf); raw_store<128>(X, X.lds + L1_RAW + 16384, R.rzb);
    asm volatile("" : "+v"(lb0), "+v"(lb1)); __builtin_amdgcn_sched_barrier(0);
    if (has_next) loc_load<RET>(X, H, r + X.G, R);
    __builtin_amdgcn_sched_barrier(0);
    BAR_LDS();
    const int chain = (b * 6 + head) * 2;
    gla_local_dir<DK, RET, 0>(X, chain, n, lb0, St, dd);
    gla_local_dir<DK, RET, 1>(X, chain + 1, n, lb1, St, dd);
}

template <int DK, bool RET> struct L3 { static constexpr int SQ = (DK + 8) * 2, Q0 = 0, Q1 = 64 * SQ, KD = 96 * SQ, KH = 160 * SQ, VT = 192 * SQ, AM = VT + 128 * 144, SEG = AM + 64 * 144, RED = SEG + 4096, RAW = RED + 1024,
    ST = RAW + 32768, END = ST + 128 * 272; };
static_assert(L3<128, false>::END <= PH_BYTES && L1_END <= PH_BYTES, "mixer LDS maps");
template <int DK, bool RET, int DIR>
__device__ __forceinline__ void gla_out_dir(const Ctx& X, int chain, int n, f32x2v lb, const bf16* St, f32x4 (&o)[4], const bf16* H, size_t m0, int zbcol) {
    static_assert(DK == 128 && !RET, "HGRN2 only (retention has its own path)");
    typedef L3<DK, RET> L; constexpr int SQ = L::SQ;
    const lptr Q0 = X.lds + L::Q0, Q1 = X.lds + L::Q1, KD = X.lds + L::KD, KH = X.lds + L::KH, VT = X.lds + L::VT, AM = X.lds + L::AM; LAS float* seg = (LAS float*)(X.lds + L::SEG);
    const lptr rawz = X.lds + L::RAW, rawq = X.lds + L::RAW + 16384, ST = X.lds + L::ST;
    int t_ = X.tid; asm volatile("" : "+v"(t_));
    const int kp = t_ & 63, rg = __builtin_amdgcn_readfirstlane(t_ >> 6);
    const int fr = X.lane & 15, fq = X.lane >> 4;
    const int tb = X.wave & 3, vh = X.wave >> 2;
    SP_BEGIN()
    const bf16* Sp = St + ((size_t)chain * NCH + n) * 128 * DK;
    v4u sr[4];
#pragma unroll
    for (int p = 0; p < 4; ++p) { const int idx = X.tid + NTHR * p; sr[p] = *(const v4u*)(Sp + (size_t)idx * 8); }
    {
        f32x2v c[8], qv[8], kv[8];
        gla_prep<DIR, true>(rawz, rawq, lb, seg, kp, rg, c, qv, kv);
        BAR_LDS(); SP_END(21);
#pragma unroll
        for (int p = 0; p < 4; ++p) { const int idx = X.tid + NTHR * p; *(LAS v4u*)(ST + (idx >> 4) * 272 + (idx & 15) * 16) = sr[p]; }
        {
            const int sg = DIR ? 7 - rg : rg, ss = sg >> 2, hq = sg & 3;
            const f32x2v T0 = SEGT(0), T1 = SEGT(1), T2 = SEGT(2), T3 = SEGT(3), sub0 = (T0 * T1) * (T2 * T3);
            f32x2v pq = (f32x2v){1.f, 1.f};
#pragma unroll
            for (int j = 0; j < 3; ++j) if (j < hq) pq = pq * SEGT(4 * ss + j);
#pragma unroll
            for (int ii = 0; ii < 8; ++ii) { const int r = 8 * rg + ii; f32x2v cp = c[ii] * pq;
                const f32x2v q0 = qv[ii] * cp; cp.x = fmaxf(cp.x, 1e-37f); cp.y = fmaxf(cp.y, 1e-37f); const f32x2v kd = kv[ii] * rcp2(cp);
                *(LAS unsigned*)(KD + r * SQ + kp * 4) = pk2(kd.x, kd.y);
                *(LAS unsigned*)(Q0 + r * SQ + kp * 4) = pk2(q0.x, q0.y);
                if (ss) { const f32x2v q1 = q0 * sub0; *(LAS unsigned*)(Q1 + (DIR ? r : r - 32) * SQ + kp * 4) = pk2(q1.x, q1.y); }
                else { const f32x2v kh = kd * sub0; *(LAS unsigned*)(KH + (DIR ? r - 32 : r) * SQ + kp * 4) = pk2(kh.x, kh.y); }
                if (ii & 1) __builtin_amdgcn_sched_barrier(0); }
        }
    }
    BAR_LDS(); SP_END(22);
    RawRegs<128> zbr; if (!RET && DIR == 0) raw_load<128>(X, H, m0, zbcol, zbr);
#pragma unroll
    for (int bi = 0; bi < 2; ++bi) { const int blk = 2 * X.wave + bi, I = blk >> 2, J = blk & 3; const int sI = DIR ? 3 - I : I, sJ = DIR ? 3 - J : J;
        v2u w; w.x = 0u; w.y = 0u;
        if (sJ <= sI) { const bool same = (sI >> 1) == (sJ >> 1); const lptr KS = same ? KD : KH; const int krow = same ? 16 * J + fr : (DIR ? 16 * J + fr - 32 : 16 * J + fr);
            f32x4 acc = (f32x4){0.f, 0.f, 0.f, 0.f};
#pragma unroll
            for (int ks = 0; ks < DK / 32; ++ks) { const bf16x8 a = ldsfrag(KS, krow, SQ, 32 * ks + 8 * fq); const bf16x8 bb = ldsfrag(Q0, 16 * I + fr, SQ, 32 * ks + 8 * fq); acc = MFMA16(a, bb, acc); }
            if (sI == sJ) {
#pragma unroll
                for (int j = 0; j < 4; ++j) { const int jl = 4 * fq + j; const bool keep = DIR ? (jl >= fr) : (jl <= fr); if (!keep) acc[j] = 0.f; } }
            w.x = pk2(acc[0], acc[1]); w.y = pk2(acc[2], acc[3]); }
        *(LAS v2u*)(AM + (16 * I + fr) * 144 + (16 * J + 4 * fq) * 2) = w; }
    BAR_LDS(); SP_END(23);
    {
        const int stb = DIR ? 3 - tb : tb; const int r = 16 * tb + fr;
#pragma unroll
        for (int ks = 0; ks < 2; ++ks) { const bf16x8 bb = ldsfrag(AM, r, 144, 32 * ks + 8 * fq);
#pragma unroll
            for (int vt = 0; vt < 4; ++vt) { const bf16x8 a = vtfrag(VT, 64 * vh + 16 * vt + fr, 144, 32 * ks + 8 * fq); o[vt] = MFMA16(a, bb, o[vt]); } }
        const lptr QI = (stb >> 1) ? Q1 : Q0; const int qrow = (stb >> 1) ? (DIR ? r : r - 32) : r;
#pragma unroll
        for (int ks = 0; ks < DK / 32; ++ks) { const bf16x8 bb = ldsfrag(QI, qrow, SQ, 32 * ks + 8 * fq);
#pragma unroll
            for (int vt = 0; vt < 4; ++vt) { const bf16x8 a = ldsfrag(ST, 64 * vh + 16 * vt + fr, 272, 32 * ks + 8 * fq); o[vt] = MFMA16(a, bb, o[vt]); } }
    }
    if (!RET && DIR == 0) raw_store<128>(X, X.lds + L::RAW, zbr);
    BAR_LDS(); SP_END(24);
}
template <bool RET> struct OutRegs { RawRegs<128> rv, rzf, rzb, rq; RawRegs<64> rq6, rk6; v2u gw[4]; };
template <bool RET> __device__ __forceinline__ void out_load(const Ctx& X, const bf16* H, int r, OutRegs<RET>& R) {
    const int b = r / 768, head = (r / 128) % 6, n = r % 128; const size_t m0 = (size_t)(b * SEQ + n * CH);
    const int fr = X.lane & 15, fq = X.lane >> 4, tb = X.wave & 3, vh = X.wave >> 2; const size_t m = m0 + 16 * tb + fr; const int gcol = (RET ? C_RG : C_HGG) + head * 128;
    raw_load<128>(X, H, m0, (RET ? C_RV : C_HGV) + head * 128, R.rv);
    if (!RET) { raw_load<128>(X, H, m0, C_ZF + head * 128, R.rzf); raw_load<128>(X, H, m0, C_HGQ + head * 128, R.rq); }
    else { raw_load<64>(X, H, m0, C_RQ + head * 64, R.rq6); raw_load<64>(X, H, m0, C_RK + head * 64, R.rk6); }
#pragma unroll
    for (int t = 0; t < 4; ++t) if (RET) R.gw[t] = *(const v2u*)hptr(H, m, gcol + 64 * vh + 16 * t + 4 * fq);
}
template <int DK, bool RET>
__device__ __forceinline__ void gla_out_item(const Ctx& X, const bf16* H, bf16* Y, int l, int r, OutRegs<RET>& R, bool has_next) {
    typedef L3<DK, RET> L;
    const int b = r / 768, head = (r / 128) % 6, n = r % 128;
    const float* LB = (const float*)(X.ws + WS_TAB);
    const bf16* St = (const bf16*)(X.ws + (RET ? WS_SRT : WS_SHG));
    const int fr = X.lane & 15, fq = X.lane >> 4, tb = X.wave & 3, vh = X.wave >> 2;
    const size_t m = (size_t)(b * SEQ + n * CH + 16 * tb + fr);
    const int ycol = (RET ? 768 : 0) + head * 128;
    SP_BEGIN()
    const int kp = X.tid & 63; f32x2v lb0 = (f32x2v){0.f, 0.f}, lb1 = lb0;
    v2u gw[4];
    if (!RET) {
        lb0 = *(const f32x2v*)(LB + (0 * 4 + l) * 768 + head * 128 + 2 * kp); lb1 = *(const f32x2v*)(LB + (1 * 4 + l) * 768 + head * 128 + 2 * kp);
        vt_store(X, X.lds + L::VT, R.rv); raw_store<128>(X, X.lds + L::RAW, R.rzf); raw_store<128>(X, X.lds + L::RAW + 16384, R.rq);
    } else {
        vt_store(X, X.lds + L::VT, R.rv); raw_store<64>(X, X.lds + L::RAW, R.rq6); raw_store<64>(X, X.lds + L::RAW + 8192, R.rk6);
    }
    asm volatile("" : "+v"(lb0), "+v"(lb1)); __builtin_amdgcn_sched_barrier(0);
    if (has_next) out_load<RET>(X, H, r + X.G, R);
    __builtin_amdgcn_sched_barrier(0);
    BAR_LDS(); SP_END(20);
    const int chain = (b * 6 + head) * 2;
    f32x4 o[4];
#pragma unroll
    for (int t = 0; t < 4; ++t) o[t] = (f32x4){0.f, 0.f, 0.f, 0.f};
    const size_t m0 = (size_t)(b * SEQ + n * CH);
    gla_out_dir<DK, RET, 0>(X, chain, n, lb0, St, o, H, m0, C_ZB + head * 128);
#pragma unroll
    for (int t = 0; t < 4; ++t) gw[t] = *(const v2u*)hptr(H, m, C_HGG + head * 128 + 64 * vh + 16 * t + 4 * fq);
    gla_out_dir<DK, RET, 1>(X, chain + 1, n, lb1, St, o, H, m0, 0);
    LAS float* red = (LAS float*)(X.lds + L::RED);
    float mu = 0.f;
    if (RET) {
        float s = 0.f;
#pragma unroll
        for (int t = 0; t < 4; ++t) s += (o[t][0] + o[t][1]) + (o[t][2] + o[t][3]);
        s += __shfl_xor(s, 16); s += __shfl_xor(s, 32);
        if (fq == 0) red[128 + X.wave * 16 + fr] = s;
        BAR_LDS();
        mu = (red[128 + X.wave * 16 + fr] + red[128 + (X.wave ^ 4) * 16 + fr]) * (1.0f / 128.0f);
    }
    float s2 = 0.f;
#pragma unroll
    for (int t = 0; t < 4; ++t)
#pragma unroll
        for (int j = 0; j < 4; ++j) { const float dlt = o[t][j] - mu; s2 += dlt * dlt; }
    s2 += __shfl_xor(s2, 16); s2 += __shfl_xor(s2, 32);
    if (fq == 0) red[X.wave * 16 + fr] = s2;
    BAR_LDS();
    const float rstd = __builtin_amdgcn_rsqf((red[X.wave * 16 + fr] + red[(X.wave ^ 4) * 16 + fr]) * (1.0f / 128.0f) + EPS);
    const float* gn = X.in(RET ? 10 : 9) + l * 768 + head * 128;
#pragma unroll
    for (int t = 0; t < 4; ++t) { const int v = 64 * vh + 16 * t + 4 * fq; const f32x4 g4 = *(const f32x4*)(gn + v);
        const float g0 = bf2f(gw[t].x & 0xffffu), g1 = bf2f(gw[t].x >> 16), g2 = bf2f(gw[t].y & 0xffffu), g3 = bf2f(gw[t].y >> 16);
        const float y0 = (o[t][0] - mu) * rstd * g4.x * (g0 * __builtin_amdgcn_rcpf(1.0f + __expf(-g0))), y1 = (o[t][1] - mu) * rstd * g4.y * (g1 * __builtin_amdgcn_rcpf(1.0f + __expf(-g1)));
        const float y2 = (o[t][2] - mu) * rstd * g4.z * (g2 * __builtin_amdgcn_rcpf(1.0f + __expf(-g2))), y3 = (o[t][3] - mu) * rstd * g4.w * (g3 * __builtin_amdgcn_rcpf(1.0f + __expf(-g3)));
        v2u w; w.x = pk2(y0, y1); w.y = pk2(y2, y3); *(LAS v2u*)(X.lds + L::Q0 + (16 * tb + fr) * 272 + v * 2) = w; }
    BAR_LDS();
    { const size_t mrow = (size_t)(b * SEQ + n * CH); int t_ = X.tid; asm volatile("" : "+v"(t_));
#pragma unroll
        for (int p = 0; p < 2; ++p) { const int idx = t_ + NTHR * p, row = idx >> 4, c8 = idx & 15; *(v4u*)(Y + (mrow + row) * D + ycol + 8 * c8) = *(const LAS v4u*)(X.lds + L::Q0 + row * 272 + c8 * 16); } }
    BAR_LDS();
}

constexpr int RCH = 128, RNCH = SEQ / RCH;
constexpr int R1_VT = 0, R1_KC0 = 128 * 144, R1_KC1 = R1_KC0 + 64 * 144, R1_RAW = R1_KC1 + 64 * 144, R1_END = R1_RAW + 32768;
__device__ __forceinline__ void ret_local_item(const Ctx& X, bf16* H, int it, LocRegs<true>& R, bool has_next) {
    const int b = it / 384, head = (it / 64) % 6, n = it % 64;
    bf16* St = (bf16*)(X.ws + WS_SRT); float* dd = (float*)(X.ws + WS_DRT);
    const lptr VT = X.lds + R1_VT, KC0 = X.lds + R1_KC0, KC1 = X.lds + R1_KC1, rawq = X.lds + R1_RAW, rawk = X.lds + R1_RAW + 8192; LAS float* cs = (LAS float*)(X.lds + R1_RAW + 16384); LAS float* sn = (LAS float*)(X.lds + R1_RAW + 24576);
    const float l2f = __log2f(1.0f - exp2f(-5.0f - (float)head)), l2b = __log2f(1.0f - exp2f(-5.0f - (float)(5 - head)));
    const int chain = (b * 6 + head) * 2;
    const int fr = X.lane & 15, fq = X.lane >> 4, rt = X.wave & 3, ct0 = (X.wave >> 2) * 4;
    const int k = X.tid & 63, rq = X.tid >> 6, k2 = k & 31; const bool active = X.tid < 256;
    f32x4 accf[4], accb[4];
#pragma unroll
    for (int t = 0; t < 4; ++t) { accf[t] = (f32x4){0.f, 0.f, 0.f, 0.f}; accb[t] = accf[t]; }
#pragma unroll 1
    for (int h = 0; h < 2; ++h) {
        const int r = 2 * it + h; const size_t m0 = (size_t)(b * SEQ + (2 * n + h) * 64);
        vt_store(X, VT, R.rv); raw_store<64>(X, rawq, R.rq); raw_store<64>(X, rawk, R.rk); *(LAS f32x4*)(cs + X.tid * 4) = R.c4; *(LAS f32x4*)(sn + X.tid * 4) = R.s4;
        __builtin_amdgcn_sched_barrier(0);
        { const int nr = h == 0 ? r + 1 : 2 * (it + X.G); if (h == 0 || has_next) loc_load<true>(X, H, nr, R); }
        __builtin_amdgcn_sched_barrier(0);
        BAR_LDS();
        float qr[16], kr[16];
        if (active) {
#pragma unroll
            for (int ii = 0; ii < 16; ++ii) { const int rr = 16 * rq + ii; const float c_ = cs[rr * 32 + k2], s_ = sn[rr * 32 + k2];
                const float q1 = bf2f(*(const LAS unsigned short*)(rawq + (rr * 64 + k2) * 2)), q2 = bf2f(*(const LAS unsigned short*)(rawq + (rr * 64 + 32 + k2) * 2));
                const float k1 = bf2f(*(const LAS unsigned short*)(rawk + (rr * 64 + k2) * 2)), k2v = bf2f(*(const LAS unsigned short*)(rawk + (rr * 64 + 32 + k2) * 2));
                qr[ii] = (k < 32) ? (q1 * c_ - q2 * s_) : (q1 * s_ + q2 * c_); kr[ii] = 0.125f * ((k < 32) ? (k1 * c_ - k2v * s_) : (k1 * s_ + k2v * c_)); } }
        BAR_LDS();
        if (active) {
            float ef[16], eb[16];
#pragma unroll
            for (int ii = 0; ii < 16; ++ii) { const int rr = 16 * rq + ii, tt = 64 * h + rr; *(LAS unsigned short*)(rawq + (rr * 64 + k) * 2) = f2bf(qr[ii]); *(LAS unsigned short*)(rawk + (rr * 64 + k) * 2) = f2bf(kr[ii]);
                ef[ii] = kr[ii] * __builtin_amdgcn_exp2f((float)(RCH - 1 - tt) * l2f); eb[ii] = kr[ii] * __builtin_amdgcn_exp2f((float)tt * l2b); }
            v4u w0, w1;
            w0.x = pk2(ef[0], ef[1]); w0.y = pk2(ef[2], ef[3]); w0.z = pk2(ef[4], ef[5]); w0.w = pk2(ef[6], ef[7]); w1.x = pk2(ef[8], ef[9]); w1.y = pk2(ef[10], ef[11]); w1.z = pk2(ef[12], ef[13]); w1.w = pk2(ef[14], ef[15]);
            *(LAS v4u*)(KC0 + k * 144 + rq * 32) = w0; *(LAS v4u*)(KC0 + k * 144 + rq * 32 + 16) = w1;
            w0.x = pk2(eb[0], eb[1]); w0.y = pk2(eb[2], eb[3]); w0.z = pk2(eb[4], eb[5]); w0.w = pk2(eb[6], eb[7]); w1.x = pk2(eb[8], eb[9]); w1.y = pk2(eb[10], eb[11]); w1.z = pk2(eb[12], eb[13]); w1.w = pk2(eb[14], eb[15]);
            *(LAS v4u*)(KC1 + k * 144 + rq * 32) = w0; *(LAS v4u*)(KC1 + k * 144 + rq * 32 + 16) = w1;
        }
        BAR_LDS();
        { const int rr = X.tid >> 3, c8 = X.tid & 7; *(v4u*)hptr(H, m0 + rr, C_RQ + head * 64 + 8 * c8) = *(const LAS v4u*)(rawq + X.tid * 16); *(v4u*)hptr(H, m0 + rr, C_RK + head * 64 + 8 * c8) = *(const LAS v4u*)(rawk + X.tid * 16); }
#pragma unroll
        for (int ks = 0; ks < 2; ++ks) { const bf16x8 af = ldsfrag(KC0, 16 * rt + fr, 144, 32 * ks + 8 * fq), ab = ldsfrag(KC1, 16 * rt + fr, 144, 32 * ks + 8 * fq);
#pragma unroll
            for (int t = 0; t < 4; ++t) { const bf16x8 bb = vtfrag(VT, 16 * (ct0 + t) + fr, 144, 32 * ks + 8 * fq); accf[t] = MFMA16(af, bb, accf[t]); accb[t] = MFMA16(ab, bb, accb[t]); } }
        BAR_LDS();
    }
#pragma unroll
    for (int t = 0; t < 4; ++t) { v2u w; w.x = pk2(accf[t][0], accf[t][1]); w.y = pk2(accf[t][2], accf[t][3]); *(LAS v2u*)(X.lds + R1_END + (16 * (ct0 + t) + fr) * 144 + (16 * rt + 4 * fq) * 2) = w;
        w.x = pk2(accb[t][0], accb[t][1]); w.y = pk2(accb[t][2], accb[t][3]); *(LAS v2u*)(X.lds + R1_END + 128 * 144 + (16 * (ct0 + t) + fr) * 144 + (16 * rt + 4 * fq) * 2) = w; }
    if (X.tid < 64) { dd[((size_t)chain * RNCH + n) * 64 + X.tid] = __builtin_amdgcn_exp2f((float)RCH * l2f); dd[((size_t)(chain + 1) * RNCH + n) * 64 + X.tid] = __builtin_amdgcn_exp2f((float)RCH * l2b); }
    BAR_LDS();
#pragma unroll
    for (int dir = 0; dir < 2; ++dir) { bf16* Sp = St + ((size_t)(chain + dir) * RNCH + n) * 128 * 64; const lptr UT = X.lds + R1_END + dir * 128 * 144;
#pragma unroll
        for (int p = 0; p < 2; ++p) { const int idx = X.tid + NTHR * p, row = idx >> 3, c8 = idx & 7; *(v4u*)(Sp + (size_t)row * 64 + 8 * c8) = *(const LAS v4u*)(UT + row * 144 + c8 * 16); } }
    BAR_LDS();
}
struct RetOutRegs { v4u q[2], k[2], v[4]; };
__device__ __forceinline__ void ret_out_load(const Ctx& X, const bf16* H, int it, RetOutRegs& R) {
    const int b = it / 384, head = (it / 64) % 6, n = it % 64; const size_t m0 = (size_t)(b * SEQ + n * RCH);
    const int fr = X.lane & 15, fq = X.lane >> 4, tbq = X.wave & 3, vh = X.wave >> 2;
#pragma unroll
    for (int p = 0; p < 2; ++p) { const int idx = X.tid + NTHR * p, row = idx >> 3, c8 = idx & 7; R.q[p] = *(const v4u*)hptr(H, m0 + row, C_RQ + head * 64 + 8 * c8); R.k[p] = *(const v4u*)hptr(H, m0 + row, C_RK + head * 64 + 8 * c8); }
#pragma unroll
    for (int p = 0; p < 4; ++p) { const int idx = X.tid + NTHR * p, row = idx >> 4, c8 = idx & 15; R.v[p] = *(const v4u*)hptr(H, m0 + row, C_RV + head * 128 + 8 * c8); }
}
constexpr int R3_Q = 0, R3_K = 128 * 144, R3_VT = 2 * 128 * 144, R3_AM = R3_VT + 128 * 272, R3_RED = R3_AM + 128 * 272, R3_END = R3_RED + 4096;
static_assert(R3_END <= PH_BYTES && R1_END + 2 * 128 * 144 <= PH_BYTES, "retention LDS maps");
__device__ __forceinline__ void ret_out_item(const Ctx& X, const bf16* H, bf16* Y, int l, int it, RetOutRegs& R, bool has_next) {
    const int b = it / 384, head = (it / 64) % 6, n = it % 64; const size_t m0 = (size_t)(b * SEQ + n * RCH);
    const bf16* St = (const bf16*)(X.ws + WS_SRT);
    const lptr Q = X.lds + R3_Q, K = X.lds + R3_K, VT = X.lds + R3_VT, AM = X.lds + R3_AM; LAS float* red = (LAS float*)(X.lds + R3_RED);
    const int fr = X.lane & 15, fq = X.lane >> 4, tbq = X.wave & 3, vh = X.wave >> 2; const int ycol = 768 + head * 128;
    const float l2f = __log2f(1.0f - exp2f(-5.0f - (float)head)), l2b = __log2f(1.0f - exp2f(-5.0f - (float)(5 - head)));
    const int chain = (b * 6 + head) * 2;
#pragma unroll
    for (int p = 0; p < 2; ++p) { const int idx = X.tid + NTHR * p, row = idx >> 3, c8 = idx & 7; *(LAS v4u*)(Q + row * 144 + c8 * 16) = R.q[p]; *(LAS v4u*)(K + row * 144 + c8 * 16) = R.k[p]; }
#pragma unroll
    for (int p = 0; p < 4; ++p) { const int idx = X.tid + NTHR * p, row = idx >> 4, c8 = idx & 15; const v4u w = R.v[p];
        LAS unsigned short* d = (LAS unsigned short*)(VT + (8 * c8) * 272 + (row ^ (8 * (c8 & 7))) * 2);
        d[0] = (unsigned short)w.x; d[136] = (unsigned short)(w.x >> 16); d[272] = (unsigned short)w.y; d[408] = (unsigned short)(w.y >> 16);
        d[544] = (unsigned short)w.z; d[680] = (unsigned short)(w.z >> 16); d[816] = (unsigned short)w.w; d[952] = (unsigned short)(w.w >> 16); }
    __builtin_amdgcn_sched_barrier(0);
    if (has_next) ret_out_load(X, H, it + X.G, R);
    bf16x8 sff[2][4], sfb[2][4];
    { const bf16* Sf = St + ((size_t)chain * RNCH + n) * 128 * 64; const bf16* Sb = St + ((size_t)(chain + 1) * RNCH + n) * 128 * 64;
#pragma unroll
        for (int ks = 0; ks < 2; ++ks)
#pragma unroll
            for (int vt = 0; vt < 4; ++vt) { const size_t o_ = (size_t)(64 * vh + 16 * vt + fr) * 64 + 32 * ks + 8 * fq; sff[ks][vt] = *(const bf16x8*)(Sf + o_); sfb[ks][vt] = *(const bf16x8*)(Sb + o_); } }
    __builtin_amdgcn_sched_barrier(0);
    BAR_LDS();
#pragma unroll 1
    for (int J = 0; J < 8; ++J) { const int I = X.wave;
        f32x4 acc = (f32x4){0.f, 0.f, 0.f, 0.f};
#pragma unroll
        for (int ks = 0; ks < 2; ++ks) { const bf16x8 a = ldsfrag(K, 16 * J + fr, 144, 32 * ks + 8 * fq); const bf16x8 bb = ldsfrag(Q, 16 * I + fr, 144, 32 * ks + 8 * fq); acc = MFMA16(a, bb, acc); }
#pragma unroll
        for (int j = 0; j < 4; ++j) { const int d = (16 * I + fr) - (16 * J + 4 * fq + j); const float dec = d > 0 ? __builtin_amdgcn_exp2f((float)d * l2f) : (d < 0 ? __builtin_amdgcn_exp2f((float)(-d) * l2b) : 2.0f); acc[j] *= dec; }
        v2u w; w.x = pk2(acc[0], acc[1]); w.y = pk2(acc[2], acc[3]); *(LAS v2u*)(AM + (16 * I + fr) * 272 + (16 * J + 4 * fq) * 2) = w; }
    BAR_LDS();
    const float* gn = X.in(10) + l * 768 + head * 128;
    v2u gw[2][4];
#pragma unroll
    for (int ps = 0; ps < 2; ++ps)
#pragma unroll
        for (int t = 0; t < 4; ++t) gw[ps][t] = *(const v2u*)hptr(H, m0 + 16 * (tbq + 4 * ps) + fr, C_RG + head * 128 + 64 * vh + 16 * t + 4 * fq);
#pragma unroll
    for (int ps = 0; ps < 2; ++ps) { const int tok = 16 * (tbq + 4 * ps) + fr; f32x4 o[4];
#pragma unroll
        for (int t = 0; t < 4; ++t) o[t] = (f32x4){0.f, 0.f, 0.f, 0.f};
#pragma unroll
        for (int ks = 0; ks < 4; ++ks) { const bf16x8 bb = ldsfrag(AM, tok, 272, 32 * ks + 8 * fq);
#pragma unroll
            for (int vt = 0; vt < 4; ++vt) { const bf16x8 a = vtfrag(VT, 64 * vh + 16 * vt + fr, 272, 32 * ks + 8 * fq); o[vt] = MFMA16(a, bb, o[vt]); } }
        const bf16x8 bq0 = ldsfrag(Q, tok, 144, 8 * fq), bq1 = ldsfrag(Q, tok, 144, 32 + 8 * fq);
        const float cf = __builtin_amdgcn_exp2f((float)(tok + 1) * l2f), cb = __builtin_amdgcn_exp2f((float)(RCH - tok) * l2b);
        {
            f32x4 tf[4];
#pragma unroll
            for (int vt = 0; vt < 4; ++vt) { tf[vt] = MFMA16(sff[0][vt], bq0, ((f32x4){0.f, 0.f, 0.f, 0.f})); tf[vt] = MFMA16(sff[1][vt], bq1, tf[vt]); }
#pragma unroll
            for (int t = 0; t < 4; ++t) o[t] = o[t] + tf[t] * cf;
#pragma unroll
            for (int vt = 0; vt < 4; ++vt) { tf[vt] = MFMA16(sfb[0][vt], bq0, ((f32x4){0.f, 0.f, 0.f, 0.f})); tf[vt] = MFMA16(sfb[1][vt], bq1, tf[vt]); }
#pragma unroll
            for (int t = 0; t < 4; ++t) o[t] = o[t] + tf[t] * cb;
        }
        float s_ = 0.f;
#pragma unroll
        for (int t = 0; t < 4; ++t) s_ += (o[t][0] + o[t][1]) + (o[t][2] + o[t][3]);
        s_ += __shfl_xor(s_, 16); s_ += __shfl_xor(s_, 32);
        if (fq == 0) red[512 + (ps * 8 + X.wave) * 16 + fr] = s_;
        BAR_LDS();
        const float mu = (red[512 + (ps * 8 + X.wave) * 16 + fr] + red[512 + (ps * 8 + (X.wave ^ 4)) * 16 + fr]) * (1.0f / 128.0f); float s2 = 0.f;
#pragma unroll
        for (int t = 0; t < 4; ++t)
#pragma unroll
            for (int j = 0; j < 4; ++j) { const float dlt = o[t][j] - mu; s2 += dlt * dlt; }
        s2 += __shfl_xor(s2, 16); s2 += __shfl_xor(s2, 32);
        if (fq == 0) red[(ps * 8 + X.wave) * 16 + fr] = s2;
        BAR_LDS();
        const float rstd = __builtin_amdgcn_rsqf((red[(ps * 8 + X.wave) * 16 + fr] + red[(ps * 8 + (X.wave ^ 4)) * 16 + fr]) * (1.0f / 128.0f) + EPS);
#pragma unroll
        for (int t = 0; t < 4; ++t) { const int v = 64 * vh + 16 * t + 4 * fq; const f32x4 g4 = *(const f32x4*)(gn + v);
            const float g0 = bf2f(gw[ps][t].x & 0xffffu), g1 = bf2f(gw[ps][t].x >> 16), g2 = bf2f(gw[ps][t].y & 0xffffu), g3 = bf2f(gw[ps][t].y >> 16);
            const float y0 = (o[t][0] - mu) * rstd * g4.x * (g0 * __builtin_amdgcn_rcpf(1.0f + __expf(-g0))), y1 = (o[t][1] - mu) * rstd * g4.y * (g1 * __builtin_amdgcn_rcpf(1.0f + __expf(-g1)));
            const float y2 = (o[t][2] - mu) * rstd * g4.z * (g2 * __builtin_amdgcn_rcpf(1.0f + __expf(-g2))), y3 = (o[t][3] - mu) * rstd * g4.w * (g3 * __builtin_amdgcn_rcpf(1.0f + __expf(-g3)));
            v2u w; w.x = pk2(y0, y1); w.y = pk2(y2, y3); *(LAS v2u*)(AM + tok * 272 + v * 2) = w; } }
    BAR_LDS();
#pragma unroll
    for (int p = 0; p < 4; ++p) { const int idx = X.tid + NTHR * p, row = idx >> 4, c8 = idx & 15; *(v4u*)(Y + (m0 + row) * D + ycol + 8 * c8) = *(const LAS v4u*)(AM + row * 272 + c8 * 16); }
    BAR_LDS();
}

struct ScanBatch { v4u u[4]; f32x4 d0[4], d1[4]; };
__device__ __forceinline__ void scan_load(ScanBatch& B, const bf16* p, const float* dp, int cstride, int dstride, int dir, int s0, int nch) {
#pragma unroll
    for (int j = 0; j < 4; ++j) { const int n = dir ? nch - 1 - (s0 + j) : s0 + j; B.u[j] = *(const v4u*)(p + (size_t)n * cstride); B.d0[j] = *(const f32x4*)(dp + (size_t)n * dstride); B.d1[j] = *(const f32x4*)(dp + (size_t)n * dstride + 4); }
}
__device__ __forceinline__ void scan_step(const ScanBatch& B, float (&S)[8], bf16* p, int cstride, int dir, int s0, int nch) {
#pragma unroll
    for (int j = 0; j < 4; ++j) { const int n = dir ? nch - 1 - (s0 + j) : s0 + j;
        v4u w; w.x = pk2(S[0], S[1]); w.y = pk2(S[2], S[3]); w.z = pk2(S[4], S[5]); w.w = pk2(S[6], S[7]); *(v4u*)(p + (size_t)n * cstride) = w;
        S[0] = B.d0[j].x * S[0] + bf2f(B.u[j].x & 0xffffu); S[1] = B.d0[j].y * S[1] + bf2f(B.u[j].x >> 16); S[2] = B.d0[j].z * S[2] + bf2f(B.u[j].y & 0xffffu); S[3] = B.d0[j].w * S[3] + bf2f(B.u[j].y >> 16);
        S[4] = B.d1[j].x * S[4] + bf2f(B.u[j].z & 0xffffu); S[5] = B.d1[j].y * S[5] + bf2f(B.u[j].z >> 16); S[6] = B.d1[j].z * S[6] + bf2f(B.u[j].w & 0xffffu); S[7] = B.d1[j].w * S[7] + bf2f(B.u[j].w >> 16); }
}
__device__ __forceinline__ void scan_phase(const Ctx& X) {
    constexpr int T_HG = 24 * 2048, T_RT = 24 * 1024;
    for (int task = X.bid * NTHR + X.tid; task < T_HG + T_RT; task += X.G * NTHR) {
        bf16* p; const float* dp; int cstride, dstride, dir, nch;
        if (task < T_HG) { const int chain = task / 2048, e = task % 2048; p = (bf16*)(X.ws + WS_SHG) + (size_t)chain * NCH * 16384 + e * 8; dp = (const float*)(X.ws + WS_DHG) + (size_t)chain * NCH * 128 + (e & 15) * 8; cstride = 16384; dstride = 128; dir = chain & 1; nch = NCH; }
        else { const int t2 = task - T_HG, chain = t2 / 1024, e = t2 % 1024; p = (bf16*)(X.ws + WS_SRT) + (size_t)chain * RNCH * 8192 + e * 8; dp = (const float*)(X.ws + WS_DRT) + (size_t)chain * RNCH * 64 + (e & 7) * 8; cstride = 8192; dstride = 64; dir = chain & 1; nch = RNCH; }
        float S[8];
#pragma unroll
        for (int i = 0; i < 8; ++i) S[i] = 0.f;
        ScanBatch A, B;
        scan_load(A, p, dp, cstride, dstride, dir, 0, nch);
        for (int s0 = 0; s0 < nch; s0 += 8) {
            scan_load(B, p, dp, cstride, dstride, dir, s0 + 4, nch);
            scan_step(A, S, p, cstride, dir, s0, nch);
            if (s0 + 8 < nch) scan_load(A, p, dp, cstride, dstride, dir, s0 + 8, nch);
            scan_step(B, S, p, cstride, dir, s0 + 4, nch);
        }
    }
}

constexpr int DA_KN = 0, DA_VT = 192 * 272, DA_P = DA_VT + 128 * 400, DA_BIAS = DA_P + 64 * 400, DA_MX = DA_BIAS + 1024, DA_LX = DA_MX + 512, DA_END = DA_LX + 512;
static_assert(DA_END <= PH_BYTES, "dilated-attention LDS map");
struct DaBlk { v4u kw[2], vw[2]; };
struct DaRun { int b, g, slot, dil, rho, nb0, nbper, qcol; };
__device__ __forceinline__ DaRun da_decode(int run) {
    DaRun I; I.b = run / 384; const int rem = run % 384; I.g = rem / 128; const int rem2 = rem % 128; I.slot = rem2 / 32; const int rb = rem2 % 32;
    I.dil = I.g == 0 ? 1 : (I.g == 1 ? 4 : 16); I.nbper = 128 / I.dil; const int rpr = I.nbper / 4; I.rho = rb / rpr; I.nb0 = 4 * (rb % rpr); I.qcol = C_DIL + (3 * I.g) * 512 + I.slot * 128; return I;
}
__device__ __forceinline__ void da_blk_load(const Ctx& X, const bf16* H, const DaRun& I, int kb, DaBlk& R) {
    const bool ok = kb >= 0 && kb < I.nbper; const size_t mb = (size_t)I.b * SEQ; const int kcol = I.qcol + 512, vcol = I.qcol + 1024;
#pragma unroll
    for (int p = 0; p < 2; ++p) { const int r = (X.tid >> 4) + 32 * p, c8 = X.tid & 15; R.kw[p] = (v4u){0u, 0u, 0u, 0u}; R.vw[p] = (v4u){0u, 0u, 0u, 0u};
        if (ok) { const size_t mr = mb + (size_t)((64 * kb + r) * I.dil + I.rho); R.kw[p] = *(const v4u*)hptr(H, mr, kcol + 8 * c8); R.vw[p] = *(const v4u*)hptr(H, mr, vcol + 8 * c8); } }
}
__device__ __forceinline__ void da_blk_stage(const Ctx& X, const float* kg, int kb, const DaBlk& R) {
    const lptr KN = X.lds + DA_KN, VT = X.lds + DA_VT; const int slot = ((kb % 3) + 3) % 3;
#pragma unroll
    for (int p = 0; p < 2; ++p) { const int row = slot * 64 + (X.tid >> 4) + 32 * p, c8 = X.tid & 15; const v4u kw = R.kw[p], vw = R.vw[p];
        float f[8]; f[0] = bf2f(kw.x & 0xffffu); f[1] = bf2f(kw.x >> 16); f[2] = bf2f(kw.y & 0xffffu); f[3] = bf2f(kw.y >> 16); f[4] = bf2f(kw.z & 0xffffu); f[5] = bf2f(kw.z >> 16); f[6] = bf2f(kw.w & 0xffffu); f[7] = bf2f(kw.w >> 16);
        float s = 0.f;
#pragma unroll
        for (int e = 0; e < 8; ++e) s += f[e] * f[e];
        s += __shfl_xor(s, 1); s += __shfl_xor(s, 2); s += __shfl_xor(s, 4); s += __shfl_xor(s, 8);
        const float sc = __builtin_amdgcn_rsqf(s * (1.0f / 128.0f) + EPS); const f32x4 g0 = *(const f32x4*)(kg + 8 * c8), g1 = *(const f32x4*)(kg + 8 * c8 + 4);
        v4u o; o.x = pk2(f[0] * sc * g0.x, f[1] * sc * g0.y); o.y = pk2(f[2] * sc * g0.z, f[3] * sc * g0.w); o.z = pk2(f[4] * sc * g1.x, f[5] * sc * g1.y); o.w = pk2(f[6] * sc * g1.z, f[7] * sc * g1.w);
        *(LAS v4u*)(KN + row * 272 + c8 * 16) = o;
        LAS unsigned short* d = (LAS unsigned short*)(VT + (8 * c8) * 400 + (row ^ (8 * (c8 & 7))) * 2);
        d[0] = (unsigned short)vw.x; d[200] = (unsigned short)(vw.x >> 16); d[400] = (unsigned short)vw.y; d[600] = (unsigned short)(vw.y >> 16);
        d[800] = (unsigned short)vw.z; d[1000] = (unsigned short)(vw.z >> 16); d[1200] = (unsigned short)vw.w; d[1400] = (unsigned short)(vw.w >> 16); }
}
__device__ __forceinline__ void da_q_load(const Ctx& X, const bf16* H, const DaRun& I, int nb, v4u (&qw)[4]) {
    const int fr = X.lane & 15, fq = X.lane >> 4, qb = X.wave & 3; const size_t m = (size_t)I.b * SEQ + (size_t)((64 * nb + 16 * qb + fr) * I.dil + I.rho);
#pragma unroll
    for (int ks = 0; ks < 4; ++ks) qw[ks] = *(const v4u*)hptr(H, m, I.qcol + 32 * ks + 8 * fq);
}
__device__ __forceinline__ void dil_run(const Ctx& X, bf16* H, int l, int run) {
    const DaRun I = da_decode(run); const int b = I.b, g = I.g, slot = I.slot, dil = I.dil, rho = I.rho, qcol = I.qcol, Ls = SEQ / I.dil;
    const lptr KN = X.lds + DA_KN, VT = X.lds + DA_VT, P = X.lds + DA_P; LAS float* bias = (LAS float*)(X.lds + DA_BIAS); LAS float* mx = (LAS float*)(X.lds + DA_MX); LAS float* lx = (LAS float*)(X.lds + DA_LX);
    const float* qg = X.in(11) + l * 128; const float* kg = X.in(12) + l * 128; asm volatile("" : "+s"(qg), "+s"(kg));
    const int fr = X.lane & 15, fq = X.lane >> 4, qb = X.wave & 3, kh = X.wave >> 2; const int qi = 16 * qb + fr;
    SP_BEGIN()
    {
        DaBlk B0, B1, B2; da_blk_load(X, H, I, I.nb0 - 1, B0); da_blk_load(X, H, I, I.nb0, B1); da_blk_load(X, H, I, I.nb0 + 1, B2);
        if (X.tid < 256) bias[X.tid] = (X.tid >= 63 && X.tid <= 191) ? ((const float*)(X.ws + WS_TAB) + 2 * 4 * 768)[(g * 4 + slot) * 132 + X.tid - 63] : -1e30f;
        da_blk_stage(X, kg, I.nb0 - 1, B0); da_blk_stage(X, kg, I.nb0, B1); da_blk_stage(X, kg, I.nb0 + 1, B2);
    }
    v4u qw_[4]; da_q_load(X, H, I, I.nb0, qw_);
    for (int i = 0; i < 4; ++i) {
        const int nb = I.nb0 + i; const size_t qtok = (size_t)((64 * nb + qi) * dil + rho);
        bf16x8 qf[4];
        {
            float s = 0.f;
#pragma unroll
            for (int ks = 0; ks < 4; ++ks) { const v4u qw = qw_[ks];
                const float a0 = bf2f(qw.x & 0xffffu), a1 = bf2f(qw.x >> 16), a2 = bf2f(qw.y & 0xffffu), a3 = bf2f(qw.y >> 16), a4 = bf2f(qw.z & 0xffffu), a5 = bf2f(qw.z >> 16), a6 = bf2f(qw.w & 0xffffu), a7 = bf2f(qw.w >> 16);
                s += (a0 * a0 + a1 * a1) + (a2 * a2 + a3 * a3) + (a4 * a4 + a5 * a5) + (a6 * a6 + a7 * a7); }
            s += __shfl_xor(s, 16); s += __shfl_xor(s, 32);
            const float sc = (0.08838834764831845f * 1.4426950408889634f) * __builtin_amdgcn_rsqf(s * (1.0f / 128.0f) + EPS);
#pragma unroll
            for (int ks = 0; ks < 4; ++ks) { const v4u qw = qw_[ks]; const f32x4 g0 = *(const f32x4*)(qg + 32 * ks + 8 * fq), g1 = *(const f32x4*)(qg + 32 * ks + 8 * fq + 4);
                v4u o; o.x = pk2(bf2f(qw.x & 0xffffu) * sc * g0.x, bf2f(qw.x >> 16) * sc * g0.y); o.y = pk2(bf2f(qw.y & 0xffffu) * sc * g0.z, bf2f(qw.y >> 16) * sc * g0.w);
                o.z = pk2(bf2f(qw.z & 0xffffu) * sc * g1.x, bf2f(qw.z >> 16) * sc * g1.y); o.w = pk2(bf2f(qw.w & 0xffffu) * sc * g1.z, bf2f(qw.w >> 16) * sc * g1.w);
                qf[ks] = __builtin_bit_cast(bf16x8, o); }
        }
        asm volatile("" : "+v"(qf[0]), "+v"(qf[1]), "+v"(qf[2]), "+v"(qf[3]));
        __builtin_amdgcn_sched_barrier(0);
        DaBlk Bn; if (i < 3) { da_blk_load(X, H, I, nb + 2, Bn); da_q_load(X, H, I, nb + 1, qw_); }
        __builtin_amdgcn_sched_barrier(0);
        BAR_LDS(); SP_END(16);
        f32x4 sc[6]; float mloc = -1e30f;
        const LAS float* tb = bias + (96 * kh + 4 * fq - qi + 63);
        const bool edge_lo = nb == 0, edge_hi = nb == I.nbper - 1;
#pragma unroll
        for (int t = 0; t < 6; ++t) { f32x4 acc = (f32x4){0.f, 0.f, 0.f, 0.f}; const int rrow = (64 * nb + 128 + 96 * kh + 16 * t) % 192;
#pragma unroll
            for (int ks = 0; ks < 4; ++ks) { const bf16x8 a = ldsfrag(KN, rrow + fr, 272, 32 * ks + 8 * fq); acc = MFMA16(a, qf[ks], acc); }
#pragma unroll
            for (int j = 0; j < 4; ++j) acc[j] += tb[16 * t + j];
            if (edge_lo || edge_hi) {
#pragma unroll
                for (int j = 0; j < 4; ++j) { const int kj = 64 * nb - 64 + 96 * kh + 16 * t + 4 * fq + j; if (kj < 0 || kj >= Ls) acc[j] = -1e30f; } }
            mloc = fmaxf(fmaxf(mloc, fmaxf(acc[0], acc[1])), fmaxf(acc[2], acc[3]));
            sc[t] = acc; }
        mloc = fmaxf(mloc, __shfl_xor(mloc, 16)); mloc = fmaxf(mloc, __shfl_xor(mloc, 32));
        if (fq == 0) mx[kh * 64 + qi] = mloc;
        BAR_LDS(); SP_END(17);
        const float mrow = fmaxf(mx[qi], mx[64 + qi]); float lloc = 0.f;
#pragma unroll
        for (int t = 0; t < 6; ++t) { float p[4];
#pragma unroll
            for (int j = 0; j < 4; ++j) { p[j] = __builtin_amdgcn_exp2f(sc[t][j] - mrow); lloc += p[j]; }
            v2u w; w.x = pk2(p[0], p[1]); w.y = pk2(p[2], p[3]); *(LAS v2u*)(P + qi * 400 + (96 * kh + 16 * t + 4 * fq) * 2) = w; }
        lloc += __shfl_xor(lloc, 16); lloc += __shfl_xor(lloc, 32);
        if (fq == 0) lx[kh * 64 + qi] = lloc;
        BAR_LDS(); SP_END(18);
        const int dh = kh; const float lrow = lx[qi] + lx[64 + qi]; const float inv = __builtin_amdgcn_rcpf(lrow);
        f32x4 oo[4];
#pragma unroll
        for (int t = 0; t < 4; ++t) oo[t] = (f32x4){0.f, 0.f, 0.f, 0.f};
#pragma unroll
        for (int ks = 0; ks < 6; ++ks) { const bf16x8 bb = ldsfrag(P, qi, 400, 32 * ks + 8 * fq); const int rcol = (64 * nb + 128 + 32 * ks) % 192;
#pragma unroll
            for (int t = 0; t < 4; ++t) { const bf16x8 a = vtfrag(VT, 64 * dh + 16 * t + fr, 400, rcol + 8 * fq); oo[t] = MFMA16(a, bb, oo[t]); } }
        BAR_LDS();
#pragma unroll
        for (int t = 0; t < 4; ++t) { v2u w; w.x = pk2(oo[t][0] * inv, oo[t][1] * inv); w.y = pk2(oo[t][2] * inv, oo[t][3] * inv); *(LAS v2u*)(P + qi * 272 + (64 * dh + 16 * t + 4 * fq) * 2) = w; }
        if (dh == 0 && fq == 0) ((float*)(X.ws + WS_LSE))[((size_t)g * M + (size_t)b * SEQ + qtok) * 4 + slot] = 0.6931471805599453f * (mrow + __log2f(lrow));
        BAR_LDS(); SP_END(19);
#pragma unroll
        for (int p = 0; p < 2; ++p) { const int idx = X.tid + NTHR * p, row = idx >> 4, c8 = idx & 15; *(v4u*)hptr(H, (size_t)b * SEQ + (size_t)((64 * nb + row) * dil + rho), qcol + 8 * c8) = *(const LAS v4u*)(P + row * 272 + c8 * 16); }
        if (i < 3) da_blk_stage(X, kg, nb + 2, Bn);
    }
    BAR_LDS();
}
__device__ __forceinline__ void dil_merge_item(const Ctx& X, const bf16* H, bf16* Y, int it) {
    const float* LSE = (const float*)(X.ws + WS_LSE);
#pragma unroll
    for (int p = 0; p < 8; ++p) { const int idx = X.tid + NTHR * p; const int tk = idx >> 6, slot = (idx >> 4) & 3, c8 = idx & 15; const size_t m = (size_t)it * 64 + tk;
        const float l0 = LSE[(0 * (size_t)M + m) * 4 + slot], l1 = LSE[(1 * (size_t)M + m) * 4 + slot], l2 = LSE[(2 * (size_t)M + m) * 4 + slot]; const float mxl = fmaxf(l0, fmaxf(l1, l2));
        const float e0 = __expf(l0 - mxl), e1 = __expf(l1 - mxl), e2 = __expf(l2 - mxl), inv = __builtin_amdgcn_rcpf(e0 + e1 + e2); const float w[3] = {e0 * inv, e1 * inv, e2 * inv};
        float acc[8];
#pragma unroll
        for (int e = 0; e < 8; ++e) acc[e] = 0.f;
#pragma unroll
        for (int g = 0; g < 3; ++g) { const v4u ow = *(const v4u*)hptr(H, m, C_DIL + (3 * g) * 512 + slot * 128 + 8 * c8);
            acc[0] += w[g] * bf2f(ow.x & 0xffffu); acc[1] += w[g] * bf2f(ow.x >> 16); acc[2] += w[g] * bf2f(ow.y & 0xffffu); acc[3] += w[g] * bf2f(ow.y >> 16);
            acc[4] += w[g] * bf2f(ow.z & 0xffffu); acc[5] += w[g] * bf2f(ow.z >> 16); acc[6] += w[g] * bf2f(ow.w & 0xffffu); acc[7] += w[g] * bf2f(ow.w >> 16); }
        v4u o; o.x = pk2(acc[0], acc[1]); o.y = pk2(acc[2], acc[3]); o.z = pk2(acc[4], acc[5]); o.w = pk2(acc[6], acc[7]);
        *(v4u*)(Y + m * D + 1536 + slot * 128 + 8 * c8) = o; }
}

#ifndef MK_N_LAUNCHES
#define MK_N_LAUNCHES 1
#endif
__global__ void __launch_bounds__(NTHR, 2) mega_fwd(Args args) {
    extern __shared__ __attribute__((aligned(16))) unsigned char lds_raw[];
    const lptr lds = (lptr)lds_raw;
    volatile LAS unsigned* MISC = (volatile LAS unsigned*)(lds + MISC_OFF);
    for (int u = threadIdx.x; u < (LDS_BYTES - LDSCTL_OFF) / 4; u += NTHR) ((LAS unsigned*)(lds + LDSCTL_OFF))[u] = 0u;
    __syncthreads();
    XcdBarrier bar; bar.bar = (unsigned*)(args.ws + WS_CTL) + CW_BAR; bar.x = 0; bar.st = nullptr;
    if (MK_N_LAUNCHES == 1) bar = xcd_barrier_post((unsigned*)(args.ws + WS_CTL) + CW_BAR, MISC + 8);
    const int lo = args.ph_lo, hi = args.ph_hi;
#ifndef PROBE_K
#define PROBE_K 1
#endif
#define PB_BEGIN(bit) unsigned long long pt0_ = 0; if (PROBE_MASK & (1 << (bit))) pt0_ = __builtin_amdgcn_s_memrealtime();
#define PB_END(bit) if ((PROBE_MASK & (1 << 15)) && ((226 >> (bit)) & 1)) { const unsigned long long t1_ = __builtin_amdgcn_s_memrealtime(); while (__builtin_amdgcn_s_memrealtime() - t1_ < 10000ull) __builtin_amdgcn_s_sleep(8); } \
    if (PROBE_MASK & (1 << (bit))) { const unsigned long long t1_ = __builtin_amdgcn_s_memrealtime(), dt_ = (t1_ - pt0_) * PROBE_K; while (__builtin_amdgcn_s_memrealtime() - t1_ < dt_) __builtin_amdgcn_s_sleep(8); }
#define IN(k) (lo <= (k) && (k) < hi)
#define SEAM(k) do { if (IN(k) && IN((k) + 1)) { xcd_barrier(bar); if (PROBE_MASK & (1 << 14)) xcd_barrier(bar); } } while (0)
#define PHASE_CTX() const Ctx X = mkctx(lds); bf16* const XB = (bf16*)(X.ws + WS_XB); bf16* const Y = (bf16*)(X.ws + WS_Y); bf16* const H = (bf16*)(X.ws + WS_H); float* const ss_mix = (float*)(X.ws + WS_PART); \
        float* const ss_mix_next = ss_mix; float* const ss_mlp = ss_mix + (size_t)M * 32; (void)XB; (void)Y; (void)H; (void)ss_mix; (void)ss_mix_next; (void)ss_mlp;

    #ifndef NO_PRO
    if (IN(0)) { PB_BEGIN(0) const Ctx X = mkctx(lds); prologue(X); PB_END(0) }
#endif
    SEAM(0);
    for (int l = 0; l < DEPTH; ++l) {
        const int pb = 1 + 7 * l;
#if !defined(NO_GEMM) && !defined(NO_GA)
        if (IN(pb + 0)) { PB_BEGIN(1) PHASE_CTX(); pg8::Gemm g{XB, (const bf16*)(X.ws + WS_WIN) + (size_t)l * INW * D, M, INW, D}; pg8::StaticOrder S; S.init(M, INW, X.G, X.bid);
            pg8::EpiScaleBf16<0, true> E{H, M, ss_mix, (LAS float*)(X.lds + 131072)}; pg8::gemm_phase<pg8::EpiScaleBf16<0, true>, pg8::StaticOrder, true, true>(X.lds, g, S, E);
            if (X.G == 256 && X.bid >= 128 && l + 1 < DEPTH) {
                LAS float* scr = (LAS float*)(X.lds + X.wave * TR_SCR);
                for (int r = (X.bid - 128) * NWAVES + X.wave; r < TAILQ; r += 128 * NWAVES) convert_item(X, l + 1, r, scr); }
            PB_END(1) }
#endif
        SEAM(pb + 0);
#ifndef NO_MIX1
        if (IN(pb + 1)) { PB_BEGIN(2)
#ifndef NO_DA
            { PB_BEGIN(8) PHASE_CTX(); const int vcu = (X.G % 8 == 0) ? (X.bid % 8) * (X.G / 8) + X.bid / 8 : X.bid;
              for (int run = vcu; run < 768; run += X.G) dil_run(X, H, l, run); PB_END(8) }
#endif
#ifndef NO_HG1
            { PB_BEGIN(9) PHASE_CTX(); LocRegs<false> R; loc_load<false>(X, H, X.bid, R); for (int r = X.bid; r < 1536; r += X.G) gla_local_item<128, false>(X, H, l, r, R, r + X.G < 1536); PB_END(9) }
#endif
#ifndef NO_RT1
            { PB_BEGIN(10) PHASE_CTX(); LocRegs<true> R; loc_load<true>(X, H, 2 * X.bid, R); for (int it = X.bid; it < 768; it += X.G) ret_local_item(X, H, it, R, it + X.G < 768); PB_END(10) }
#endif
        PB_END(2) }
#endif
        SEAM(pb + 1);
#ifndef NO_SCAN
        if (IN(pb + 2)) { PB_BEGIN(3) const Ctx X = mkctx(lds); scan_phase(X); PB_END(3) }
#endif
        SEAM(pb + 2);
#ifndef NO_MIX2
        if (IN(pb + 3)) { PB_BEGIN(4)
#ifndef NO_HG2
            { PB_BEGIN(11) PHASE_CTX(); OutRegs<false> R; out_load<false>(X, H, X.bid, R); for (int r = X.bid; r < 1536; r += X.G) gla_out_item<128, false>(X, H, Y, l, r, R, r + X.G < 1536); PB_END(11) }
#endif
#ifndef NO_RT2
            { PB_BEGIN(12) PHASE_CTX(); RetOutRegs R; ret_out_load(X, H, X.bid, R); for (int it = X.bid; it < 768; it += X.G) ret_out_item(X, H, Y, l, it, R, it + X.G < 768); PB_END(12) }
#endif
#ifndef NO_DM
            { PHASE_CTX(); for (int it = X.bid; it < 256; it += X.G) dil_merge_item(X, H, Y, it); }
#endif
        PB_END(4) }
#endif
        SEAM(pb + 3);
#if !defined(NO_GEMM) && !defined(NO_GE)
        if (IN(pb + 4)) { PB_BEGIN(5) PHASE_CTX(); pg8::Gemm g{Y, (const bf16*)(X.ws + WS_WOUT) + (size_t)l * D * D, M, D, D}; pg8::StaticOrder S; S.init(M, D, X.G, X.bid);
            pg8::EpiResid<false> E{XB, nullptr, ss_mlp}; pg8::gemm_phase<pg8::EpiResid<false>, pg8::StaticOrder, true, true>(X.lds, g, S, E); PB_END(5) }
#endif
        SEAM(pb + 4);
#if !defined(NO_GEMM) && !defined(NO_GF)
        if (IN(pb + 5)) { PB_BEGIN(6) PHASE_CTX(); pg8::Gemm g{XB, (const bf16*)(X.ws + WS_WUP) + (size_t)l * FF * D, M, FF, D}; pg8::StaticOrder S; S.init(M, FF, X.G, X.bid);
            pg8::EpiScaleBf16<1> E{H, FF, ss_mlp, (LAS float*)(X.lds + 131072)}; pg8::gemm_phase<pg8::EpiScaleBf16<1>, pg8::StaticOrder, true, true>(X.lds, g, S, E); PB_END(6) }
#endif
        SEAM(pb + 5);
#if !defined(NO_GEMM) && !defined(NO_GG)
        if (IN(pb + 6)) { PB_BEGIN(7) PHASE_CTX(); pg8::Gemm g{H, (const bf16*)(X.ws + WS_WDN) + (size_t)l * D * FF, M, D, FF}; pg8::StaticOrder S; S.init(M, D, X.G, X.bid);
            if (l < DEPTH - 1) { pg8::EpiResid<false> E{XB, nullptr, ss_mix_next}; pg8::gemm_phase<pg8::EpiResid<false>, pg8::StaticOrder, true, true>(X.lds, g, S, E); }
            else { pg8::EpiResid<true> E{XB, X.out(), nullptr}; pg8::gemm_phase<pg8::EpiResid<true>, pg8::StaticOrder, true, true>(X.lds, g, S, E); }
            PB_END(7) }
#endif
        SEAM(pb + 6);
    }
#undef IN
#undef SEAM
}

extern "C" void kernel_launch(void* const* d_in, const int* in_sizes, int n_in, void* d_out, int out_size, void* d_ws, size_t ws_size, hipStream_t stream) {
    static int grid = 0;
    if (grid == 0) {
        if (n_in != 14 || in_sizes[0] != M * D || out_size != M * D || ws_size < WS_END) { fprintf(stderr, "kernel_launch: unexpected problem (n_in %d, in0 %d, out %d, ws %zu < %zu); nothing launched\n", n_in, n_in > 0 ? in_sizes[0] : -1, out_size, ws_size, (size_t)WS_END); grid = -1; return; }
        int dev = 0, cus = 0, per_cu = 0;
        if (hipGetDevice(&dev) != hipSuccess || hipDeviceGetAttribute(&cus, hipDeviceAttributeMultiprocessorCount, dev) != hipSuccess) { grid = -1; return; }
        if (hipFuncSetAttribute((const void*)mega_fwd, hipFuncAttributeMaxDynamicSharedMemorySize, LDS_BYTES) != hipSuccess) { fprintf(stderr, "kernel_launch: hipFuncSetAttribute failed\n"); grid = -1; return; }
        if (hipOccupancyMaxActiveBlocksPerMultiprocessor(&per_cu, (const void*)mega_fwd, NTHR, LDS_BYTES) != hipSuccess || per_cu < 1) fprintf(stderr, "kernel_launch: occupancy query reports %d workgroups per CU\n", per_cu);
        (void)hipGetLastError();
        grid = cus;
    }
    if (grid < 0) return;
    (void)hipMemsetAsync((char*)d_ws + WS_CTL, 0, CTL_ZERO_BYTES, stream);
    Args a{};
    for (int i = 0; i < 14; ++i) a.in[i] = (const float*)d_in[i];
    a.out = (float*)d_out; a.ws = (unsigned char*)d_ws;
    if (MK_N_LAUNCHES == 1) { a.ph_lo = 0; a.ph_hi = NPHASE; hipLaunchKernelGGL(mega_fwd, dim3(grid), dim3(NTHR), LDS_BYTES, stream, a); }
    else for (int p = 0; p < NPHASE; ++p) { a.ph_lo = p; a.ph_hi = p + 1; hipLaunchKernelGGL(mega_fwd, dim3(grid), dim3(NTHR), LDS_BYTES, stream, a); }
}
```

```cpp
#include <hip/hip_runtime.h>
#include <cstdio>
#include <cstdint>
namespace pg8 {
#define PG8_LAS __attribute__((address_space(3)))
typedef unsigned short bf16_t;
typedef short bf16x8 __attribute__((ext_vector_type(8)));
typedef float f32x4 __attribute__((ext_vector_type(4)));
typedef unsigned u32x4 __attribute__((ext_vector_type(4)));
constexpr int BM = 256, BK = 64, HALF = 128, HTB = HALF * BK * 2  , STAGE_BYTES = 8 * HTB, NXCD = 8, WGM = 4;

__host__ __device__ __forceinline__ int lds_byte(int r, int c) { const int st = (r >> 4) * 2 + (c >> 5), rr = r & 15, cc = c & 31, ob = rr * 64 + cc * 2; return st * 1024 + (ob ^ (((ob >> 9) & 1) << 5)); }
__host__ __device__ __forceinline__ void stage_rc(int b, int& R, int& C) { const int st = b / 1024, sb = b % 1024, swz = sb ^ (((sb >> 9) & 1) << 5); R = (st >> 1) * 16 + swz / 64; C = (st & 1) * 32 + (swz % 64) / 2; }
__host__ __device__ __forceinline__ int perm32(int rho) { const int n = rho >> 4, i = rho & 15; return 8 * (i >> 2) + 4 * n + (i & 3); }

struct Unit { int pm, pn; };
struct Gemm { const bf16_t* A; const bf16_t* Bt; int M, N, K; };

struct StaticOrder {
    int nM, nN, nwg, G, c;
    __host__ __device__ void init(int M, int N, int G_, int c_) { nM = M / BM; nN = N / BM; nwg = nM * nN; G = G_; c = c_; }
    __host__ __device__ bool next(int i, Unit& u) const {
        const long L = (long)i * G + c; if (L >= nwg) return false;
        int wgid = (int)L; { const int q = nwg / NXCD, r = nwg % NXCD, xcd = wgid % NXCD, off = wgid / NXCD; wgid = (xcd < r ? xcd * (q + 1) : r * (q + 1) + (xcd - r) * q) + off; }
        const int nig = WGM * nN, gid = wgid / nig, fm = gid * WGM, gsz = (nM - fm) < WGM ? (nM - fm) : WGM;
        u.pm = fm + ((wgid % nig) % gsz); u.pn = (wgid % nig) / gsz; return true;
    }
    __device__ __forceinline__ void a_ready(const Unit&) const {}
    __device__ __forceinline__ void done(const Unit&) const {}
};

typedef float f32x2 __attribute__((ext_vector_type(2))); typedef __bf16 bf16x2_t __attribute__((ext_vector_type(2)));
__device__ __forceinline__ unsigned cvt_pk_bf16(float lo, float hi) { f32x2 v = {lo, hi}; bf16x2_t b = __builtin_convertvector(v, bf16x2_t); return __builtin_bit_cast(unsigned, b); }

template <int ACT, bool BLK = false, bool PERMROWS = false> struct EpiScaleBf16 {
    static constexpr bool PERM = true, AFTER_DRAIN = false, HAS_PREP = true;
    bf16_t* O; int ldc; const float* ss; PG8_LAS float* rtab;
    __device__ __forceinline__ void prep(const Unit& u, int tid, int buf) const {
        if (tid < BM) { const float* p = ss + (size_t)(u.pm * BM + tid) * 32; float sq = 0.f;
#pragma unroll
            for (int i = 0; i < 8; ++i) { const f32x4 v = *(const f32x4*)(p + 4 * i); sq += (v[0] + v[1]) + (v[2] + v[3]); }
            rtab[buf * BM + tid] = __builtin_amdgcn_rsqf(sq * (1.0f / 2048.0f) + 1e-6f); }
    }
    __device__ __forceinline__ void operator()(const f32x4 (&acc)[2][2][4][2], const Unit& u, int wr, int wc, int fr, int fq, int buf) const {
        const int row0 = u.pm * BM + wr * 64 + fr; const int col0 = u.pn * BM + wc * 32 + 8 * fq;
#pragma unroll
        for (int ai = 0; ai < 2; ++ai)
#pragma unroll
            for (int m = 0; m < 4; ++m) { const int row = row0 + ai * HALF + m * 16;
                const float sc = rtab[buf * BM + wr * 64 + fr + ai * HALF + m * 16];
                int prow = row;
                if (PERMROWS && u.pn >= 24) { const int sh = 2 * ((u.pn - 24) / 6), t = row & 8191; prow = (row & ~8191) + ((t & ((1 << sh) - 1)) << (13 - sh)) + (t >> sh); }
                bf16_t* rowp = BLK ? O + ((size_t)(2 * u.pn) * ldc + prow) * 128 + wc * 32 + 8 * fq : O + (size_t)row * ldc + col0;
#pragma unroll
                for (int bj = 0; bj < 2; ++bj) { f32x4 v0 = acc[ai][bj][m][0] * sc, v1 = acc[ai][bj][m][1] * sc;
                    if (ACT == 1) {
#pragma unroll
                        for (int e = 0; e < 4; ++e) { float a = v0[e] > 0.f ? v0[e] : 0.f; v0[e] = a * a; float b = v1[e] > 0.f ? v1[e] : 0.f; v1[e] = b * b; } }
                    u32x4 w; w.x = cvt_pk_bf16(v0[0], v0[1]); w.y = cvt_pk_bf16(v0[2], v0[3]); w.z = cvt_pk_bf16(v1[0], v1[1]); w.w = cvt_pk_bf16(v1[2], v1[3]);
                    *(u32x4*)(rowp + (BLK ? (size_t)bj * ldc * 128 : (size_t)bj * HALF)) = w; } }
    }
};
template <bool FINAL> struct EpiResid {
    static constexpr bool PERM = true, AFTER_DRAIN = false, HAS_PREP = false;
    bf16_t* xb; float* out; float* ssn;
    __device__ __forceinline__ void operator()(const f32x4 (&acc)[2][2][4][2], const Unit& u, int wr, int wc, int fr, int fq) const {
        const int col0 = u.pn * BM + wc * 32 + 8 * fq;
#pragma unroll
        for (int ai = 0; ai < 2; ++ai)
#pragma unroll
            for (int m = 0; m < 4; ++m) { const int row = u.pm * BM + ai * HALF + wr * 64 + m * 16 + fr; const size_t off = (size_t)row * 2048 + col0; float sq = 0.f;
#pragma unroll
                for (int bj = 0; bj < 2; ++bj) { const size_t o2 = off + bj * HALF; const u32x4 xw = *(const u32x4*)(xb + o2);
                    f32x4 x0, x1; x0[0] = __uint_as_float(xw.x << 16); x0[1] = __uint_as_float(xw.x & 0xffff0000u); x0[2] = __uint_as_float(xw.y << 16); x0[3] = __uint_as_float(xw.y & 0xffff0000u);
                    x1[0] = __uint_as_float(xw.z << 16); x1[1] = __uint_as_float(xw.z & 0xffff0000u); x1[2] = __uint_as_float(xw.w << 16); x1[3] = __uint_as_float(xw.w & 0xffff0000u);
                    x0 = x0 + acc[ai][bj][m][0]; x1 = x1 + acc[ai][bj][m][1];
                    if (FINAL) { *(f32x4*)(out + o2) = x0; *(f32x4*)(out + o2 + 4) = x1; }
                    else { u32x4 w; w.x = cvt_pk_bf16(x0[0], x0[1]); w.y = cvt_pk_bf16(x0[2], x0[3]); w.z = cvt_pk_bf16(x1[0], x1[1]); w.w = cvt_pk_bf16(x1[2], x1[3]); *(u32x4*)(xb + o2) = w; }
                    sq += ((x0[0] * x0[0] + x0[1] * x0[1]) + (x0[2] * x0[2] + x0[3] * x0[3])) + ((x1[0] * x1[0] + x1[1] * x1[1]) + (x1[2] * x1[2] + x1[3] * x1[3])); }
                sq += __shfl_xor(sq, 16); sq += __shfl_xor(sq, 32);
                if (!FINAL && fq == 0) ssn[(size_t)row * 32 + u.pn * 4 + wc] = sq; }
    }
};
template <class Epi, class Sched, bool ALIGN_EPI = false, bool SP2 = false>
__device__ __forceinline__ void gemm_phase(PG8_LAS unsigned char* lds, const Gemm g, const Sched& S, const Epi& E) {
    int tid_ = threadIdx.x; asm volatile("" : "+v"(tid_));
    const int tid = tid_, wid = __builtin_amdgcn_readfirstlane(tid >> 6), lane = tid & 63, wr = wid >> 2, wc = wid & 3, fr = lane & 15, fq = lane >> 4;
    const int K = g.K, nt = K / BK;
    unsigned voffA[2], voffB[2];
#pragma unroll
    for (int i = 0; i < 2; ++i) { int R, C; stage_rc(tid * 16 + i * 8192, R, C); const int Rb = Epi::PERM ? ((R & ~31) + perm32(R & 31)) : R;
        voffA[i] = (unsigned)(R * K + C) * 2u; voffB[i] = (unsigned)(Rb * K + C) * 2u; }
    const size_t kstep = (size_t)(BK * 2);
    const size_t hstep = (size_t)HALF * K * 2;
    const size_t tstep = 2 * hstep;
    const unsigned ldsw = (unsigned)wid * 1024u;
    const int aoff = lds_byte(wr * 64 + fr, fq * 8), boff = lds_byte(wc * 32 + fr, fq * 8);
#define PG8_SA(b, h) (((b) * 2 + (h)) * HTB)
#define PG8_SB(b, h) ((4 + (b) * 2 + (h)) * HTB)
#define PG8_STAGE(bufoff, gbase, voff) do { _Pragma("unroll") for (int _i = 0; _i < 2; ++_i) \
        __builtin_amdgcn_global_load_lds((const unsigned*)((const char*)(gbase) + (voff)[_i]), (PG8_LAS unsigned*)(lds + (bufoff) + ldsw + _i * 8192), 16, 0, 0); } while (0)
#define PG8_LDA(dst, b, h) do { _Pragma("unroll") for (int m = 0; m < 4; ++m) _Pragma("unroll") for (int k = 0; k < 2; ++k) dst[m][k] = *(const PG8_LAS bf16x8*)(lds + PG8_SA(b, h) + aoff + m * 2048 + k * 1024); } while (0)
#define PG8_LDB(dst, b, h) do { _Pragma("unroll") for (int n = 0; n < 2; ++n) _Pragma("unroll") for (int k = 0; k < 2; ++k) dst[n][k] = *(const PG8_LAS bf16x8*)(lds + PG8_SB(b, h) + boff + n * 2048 + k * 1024); } while (0)
#define PG8_MMA(ai, bj, At, Bt) do { __builtin_amdgcn_s_setprio(1); _Pragma("unroll") for (int m = 0; m < 4; ++m) _Pragma("unroll") for (int n = 0; n < 2; ++n) _Pragma("unroll") for (int k = 0; k < 2; ++k) \
        acc[ai][bj][m][n] = __builtin_amdgcn_mfma_f32_16x16x32_bf16(Bt[n][k], At[m][k], acc[ai][bj][m][n], 0, 0, 0); __builtin_amdgcn_s_setprio(0); } while (0)
#define PG8_WAIT_V(n) asm volatile("s_waitcnt vmcnt(" #n ")" ::: "memory")
#define PG8_WAIT_L(n) asm volatile("s_waitcnt lgkmcnt(" #n ")" ::: "memory")
#define PG8_BAR __builtin_amdgcn_s_barrier()
#define PG8_SCHED __builtin_amdgcn_sched_barrier(0)
    Unit cur, nxt; int ui = 0;
    if (!S.next(0, cur)) return;
    f32x4 acc[2][2][4][2];
#pragma unroll
    for (int a = 0; a < 2; ++a)
#pragma unroll
        for (int b = 0; b < 2; ++b)
#pragma unroll
            for (int m = 0; m < 4; ++m)
#pragma unroll
                for (int n = 0; n < 2; ++n) acc[a][b][m][n] = (f32x4){0.f, 0.f, 0.f, 0.f};
    bf16x8 At[4][2], B0[2][2], B1[2][2];
    const char* cA = (const char*)g.A + (size_t)cur.pm * tstep; const char* cB = (const char*)g.Bt + (size_t)cur.pn * tstep;
    S.a_ready(cur);
    int prep_pm = cur.pm, prep_gen = 0; if constexpr (Epi::HAS_PREP) E.prep(cur, tid, 0);
    if constexpr (SP2) {
        PG8_STAGE(PG8_SB(0, 0), cB, voffB); PG8_STAGE(PG8_SB(0, 1), cB + hstep, voffB); PG8_STAGE(PG8_SA(0, 0), cA, voffA); PG8_STAGE(PG8_SA(0, 1), cA + hstep, voffA);
        if (wr == 1) PG8_BAR;
        PG8_WAIT_V(2); PG8_BAR;
        PG8_STAGE(PG8_SB(1, 0), cB + kstep, voffB); PG8_STAGE(PG8_SA(1, 0), cA + kstep, voffA); PG8_STAGE(PG8_SB(1, 1), cB + hstep + kstep, voffB);
        PG8_WAIT_V(6); PG8_BAR;
    } else {
        PG8_STAGE(PG8_SB(0, 0), cB, voffB); PG8_STAGE(PG8_SA(0, 0), cA, voffA); PG8_STAGE(PG8_SB(0, 1), cB + hstep, voffB); PG8_STAGE(PG8_SA(0, 1), cA + hstep, voffA);
        if (wr == 1) PG8_BAR;
        PG8_WAIT_V(4); PG8_BAR;
        PG8_STAGE(PG8_SB(1, 0), cB + kstep, voffB); PG8_STAGE(PG8_SA(1, 0), cA + kstep, voffA); PG8_STAGE(PG8_SB(1, 1), cB + hstep + kstep, voffB);
        PG8_WAIT_V(6); PG8_BAR;
    }
    for (;;) {
        const bool has_next = S.next(ui + 1, nxt);
        const char* nA = has_next ? (const char*)g.A + (size_t)nxt.pm * tstep : cA; const char* nB = has_next ? (const char*)g.Bt + (size_t)nxt.pn * tstep : cB;
        for (int t = 0; t < nt; t += 2) {
            const bool last = (t == nt - 2);
            const char* a1 = cA + (size_t)(t + 1) * kstep;
            const char* a2 = last ? nA : cA + (size_t)(t + 2) * kstep; const char* b2 = last ? nB : cB + (size_t)(t + 2) * kstep;
            const char* a3 = a2 + kstep; const char* b3 = b2 + kstep;
            if (last && has_next) S.a_ready(nxt);
            if constexpr (SP2) {
            PG8_LDB(B0, 0, 0); PG8_LDB(B1, 0, 1); PG8_SCHED; PG8_LDA(At, 0, 0); PG8_STAGE(PG8_SA(1, 1), a1 + hstep, voffA);
            PG8_WAIT_V(8); PG8_WAIT_L(0); PG8_BAR; PG8_MMA(0, 0, At, B0); PG8_MMA(0, 1, At, B1); PG8_BAR; PG8_SCHED;
            PG8_LDA(At, 0, 1); PG8_STAGE(PG8_SB(0, 0), b2, voffB); PG8_STAGE(PG8_SB(0, 1), b2 + hstep, voffB); PG8_STAGE(PG8_SA(0, 0), a2, voffA);
            PG8_WAIT_V(8); PG8_WAIT_L(0); PG8_BAR; PG8_MMA(1, 0, At, B0); PG8_MMA(1, 1, At, B1); PG8_BAR; PG8_SCHED;
            PG8_LDB(B0, 1, 0); PG8_LDB(B1, 1, 1); PG8_SCHED; PG8_LDA(At, 1, 0); PG8_STAGE(PG8_SA(0, 1), a2 + hstep, voffA);
            PG8_WAIT_V(8); PG8_WAIT_L(0); PG8_BAR; PG8_MMA(0, 0, At, B0); PG8_MMA(0, 1, At, B1); PG8_BAR; PG8_SCHED;
            PG8_LDA(At, 1, 1); PG8_STAGE(PG8_SB(1, 0), b3, voffB); PG8_STAGE(PG8_SB(1, 1), b3 + hstep, voffB); PG8_STAGE(PG8_SA(1, 0), a3, voffA);
            PG8_WAIT_V(8); PG8_WAIT_L(0); PG8_BAR; PG8_MMA(1, 0, At, B0); PG8_MMA(1, 1, At, B1); PG8_BAR; PG8_SCHED;
            } else {
            PG8_LDB(B0, 0, 0); PG8_SCHED; PG8_LDA(At, 0, 0); PG8_STAGE(PG8_SA(1, 1), a1 + hstep, voffA);
            PG8_WAIT_L(8); PG8_BAR; PG8_WAIT_L(0); PG8_MMA(0, 0, At, B0); PG8_BAR; PG8_SCHED;
            PG8_LDB(B1, 0, 1); PG8_STAGE(PG8_SB(0, 0), b2, voffB);
            PG8_BAR; PG8_WAIT_L(0); PG8_MMA(0, 1, At, B1); PG8_BAR;
            PG8_LDA(At, 0, 1); PG8_STAGE(PG8_SA(0, 0), a2, voffA);
            PG8_BAR; PG8_WAIT_L(0); PG8_MMA(1, 0, At, B0); PG8_BAR; PG8_SCHED;
            PG8_STAGE(PG8_SB(0, 1), b2 + hstep, voffB);
            PG8_WAIT_V(6); PG8_BAR; PG8_MMA(1, 1, At, B1); PG8_BAR;
            PG8_LDB(B0, 1, 0); PG8_SCHED; PG8_LDA(At, 1, 0); PG8_STAGE(PG8_SA(0, 1), a2 + hstep, voffA);
            PG8_WAIT_L(8); PG8_BAR; PG8_WAIT_L(0); PG8_MMA(0, 0, At, B0); PG8_BAR; PG8_SCHED;
            PG8_LDB(B1, 1, 1); PG8_STAGE(PG8_SB(1, 0), b3, voffB);
            PG8_BAR; PG8_WAIT_L(0); PG8_MMA(0, 1, At, B1); PG8_BAR;
            PG8_LDA(At, 1, 1); PG8_STAGE(PG8_SA(1, 0), a3, voffA);
            PG8_BAR; PG8_WAIT_L(0); PG8_MMA(1, 0, At, B0); PG8_BAR; PG8_SCHED;
            PG8_STAGE(PG8_SB(1, 1), b3 + hstep, voffB);
            PG8_WAIT_V(6); PG8_BAR; PG8_MMA(1, 1, At, B1); PG8_BAR;
            }
        }
        if constexpr (ALIGN_EPI) { if (wr == 0) PG8_BAR; }
        if constexpr (!Epi::AFTER_DRAIN) { if constexpr (Epi::HAS_PREP) E(acc, cur, wr, wc, fr, fq, prep_gen & 1); else E(acc, cur, wr, wc, fr, fq); S.done(cur); }
        if (!has_next) break;
#pragma unroll
        for (int a = 0; a < 2; ++a)
#pragma unroll
            for (int b = 0; b < 2; ++b)
#pragma unroll
                for (int m = 0; m < 4; ++m)
#pragma unroll
                    for (int n = 0; n < 2; ++n) acc[a][b][m][n] = (f32x4){0.f, 0.f, 0.f, 0.f};
        cur = nxt; cA = nA; cB = nB; ++ui;
        if constexpr (Epi::HAS_PREP) { if (cur.pm != prep_pm) { ++prep_gen; E.prep(cur, tid, prep_gen & 1); prep_pm = cur.pm; } }
        if constexpr (ALIGN_EPI) { if (wr == 1) PG8_BAR; }
    }
    PG8_WAIT_V(0);
    if constexpr (!ALIGN_EPI) { if (wr == 0) PG8_BAR; }
    PG8_BAR;
    if constexpr (Epi::AFTER_DRAIN) { E.fused(acc, cur, wr, wc, fr, fq, lds, wid, lane); S.done(cur); }
#undef PG8_SA
#undef PG8_SB
#undef PG8_STAGE
#undef PG8_LDA
#undef PG8_LDB
#undef PG8_MMA
#undef PG8_WAIT_V
#undef PG8_WAIT_L
#undef PG8_BAR
#undef PG8_SCHED
}
}
constexpr int NWAVES = 8, NTHR = 512;
constexpr int BATCH = 2, SEQ = 8192, M = BATCH * SEQ, D = 2048, DEPTH = 4, INW = 10752, FF = 8192;
constexpr int C_HGQ = 0, C_HGV = 768, C_ZF = 1536, C_ZB = 2304, C_HGG = 3072, C_RQ = 3840, C_RK = 4224, C_RV = 4608, C_RG = 5376, C_DIL = 6144;
constexpr int CH = 64, NCH = SEQ / CH;
constexpr float EPS = 1e-6f;
constexpr int NPHASE = 1 + 7 * DEPTH;

constexpr size_t MiB = 1u << 20;
constexpr size_t WS_CTL = 0, CTL_ZERO_BYTES = 1 * MiB;
constexpr size_t WS_PART = 10 * MiB;
constexpr size_t WS_ROPE = 2 * MiB;
constexpr size_t WS_TAB = 4 * MiB;
constexpr size_t WS_LSE = 5 * MiB;
constexpr size_t WS_DHG = 6 * MiB;
constexpr size_t WS_DRT = 8 * MiB;
constexpr size_t WS_WIN = 16 * MiB, WS_WOUT = 184 * MiB, WS_WUP = 216 * MiB, WS_WDN = 344 * MiB;
constexpr size_t WS_XB = 472 * MiB;
constexpr size_t WS_Y = 536 * MiB;
constexpr size_t WS_H = 600 * MiB;
constexpr size_t WS_SHG = 936 * MiB;
constexpr size_t WS_SRT = 1032 * MiB;
constexpr size_t WS_END = 1080 * MiB;
constexpr int CW_BAR = 4096;

constexpr int PH_BYTES = 155648;
constexpr int LDSCTL_OFF = PH_BYTES, MISC_OFF = LDSCTL_OFF + 320;
constexpr int LDS_BYTES = PH_BYTES + 1024;

#define GAS __attribute__((address_space(1)))
#define LAS __attribute__((address_space(3)))
typedef unsigned short bf16;
typedef unsigned v4u __attribute__((ext_vector_type(4)));
typedef unsigned v2u __attribute__((ext_vector_type(2)));
typedef float f32x4 __attribute__((ext_vector_type(4)));
typedef short bf16x8 __attribute__((ext_vector_type(8)));
typedef LAS unsigned char* lptr;
#define LDS_WAIT() asm volatile("s_waitcnt lgkmcnt(0)" ::: "memory")
#define VM_WAIT() asm volatile("s_waitcnt vmcnt(0)" ::: "memory")
#ifndef PROBE_MASK
#define PROBE_MASK 0
#endif
#define SP_BEGIN() unsigned long long sp0_ = 0; if (PROBE_MASK >> 16) sp0_ = __builtin_amdgcn_s_memrealtime();
#define SP_END(bit) do { if (PROBE_MASK >> 16) { const unsigned long long t1_ = __builtin_amdgcn_s_memrealtime(); if (PROBE_MASK & (1 << (bit))) { const unsigned long long dt_ = t1_ - sp0_; while (__builtin_amdgcn_s_memrealtime() - t1_ < dt_) __builtin_amdgcn_s_sleep(2); } sp0_ = __builtin_amdgcn_s_memrealtime(); } } while (0)
#define BAR_LDS() do { asm volatile("s_waitcnt lgkmcnt(0)" ::: "memory"); __builtin_amdgcn_s_barrier(); asm volatile("" ::: "memory"); } while (0)
__device__ __forceinline__ float bf2f(unsigned h) { return __uint_as_float(h << 16); }
__device__ __forceinline__ unsigned pk2(float lo, float hi) { return pg8::cvt_pk_bf16(lo, hi); }
__device__ __forceinline__ unsigned short f2bf(float f) { return (unsigned short)(pk2(f, 0.f) & 0xffffu); }
__device__ __forceinline__ bf16x8 ldsfrag(lptr base, int row, int stride_b, int kel) { return *(const LAS bf16x8*)(base + row * stride_b + kel * 2); }
#define MFMA16(a, b, c) __builtin_amdgcn_mfma_f32_16x16x32_bf16((a), (b), (c), 0, 0, 0)
template <class T> __device__ __forceinline__ T* hptr(T* H, size_t m, int col) { return H + ((size_t)(col >> 7) * M + m) * 128 + (col & 127); }
__device__ __forceinline__ float wave_sum(float v) {
#pragma unroll
    for (int o = 1; o < 64; o <<= 1) v += __shfl_xor(v, o);
    return v;
}
typedef GAS unsigned gu32;
#define XB_TMO      128
#define XB_XCNT(j)  (256  + 64 * (j))
#define XB_XSUB(j)  (1280 + 64 * (j))
#define XB_XGEN(j)  (2304 + 64 * (j))
#define XB_TOP      3328
#define XB_TOPGEN   3392
#define XCD_BAR_WORDS 3456
#define XB_SPIN_CAP (1u << 18)

__device__ __forceinline__ unsigned xb_ld(unsigned* p)              { return __hip_atomic_load(p, __ATOMIC_RELAXED, __HIP_MEMORY_SCOPE_AGENT); }
__device__ __forceinline__ unsigned xb_add(unsigned* p, unsigned v) { return __hip_atomic_fetch_add(p, v, __ATOMIC_RELAXED, __HIP_MEMORY_SCOPE_AGENT); }
__device__ __forceinline__ unsigned xb_xcc_id() { return (unsigned)__builtin_amdgcn_s_getreg((3 << 11) | 20) & 0xFu; }
#define XB_SPIN(cond, bar) do { unsigned _sp = 0; while (cond) { __builtin_amdgcn_s_sleep(1); \
    if ((++_sp & 255u) == 0u) { if (xb_ld(&(bar)[XB_TMO])) break; if (_sp > XB_SPIN_CAP) { atomicAdd(&(bar)[XB_TMO], 1u); break; } } } } while (0)

struct XcdBarrier {
    unsigned* bar; unsigned x;
    volatile LAS unsigned* st;
};

__device__ __forceinline__ XcdBarrier xcd_barrier_post(unsigned* bar, volatile LAS unsigned* st) {
    XcdBarrier b; b.bar = bar; b.x = xb_xcc_id(); b.st = st;
    if (threadIdx.x == 0) (void)xb_add(&bar[XB_XCNT(b.x)], 1u);
    return b;
}
__device__ __forceinline__ void xcd_barrier_complete(unsigned* bar, unsigned x, unsigned& nloc, unsigned& nx) {
    const unsigned G = gridDim.x * gridDim.y * gridDim.z;
    unsigned sum, cnt, mine, sp = 0u;
    for (;;) {
        sum = 0u; cnt = 0u; mine = 0u;
#pragma unroll
        for (unsigned j = 0; j < 16; ++j) { const unsigned c = xb_ld(&bar[XB_XCNT(j)]); sum += c; cnt += (c > 0u) ? 1u : 0u; mine = (j == x) ? c : mine; }
        if (sum == G) break;
        __builtin_amdgcn_s_sleep(1);
        if ((++sp & 255u) == 0u) { if (xb_ld(&bar[XB_TMO])) break; if (sp > XB_SPIN_CAP) { atomicAdd(&bar[XB_TMO], 1u); break; } }
    }
    nloc = mine > 0u ? mine : 1u; nx = cnt > 0u ? cnt : 1u;
}

__device__ __forceinline__ void xcd_barrier(const XcdBarrier& b) {
    asm volatile("s_waitcnt vmcnt(0)" ::: "memory");
    __syncthreads();
    if (threadIdx.x == 0) {
        unsigned* bar = b.bar;
        __builtin_amdgcn_s_waitcnt(0);
        unsigned nloc = b.st[0], nx = b.st[1];
        if (nloc == 0u) { xcd_barrier_complete(bar, b.x, nloc, nx); b.st[0] = nloc; b.st[1] = nx; }
        const unsigned old = xb_add(&bar[XB_XSUB(b.x)], 1u);
        const unsigned gen = old / nloc;
        if (old + 1u == (gen + 1u) * nloc) {
            __builtin_amdgcn_fence(__ATOMIC_RELEASE, "agent");
            asm volatile("s_waitcnt vmcnt(0)" ::: "memory");
            const unsigned og = xb_add(&bar[XB_TOP], 1u);
            const unsigned tg = og / nx;
            if (og + 1u == (tg + 1u) * nx) xb_add(&bar[XB_TOPGEN], 1u);
            else XB_SPIN(xb_ld(&bar[XB_TOPGEN]) == tg, bar);
            __builtin_amdgcn_fence(__ATOMIC_ACQUIRE, "agent");
            xb_add(&bar[XB_XGEN(b.x)], 1u);
            asm volatile("s_waitcnt vmcnt(0)" ::: "memory");
        } else {
            XB_SPIN(xb_ld(&bar[XB_XGEN(b.x)]) == gen, bar);
            __builtin_amdgcn_fence(__ATOMIC_ACQUIRE, "agent");
            asm volatile("s_waitcnt vmcnt(0)" ::: "memory");
        }
    }
    __syncthreads();
}
constexpr int TR_SCR = 64 * 65 * 4;
__device__ __forceinline__ void transpose_item(const float* W, const float* g, int K, int N, bf16* WT, LAS float* scr, int item, int lane) {
    const int nblk = N / 64, kb = item / nblk, nb = item % nblk, k0 = 64 * kb, n0 = 64 * nb;
    const int n4 = lane & 15, kr = lane >> 4;
    f32x4 w[16];
#pragma unroll
    for (int i = 0; i < 16; ++i) w[i] = *(const f32x4*)(W + (size_t)(k0 + 4 * i + kr) * N + n0 + 4 * n4);
    if (g) {
#pragma unroll
        for (int i = 0; i < 16; ++i) w[i] = w[i] * g[k0 + 4 * i + kr]; }
#pragma unroll
    for (int i = 0; i < 16; ++i) { LAS float* d = scr + (4 * i + kr) * 65 + 4 * n4; d[0] = w[i].x; d[1] = w[i].y; d[2] = w[i].z; d[3] = w[i].w; }
    LDS_WAIT(); asm volatile("" ::: "memory");
    const int c = lane & 7;
#pragma unroll
    for (int j = 0; j < 8; ++j) { const int n = (lane >> 3) + 8 * j; const LAS float* s = scr + (8 * c) * 65 + n;
        v4u o; o.x = pk2(s[0 * 65], s[1 * 65]); o.y = pk2(s[2 * 65], s[3 * 65]); o.z = pk2(s[4 * 65], s[5 * 65]); o.w = pk2(s[6 * 65], s[7 * 65]);
        *(v4u*)(WT + (size_t)(n0 + n) * K + k0 + 8 * c) = o; }
    LDS_WAIT(); asm volatile("" ::: "memory");
}
__device__ __forceinline__ void sincos_d(double a, float& s, float& c) {
    const double kq = __builtin_rint(a * 0.6366197723675814); const double r = a - kq * 1.5707963267948966; const int q = ((int)kq) & 3; const double r2 = r * r;
    double sp = 1.0 / 6227020800.0; sp = sp * r2 - 1.0 / 39916800.0; sp = sp * r2 + 1.0 / 362880.0; sp = sp * r2 - 1.0 / 5040.0; sp = sp * r2 + 1.0 / 120.0; sp = sp * r2 - 1.0 / 6.0; sp = sp * r2 + 1.0; sp *= r;
    double cp = -1.0 / 87178291200.0; cp = cp * r2 + 1.0 / 479001600.0; cp = cp * r2 - 1.0 / 3628800.0; cp = cp * r2 + 1.0 / 40320.0; cp = cp * r2 - 1.0 / 720.0; cp = cp * r2 + 1.0 / 24.0; cp = cp * r2 - 0.5; cp = cp * r2 + 1.0;
    const double ss = (q == 0) ? sp : (q == 1) ? cp : (q == 2) ? -sp : -cp; const double cc = (q == 0) ? cp : (q == 1) ? -sp : (q == 2) ? -cp : sp;
    s = (float)ss; c = (float)cc;
}
__device__ __forceinline__ int t5_bucket(int rel) {
    const int n = rel < 0 ? -rel : rel; int b;
    if (n < 8) b = n; else { b = 8 + (n >= 15) + (n >= 27) + (n >= 50) + (n >= 91) + (n >= 166) + (n >= 305) + (n >= 559); }
    return b + (rel > 0 ? 16 : 0);
}

struct Args { const float* in[14]; float* out; unsigned char* ws; int ph_lo, ph_hi; };
typedef const __attribute__((address_space(4))) Args* kargp;
struct Ctx {
    lptr lds; int tid, lane, wave, G, bid; kargp ka; unsigned char* ws;
    __device__ __forceinline__ const float* in(int i) const { return ka->in[i]; }
    __device__ __forceinline__ float* out() const { return ka->out; }
};
__device__ __forceinline__ Ctx mkctx(lptr lds) {
    Ctx X; int tid = threadIdx.x; asm volatile("" : "+v"(tid));
    kargp ka = (kargp)__builtin_amdgcn_kernarg_segment_ptr(); asm volatile("" : "+s"(ka));
    X.lds = lds; X.tid = tid; X.lane = tid & 63; X.wave = __builtin_amdgcn_readfirstlane(tid >> 6); X.G = gridDim.x; X.bid = blockIdx.x; X.ka = ka; X.ws = ka->ws; return X;
}

constexpr int I_IN = (D / 64) * (INW / 64), I_OUT = (D / 64) * (D / 64), I_UP = (D / 64) * (FF / 64), I_DN = (FF / 64) * (D / 64), I_L = I_IN + I_OUT + I_UP + I_DN;
constexpr int TAILQ = 8192;
__device__ __forceinline__ void convert_item(const Ctx& X, int l, int r, LAS float* scr) {
    if (r < I_IN) { transpose_item(X.in(1) + (size_t)l * D * INW, X.in(5) + l * D, D, INW, (bf16*)(X.ws + WS_WIN) + (size_t)l * INW * D, scr, r, X.lane); return; } r -= I_IN;
    if (r < I_OUT) { transpose_item(X.in(2) + (size_t)l * D * D, nullptr, D, D, (bf16*)(X.ws + WS_WOUT) + (size_t)l * D * D, scr, r, X.lane); return; } r -= I_OUT;
    if (r < I_UP) { transpose_item(X.in(3) + (size_t)l * D * FF, X.in(6) + l * D, D, FF, (bf16*)(X.ws + WS_WUP) + (size_t)l * FF * D, scr, r, X.lane); return; } r -= I_UP;
    transpose_item(X.in(4) + (size_t)l * FF * D, nullptr, FF, D, (bf16*)(X.ws + WS_WDN) + (size_t)l * D * FF, scr, r, X.lane);
}
__device__ __forceinline__ void prologue(const Ctx& X) {
    const int gw = X.bid * NWAVES + X.wave, NGW = X.G * NWAVES;
    LAS float* scr = (LAS float*)(X.lds + X.wave * TR_SCR);
    static_assert(8 * TR_SCR <= PH_BYTES, "transpose scratch");
    const int tq = X.G == 256 ? TAILQ : 0, per = I_L - tq;
    for (int it = gw; it < I_L + (DEPTH - 1) * per; it += NGW) {
        if (it < I_L) convert_item(X, 0, it, scr);
        else { const int j = it - I_L; convert_item(X, 1 + j / per, tq + j % per, scr); }
    }
    float* ss0 = (float*)(X.ws + WS_PART); bf16* xb = (bf16*)(X.ws + WS_XB);
    for (int m = gw; m < M; m += NGW) {
        const f32x4* xr = (const f32x4*)(X.in(0) + (size_t)m * D) + X.lane; f32x4 v[8]; float s = 0.f;
#pragma unroll
        for (int j = 0; j < 8; ++j) { v[j] = xr[64 * j]; s += (v[j].x * v[j].x + v[j].y * v[j].y) + (v[j].z * v[j].z + v[j].w * v[j].w); }
        s = wave_sum(s); if (X.lane < 32) ss0[(size_t)m * 32 + X.lane] = X.lane == 0 ? s : 0.f;
        v2u* o8 = (v2u*)(xb + (size_t)m * D) + X.lane;
#pragma unroll
        for (int j = 0; j < 8; ++j) { v2u w; w.x = pk2(v[j].x, v[j].y); w.y = pk2(v[j].z, v[j].w); o8[64 * j] = w; }
    }
    const int gt = X.bid * NTHR + X.tid, NGT = X.G * NTHR;
    float* rc = (float*)(X.ws + WS_ROPE); float* rs = rc + SEQ * 32;
    for (int i = gt; i < SEQ * 32; i += NGT) { const int pos = i >> 5, f = i & 31; double inv = 1.0; for (int e = 0; e < f; ++e) inv *= 0.7498942093324558; const float ang = (float)pos * (float)inv; float s, c; sincos_d((double)ang, s, c); rc[i] = c; rs[i] = s; }
    float* LB = (float*)(X.ws + WS_TAB); float* BT = LB + 2 * 4 * 768;
    for (int i = gt; i < 2 * 768; i += NGT) { const int dir = i / 768, c = i % 768; const float* src = dir ? X.in(8) : X.in(7);
        const float a0 = src[c], a1 = src[768 + c], a2 = src[2 * 768 + c], a3 = src[3 * 768 + c]; const float mx = fmaxf(fmaxf(a0, a1), fmaxf(a2, a3));
        const float e0 = __expf(a0 - mx), e1 = __expf(a1 - mx), e2 = __expf(a2 - mx), e3 = __expf(a3 - mx); const float inv = 1.0f / (e0 + e1 + e2 + e3);
        float* o = LB + dir * 4 * 768 + c; o[0] = 0.f; o[768] = e1 * inv; o[2 * 768] = (e1 + e2) * inv; o[3 * 768] = (e1 + e2 + e3) * inv; }
    for (int i = gt; i < 3 * 4 * 132; i += NGT) { const int g = i / (4 * 132), sl = (i / 132) % 4, rr = i % 132; const int dil = g == 0 ? 1 : (g == 1 ? 4 : 16);
        BT[i] = rr < 129 ? 1.4426950408889634f * X.in(13)[t5_bucket((rr - 64) * dil) * 12 + g * 4 + sl] : 0.f; }
}

template <int NC> struct RawRegs { v4u w[NC / 64]; };
template <int NC> __device__ __forceinline__ void raw_load(const Ctx& X, const bf16* H, size_t m0, int col, RawRegs<NC>& R) {
#pragma unroll
    for (int p = 0; p < NC / 64; ++p) { const int idx = X.tid + NTHR * p, r = idx / (NC / 8), c8 = idx % (NC / 8); R.w[p] = *(const v4u*)hptr(H, m0 + r, col + 8 * c8); }
}
template <int NC> __device__ __forceinline__ void raw_store(const Ctx& X, lptr dst, const RawRegs<NC>& R) {
#pragma unroll
    for (int p = 0; p < NC / 64; ++p) { const int idx = X.tid + NTHR * p; *(LAS v4u*)(dst + idx * 16) = R.w[p]; }
}
__device__ __forceinline__ void vt_store(const Ctx& X, lptr VT, const RawRegs<128>& R) {
#pragma unroll
    for (int p = 0; p < 2; ++p) { const int idx = X.tid + NTHR * p, r = idx >> 4, c8 = idx & 15; const v4u w = R.w[p];
        LAS unsigned short* d = (LAS unsigned short*)(VT + (8 * c8) * 144 + (r ^ (8 * (c8 & 7))) * 2);
        d[0] = (unsigned short)w.x; d[72] = (unsigned short)(w.x >> 16); d[144] = (unsigned short)w.y; d[216] = (unsigned short)(w.y >> 16);
        d[288] = (unsigned short)w.z; d[360] = (unsigned short)(w.z >> 16); d[432] = (unsigned short)w.w; d[504] = (unsigned short)(w.w >> 16); }
}
__device__ __forceinline__ bf16x8 vtfrag(lptr VT, int row, int stride_b, int kel) { return *(const LAS bf16x8*)(VT + row * stride_b + (kel ^ (8 * ((row >> 3) & 7))) * 2); }
typedef float f32x2v __attribute__((ext_vector_type(2)));
__device__ __forceinline__ f32x2v bfpair(unsigned w) { f32x2v r; r.x = __uint_as_float(w << 16); r.y = __uint_as_float(w & 0xffff0000u); return r; }
__device__ __forceinline__ f32x2v rcp2(f32x2v v) { f32x2v r; r.x = __builtin_amdgcn_rcpf(v.x); r.y = __builtin_amdgcn_rcpf(v.y); return r; }
template <int DIR, bool NEEDQ>
__device__ __forceinline__ void gla_prep(lptr rawz, lptr rawq, f32x2v lb, LAS float* seg, int kp, int rg, f32x2v (&c)[8], f32x2v (&qv)[8], f32x2v (&kv)[8]) {
    f32x2v run = (f32x2v){1.f, 1.f}; const f32x2v oml = 1.0f - lb;
#pragma unroll
    for (int i = 0; i < 8; ++i) { const int ii = DIR ? 7 - i : i; const int r = 8 * rg + ii;
        const f32x2v z = bfpair(*(const LAS unsigned*)(rawz + (r * 128 + 2 * kp) * 2)); f32x2v e; e.x = __expf(-z.x); e.y = __expf(-z.y);
        const f32x2v f = lb + oml * rcp2(e + 1.0f); run = run * f; kv[ii] = 1.0f - f; c[ii] = run;
        if (NEEDQ) qv[ii] = bfpair(*(const LAS unsigned*)(rawq + (r * 128 + 2 * kp) * 2)); }
    *(LAS f32x2v*)(seg + rg * 128 + 2 * kp) = run;
}
#define SEGT(j) (*(const LAS f32x2v*)(seg + ((DIR) ? 7 - (j) : (j)) * 128 + 2 * kp))

constexpr int L1_VT = 0, L1_KC = 128 * 144, L1_SEG = 2 * 128 * 144, L1_RAW = L1_SEG + 4096, L1_END = L1_RAW + 32768;
template <int DK, bool RET, int DIR>
__device__ __forceinline__ void gla_local_dir(const Ctx& X, int chain, int n, f32x2v lb, bf16* St, float* dd) {
    static_assert(DK == 128 && !RET, "HGRN2 only (retention has its own path)");
    const lptr VT = X.lds + L1_VT, KC = X.lds + L1_KC; LAS float* seg = (LAS float*)(X.lds + L1_SEG);
    const lptr rawz = X.lds + L1_RAW + (DIR ? 16384 : 0);
    int t_ = X.tid; asm volatile("" : "+v"(t_));
    const int kp = t_ & 63, rg = __builtin_amdgcn_readfirstlane(t_ >> 6);
    f32x2v c[8], qv[8], kv[8];
    gla_prep<DIR, false>(rawz, rawz, lb, seg, kp, rg, c, qv, kv);
    BAR_LDS();
    {
        const int sg = DIR ? 7 - rg : rg;
        f32x2v base = (f32x2v){1.f, 1.f}, all = (f32x2v){1.f, 1.f};
#pragma unroll
        for (int j = 0; j < 8; ++j) { const f32x2v T = SEGT(j); all = all * T; if (j >= sg) base = base * T; }
        f32x2v e[8];
#pragma unroll
        for (int ii = 0; ii < 8; ++ii) { f32x2v cc = c[ii]; cc.x = fmaxf(cc.x, 1e-37f); cc.y = fmaxf(cc.y, 1e-37f); e[ii] = kv[ii] * base * rcp2(cc); }
        v4u w0, w1;
        w0.x = pk2(e[0].x, e[1].x); w0.y = pk2(e[2].x, e[3].x); w0.z = pk2(e[4].x, e[5].x); w0.w = pk2(e[6].x, e[7].x);
        w1.x = pk2(e[0].y, e[1].y); w1.y = pk2(e[2].y, e[3].y); w1.z = pk2(e[4].y, e[5].y); w1.w = pk2(e[6].y, e[7].y);
        *(LAS v4u*)(KC + (2 * kp) * 144 + rg * 16) = w0; *(LAS v4u*)(KC + (2 * kp + 1) * 144 + rg * 16) = w1;
        if (rg == 0) *(f32x2v*)(dd + ((size_t)chain * NCH + n) * DK + 2 * kp) = all;
    }
    BAR_LDS();
    {
        const int fr = X.lane & 15, fq = X.lane >> 4; const int rt = X.wave; constexpr int NCT = 8;
        f32x4 acc[NCT];
#pragma unroll
        for (int t = 0; t < NCT; ++t) acc[t] = (f32x4){0.f, 0.f, 0.f, 0.f};
#pragma unroll
        for (int ks = 0; ks < 2; ++ks) { const bf16x8 a = ldsfrag(KC, 16 * rt + fr, 144, 32 * ks + 8 * fq);
#pragma unroll
            for (int t = 0; t < NCT; ++t) { const bf16x8 bb = vtfrag(VT, 16 * t + fr, 144, 32 * ks + 8 * fq); acc[t] = MFMA16(a, bb, acc[t]); } }
        bf16* Sp = St + ((size_t)chain * NCH + n) * 128 * DK;
        const lptr UT = X.lds + L1_END;
#pragma unroll
        for (int t = 0; t < NCT; ++t) { v2u w; w.x = pk2(acc[t][0], acc[t][1]); w.y = pk2(acc[t][2], acc[t][3]); *(LAS v2u*)(UT + (16 * t + fr) * 272 + (16 * rt + 4 * fq) * 2) = w; }
        BAR_LDS();
#pragma unroll
        for (int p = 0; p < 4; ++p) { const int idx = X.tid + NTHR * p, row = idx >> 4, c8 = idx & 15; *(v4u*)(Sp + (size_t)row * DK + 8 * c8) = *(const LAS v4u*)(UT + row * 272 + c8 * 16); }
    }
    BAR_LDS();
}
template <bool RET> struct LocRegs { RawRegs<128> rv, rzf, rzb; RawRegs<64> rq, rk; f32x4 c4, s4; };
template <bool RET> __device__ __forceinline__ void loc_load(const Ctx& X, const bf16* H, int r, LocRegs<RET>& R) {
    const int b = r / 768, head = (r / 128) % 6, n = r % 128; const size_t m0 = (size_t)(b * SEQ + n * CH);
    raw_load<128>(X, H, m0, (RET ? C_RV : C_HGV) + head * 128, R.rv);
    if (!RET) { raw_load<128>(X, H, m0, C_ZF + head * 128, R.rzf); raw_load<128>(X, H, m0, C_ZB + head * 128, R.rzb); }
    else { raw_load<64>(X, H, m0, C_RQ + head * 64, R.rq); raw_load<64>(X, H, m0, C_RK + head * 64, R.rk);
        const float* rc = (const float*)(X.ws + WS_ROPE) + (size_t)n * CH * 32; R.c4 = *(const f32x4*)(rc + X.tid * 4); R.s4 = *(const f32x4*)(rc + SEQ * 32 + X.tid * 4); }
}
template <int DK, bool RET>
__device__ __forceinline__ void gla_local_item(const Ctx& X, bf16* H, int l, int r, LocRegs<RET>& R, bool has_next) {
    static_assert(DK == 128 && !RET, "HGRN2 only (retention has its own path)");
    const int b = r / 768, head = (r / 128) % 6, n = r % 128;
    const float* LB = (const float*)(X.ws + WS_TAB);
    bf16* St = (bf16*)(X.ws + WS_SHG); float* dd = (float*)(X.ws + WS_DHG);
    const int kp = X.tid & 63;
    f32x2v lb0 = *(const f32x2v*)(LB + (0 * 4 + l) * 768 + head * 128 + 2 * kp), lb1 = *(const f32x2v*)(LB + (1 * 4 + l) * 768 + head * 128 + 2 * kp);
    vt_store(X, X.lds + L1_VT, R.rv); raw_store<128>(X, X.lds + L1_RAW, R.rzf); raw_store<128>(X, X.lds + L1_RAW + 16384, R.rzb);
    asm volatile("" : "+v"(lb0), "+v"(lb1)); __builtin_amdgcn_sched_barrier(0);
    if (has_next) loc_load<RET>(X, H, r + X.G, R);
    __builtin_amdgcn_sched_barrier(0);
    BAR_LDS();
    const int chain = (b * 6 + head) * 2;
    gla_local_dir<DK, RET, 0>(X, chain, n, lb0, St, dd);
    gla_local_dir<DK, RET, 1>(X, chain + 1, n, lb1, St, dd);
}

template <int DK, bool RET> struct L3 { static constexpr int SQ = (DK + 8) * 2, Q0 = 0, Q1 = 64 * SQ, KD = 96 * SQ, KH = 160 * SQ, VT = 192 * SQ, AM = VT + 128 * 144, SEG = AM + 64 * 144, RED = SEG + 4096, RAW = RED + 1024,
    ST = RAW + 32768, END = ST + 128 * 272; };
static_assert(L3<128, false>::END <= PH_BYTES && L1_END <= PH_BYTES, "mixer LDS maps");
template <int DK, bool RET, int DIR>
__device__ __forceinline__ void gla_out_dir(const Ctx& X, int chain, int n, f32x2v lb, const bf16* St, f32x4 (&o)[4], const bf16* H, size_t m0, int zbcol) {
    static_assert(DK == 128 && !RET, "HGRN2 only (retention has its own path)");
    typedef L3<DK, RET> L; constexpr int SQ = L::SQ;
    const lptr Q0 = X.lds + L::Q0, Q1 = X.lds + L::Q1, KD = X.lds + L::KD, KH = X.lds + L::KH, VT = X.lds + L::VT, AM = X.lds + L::AM; LAS float* seg = (LAS float*)(X.lds + L::SEG);
    const lptr rawz = X.lds + L::RAW, rawq = X.lds + L::RAW + 16384, ST = X.lds + L::ST;
    int t_ = X.tid; asm volatile("" : "+v"(t_));
    const int kp = t_ & 63, rg = __builtin_amdgcn_readfirstlane(t_ >> 6);
    const int fr = X.lane & 15, fq = X.lane >> 4;
    const int tb = X.wave & 3, vh = X.wave >> 2;
    SP_BEGIN()
    const bf16* Sp = St + ((size_t)chain * NCH + n) * 128 * DK;
    v4u sr[4];
#pragma unroll
    for (int p = 0; p < 4; ++p) { const int idx = X.tid + NTHR * p; sr[p] = *(const v4u*)(Sp + (size_t)idx * 8); }
    {
        f32x2v c[8], qv[8], kv[8];
        gla_prep<DIR, true>(rawz, rawq, lb, seg, kp, rg, c, qv, kv);
        BAR_LDS(); SP_END(21);
#pragma unroll
        for (int p = 0; p < 4; ++p) { const int idx = X.tid + NTHR * p; *(LAS v4u*)(ST + (idx >> 4) * 272 + (idx & 15) * 16) = sr[p]; }
        {
            const int sg = DIR ? 7 - rg : rg, ss = sg >> 2, hq = sg & 3;
            const f32x2v T0 = SEGT(0), T1 = SEGT(1), T2 = SEGT(2), T3 = SEGT(3), sub0 = (T0 * T1) * (T2 * T3);
            f32x2v pq = (f32x2v){1.f, 1.f};
#pragma unroll
            for (int j = 0; j < 3; ++j) if (j < hq) pq = pq * SEGT(4 * ss + j);
#pragma unroll
            for (int ii = 0; ii < 8; ++ii) { const int r = 8 * rg + ii; f32x2v cp = c[ii] * pq;
                const f32x2v q0 = qv[ii] * cp; cp.x = fmaxf(cp.x, 1e-37f); cp.y = fmaxf(cp.y, 1e-37f); const f32x2v kd = kv[ii] * rcp2(cp);
                *(LAS unsigned*)(KD + r * SQ + kp * 4) = pk2(kd.x, kd.y);
                *(LAS unsigned*)(Q0 + r * SQ + kp * 4) = pk2(q0.x, q0.y);
                if (ss) { const f32x2v q1 = q0 * sub0; *(LAS unsigned*)(Q1 + (DIR ? r : r - 32) * SQ + kp * 4) = pk2(q1.x, q1.y); }
                else { const f32x2v kh = kd * sub0; *(LAS unsigned*)(KH + (DIR ? r - 32 : r) * SQ + kp * 4) = pk2(kh.x, kh.y); }
                if (ii & 1) __builtin_amdgcn_sched_barrier(0); }
        }
    }
    BAR_LDS(); SP_END(22);
    RawRegs<128> zbr; if (!RET && DIR == 0) raw_load<128>(X, H, m0, zbcol, zbr);
#pragma unroll
    for (int bi = 0; bi < 2; ++bi) { const int blk = 2 * X.wave + bi, I = blk >> 2, J = blk & 3; const int sI = DIR ? 3 - I : I, sJ = DIR ? 3 - J : J;
        v2u w; w.x = 0u; w.y = 0u;
        if (sJ <= sI) { const bool same = (sI >> 1) == (sJ >> 1); const lptr KS = same ? KD : KH; const int krow = same ? 16 * J + fr : (DIR ? 16 * J + fr - 32 : 16 * J + fr);
            f32x4 acc = (f32x4){0.f, 0.f, 0.f, 0.f};
#pragma unroll
            for (int ks = 0; ks < DK / 32; ++ks) { const bf16x8 a = ldsfrag(KS, krow, SQ, 32 * ks + 8 * fq); const bf16x8 bb = ldsfrag(Q0, 16 * I + fr, SQ, 32 * ks + 8 * fq); acc = MFMA16(a, bb, acc); }
            if (sI == sJ) {
#pragma unroll
                for (int j = 0; j < 4; ++j) { const int jl = 4 * fq + j; const bool keep = DIR ? (jl >= fr) : (jl <= fr); if (!keep) acc[j] = 0.f; } }
            w.x = pk2(acc[0], acc[1]); w.y = pk2(acc[2], acc[3]); }
        *(LAS v2u*)(AM + (16 * I + fr) * 144 + (16 * J + 4 * fq) * 2) = w; }
    BAR_LDS(); SP_END(23);
    {
        const int stb = DIR ? 3 - tb : tb; const int r = 16 * tb + fr;
#pragma unroll
        for (int ks = 0; ks < 2; ++ks) { const bf16x8 bb = ldsfrag(AM, r, 144, 32 * ks + 8 * fq);
#pragma unroll
            for (int vt = 0; vt < 4; ++vt) { const bf16x8 a = vtfrag(VT, 64 * vh + 16 * vt + fr, 144, 32 * ks + 8 * fq); o[vt] = MFMA16(a, bb, o[vt]); } }
        const lptr QI = (stb >> 1) ? Q1 : Q0; const int qrow = (stb >> 1) ? (DIR ? r : r - 32) : r;
#pragma unroll
        for (int ks = 0; ks < DK / 32; ++ks) { const bf16x8 bb = ldsfrag(QI, qrow, SQ, 32 * ks + 8 * fq);
#pragma unroll
            for (int vt = 0; vt < 4; ++vt) { const bf16x8 a = ldsfrag(ST, 64 * vh + 16 * vt + fr, 272, 32 * ks + 8 * fq); o[vt] = MFMA16(a, bb, o[vt]); } }
    }
    if (!RET && DIR == 0) raw_store<128>(X, X.lds + L::RAW, zbr);
    BAR_LDS(); SP_END(24);
}
template <bool RET> struct OutRegs { RawRegs<128> rv, rzf, rzb, rq; RawRegs<64> rq6, rk6; v2u gw[4]; };
template <bool RET> __device__ __forceinline__ void out_load(const Ctx& X, const bf16* H, int r, OutRegs<RET>& R) {
    const int b = r / 768, head = (r / 128) % 6, n = r % 128; const size_t m0 = (size_t)(b * SEQ + n * CH);
    const int fr = X.lane & 15, fq = X.lane >> 4, tb = X.wave & 3, vh = X.wave >> 2; const size_t m = m0 + 16 * tb + fr; const int gcol = (RET ? C_RG : C_HGG) + head * 128;
    raw_load<128>(X, H, m0, (RET ? C_RV : C_HGV) + head * 128, R.rv);
    if (!RET) { raw_load<128>(X, H, m0, C_ZF + head * 128, R.rzf); raw_load<128>(X, H, m0, C_HGQ + head * 128, R.rq); }
    else { raw_load<64>(X, H, m0, C_RQ + head * 64, R.rq6); raw_load<64>(X, H, m0, C_RK + head * 64, R.rk6); }
#pragma unroll
    for (int t = 0; t < 4; ++t) if (RET) R.gw[t] = *(const v2u*)hptr(H, m, gcol + 64 * vh + 16 * t + 4 * fq);
}
template <int DK, bool RET>
__device__ __forceinline__ void gla_out_item(const Ctx& X, const bf16* H, bf16* Y, int l, int r, OutRegs<RET>& R, bool has_next) {
    typedef L3<DK, RET> L;
    const int b = r / 768, head = (r / 128) % 6, n = r % 128;
    const float* LB = (const float*)(X.ws + WS_TAB);
    const bf16* St = (const bf16*)(X.ws + (RET ? WS_SRT : WS_SHG));
    const int fr = X.lane & 15, fq = X.lane >> 4, tb = X.wave & 3, vh = X.wave >> 2;
    const size_t m = (size_t)(b * SEQ + n * CH + 16 * tb + fr);
    const int ycol = (RET ? 768 : 0) + head * 128;
    SP_BEGIN()
    const int kp = X.tid & 63; f32x2v lb0 = (f32x2v){0.f, 0.f}, lb1 = lb0;
    v2u gw[4];
    if (!RET) {
        lb0 = *(const f32x2v*)(LB + (0 * 4 + l) * 768 + head * 128 + 2 * kp); lb1 = *(const f32x2v*)(LB + (1 * 4 + l) * 768 + head * 128 + 2 * kp);
        vt_store(X, X.lds + L::VT, R.rv); raw_store<128>(X, X.lds + L::RAW, R.rzf); raw_store<128>(X, X.lds + L::RAW + 16384, R.rq);
    } else {
        vt_store(X, X.lds + L::VT, R.rv); raw_store<64>(X, X.lds + L::RAW, R.rq6); raw_store<64>(X, X.lds + L::RAW + 8192, R.rk6);
    }
    asm volatile("" : "+v"(lb0), "+v"(lb1)); __builtin_amdgcn_sched_barrier(0);
    if (has_next) out_load<RET>(X, H, r + X.G, R);
    __builtin_amdgcn_sched_barrier(0);
    BAR_LDS(); SP_END(20);
    const int chain = (b * 6 + head) * 2;
    f32x4 o[4];
#pragma unroll
    for (int t = 0; t < 4; ++t) o[t] = (f32x4){0.f, 0.f, 0.f, 0.f};
    const size_t m0 = (size_t)(b * SEQ + n * CH);
    gla_out_dir<DK, RET, 0>(X, chain, n, lb0, St, o, H, m0, C_ZB + head * 128);
#pragma unroll
    for (int t = 0; t < 4; ++t) gw[t] = *(const v2u*)hptr(H, m, C_HGG + head * 128 + 64 * vh + 16 * t + 4 * fq);
    gla_out_dir<DK, RET, 1>(X, chain + 1, n, lb1, St, o, H, m0, 0);
    LAS float* red = (LAS float*)(X.lds + L::RED);
    float mu = 0.f;
    if (RET) {
        float s = 0.f;
#pragma unroll
        for (int t = 0; t < 4; ++t) s += (o[t][0] + o[t][1]) + (o[t][2] + o[t][3]);
        s += __shfl_xor(s, 16); s += __shfl_xor(s, 32);
        if (fq == 0) red[128 + X.wave * 16 + fr] = s;
        BAR_LDS();
        mu = (red[128 + X.wave * 16 + fr] + red[128 + (X.wave ^ 4) * 16 + fr]) * (1.0f / 128.0f);
    }
    float s2 = 0.f;
#pragma unroll
    for (int t = 0; t < 4; ++t)
#pragma unroll
        for (int j = 0; j < 4; ++j) { const float dlt = o[t][j] - mu; s2 += dlt * dlt; }
    s2 += __shfl_xor(s2, 16); s2 += __shfl_xor(s2, 32);
    if (fq == 0) red[X.wave * 16 + fr] = s2;
    BAR_LDS();
    const float rstd = __builtin_amdgcn_rsqf((red[X.wave * 16 + fr] + red[(X.wave ^ 4) * 16 + fr]) * (1.0f / 128.0f) + EPS);
    const float* gn = X.in(RET ? 10 : 9) + l * 768 + head * 128;
#pragma unroll
    for (int t = 0; t < 4; ++t) { const int v = 64 * vh + 16 * t + 4 * fq; const f32x4 g4 = *(const f32x4*)(gn + v);
        const float g0 = bf2f(gw[t].x & 0xffffu), g1 = bf2f(gw[t].x >> 16), g2 = bf2f(gw[t].y & 0xffffu), g3 = bf2f(gw[t].y >> 16);
        const float y0 = (o[t][0] - mu) * rstd * g4.x * (g0 * __builtin_amdgcn_rcpf(1.0f + __expf(-g0))), y1 = (o[t][1] - mu) * rstd * g4.y * (g1 * __builtin_amdgcn_rcpf(1.0f + __expf(-g1)));
        const float y2 = (o[t][2] - mu) * rstd * g4.z * (g2 * __builtin_amdgcn_rcpf(1.0f + __expf(-g2))), y3 = (o[t][3] - mu) * rstd * g4.w * (g3 * __builtin_amdgcn_rcpf(1.0f + __expf(-g3)));
        v2u w; w.x = pk2(y0, y1); w.y = pk2(y2, y3); *(LAS v2u*)(X.lds + L::Q0 + (16 * tb + fr) * 272 + v * 2) = w; }
    BAR_LDS();
    { const size_t mrow = (size_t)(b * SEQ + n * CH); int t_ = X.tid; asm volatile("" : "+v"(t_));
#pragma unroll
        for (int p = 0; p < 2; ++p) { const int idx = t_ + NTHR * p, row = idx >> 4, c8 = idx & 15; *(v4u*)(Y + (mrow + row) * D + ycol + 8 * c8) = *(const LAS v4u*)(X.lds + L::Q0 + row * 272 + c8 * 16); } }
    BAR_LDS();
}

constexpr int RCH = 128, RNCH = SEQ / RCH;
constexpr int R1_VT = 0, R1_KC0 = 128 * 144, R1_KC1 = R1_KC0 + 64 * 144, R1_RAW = R1_KC1 + 64 * 144, R1_END = R1_RAW + 32768;
__device__ __forceinline__ void ret_local_item(const Ctx& X, bf16* H, int it, LocRegs<true>& R, bool has_next) {
    const int b = it / 384, head = (it / 64) % 6, n = it % 64;
    bf16* St = (bf16*)(X.ws + WS_SRT); float* dd = (float*)(X.ws + WS_DRT);
    const lptr VT = X.lds + R1_VT, KC0 = X.lds + R1_KC0, KC1 = X.lds + R1_KC1, rawq = X.lds + R1_RAW, rawk = X.lds + R1_RAW + 8192; LAS float* cs = (LAS float*)(X.lds + R1_RAW + 16384); LAS float* sn = (LAS float*)(X.lds + R1_RAW + 24576);
    const float l2f = __log2f(1.0f - exp2f(-5.0f - (float)head)), l2b = __log2f(1.0f - exp2f(-5.0f - (float)(5 - head)));
    const int chain = (b * 6 + head) * 2;
    const int fr = X.lane & 15, fq = X.lane >> 4, rt = X.wave & 3, ct0 = (X.wave >> 2) * 4;
    const int k = X.tid & 63, rq = X.tid >> 6, k2 = k & 31; const bool active = X.tid < 256;
    f32x4 accf[4], accb[4];
#pragma unroll
    for (int t = 0; t < 4; ++t) { accf[t] = (f32x4){0.f, 0.f, 0.f, 0.f}; accb[t] = accf[t]; }
#pragma unroll 1
    for (int h = 0; h < 2; ++h) {
        const int r = 2 * it + h; const size_t m0 = (size_t)(b * SEQ + (2 * n + h) * 64);
        vt_store(X, VT, R.rv); raw_store<64>(X, rawq, R.rq); raw_store<64>(X, rawk, R.rk); *(LAS f32x4*)(cs + X.tid * 4) = R.c4; *(LAS f32x4*)(sn + X.tid * 4) = R.s4;
        __builtin_amdgcn_sched_barrier(0);
        { const int nr = h == 0 ? r + 1 : 2 * (it + X.G); if (h == 0 || has_next) loc_load<true>(X, H, nr, R); }
        __builtin_amdgcn_sched_barrier(0);
        BAR_LDS();
        float qr[16], kr[16];
        if (active) {
#pragma unroll
            for (int ii = 0; ii < 16; ++ii) { const int rr = 16 * rq + ii; const float c_ = cs[rr * 32 + k2], s_ = sn[rr * 32 + k2];
                const float q1 = bf2f(*(const LAS unsigned short*)(rawq + (rr * 64 + k2) * 2)), q2 = bf2f(*(const LAS unsigned short*)(rawq + (rr * 64 + 32 + k2) * 2));
                const float k1 = bf2f(*(const LAS unsigned short*)(rawk + (rr * 64 + k2) * 2)), k2v = bf2f(*(const LAS unsigned short*)(rawk + (rr * 64 + 32 + k2) * 2));
                qr[ii] = (k < 32) ? (q1 * c_ - q2 * s_) : (q1 * s_ + q2 * c_); kr[ii] = 0.125f * ((k < 32) ? (k1 * c_ - k2v * s_) : (k1 * s_ + k2v * c_)); } }
        BAR_LDS();
        if (active) {
            float ef[16], eb[16];
#pragma unroll
            for (int ii = 0; ii < 16; ++ii) { const int rr = 16 * rq + ii, tt = 64 * h + rr; *(LAS unsigned short*)(rawq + (rr * 64 + k) * 2) = f2bf(qr[ii]); *(LAS unsigned short*)(rawk + (rr * 64 + k) * 2) = f2bf(kr[ii]);
                ef[ii] = kr[ii] * __builtin_amdgcn_exp2f((float)(RCH - 1 - tt) * l2f); eb[ii] = kr[ii] * __builtin_amdgcn_exp2f((float)tt * l2b); }
            v4u w0, w1;
            w0.x = pk2(ef[0], ef[1]); w0.y = pk2(ef[2], ef[3]); w0.z = pk2(ef[4], ef[5]); w0.w = pk2(ef[6], ef[7]); w1.x = pk2(ef[8], ef[9]); w1.y = pk2(ef[10], ef[11]); w1.z = pk2(ef[12], ef[13]); w1.w = pk2(ef[14], ef[15]);
            *(LAS v4u*)(KC0 + k * 144 + rq * 32) = w0; *(LAS v4u*)(KC0 + k * 144 + rq * 32 + 16) = w1;
            w0.x = pk2(eb[0], eb[1]); w0.y = pk2(eb[2], eb[3]); w0.z = pk2(eb[4], eb[5]); w0.w = pk2(eb[6], eb[7]); w1.x = pk2(eb[8], eb[9]); w1.y = pk2(eb[10], eb[11]); w1.z = pk2(eb[12], eb[13]); w1.w = pk2(eb[14], eb[15]);
            *(LAS v4u*)(KC1 + k * 144 + rq * 32) = w0; *(LAS v4u*)(KC1 + k * 144 + rq * 32 + 16) = w1;
        }
        BAR_LDS();
        { const int rr = X.tid >> 3, c8 = X.tid & 7; *(v4u*)hptr(H, m0 + rr, C_RQ + head * 64 + 8 * c8) = *(const LAS v4u*)(rawq + X.tid * 16); *(v4u*)hptr(H, m0 + rr, C_RK + head * 64 + 8 * c8) = *(const LAS v4u*)(rawk + X.tid * 16); }
#pragma unroll
        for (int ks = 0; ks < 2; ++ks) { const bf16x8 af = ldsfrag(KC0, 16 * rt + fr, 144, 32 * ks + 8 * fq), ab = ldsfrag(KC1, 16 * rt + fr, 144, 32 * ks + 8 * fq);
#pragma unroll
            for (int t = 0; t < 4; ++t) { const bf16x8 bb = vtfrag(VT, 16 * (ct0 + t) + fr, 144, 32 * ks + 8 * fq); accf[t] = MFMA16(af, bb, accf[t]); accb[t] = MFMA16(ab, bb, accb[t]); } }
        BAR_LDS();
    }
#pragma unroll
    for (int t = 0; t < 4; ++t) { v2u w; w.x = pk2(accf[t][0], accf[t][1]); w.y = pk2(accf[t][2], accf[t][3]); *(LAS v2u*)(X.lds + R1_END + (16 * (ct0 + t) + fr) * 144 + (16 * rt + 4 * fq) * 2) = w;
        w.x = pk2(accb[t][0], accb[t][1]); w.y = pk2(accb[t][2], accb[t][3]); *(LAS v2u*)(X.lds + R1_END + 128 * 144 + (16 * (ct0 + t) + fr) * 144 + (16 * rt + 4 * fq) * 2) = w; }
    if (X.tid < 64) { dd[((size_t)chain * RNCH + n) * 64 + X.tid] = __builtin_amdgcn_exp2f((float)RCH * l2f); dd[((size_t)(chain + 1) * RNCH + n) * 64 + X.tid] = __builtin_amdgcn_exp2f((float)RCH * l2b); }
    BAR_LDS();
#pragma unroll
    for (int dir = 0; dir < 2; ++dir) { bf16* Sp = St + ((size_t)(chain + dir) * RNCH + n) * 128 * 64; const lptr UT = X.lds + R1_END + dir * 128 * 144;
#pragma unroll
        for (int p = 0; p < 2; ++p) { const int idx = X.tid + NTHR * p, row = idx >> 3, c8 = idx & 7; *(v4u*)(Sp + (size_t)row * 64 + 8 * c8) = *(const LAS v4u*)(UT + row * 144 + c8 * 16); } }
    BAR_LDS();
}
struct RetOutRegs { v4u q[2], k[2], v[4]; };
__device__ __forceinline__ void ret_out_load(const Ctx& X, const bf16* H, int it, RetOutRegs& R) {
    const int b = it / 384, head = (it / 64) % 6, n = it % 64; const size_t m0 = (size_t)(b * SEQ + n * RCH);
    const int fr = X.lane & 15, fq = X.lane >> 4, tbq = X.wave & 3, vh = X.wave >> 2;
#pragma unroll
    for (int p = 0; p < 2; ++p) { const int idx = X.tid + NTHR * p, row = idx >> 3, c8 = idx & 7; R.q[p] = *(const v4u*)hptr(H, m0 + row, C_RQ + head * 64 + 8 * c8); R.k[p] = *(const v4u*)hptr(H, m0 + row, C_RK + head * 64 + 8 * c8); }
#pragma unroll
    for (int p = 0; p < 4; ++p) { const int idx = X.tid + NTHR * p, row = idx >> 4, c8 = idx & 15; R.v[p] = *(const v4u*)hptr(H, m0 + row, C_RV + head * 128 + 8 * c8); }
}
constexpr int R3_Q = 0, R3_K = 128 * 144, R3_VT = 2 * 128 * 144, R3_AM = R3_VT + 128 * 272, R3_RED = R3_AM + 128 * 272, R3_END = R3_RED + 4096;
static_assert(R3_END <= PH_BYTES && R1_END + 2 * 128 * 144 <= PH_BYTES, "retention LDS maps");
__device__ __forceinline__ void ret_out_item(const Ctx& X, const bf16* H, bf16* Y, int l, int it, RetOutRegs& R, bool has_next) {
    const int b = it / 384, head = (it / 64) % 6, n = it % 64; const size_t m0 = (size_t)(b * SEQ + n * RCH);
    const bf16* St = (const bf16*)(X.ws + WS_SRT);
    const lptr Q = X.lds + R3_Q, K = X.lds + R3_K, VT = X.lds + R3_VT, AM = X.lds + R3_AM; LAS float* red = (LAS float*)(X.lds + R3_RED);
    const int fr = X.lane & 15, fq = X.lane >> 4, tbq = X.wave & 3, vh = X.wave >> 2; const int ycol = 768 + head * 128;
    const float l2f = __log2f(1.0f - exp2f(-5.0f - (float)head)), l2b = __log2f(1.0f - exp2f(-5.0f - (float)(5 - head)));
    const int chain = (b * 6 + head) * 2;
#pragma unroll
    for (int p = 0; p < 2; ++p) { const int idx = X.tid + NTHR * p, row = idx >> 3, c8 = idx & 7; *(LAS v4u*)(Q + row * 144 + c8 * 16) = R.q[p]; *(LAS v4u*)(K + row * 144 + c8 * 16) = R.k[p]; }
#pragma unroll
    for (int p = 0; p < 4; ++p) { const int idx = X.tid + NTHR * p, row = idx >> 4, c8 = idx & 15; const v4u w = R.v[p];
        LAS unsigned short* d = (LAS unsigned short*)(VT + (8 * c8) * 272 + (row ^ (8 * (c8 & 7))) * 2);
        d[0] = (unsigned short)w.x; d[136] = (unsigned short)(w.x >> 16); d[272] = (unsigned short)w.y; d[408] = (unsigned short)(w.y >> 16);
        d[544] = (unsigned short)w.z; d[680] = (unsigned short)(w.z >> 16); d[816] = (unsigned short)w.w; d[952] = (unsigned short)(w.w >> 16); }
    __builtin_amdgcn_sched_barrier(0);
    if (has_next) ret_out_load(X, H, it + X.G, R);
    bf16x8 sff[2][4], sfb[2][4];
    { const bf16* Sf = St + ((size_t)chain * RNCH + n) * 128 * 64; const bf16* Sb = St + ((size_t)(chain + 1) * RNCH + n) * 128 * 64;
#pragma unroll
        for (int ks = 0; ks < 2; ++ks)
#pragma unroll
            for (int vt = 0; vt < 4; ++vt) { const size_t o_ = (size_t)(64 * vh + 16 * vt + fr) * 64 + 32 * ks + 8 * fq; sff[ks][vt] = *(const bf16x8*)(Sf + o_); sfb[ks][vt] = *(const bf16x8*)(Sb + o_); } }
    __builtin_amdgcn_sched_barrier(0);
    BAR_LDS();
#pragma unroll 1
    for (int J = 0; J < 8; ++J) { const int I = X.wave;
        f32x4 acc = (f32x4){0.f, 0.f, 0.f, 0.f};
#pragma unroll
        for (int ks = 0; ks < 2; ++ks) { const bf16x8 a = ldsfrag(K, 16 * J + fr, 144, 32 * ks + 8 * fq); const bf16x8 bb = ldsfrag(Q, 16 * I + fr, 144, 32 * ks + 8 * fq); acc = MFMA16(a, bb, acc); }
#pragma unroll
        for (int j = 0; j < 4; ++j) { const int d = (16 * I + fr) - (16 * J + 4 * fq + j); const float dec = d > 0 ? __builtin_amdgcn_exp2f((float)d * l2f) : (d < 0 ? __builtin_amdgcn_exp2f((float)(-d) * l2b) : 2.0f); acc[j] *= dec; }
        v2u w; w.x = pk2(acc[0], acc[1]); w.y = pk2(acc[2], acc[3]); *(LAS v2u*)(AM + (16 * I + fr) * 272 + (16 * J + 4 * fq) * 2) = w; }
    BAR_LDS();
    const float* gn = X.in(10) + l * 768 + head * 128;
    v2u gw[2][4];
#pragma unroll
    for (int ps = 0; ps < 2; ++ps)
#pragma unroll
        for (int t = 0; t < 4; ++t) gw[ps][t] = *(const v2u*)hptr(H, m0 + 16 * (tbq + 4 * ps) + fr, C_RG + head * 128 + 64 * vh + 16 * t + 4 * fq);
#pragma unroll
    for (int ps = 0; ps < 2; ++ps) { const int tok = 16 * (tbq + 4 * ps) + fr; f32x4 o[4];
#pragma unroll
        for (int t = 0; t < 4; ++t) o[t] = (f32x4){0.f, 0.f, 0.f, 0.f};
#pragma unroll
        for (int ks = 0; ks < 4; ++ks) { const bf16x8 bb = ldsfrag(AM, tok, 272, 32 * ks + 8 * fq);
#pragma unroll
            for (int vt = 0; vt < 4; ++vt) { const bf16x8 a = vtfrag(VT, 64 * vh + 16 * vt + fr, 272, 32 * ks + 8 * fq); o[vt] = MFMA16(a, bb, o[vt]); } }
        const bf16x8 bq0 = ldsfrag(Q, tok, 144, 8 * fq), bq1 = ldsfrag(Q, tok, 144, 32 + 8 * fq);
        const float cf = __builtin_amdgcn_exp2f((float)(tok + 1) * l2f), cb = __builtin_amdgcn_exp2f((float)(RCH - tok) * l2b);
        {
            f32x4 tf[4];
#pragma unroll
            for (int vt = 0; vt < 4; ++vt) { tf[vt] = MFMA16(sff[0][vt], bq0, ((f32x4){0.f, 0.f, 0.f, 0.f})); tf[vt] = MFMA16(sff[1][vt], bq1, tf[vt]); }
#pragma unroll
            for (int t = 0; t < 4; ++t) o[t] = o[t] + tf[t] * cf;
#pragma unroll
            for (int vt = 0; vt < 4; ++vt) { tf[vt] = MFMA16(sfb[0][vt], bq0, ((f32x4){0.f, 0.f, 0.f, 0.f})); tf[vt] = MFMA16(sfb[1][vt], bq1, tf[vt]); }
#pragma unroll
            for (int t = 0; t < 4; ++t) o[t] = o[t] + tf[t] * cb;
        }
        float s_ = 0.f;
#pragma unroll
        for (int t = 0; t < 4; ++t) s_ += (o[t][0] + o[t][1]) + (o[t][2] + o[t][3]);
        s_ += __shfl_xor(s_, 16); s_ += __shfl_xor(s_, 32);
        if (fq == 0) red[512 + (ps * 8 + X.wave) * 16 + fr] = s_;
        BAR_LDS();
        const float mu = (red[512 + (ps * 8 + X.wave) * 16 + fr] + red[512 + (ps * 8 + (X.wave ^ 4)) * 16 + fr]) * (1.0f / 128.0f); float s2 = 0.f;
#pragma unroll
        for (int t = 0; t < 4; ++t)
#pragma unroll
            for (int j = 0; j < 4; ++j) { const float dlt = o[t][j] - mu; s2 += dlt * dlt; }
        s2 += __shfl_xor(s2, 16); s2 += __shfl_xor(s2, 32);
        if (fq == 0) red[(ps * 8 + X.wave) * 16 + fr] = s2;
        BAR_LDS();
        const float rstd = __builtin_amdgcn_rsqf((red[(ps * 8 + X.wave) * 16 + fr] + red[(ps * 8 + (X.wave ^ 4)) * 16 + fr]) * (1.0f / 128.0f) + EPS);
#pragma unroll
        for (int t = 0; t < 4; ++t) { const int v = 64 * vh + 16 * t + 4 * fq; const f32x4 g4 = *(const f32x4*)(gn + v);
            const float g0 = bf2f(gw[ps][t].x & 0xffffu), g1 = bf2f(gw[ps][t].x >> 16), g2 = bf2f(gw[ps][t].y & 0xffffu), g3 = bf2f(gw[ps][t].y >> 16);
            const float y0 = (o[t][0] - mu) * rstd * g4.x * (g0 * __builtin_amdgcn_rcpf(1.0f + __expf(-g0))), y1 = (o[t][1] - mu) * rstd * g4.y * (g1 * __builtin_amdgcn_rcpf(1.0f + __expf(-g1)));
            const float y2 = (o[t][2] - mu) * rstd * g4.z * (g2 * __builtin_amdgcn_rcpf(1.0f + __expf(-g2))), y3 = (o[t][3] - mu) * rstd * g4.w * (g3 * __builtin_amdgcn_rcpf(1.0f + __expf(-g3)));
            v2u w; w.x = pk2(y0, y1); w.y = pk2(y2, y3); *(LAS v2u*)(AM + tok * 272 + v * 2) = w; } }
    BAR_LDS();
#pragma unroll
    for (int p = 0; p < 4; ++p) { const int idx = X.tid + NTHR * p, row = idx >> 4, c8 = idx & 15; *(v4u*)(Y + (m0 + row) * D + ycol + 8 * c8) = *(const LAS v4u*)(AM + row * 272 + c8 * 16); }
    BAR_LDS();
}

struct ScanBatch { v4u u[4]; f32x4 d0[4], d1[4]; };
__device__ __forceinline__ void scan_load(ScanBatch& B, const bf16* p, const float* dp, int cstride, int dstride, int dir, int s0, int nch) {
#pragma unroll
    for (int j = 0; j < 4; ++j) { const int n = dir ? nch - 1 - (s0 + j) : s0 + j; B.u[j] = *(const v4u*)(p + (size_t)n * cstride); B.d0[j] = *(const f32x4*)(dp + (size_t)n * dstride); B.d1[j] = *(const f32x4*)(dp + (size_t)n * dstride + 4); }
}
__device__ __forceinline__ void scan_step(const ScanBatch& B, float (&S)[8], bf16* p, int cstride, int dir, int s0, int nch) {
#pragma unroll
    for (int j = 0; j < 4; ++j) { const int n = dir ? nch - 1 - (s0 + j) : s0 + j;
        v4u w; w.x = pk2(S[0], S[1]); w.y = pk2(S[2], S[3]); w.z = pk2(S[4], S[5]); w.w = pk2(S[6], S[7]); *(v4u*)(p + (size_t)n * cstride) = w;
        S[0] = B.d0[j].x * S[0] + bf2f(B.u[j].x & 0xffffu); S[1] = B.d0[j].y * S[1] + bf2f(B.u[j].x >> 16); S[2] = B.d0[j].z * S[2] + bf2f(B.u[j].y & 0xffffu); S[3] = B.d0[j].w * S[3] + bf2f(B.u[j].y >> 16);
        S[4] = B.d1[j].x * S[4] + bf2f(B.u[j].z & 0xffffu); S[5] = B.d1[j].y * S[5] + bf2f(B.u[j].z >> 16); S[6] = B.d1[j].z * S[6] + bf2f(B.u[j].w & 0xffffu); S[7] = B.d1[j].w * S[7] + bf2f(B.u[j].w >> 16); }
}
__device__ __forceinline__ void scan_phase(const Ctx& X) {
    constexpr int T_HG = 24 * 2048, T_RT = 24 * 1024;
    for (int task = X.bid * NTHR + X.tid; task < T_HG + T_RT; task += X.G * NTHR) {
        bf16* p; const float* dp; int cstride, dstride, dir, nch;
        if (task < T_HG) { const int chain = task / 2048, e = task % 2048; p = (bf16*)(X.ws + WS_SHG) + (size_t)chain * NCH * 16384 + e * 8; dp = (const float*)(X.ws + WS_DHG) + (size_t)chain * NCH * 128 + (e & 15) * 8; cstride = 16384; dstride = 128; dir = chain & 1; nch = NCH; }
        else { const int t2 = task - T_HG, chain = t2 / 1024, e = t2 % 1024; p = (bf16*)(X.ws + WS_SRT) + (size_t)chain * RNCH * 8192 + e * 8; dp = (const float*)(X.ws + WS_DRT) + (size_t)chain * RNCH * 64 + (e & 7) * 8; cstride = 8192; dstride = 64; dir = chain & 1; nch = RNCH; }
        float S[8];
#pragma unroll
        for (int i = 0; i < 8; ++i) S[i] = 0.f;
        ScanBatch A, B;
        scan_load(A, p, dp, cstride, dstride, dir, 0, nch);
        for (int s0 = 0; s0 < nch; s0 += 8) {
            scan_load(B, p, dp, cstride, dstride, dir, s0 + 4, nch);
            scan_step(A, S, p, cstride, dir, s0, nch);
            if (s0 + 8 < nch) scan_load(A, p, dp, cstride, dstride, dir, s0 + 8, nch);
            scan_step(B, S, p, cstride, dir, s0 + 4, nch);
        }
    }
}

constexpr int DA_KN = 0, DA_VT = 192 * 272, DA_P = DA_VT + 128 * 400, DA_BIAS = DA_P + 64 * 400, DA_MX = DA_BIAS + 1024, DA_LX = DA_MX + 512, DA_END = DA_LX + 512;
static_assert(DA_END <= PH_BYTES, "dilated-attention LDS map");
struct DaBlk { v4u kw[2], vw[2]; };
struct DaRun { int b, g, slot, dil, rho, nb0, nbper, qcol; };
__device__ __forceinline__ DaRun da_decode(int run) {
    DaRun I; I.b = run / 384; const int rem = run % 384; I.g = rem / 128; const int rem2 = rem % 128; I.slot = rem2 / 32; const int rb = rem2 % 32;
    I.dil = I.g == 0 ? 1 : (I.g == 1 ? 4 : 16); I.nbper = 128 / I.dil; const int rpr = I.nbper / 4; I.rho = rb / rpr; I.nb0 = 4 * (rb % rpr); I.qcol = C_DIL + (3 * I.g) * 512 + I.slot * 128; return I;
}
__device__ __forceinline__ void da_blk_load(const Ctx& X, const bf16* H, const DaRun& I, int kb, DaBlk& R) {
    const bool ok = kb >= 0 && kb < I.nbper; const size_t mb = (size_t)I.b * SEQ; const int kcol = I.qcol + 512, vcol = I.qcol + 1024;
#pragma unroll
    for (int p = 0; p < 2; ++p) { const int r = (X.tid >> 4) + 32 * p, c8 = X.tid & 15; R.kw[p] = (v4u){0u, 0u, 0u, 0u}; R.vw[p] = (v4u){0u, 0u, 0u, 0u};
        if (ok) { const size_t mr = mb + (size_t)(I.rho * (SEQ / I.dil) + 64 * kb + r); R.kw[p] = *(const v4u*)hptr(H, mr, kcol + 8 * c8); R.vw[p] = *(const v4u*)hptr(H, mr, vcol + 8 * c8); } }
}
__device__ __forceinline__ void da_blk_stage(const Ctx& X, const float* kg, int kb, const DaBlk& R) {
    const lptr KN = X.lds + DA_KN, VT = X.lds + DA_VT; const int slot = ((kb % 3) + 3) % 3;
#pragma unroll
    for (int p = 0; p < 2; ++p) { const int row = slot * 64 + (X.tid >> 4) + 32 * p, c8 = X.tid & 15; const v4u kw = R.kw[p], vw = R.vw[p];
        float f[8]; f[0] = bf2f(kw.x & 0xffffu); f[1] = bf2f(kw.x >> 16); f[2] = bf2f(kw.y & 0xffffu); f[3] = bf2f(kw.y >> 16); f[4] = bf2f(kw.z & 0xffffu); f[5] = bf2f(kw.z >> 16); f[6] = bf2f(kw.w & 0xffffu); f[7] = bf2f(kw.w >> 16);
        float s = 0.f;
#pragma unroll
        for (int e = 0; e < 8; ++e) s += f[e] * f[e];
        s += __shfl_xor(s, 1); s += __shfl_xor(s, 2); s += __shfl_xor(s, 4); s += __shfl_xor(s, 8);
        const float sc = __builtin_amdgcn_rsqf(s * (1.0f / 128.0f) + EPS); const f32x4 g0 = *(const f32x4*)(kg + 8 * c8), g1 = *(const f32x4*)(kg + 8 * c8 + 4);
        v4u o; o.x = pk2(f[0] * sc * g0.x, f[1] * sc * g0.y); o.y = pk2(f[2] * sc * g0.z, f[3] * sc * g0.w); o.z = pk2(f[4] * sc * g1.x, f[5] * sc * g1.y); o.w = pk2(f[6] * sc * g1.z, f[7] * sc * g1.w);
        *(LAS v4u*)(KN + row * 272 + c8 * 16) = o;
        LAS unsigned short* d = (LAS unsigned short*)(VT + (8 * c8) * 400 + (row ^ (8 * (c8 & 7))) * 2);
        d[0] = (unsigned short)vw.x; d[200] = (unsigned short)(vw.x >> 16); d[400] = (unsigned short)vw.y; d[600] = (unsigned short)(vw.y >> 16);
        d[800] = (unsigned short)vw.z; d[1000] = (unsigned short)(vw.z >> 16); d[1200] = (unsigned short)vw.w; d[1400] = (unsigned short)(vw.w >> 16); }
}
__device__ __forceinline__ void da_q_load(const Ctx& X, const bf16* H, const DaRun& I, int nb, v4u (&qw)[4]) {
    const int fr = X.lane & 15, fq = X.lane >> 4, qb = X.wave & 3; const size_t m = (size_t)I.b * SEQ + (size_t)(I.rho * (SEQ / I.dil) + 64 * nb + 16 * qb + fr);
#pragma unroll
    for (int ks = 0; ks < 4; ++ks) qw[ks] = *(const v4u*)hptr(H, m, I.qcol + 32 * ks + 8 * fq);
}
__device__ __forceinline__ void dil_run(const Ctx& X, bf16* H, int l, int run) {
    const DaRun I = da_decode(run); const int b = I.b, g = I.g, slot = I.slot, dil = I.dil, rho = I.rho, qcol = I.qcol, Ls = SEQ / I.dil;
    const lptr KN = X.lds + DA_KN, VT = X.lds + DA_VT, P = X.lds + DA_P; LAS float* bias = (LAS float*)(X.lds + DA_BIAS); LAS float* mx = (LAS float*)(X.lds + DA_MX); LAS float* lx = (LAS float*)(X.lds + DA_LX);
    const float* qg = X.in(11) + l * 128; const float* kg = X.in(12) + l * 128; asm volatile("" : "+s"(qg), "+s"(kg));
    const int fr = X.lane & 15, fq = X.lane >> 4, qb = X.wave & 3, kh = X.wave >> 2; const int qi = 16 * qb + fr;
    SP_BEGIN()
    {
        DaBlk B0, B1, B2; da_blk_load(X, H, I, I.nb0 - 1, B0); da_blk_load(X, H, I, I.nb0, B1); da_blk_load(X, H, I, I.nb0 + 1, B2);
        if (X.tid < 256) bias[X.tid] = (X.tid >= 63 && X.tid <= 191) ? ((const float*)(X.ws + WS_TAB) + 2 * 4 * 768)[(g * 4 + slot) * 132 + X.tid - 63] : -1e30f;
        da_blk_stage(X, kg, I.nb0 - 1, B0); da_blk_stage(X, kg, I.nb0, B1); da_blk_stage(X, kg, I.nb0 + 1, B2);
    }
    v4u qw_[4]; da_q_load(X, H, I, I.nb0, qw_);
    for (int i = 0; i < 4; ++i) {
        const int nb = I.nb0 + i; const size_t qtok = (size_t)((64 * nb + qi) * dil + rho);
        bf16x8 qf[4];
        {
            float s = 0.f;
#pragma unroll
            for (int ks = 0; ks < 4; ++ks) { const v4u qw = qw_[ks];
                const float a0 = bf2f(qw.x & 0xffffu), a1 = bf2f(qw.x >> 16), a2 = bf2f(qw.y & 0xffffu), a3 = bf2f(qw.y >> 16), a4 = bf2f(qw.z & 0xffffu), a5 = bf2f(qw.z >> 16), a6 = bf2f(qw.w & 0xffffu), a7 = bf2f(qw.w >> 16);
                s += (a0 * a0 + a1 * a1) + (a2 * a2 + a3 * a3) + (a4 * a4 + a5 * a5) + (a6 * a6 + a7 * a7); }
            s += __shfl_xor(s, 16); s += __shfl_xor(s, 32);
            const float sc = (0.08838834764831845f * 1.4426950408889634f) * __builtin_amdgcn_rsqf(s * (1.0f / 128.0f) + EPS);
#pragma unroll
            for (int ks = 0; ks < 4; ++ks) { const v4u qw = qw_[ks]; const f32x4 g0 = *(const f32x4*)(qg + 32 * ks + 8 * fq), g1 = *(const f32x4*)(qg + 32 * ks + 8 * fq + 4);
                v4u o; o.x = pk2(bf2f(qw.x & 0xffffu) * sc * g0.x, bf2f(qw.x >> 16) * sc * g0.y); o.y = pk2(bf2f(qw.y & 0xffffu) * sc * g0.z, bf2f(qw.y >> 16) * sc * g0.w);
                o.z = pk2(bf2f(qw.z & 0xffffu) * sc * g1.x, bf2f(qw.z >> 16) * sc * g1.y); o.w = pk2(bf2f(qw.w & 0xffffu) * sc * g1.z, bf2f(qw.w >> 16) * sc * g1.w);
                qf[ks] = __builtin_bit_cast(bf16x8, o); }
        }
        asm volatile("" : "+v"(qf[0]), "+v"(qf[1]), "+v"(qf[2]), "+v"(qf[3]));
        __builtin_amdgcn_sched_barrier(0);
        DaBlk Bn; if (i < 3) { da_blk_load(X, H, I, nb + 2, Bn); da_q_load(X, H, I, nb + 1, qw_); }
        __builtin_amdgcn_sched_barrier(0);
        BAR_LDS(); SP_END(16);
        f32x4 sc[6]; float mloc = -1e30f;
        const LAS float* tb = bias + (96 * kh + 4 * fq - qi + 63);
        const bool edge_lo = nb == 0, edge_hi = nb == I.nbper - 1;
#pragma unroll
        for (int t = 0; t < 6; ++t) { f32x4 acc = (f32x4){0.f, 0.f, 0.f, 0.f}; const int rrow = (64 * nb + 128 + 96 * kh + 16 * t) % 192;
#pragma unroll
            for (int ks = 0; ks < 4; ++ks) { const bf16x8 a = ldsfrag(KN, rrow + fr, 272, 32 * ks + 8 * fq); acc = MFMA16(a, qf[ks], acc); }
#pragma unroll
            for (int j = 0; j < 4; ++j) acc[j] += tb[16 * t + j];
            if (edge_lo || edge_hi) {
#pragma unroll
                for (int j = 0; j < 4; ++j) { const int kj = 64 * nb - 64 + 96 * kh + 16 * t + 4 * fq + j; if (kj < 0 || kj >= Ls) acc[j] = -1e30f; } }
            mloc = fmaxf(fmaxf(mloc, fmaxf(acc[0], acc[1])), fmaxf(acc[2], acc[3]));
            sc[t] = acc; }
        mloc = fmaxf(mloc, __shfl_xor(mloc, 16)); mloc = fmaxf(mloc, __shfl_xor(mloc, 32));
        if (fq == 0) mx[kh * 64 + qi] = mloc;
        BAR_LDS(); SP_END(17);
        const float mrow = fmaxf(mx[qi], mx[64 + qi]); float lloc = 0.f;
#pragma unroll
        for (int t = 0; t < 6; ++t) { float p[4];
#pragma unroll
            for (int j = 0; j < 4; ++j) { p[j] = __builtin_amdgcn_exp2f(sc[t][j] - mrow); lloc += p[j]; }
            v2u w; w.x = pk2(p[0], p[1]); w.y = pk2(p[2], p[3]); *(LAS v2u*)(P + qi * 400 + (96 * kh + 16 * t + 4 * fq) * 2) = w; }
        lloc += __shfl_xor(lloc, 16); lloc += __shfl_xor(lloc, 32);
        if (fq == 0) lx[kh * 64 + qi] = lloc;
        BAR_LDS(); SP_END(18);
        const int dh = kh; const float lrow = lx[qi] + lx[64 + qi]; const float inv = __builtin_amdgcn_rcpf(lrow);
        f32x4 oo[4];
#pragma unroll
        for (int t = 0; t < 4; ++t) oo[t] = (f32x4){0.f, 0.f, 0.f, 0.f};
#pragma unroll
        for (int ks = 0; ks < 6; ++ks) { const bf16x8 bb = ldsfrag(P, qi, 400, 32 * ks + 8 * fq); const int rcol = (64 * nb + 128 + 32 * ks) % 192;
#pragma unroll
            for (int t = 0; t < 4; ++t) { const bf16x8 a = vtfrag(VT, 64 * dh + 16 * t + fr, 400, rcol + 8 * fq); oo[t] = MFMA16(a, bb, oo[t]); } }
        BAR_LDS();
#pragma unroll
        for (int t = 0; t < 4; ++t) { v2u w; w.x = pk2(oo[t][0] * inv, oo[t][1] * inv); w.y = pk2(oo[t][2] * inv, oo[t][3] * inv); *(LAS v2u*)(P + qi * 272 + (64 * dh + 16 * t + 4 * fq) * 2) = w; }
        if (dh == 0 && fq == 0) ((float*)(X.ws + WS_LSE))[((size_t)g * M + (size_t)b * SEQ + qtok) * 4 + slot] = 0.6931471805599453f * (mrow + __log2f(lrow));
        BAR_LDS(); SP_END(19);
#pragma unroll
        for (int p = 0; p < 2; ++p) { const int idx = X.tid + NTHR * p, row = idx >> 4, c8 = idx & 15; *(v4u*)hptr(H, (size_t)b * SEQ + (size_t)(rho * Ls + 64 * nb + row), qcol + 8 * c8) = *(const LAS v4u*)(P + row * 272 + c8 * 16); }
        if (i < 3) da_blk_stage(X, kg, nb + 2, Bn);
    }
    BAR_LDS();
}
__device__ __forceinline__ void dil_merge_item(const Ctx& X, const bf16* H, bf16* Y, int it) {
    const float* LSE = (const float*)(X.ws + WS_LSE);
#pragma unroll
    for (int p = 0; p < 8; ++p) { const int idx = X.tid + NTHR * p; const int tk = idx >> 6, slot = (idx >> 4) & 3, c8 = idx & 15; const size_t m = (size_t)it * 64 + tk;
        const float l0 = LSE[(0 * (size_t)M + m) * 4 + slot], l1 = LSE[(1 * (size_t)M + m) * 4 + slot], l2 = LSE[(2 * (size_t)M + m) * 4 + slot]; const float mxl = fmaxf(l0, fmaxf(l1, l2));
        const float e0 = __expf(l0 - mxl), e1 = __expf(l1 - mxl), e2 = __expf(l2 - mxl), inv = __builtin_amdgcn_rcpf(e0 + e1 + e2); const float w[3] = {e0 * inv, e1 * inv, e2 * inv};
        float acc[8];
#pragma unroll
        for (int e = 0; e < 8; ++e) acc[e] = 0.f;
#pragma unroll
        for (int g = 0; g < 3; ++g) { const int sh = 2 * g, t = (int)(m & 8191); const size_t pm = (m & ~(size_t)8191) + (size_t)(((t & ((1 << sh) - 1)) << (13 - sh)) + (t >> sh));
            const v4u ow = *(const v4u*)hptr(H, pm, C_DIL + (3 * g) * 512 + slot * 128 + 8 * c8);
            acc[0] += w[g] * bf2f(ow.x & 0xffffu); acc[1] += w[g] * bf2f(ow.x >> 16); acc[2] += w[g] * bf2f(ow.y & 0xffffu); acc[3] += w[g] * bf2f(ow.y >> 16);
            acc[4] += w[g] * bf2f(ow.z & 0xffffu); acc[5] += w[g] * bf2f(ow.z >> 16); acc[6] += w[g] * bf2f(ow.w & 0xffffu); acc[7] += w[g] * bf2f(ow.w >> 16); }
        v4u o; o.x = pk2(acc[0], acc[1]); o.y = pk2(acc[2], acc[3]); o.z = pk2(acc[4], acc[5]); o.w = pk2(acc[6], acc[7]);
        *(v4u*)(Y + m * D + 1536 + slot * 128 + 8 * c8) = o; }
}

#ifndef MK_N_LAUNCHES
#define MK_N_LAUNCHES 1
#endif
__global__ void __launch_bounds__(NTHR, 2) mega_fwd(Args args) {
    extern __shared__ __attribute__((aligned(16))) unsigned char lds_raw[];
    const lptr lds = (lptr)lds_raw;
    volatile LAS unsigned* MISC = (volatile LAS unsigned*)(lds + MISC_OFF);
    for (int u = threadIdx.x; u < (LDS_BYTES - LDSCTL_OFF) / 4; u += NTHR) ((LAS unsigned*)(lds + LDSCTL_OFF))[u] = 0u;
    __syncthreads();
    XcdBarrier bar; bar.bar = (unsigned*)(args.ws + WS_CTL) + CW_BAR; bar.x = 0; bar.st = nullptr;
    if (MK_N_LAUNCHES == 1) bar = xcd_barrier_post((unsigned*)(args.ws + WS_CTL) + CW_BAR, MISC + 8);
    const int lo = args.ph_lo, hi = args.ph_hi;
#ifndef PROBE_K
#define PROBE_K 1
#endif
#define PB_BEGIN(bit) unsigned long long pt0_ = 0; if (PROBE_MASK & (1 << (bit))) pt0_ = __builtin_amdgcn_s_memrealtime();
#define PB_END(bit) if ((PROBE_MASK & (1 << 15)) && ((226 >> (bit)) & 1)) { const unsigned long long t1_ = __builtin_amdgcn_s_memrealtime(); while (__builtin_amdgcn_s_memrealtime() - t1_ < 10000ull) __builtin_amdgcn_s_sleep(8); } \
    if (PROBE_MASK & (1 << (bit))) { const unsigned long long t1_ = __builtin_amdgcn_s_memrealtime(), dt_ = (t1_ - pt0_) * PROBE_K; while (__builtin_amdgcn_s_memrealtime() - t1_ < dt_) __builtin_amdgcn_s_sleep(8); }
#define IN(k) (lo <= (k) && (k) < hi)
#define SEAM(k) do { if (IN(k) && IN((k) + 1)) { xcd_barrier(bar); if (PROBE_MASK & (1 << 14)) xcd_barrier(bar); } } while (0)
#define PHASE_CTX() const Ctx X = mkctx(lds); bf16* const XB = (bf16*)(X.ws + WS_XB); bf16* const Y = (bf16*)(X.ws + WS_Y); bf16* const H = (bf16*)(X.ws + WS_H); float* const ss_mix = (float*)(X.ws + WS_PART); \
        float* const ss_mix_next = ss_mix; float* const ss_mlp = ss_mix + (size_t)M * 32; (void)XB; (void)Y; (void)H; (void)ss_mix; (void)ss_mix_next; (void)ss_mlp;

    #ifndef NO_PRO
    if (IN(0)) { PB_BEGIN(0) const Ctx X = mkctx(lds); prologue(X); PB_END(0) }
#endif
    SEAM(0);
    for (int l = 0; l < DEPTH; ++l) {
        const int pb = 1 + 7 * l;
#if !defined(NO_GEMM) && !defined(NO_GA)
        if (IN(pb + 0)) { PB_BEGIN(1) PHASE_CTX(); pg8::Gemm g{XB, (const bf16*)(X.ws + WS_WIN) + (size_t)l * INW * D, M, INW, D}; pg8::StaticOrder S; S.init(M, INW, X.G, X.bid);
            pg8::EpiScaleBf16<0, true, true> E{H, M, ss_mix, (LAS float*)(X.lds + 131072)}; pg8::gemm_phase<pg8::EpiScaleBf16<0, true, true>, pg8::StaticOrder, true, true>(X.lds, g, S, E);
            if (X.G == 256 && X.bid >= 128 && l + 1 < DEPTH) {
                LAS float* scr = (LAS float*)(X.lds + X.wave * TR_SCR);
                for (int r = (X.bid - 128) * NWAVES + X.wave; r < TAILQ; r += 128 * NWAVES) convert_item(X, l + 1, r, scr); }
            PB_END(1) }
#endif
        SEAM(pb + 0);
#ifndef NO_MIX1
        if (IN(pb + 1)) { PB_BEGIN(2)
#ifndef NO_DA
            { PB_BEGIN(8) PHASE_CTX(); const int vcu = (X.G % 8 == 0) ? (X.bid % 8) * (X.G / 8) + X.bid / 8 : X.bid;
              for (int run = vcu; run < 768; run += X.G) dil_run(X, H, l, run); PB_END(8) }
#endif
#ifndef NO_HG1
            { PB_BEGIN(9) PHASE_CTX(); LocRegs<false> R; loc_load<false>(X, H, X.bid, R); for (int r = X.bid; r < 1536; r += X.G) gla_local_item<128, false>(X, H, l, r, R, r + X.G < 1536); PB_END(9) }
#endif
#ifndef NO_RT1
            { PB_BEGIN(10) PHASE_CTX(); LocRegs<true> R; loc_load<true>(X, H, 2 * X.bid, R); for (int it = X.bid; it < 768; it += X.G) ret_local_item(X, H, it, R, it + X.G < 768); PB_END(10) }
#endif
        PB_END(2) }
#endif
        SEAM(pb + 1);
#ifndef NO_SCAN
        if (IN(pb + 2)) { PB_BEGIN(3) const Ctx X = mkctx(lds); scan_phase(X); PB_END(3) }
#endif
        SEAM(pb + 2);
#ifndef NO_MIX2
        if (IN(pb + 3)) { PB_BEGIN(4)
#ifndef NO_HG2
            { PB_BEGIN(11) PHASE_CTX(); OutRegs<false> R; out_load<false>(X, H, X.bid, R); for (int r = X.bid; r < 1536; r += X.G) gla_out_item<128, false>(X, H, Y, l, r, R, r + X.G < 1536); PB_END(11) }
#endif
#ifndef NO_RT2
            { PB_BEGIN(12) PHASE_CTX(); RetOutRegs R; ret_out_load(X, H, X.bid, R); for (int it = X.bid; it < 768; it += X.G) ret_out_item(X, H, Y, l, it, R, it + X.G < 768); PB_END(12) }
#endif
#ifndef NO_DM
            { PHASE_CTX(); for (int it = X.bid; it < 256; it += X.G) dil_merge_item(X, H, Y, it); }
#endif
        PB_END(4) }
#endif
        SEAM(pb + 3);
#if !defined(NO_GEMM) && !defined(NO_GE)
        if (IN(pb + 4)) { PB_BEGIN(5) PHASE_CTX(); pg8::Gemm g{Y, (const bf16*)(X.ws + WS_WOUT) + (size_t)l * D * D, M, D, D}; pg8::StaticOrder S; S.init(M, D, X.G, X.bid);
            pg8::EpiResid<false> E{XB, nullptr, ss_mlp}; pg8::gemm_phase<pg8::EpiResid<false>, pg8::StaticOrder, true, true>(X.lds, g, S, E); PB_END(5) }
#endif
        SEAM(pb + 4);
#if !defined(NO_GEMM) && !defined(NO_GF)
        if (IN(pb + 5)) { PB_BEGIN(6) PHASE_CTX(); pg8::Gemm g{XB, (const bf16*)(X.ws + WS_WUP) + (size_t)l * FF * D, M, FF, D}; pg8::StaticOrder S; S.init(M, FF, X.G, X.bid);
            pg8::EpiScaleBf16<1> E{H, FF, ss_mlp, (LAS float*)(X.lds + 131072)}; pg8::gemm_phase<pg8::EpiScaleBf16<1>, pg8::StaticOrder, true, true>(X.lds, g, S, E); PB_END(6) }
#endif
        SEAM(pb + 5);
#if !defined(NO_GEMM) && !defined(NO_GG)
        if (IN(pb + 6)) { PB_BEGIN(7) PHASE_CTX(); pg8::Gemm g{H, (const bf16*)(X.ws + WS_WDN) + (size_t)l * D * FF, M, D, FF}; pg8::StaticOrder S; S.init(M, D, X.G, X.bid);
            if (l < DEPTH - 1) { pg8::EpiResid<false> E{XB, nullptr, ss_mix_next}; pg8::gemm_phase<pg8::EpiResid<false>, pg8::StaticOrder, true, true>(X.lds, g, S, E); }
            else { pg8::EpiResid<true> E{XB, X.out(), nullptr}; pg8::gemm_phase<pg8::EpiResid<true>, pg8::StaticOrder, true, true>(X.lds, g, S, E); }
            PB_END(7) }
#endif
        SEAM(pb + 6);
    }
#undef IN
#undef SEAM
}

extern "C" void kernel_launch(void* const* d_in, const int* in_sizes, int n_in, void* d_out, int out_size, void* d_ws, size_t ws_size, hipStream_t stream) {
    static int grid = 0;
    if (grid == 0) {
        if (n_in != 14 || in_sizes[0] != M * D || out_size != M * D || ws_size < WS_END) { fprintf(stderr, "kernel_launch: unexpected problem (n_in %d, in0 %d, out %d, ws %zu < %zu); nothing launched\n", n_in, n_in > 0 ? in_sizes[0] : -1, out_size, ws_size, (size_t)WS_END); grid = -1; return; }
        int dev = 0, cus = 0, per_cu = 0;
        if (hipGetDevice(&dev) != hipSuccess || hipDeviceGetAttribute(&cus, hipDeviceAttributeMultiprocessorCount, dev) != hipSuccess) { grid = -1; return; }
        if (hipFuncSetAttribute((const void*)mega_fwd, hipFuncAttributeMaxDynamicSharedMemorySize, LDS_BYTES) != hipSuccess) { fprintf(stderr, "kernel_launch: hipFuncSetAttribute failed\n"); grid = -1; return; }
        if (hipOccupancyMaxActiveBlocksPerMultiprocessor(&per_cu, (const void*)mega_fwd, NTHR, LDS_BYTES) != hipSuccess || per_cu < 1) fprintf(stderr, "kernel_launch: occupancy query reports %d workgroups per CU\n", per_cu);
        (void)hipGetLastError();
        grid = cus;
    }
    if (grid < 0) return;
    (void)hipMemsetAsync((char*)d_ws + WS_CTL, 0, CTL_ZERO_BYTES, stream);
    Args a{};
    for (int i = 0; i < 14; ++i) a.in[i] = (const float*)d_in[i];
    a.out = (float*)d_out; a.ws = (unsigned char*)d_ws;
    if (MK_N_LAUNCHES == 1) { a.ph_lo = 0; a.ph_hi = NPHASE; hipLaunchKernelGGL(mega_fwd, dim3(grid), dim3(NTHR), LDS_BYTES, stream, a); }
    else for (int p = 0; p < NPHASE; ++p) { a.ph_lo = p; a.ph_hi = p + 1; hipLaunchKernelGGL(mega_fwd, dim3(grid), dim3(NTHR), LDS_BYTES, stream, a); }
}
```

```cpp
#include <hip/hip_runtime.h>
#include <cstdio>
#include <cstdint>
namespace pg8 {
#define PG8_LAS __attribute__((address_space(3)))
typedef unsigned short bf16_t;
typedef short bf16x8 __attribute__((ext_vector_type(8)));
typedef float f32x4 __attribute__((ext_vector_type(4)));
typedef unsigned u32x4 __attribute__((ext_vector_type(4)));
constexpr int BM = 256, BK = 64, HALF = 128, HTB = HALF * BK * 2  , STAGE_BYTES = 8 * HTB, NXCD = 8, WGM = 4;

__host__ __device__ __forceinline__ int lds_byte(int r, int c) { const int st = (r >> 4) * 2 + (c >> 5), rr = r & 15, cc = c & 31, ob = rr * 64 + cc * 2; return st * 1024 + (ob ^ (((ob >> 9) & 1) << 5)); }
__host__ __device__ __forceinline__ void stage_rc(int b, int& R, int& C) { const int st = b / 1024, sb = b % 1024, swz = sb ^ (((sb >> 9) & 1) << 5); R = (st >> 1) * 16 + swz / 64; C = (st & 1) * 32 + (swz % 64) / 2; }
__host__ __device__ __forceinline__ int perm32(int rho) { const int n = rho >> 4, i = rho & 15; return 8 * (i >> 2) + 4 * n + (i & 3); }

struct Unit { int pm, pn; };
struct Gemm { const bf16_t* A; const bf16_t* Bt; int M, N, K; };

struct StaticOrder {
    int nM, nN, nwg, G, c;
    __host__ __device__ void init(int M, int N, int G_, int c_) { nM = M / BM; nN = N / BM; nwg = nM * nN; G = G_; c = c_; }
    __host__ __device__ bool next(int i, Unit& u) const {
        const long L = (long)i * G + c; if (L >= nwg) return false;
        int wgid = (int)L; { const int q = nwg / NXCD, r = nwg % NXCD, xcd = wgid % NXCD, off = wgid / NXCD; wgid = (xcd < r ? xcd * (q + 1) : r * (q + 1) + (xcd - r) * q) + off; }
        const int nig = WGM * nN, gid = wgid / nig, fm = gid * WGM, gsz = (nM - fm) < WGM ? (nM - fm) : WGM;
        u.pm = fm + ((wgid % nig) % gsz); u.pn = (wgid % nig) / gsz; return true;
    }
    __device__ __forceinline__ void a_ready(const Unit&) const {}
    __device__ __forceinline__ void done(const Unit&) const {}
};

typedef float f32x2 __attribute__((ext_vector_type(2))); typedef __bf16 bf16x2_t __attribute__((ext_vector_type(2)));
__device__ __forceinline__ unsigned cvt_pk_bf16(float lo, float hi) { f32x2 v = {lo, hi}; bf16x2_t b = __builtin_convertvector(v, bf16x2_t); return __builtin_bit_cast(unsigned, b); }

template <int ACT, bool BLK = false, bool PERMROWS = false> struct EpiScaleBf16 {
    static constexpr bool PERM = true, AFTER_DRAIN = false, HAS_PREP = true;
    bf16_t* O; int ldc; const float* ss; PG8_LAS float* rtab;
    __device__ __forceinline__ void prep(const Unit& u, int tid, int buf) const {
        if (tid < BM) { const float* p = ss + (size_t)(u.pm * BM + tid) * 32; float sq = 0.f;
#pragma unroll
            for (int i = 0; i < 8; ++i) { const f32x4 v = *(const f32x4*)(p + 4 * i); sq += (v[0] + v[1]) + (v[2] + v[3]); }
            rtab[buf * BM + tid] = __builtin_amdgcn_rsqf(sq * (1.0f / 2048.0f) + 1e-6f); }
    }
    __device__ __forceinline__ void operator()(const f32x4 (&acc)[2][2][4][2], const Unit& u, int wr, int wc, int fr, int fq, int buf) const {
        const int row0 = u.pm * BM + wr * 64 + fr; const int col0 = u.pn * BM + wc * 32 + 8 * fq;
#pragma unroll
        for (int ai = 0; ai < 2; ++ai)
#pragma unroll
            for (int m = 0; m < 4; ++m) { const int row = row0 + ai * HALF + m * 16;
                const float sc = rtab[buf * BM + wr * 64 + fr + ai * HALF + m * 16];
                int prow = row;
                if (PERMROWS && u.pn >= 24) { const int sh = 2 * ((u.pn - 24) / 6), t = row & 8191; prow = (row & ~8191) + ((t & ((1 << sh) - 1)) << (13 - sh)) + (t >> sh); }
                bf16_t* rowp = BLK ? O + ((size_t)(2 * u.pn) * ldc + prow) * 128 + wc * 32 + 8 * fq : O + (size_t)row * ldc + col0;
#pragma unroll
                for (int bj = 0; bj < 2; ++bj) { f32x4 v0 = acc[ai][bj][m][0] * sc, v1 = acc[ai][bj][m][1] * sc;
                    if (ACT == 1) {
#pragma unroll
                        for (int e = 0; e < 4; ++e) { float a = v0[e] > 0.f ? v0[e] : 0.f; v0[e] = a * a; float b = v1[e] > 0.f ? v1[e] : 0.f; v1[e] = b * b; } }
                    u32x4 w; w.x = cvt_pk_bf16(v0[0], v0[1]); w.y = cvt_pk_bf16(v0[2], v0[3]); w.z = cvt_pk_bf16(v1[0], v1[1]); w.w = cvt_pk_bf16(v1[2], v1[3]);
                    *(u32x4*)(rowp + (BLK ? (size_t)bj * ldc * 128 : (size_t)bj * HALF)) = w; } }
    }
};
template <bool FINAL> struct EpiResid {
    static constexpr bool PERM = true, AFTER_DRAIN = false, HAS_PREP = false;
    bf16_t* xb; float* out; float* ssn;
    __device__ __forceinline__ void operator()(const f32x4 (&acc)[2][2][4][2], const Unit& u, int wr, int wc, int fr, int fq) const {
        const int col0 = u.pn * BM + wc * 32 + 8 * fq;
#pragma unroll
        for (int ai = 0; ai < 2; ++ai)
#pragma unroll
            for (int m = 0; m < 4; ++m) { const int row = u.pm * BM + ai * HALF + wr * 64 + m * 16 + fr; const size_t off = (size_t)row * 2048 + col0; float sq = 0.f;
#pragma unroll
                for (int bj = 0; bj < 2; ++bj) { const size_t o2 = off + bj * HALF; const u32x4 xw = *(const u32x4*)(xb + o2);
                    f32x4 x0, x1; x0[0] = __uint_as_float(xw.x << 16); x0[1] = __uint_as_float(xw.x & 0xffff0000u); x0[2] = __uint_as_float(xw.y << 16); x0[3] = __uint_as_float(xw.y & 0xffff0000u);
                    x1[0] = __uint_as_float(xw.z << 16); x1[1] = __uint_as_float(xw.z & 0xffff0000u); x1[2] = __uint_as_float(xw.w << 16); x1[3] = __uint_as_float(xw.w & 0xffff0000u);
                    x0 = x0 + acc[ai][bj][m][0]; x1 = x1 + acc[ai][bj][m][1];
                    if (FINAL) { *(f32x4*)(out + o2) = x0; *(f32x4*)(out + o2 + 4) = x1; }
                    else { u32x4 w; w.x = cvt_pk_bf16(x0[0], x0[1]); w.y = cvt_pk_bf16(x0[2], x0[3]); w.z = cvt_pk_bf16(x1[0], x1[1]); w.w = cvt_pk_bf16(x1[2], x1[3]); *(u32x4*)(xb + o2) = w; }
                    sq += ((x0[0] * x0[0] + x0[1] * x0[1]) + (x0[2] * x0[2] + x0[3] * x0[3])) + ((x1[0] * x1[0] + x1[1] * x1[1]) + (x1[2] * x1[2] + x1[3] * x1[3])); }
                sq += __shfl_xor(sq, 16); sq += __shfl_xor(sq, 32);
                if (!FINAL && fq == 0) ssn[(size_t)row * 32 + u.pn * 4 + wc] = sq; }
    }
};
template <class Epi, class Sched, bool ALIGN_EPI = false, bool SP2 = false>
__device__ __forceinline__ void gemm_phase(PG8_LAS unsigned char* lds, const Gemm g, const Sched& S, const Epi& E) {
    int tid_ = threadIdx.x; asm volatile("" : "+v"(tid_));
    const int tid = tid_, wid = __builtin_amdgcn_readfirstlane(tid >> 6), lane = tid & 63, wr = wid >> 2, wc = wid & 3, fr = lane & 15, fq = lane >> 4;
    const int K = g.K, nt = K / BK;
    unsigned voffA[2], voffB[2];
#pragma unroll
    for (int i = 0; i < 2; ++i) { int R, C; stage_rc(tid * 16 + i * 8192, R, C); const int Rb = Epi::PERM ? ((R & ~31) + perm32(R & 31)) : R;
        voffA[i] = (unsigned)(R * K + C) * 2u; voffB[i] = (unsigned)(Rb * K + C) * 2u; }
    const size_t kstep = (size_t)(BK * 2);
    const size_t hstep = (size_t)HALF * K * 2;
    const size_t tstep = 2 * hstep;
    const unsigned ldsw = (unsigned)wid * 1024u;
    const int aoff = lds_byte(wr * 64 + fr, fq * 8), boff = lds_byte(wc * 32 + fr, fq * 8);
#define PG8_SA(b, h) (((b) * 2 + (h)) * HTB)
#define PG8_SB(b, h) ((4 + (b) * 2 + (h)) * HTB)
#define PG8_STAGE(bufoff, gbase, voff) do { _Pragma("unroll") for (int _i = 0; _i < 2; ++_i) \
        __builtin_amdgcn_global_load_lds((const unsigned*)((const char*)(gbase) + (voff)[_i]), (PG8_LAS unsigned*)(lds + (bufoff) + ldsw + _i * 8192), 16, 0, 0); } while (0)
#define PG8_LDA(dst, b, h) do { _Pragma("unroll") for (int m = 0; m < 4; ++m) _Pragma("unroll") for (int k = 0; k < 2; ++k) dst[m][k] = *(const PG8_LAS bf16x8*)(lds + PG8_SA(b, h) + aoff + m * 2048 + k * 1024); } while (0)
#define PG8_LDB(dst, b, h) do { _Pragma("unroll") for (int n = 0; n < 2; ++n) _Pragma("unroll") for (int k = 0; k < 2; ++k) dst[n][k] = *(const PG8_LAS bf16x8*)(lds + PG8_SB(b, h) + boff + n * 2048 + k * 1024); } while (0)
#define PG8_MMA(ai, bj, At, Bt) do { __builtin_amdgcn_s_setprio(1); _Pragma("unroll") for (int m = 0; m < 4; ++m) _Pragma("unroll") for (int n = 0; n < 2; ++n) _Pragma("unroll") for (int k = 0; k < 2; ++k) \
        acc[ai][bj][m][n] = __builtin_amdgcn_mfma_f32_16x16x32_bf16(Bt[n][k], At[m][k], acc[ai][bj][m][n], 0, 0, 0); __builtin_amdgcn_s_setprio(0); } while (0)
#define PG8_WAIT_V(n) asm volatile("s_waitcnt vmcnt(" #n ")" ::: "memory")
#define PG8_WAIT_L(n) asm volatile("s_waitcnt lgkmcnt(" #n ")" ::: "memory")
#define PG8_BAR __builtin_amdgcn_s_barrier()
#define PG8_SCHED __builtin_amdgcn_sched_barrier(0)
    Unit cur, nxt; int ui = 0;
    if (!S.next(0, cur)) return;
    f32x4 acc[2][2][4][2];
#pragma unroll
    for (int a = 0; a < 2; ++a)
#pragma unroll
        for (int b = 0; b < 2; ++b)
#pragma unroll
            for (int m = 0; m < 4; ++m)
#pragma unroll
                for (int n = 0; n < 2; ++n) acc[a][b][m][n] = (f32x4){0.f, 0.f, 0.f, 0.f};
    bf16x8 At[4][2], B0[2][2], B1[2][2];
    const char* cA = (const char*)g.A + (size_t)cur.pm * tstep; const char* cB = (const char*)g.Bt + (size_t)cur.pn * tstep;
    S.a_ready(cur);
    int prep_pm = cur.pm, prep_gen = 0; if constexpr (Epi::HAS_PREP) E.prep(cur, tid, 0);
    if constexpr (SP2) {
        PG8_STAGE(PG8_SB(0, 0), cB, voffB); PG8_STAGE(PG8_SB(0, 1), cB + hstep, voffB); PG8_STAGE(PG8_SA(0, 0), cA, voffA); PG8_STAGE(PG8_SA(0, 1), cA + hstep, voffA);
        if (wr == 1) PG8_BAR;
        PG8_WAIT_V(2); PG8_BAR;
        PG8_STAGE(PG8_SB(1, 0), cB + kstep, voffB); PG8_STAGE(PG8_SA(1, 0), cA + kstep, voffA); PG8_STAGE(PG8_SB(1, 1), cB + hstep + kstep, voffB);
        PG8_WAIT_V(6); PG8_BAR;
    } else {
        PG8_STAGE(PG8_SB(0, 0), cB, voffB); PG8_STAGE(PG8_SA(0, 0), cA, voffA); PG8_STAGE(PG8_SB(0, 1), cB + hstep, voffB); PG8_STAGE(PG8_SA(0, 1), cA + hstep, voffA);
        if (wr == 1) PG8_BAR;
        PG8_WAIT_V(4); PG8_BAR;
        PG8_STAGE(PG8_SB(1, 0), cB + kstep, voffB); PG8_STAGE(PG8_SA(1, 0), cA + kstep, voffA); PG8_STAGE(PG8_SB(1, 1), cB + hstep + kstep, voffB);
        PG8_WAIT_V(6); PG8_BAR;
    }
    for (;;) {
        const bool has_next = S.next(ui + 1, nxt);
        const char* nA = has_next ? (const char*)g.A + (size_t)nxt.pm * tstep : cA; const char* nB = has_next ? (const char*)g.Bt + (size_t)nxt.pn * tstep : cB;
        for (int t = 0; t < nt; t += 2) {
            const bool last = (t == nt - 2);
            const char* a1 = cA + (size_t)(t + 1) * kstep;
            const char* a2 = last ? nA : cA + (size_t)(t + 2) * kstep; const char* b2 = last ? nB : cB + (size_t)(t + 2) * kstep;
            const char* a3 = a2 + kstep; const char* b3 = b2 + kstep;
            if (last && has_next) S.a_ready(nxt);
            if constexpr (SP2) {
            PG8_LDB(B0, 0, 0); PG8_LDB(B1, 0, 1); PG8_SCHED; PG8_LDA(At, 0, 0); PG8_STAGE(PG8_SA(1, 1), a1 + hstep, voffA);
            PG8_WAIT_V(8); PG8_WAIT_L(0); PG8_BAR; PG8_MMA(0, 0, At, B0); PG8_MMA(0, 1, At, B1); PG8_BAR; PG8_SCHED;
            PG8_LDA(At, 0, 1); PG8_STAGE(PG8_SB(0, 0), b2, voffB); PG8_STAGE(PG8_SB(0, 1), b2 + hstep, voffB); PG8_STAGE(PG8_SA(0, 0), a2, voffA);
            PG8_WAIT_V(8); PG8_WAIT_L(0); PG8_BAR; PG8_MMA(1, 0, At, B0); PG8_MMA(1, 1, At, B1); PG8_BAR; PG8_SCHED;
            PG8_LDB(B0, 1, 0); PG8_LDB(B1, 1, 1); PG8_SCHED; PG8_LDA(At, 1, 0); PG8_STAGE(PG8_SA(0, 1), a2 + hstep, voffA);
            PG8_WAIT_V(8); PG8_WAIT_L(0); PG8_BAR; PG8_MMA(0, 0, At, B0); PG8_MMA(0, 1, At, B1); PG8_BAR; PG8_SCHED;
            PG8_LDA(At, 1, 1); PG8_STAGE(PG8_SB(1, 0), b3, voffB); PG8_STAGE(PG8_SB(1, 1), b3 + hstep, voffB); PG8_STAGE(PG8_SA(1, 0), a3, voffA);
            PG8_WAIT_V(8); PG8_WAIT_L(0); PG8_BAR; PG8_MMA(1, 0, At, B0); PG8_MMA(1, 1, At, B1); PG8_BAR; PG8_SCHED;
            } else {
            PG8_LDB(B0, 0, 0); PG8_SCHED; PG8_LDA(At, 0, 0); PG8_STAGE(PG8_SA(1, 1), a1 + hstep, voffA);
            PG8_WAIT_L(8); PG8_BAR; PG8_WAIT_L(0); PG8_MMA(0, 0, At, B0); PG8_BAR; PG8_SCHED;
            PG8_LDB(B1, 0, 1); PG8_STAGE(PG8_SB(0, 0), b2, voffB);
            PG8_BAR; PG8_WAIT_L(0); PG8_MMA(0, 1, At, B1); PG8_BAR;
            PG8_LDA(At, 0, 1); PG8_STAGE(PG8_SA(0, 0), a2, voffA);
            PG8_BAR; PG8_WAIT_L(0); PG8_MMA(1, 0, At, B0); PG8_BAR; PG8_SCHED;
            PG8_STAGE(PG8_SB(0, 1), b2 + hstep, voffB);
            PG8_WAIT_V(6); PG8_BAR; PG8_MMA(1, 1, At, B1); PG8_BAR;
            PG8_LDB(B0, 1, 0); PG8_SCHED; PG8_LDA(At, 1, 0); PG8_STAGE(PG8_SA(0, 1), a2 + hstep, voffA);
            PG8_WAIT_L(8); PG8_BAR; PG8_WAIT_L(0); PG8_MMA(0, 0, At, B0); PG8_BAR; PG8_SCHED;
            PG8_LDB(B1, 1, 1); PG8_STAGE(PG8_SB(1, 0), b3, voffB);
            PG8_BAR; PG8_WAIT_L(0); PG8_MMA(0, 1, At, B1); PG8_BAR;
            PG8_LDA(At, 1, 1); PG8_STAGE(PG8_SA(1, 0), a3, voffA);
            PG8_BAR; PG8_WAIT_L(0); PG8_MMA(1, 0, At, B0); PG8_BAR; PG8_SCHED;
            PG8_STAGE(PG8_SB(1, 1), b3 + hstep, voffB);
            PG8_WAIT_V(6); PG8_BAR; PG8_MMA(1, 1, At, B1); PG8_BAR;
            }
        }
        if constexpr (ALIGN_EPI) { if (wr == 0) PG8_BAR; }
        if constexpr (!Epi::AFTER_DRAIN) { if constexpr (Epi::HAS_PREP) E(acc, cur, wr, wc, fr, fq, prep_gen & 1); else E(acc, cur, wr, wc, fr, fq); S.done(cur); }
        if (!has_next) break;
#pragma unroll
        for (int a = 0; a < 2; ++a)
#pragma unroll
            for (int b = 0; b < 2; ++b)
#pragma unroll
                for (int m = 0; m < 4; ++m)
#pragma unroll
                    for (int n = 0; n < 2; ++n) acc[a][b][m][n] = (f32x4){0.f, 0.f, 0.f, 0.f};
        cur = nxt; cA = nA; cB = nB; ++ui;
        if constexpr (Epi::HAS_PREP) { if (cur.pm != prep_pm) { ++prep_gen; E.prep(cur, tid, prep_gen & 1); prep_pm = cur.pm; } }
        if constexpr (ALIGN_EPI) { if (wr == 1) PG8_BAR; }
    }
    PG8_WAIT_V(0);
    if constexpr (!ALIGN_EPI) { if (wr == 0) PG8_BAR; }
    PG8_BAR;
    if constexpr (Epi::AFTER_DRAIN) { E.fused(acc, cur, wr, wc, fr, fq, lds, wid, lane); S.done(cur); }
#undef PG8_SA
#undef PG8_SB
#undef PG8_STAGE
#undef PG8_LDA
#undef PG8_LDB
#undef PG8_MMA
#undef PG8_WAIT_V
#undef PG8_WAIT_L
#undef PG8_BAR
#undef PG8_SCHED
}
}
constexpr int NWAVES = 8, NTHR = 512;
constexpr int BATCH = 2, SEQ = 8192, M = BATCH * SEQ, D = 2048, DEPTH = 4, INW = 10752, FF = 8192;
constexpr int C_HGQ = 0, C_HGV = 768, C_ZF = 1536, C_ZB = 2304, C_HGG = 3072, C_RQ = 3840, C_RK = 4224, C_RV = 4608, C_RG = 5376, C_DIL = 6144;
constexpr int CH = 64, NCH = SEQ / CH;
constexpr float EPS = 1e-6f;
constexpr int NPHASE = 1 + 7 * DEPTH;

constexpr size_t MiB = 1u << 20;
constexpr size_t WS_CTL = 0, CTL_ZERO_BYTES = 1 * MiB;
constexpr size_t WS_PART = 10 * MiB;
constexpr size_t WS_ROPE = 2 * MiB;
constexpr size_t WS_TAB = 4 * MiB;
constexpr size_t WS_LSE = 5 * MiB;
constexpr size_t WS_DHG = 6 * MiB;
constexpr size_t WS_DRT = 8 * MiB;
constexpr size_t WS_WIN = 16 * MiB, WS_WOUT = 184 * MiB, WS_WUP = 216 * MiB, WS_WDN = 344 * MiB;
constexpr size_t WS_XB = 472 * MiB;
constexpr size_t WS_Y = 536 * MiB;
constexpr size_t WS_H = 600 * MiB;
constexpr size_t WS_SHG = 936 * MiB;
constexpr size_t WS_SRT = 1032 * MiB;
constexpr size_t WS_END = 1080 * MiB;
constexpr int CW_BAR = 4096;

constexpr int PH_BYTES = 155648;
constexpr int LDSCTL_OFF = PH_BYTES, MISC_OFF = LDSCTL_OFF + 320;
constexpr int LDS_BYTES = PH_BYTES + 1024;

#define GAS __attribute__((address_space(1)))
#define LAS __attribute__((address_space(3)))
typedef unsigned short bf16;
typedef unsigned v4u __attribute__((ext_vector_type(4)));
typedef unsigned v2u __attribute__((ext_vector_type(2)));
typedef float f32x4 __attribute__((ext_vector_type(4)));
typedef short bf16x8 __attribute__((ext_vector_type(8)));
typedef LAS unsigned char* lptr;
#define LDS_WAIT() asm volatile("s_waitcnt lgkmcnt(0)" ::: "memory")
#define VM_WAIT() asm volatile("s_waitcnt vmcnt(0)" ::: "memory")
#ifndef PROBE_MASK
#define PROBE_MASK 0
#endif
#define SP_BEGIN() unsigned long long sp0_ = 0; if (PROBE_MASK >> 16) sp0_ = __builtin_amdgcn_s_memrealtime();
#define SP_END(bit) do { if (PROBE_MASK >> 16) { const unsigned long long t1_ = __builtin_amdgcn_s_memrealtime(); if (PROBE_MASK & (1 << (bit))) { const unsigned long long dt_ = t1_ - sp0_; while (__builtin_amdgcn_s_memrealtime() - t1_ < dt_) __builtin_amdgcn_s_sleep(2); } sp0_ = __builtin_amdgcn_s_memrealtime(); } } while (0)
#define BAR_LDS() do { asm volatile("s_waitcnt lgkmcnt(0)" ::: "memory"); __builtin_amdgcn_s_barrier(); asm volatile("" ::: "memory"); } while (0)
__device__ __forceinline__ float bf2f(unsigned h) { return __uint_as_float(h << 16); }
__device__ __forceinline__ unsigned pk2(float lo, float hi) { return pg8::cvt_pk_bf16(lo, hi); }
__device__ __forceinline__ unsigned short f2bf(float f) { return (unsigned short)(pk2(f, 0.f) & 0xffffu); }
__device__ __forceinline__ bf16x8 ldsfrag(lptr base, int row, int stride_b, int kel) { return *(const LAS bf16x8*)(base + row * stride_b + kel * 2); }
#define MFMA16(a, b, c) __builtin_amdgcn_mfma_f32_16x16x32_bf16((a), (b), (c), 0, 0, 0)
template <class T> __device__ __forceinline__ T* hptr(T* H, size_t m, int col) { return H + ((size_t)(col >> 7) * M + m) * 128 + (col & 127); }
__device__ __forceinline__ float wave_sum(float v) {
#pragma unroll
    for (int o = 1; o < 64; o <<= 1) v += __shfl_xor(v, o);
    return v;
}
typedef GAS unsigned gu32;
#define XB_TMO      128
#define XB_XCNT(j)  (256  + 64 * (j))
#define XB_XSUB(j)  (1280 + 64 * (j))
#define XB_XGEN(j)  (2304 + 64 * (j))
#define XB_TOP      3328
#define XB_TOPGEN   3392
#define XCD_BAR_WORDS 3456
#define XB_SPIN_CAP (1u << 18)

__device__ __forceinline__ unsigned xb_ld(unsigned* p)              { return __hip_atomic_load(p, __ATOMIC_RELAXED, __HIP_MEMORY_SCOPE_AGENT); }
__device__ __forceinline__ unsigned xb_add(unsigned* p, unsigned v) { return __hip_atomic_fetch_add(p, v, __ATOMIC_RELAXED, __HIP_MEMORY_SCOPE_AGENT); }
__device__ __forceinline__ unsigned xb_xcc_id() { return (unsigned)__builtin_amdgcn_s_getreg((3 << 11) | 20) & 0xFu; }
#define XB_SPIN(cond, bar) do { unsigned _sp = 0; while (cond) { __builtin_amdgcn_s_sleep(1); \
    if ((++_sp & 255u) == 0u) { if (xb_ld(&(bar)[XB_TMO])) break; if (_sp > XB_SPIN_CAP) { atomicAdd(&(bar)[XB_TMO], 1u); break; } } } } while (0)

struct XcdBarrier {
    unsigned* bar; unsigned x;
    volatile LAS unsigned* st;
};

__device__ __forceinline__ XcdBarrier xcd_barrier_post(unsigned* bar, volatile LAS unsigned* st) {
    XcdBarrier b; b.bar = bar; b.x = xb_xcc_id(); b.st = st;
    if (threadIdx.x == 0) (void)xb_add(&bar[XB_XCNT(b.x)], 1u);
    return b;
}
__device__ __forceinline__ void xcd_barrier_complete(unsigned* bar, unsigned x, unsigned& nloc, unsigned& nx) {
    const unsigned G = gridDim.x * gridDim.y * gridDim.z;
    unsigned sum, cnt, mine, sp = 0u;
    for (;;) {
        sum = 0u; cnt = 0u; mine = 0u;
#pragma unroll
        for (unsigned j = 0; j < 16; ++j) { const unsigned c = xb_ld(&bar[XB_XCNT(j)]); sum += c; cnt += (c > 0u) ? 1u : 0u; mine = (j == x) ? c : mine; }
        if (sum == G) break;
        __builtin_amdgcn_s_sleep(1);
        if ((++sp & 255u) == 0u) { if (xb_ld(&bar[XB_TMO])) break; if (sp > XB_SPIN_CAP) { atomicAdd(&bar[XB_TMO], 1u); break; } }
    }
    nloc = mine > 0u ? mine : 1u; nx = cnt > 0u ? cnt : 1u;
}

__device__ __forceinline__ void xcd_barrier(const XcdBarrier& b) {
    asm volatile("s_waitcnt vmcnt(0)" ::: "memory");
    __syncthreads();
    if (threadIdx.x == 0) {
        unsigned* bar = b.bar;
        __builtin_amdgcn_s_waitcnt(0);
        unsigned nloc = b.st[0], nx = b.st[1];
        if (nloc == 0u) { xcd_barrier_complete(bar, b.x, nloc, nx); b.st[0] = nloc; b.st[1] = nx; }
        const unsigned old = xb_add(&bar[XB_XSUB(b.x)], 1u);
        const unsigned gen = old / nloc;
        if (old + 1u == (gen + 1u) * nloc) {
            __builtin_amdgcn_fence(__ATOMIC_RELEASE, "agent");
            asm volatile("s_waitcnt vmcnt(0)" ::: "memory");
            const unsigned og = xb_add(&bar[XB_TOP], 1u);
            const unsigned tg = og / nx;
            if (og + 1u == (tg + 1u) * nx) xb_add(&bar[XB_TOPGEN], 1u);
            else XB_SPIN(xb_ld(&bar[XB_TOPGEN]) == tg, bar);
            __builtin_amdgcn_fence(__ATOMIC_ACQUIRE, "agent");
            xb_add(&bar[XB_XGEN(b.x)], 1u);
            asm volatile("s_waitcnt vmcnt(0)" ::: "memory");
        } else {
            XB_SPIN(xb_ld(&bar[XB_XGEN(b.x)]) == gen, bar);
            __builtin_amdgcn_fence(__ATOMIC_ACQUIRE, "agent");
            asm volatile("s_waitcnt vmcnt(0)" ::: "memory");
        }
    }
    __syncthreads();
}
constexpr int TR_SCR = 64 * 65 * 4;
__device__ __forceinline__ void transpose_item(const float* W, const float* g, int K, int N, bf16* WT, LAS float* scr, int item, int lane) {
    const int nblk = N / 64, kb = item / nblk, nb = item % nblk, k0 = 64 * kb, n0 = 64 * nb;
    const int n4 = lane & 15, kr = lane >> 4;
    f32x4 w[16];
#pragma unroll
    for (int i = 0; i < 16; ++i) w[i] = *(const f32x4*)(W + (size_t)(k0 + 4 * i + kr) * N + n0 + 4 * n4);
    if (g) {
#pragma unroll
        for (int i = 0; i < 16; ++i) w[i] = w[i] * g[k0 + 4 * i + kr]; }
#pragma unroll
    for (int i = 0; i < 16; ++i) { LAS float* d = scr + (4 * i + kr) * 65 + 4 * n4; d[0] = w[i].x; d[1] = w[i].y; d[2] = w[i].z; d[3] = w[i].w; }
    LDS_WAIT(); asm volatile("" ::: "memory");
    const int c = lane & 7;
#pragma unroll
    for (int j = 0; j < 8; ++j) { const int n = (lane >> 3) + 8 * j; const LAS float* s = scr + (8 * c) * 65 + n;
        v4u o; o.x = pk2(s[0 * 65], s[1 * 65]); o.y = pk2(s[2 * 65], s[3 * 65]); o.z = pk2(s[4 * 65], s[5 * 65]); o.w = pk2(s[6 * 65], s[7 * 65]);
        *(v4u*)(WT + (size_t)(n0 + n) * K + k0 + 8 * c) = o; }
    LDS_WAIT(); asm volatile("" ::: "memory");
}
__device__ __forceinline__ void sincos_d(double a, float& s, float& c) {
    const double kq = __builtin_rint(a * 0.6366197723675814); const double r = a - kq * 1.5707963267948966; const int q = ((int)kq) & 3; const double r2 = r * r;
    double sp = 1.0 / 6227020800.0; sp = sp * r2 - 1.0 / 39916800.0; sp = sp * r2 + 1.0 / 362880.0; sp = sp * r2 - 1.0 / 5040.0; sp = sp * r2 + 1.0 / 120.0; sp = sp * r2 - 1.0 / 6.0; sp = sp * r2 + 1.0; sp *= r;
    double cp = -1.0 / 87178291200.0; cp = cp * r2 + 1.0 / 479001600.0; cp = cp * r2 - 1.0 / 3628800.0; cp = cp * r2 + 1.0 / 40320.0; cp = cp * r2 - 1.0 / 720.0; cp = cp * r2 + 1.0 / 24.0; cp = cp * r2 - 0.5; cp = cp * r2 + 1.0;
    const double ss = (q == 0) ? sp : (q == 1) ? cp : (q == 2) ? -sp : -cp; const double cc = (q == 0) ? cp : (q == 1) ? -sp : (q == 2) ? -cp : sp;
    s = (float)ss; c = (float)cc;
}
__device__ __forceinline__ int t5_bucket(int rel) {
    const int n = rel < 0 ? -rel : rel; int b;
    if (n < 8) b = n; else { b = 8 + (n >= 15) + (n >= 27) + (n >= 50) + (n >= 91) + (n >= 166) + (n >= 305) + (n >= 559); }
    return b + (rel > 0 ? 16 : 0);
}

struct Args { const float* in[14]; float* out; unsigned char* ws; int ph_lo, ph_hi; };
typedef const __attribute__((address_space(4))) Args* kargp;
struct Ctx {
    lptr lds; int tid, lane, wave, G, bid; kargp ka; unsigned char* ws;
    __device__ __forceinline__ const float* in(int i) const { return ka->in[i]; }
    __device__ __forceinline__ float* out() const { return ka->out; }
};
__device__ __forceinline__ Ctx mkctx(lptr lds) {
    Ctx X; int tid = threadIdx.x; asm volatile("" : "+v"(tid));
    kargp ka = (kargp)__builtin_amdgcn_kernarg_segment_ptr(); asm volatile("" : "+s"(ka));
    X.lds = lds; X.tid = tid; X.lane = tid & 63; X.wave = __builtin_amdgcn_readfirstlane(tid >> 6); X.G = gridDim.x; X.bid = blockIdx.x; X.ka = ka; X.ws = ka->ws; return X;
}

constexpr int I_IN = (D / 64) * (INW / 64), I_OUT = (D / 64) * (D / 64), I_UP = (D / 64) * (FF / 64), I_DN = (FF / 64) * (D / 64), I_L = I_IN + I_OUT + I_UP + I_DN;
constexpr int TAILQ = 8192;
__device__ __forceinline__ void convert_item(const Ctx& X, int l, int r, LAS float* scr) {
    if (r < I_IN) { transpose_item(X.in(1) + (size_t)l * D * INW, X.in(5) + l * D, D, INW, (bf16*)(X.ws + WS_WIN) + (size_t)l * INW * D, scr, r, X.lane); return; } r -= I_IN;
    if (r < I_OUT) { transpose_item(X.in(2) + (size_t)l * D * D, nullptr, D, D, (bf16*)(X.ws + WS_WOUT) + (size_t)l * D * D, scr, r, X.lane); return; } r -= I_OUT;
    if (r < I_UP) { transpose_item(X.in(3) + (size_t)l * D * FF, X.in(6) + l * D, D, FF, (bf16*)(X.ws + WS_WUP) + (size_t)l * FF * D, scr, r, X.lane); return; } r -= I_UP;
    transpose_item(X.in(4) + (size_t)l * FF * D, nullptr, FF, D, (bf16*)(X.ws + WS_WDN) + (size_t)l * D * FF, scr, r, X.lane);
}
__device__ __forceinline__ void prologue(const Ctx& X) {
    const int gw = X.bid * NWAVES + X.wave, NGW = X.G * NWAVES;
    LAS float* scr = (LAS float*)(X.lds + X.wave * TR_SCR);
    static_assert(8 * TR_SCR <= PH_BYTES, "transpose scratch");
    const int tq = X.G == 256 ? TAILQ : 0, per = I_L - tq;
    for (int it = gw; it < I_L + (DEPTH - 1) * per; it += NGW) {
        if (it < I_L) convert_item(X, 0, it, scr);
        else { const int j = it - I_L; convert_item(X, 1 + j / per, tq + j % per, scr); }
    }
    float* ss0 = (float*)(X.ws + WS_PART); bf16* xb = (bf16*)(X.ws + WS_XB);
    for (int m = gw; m < M; m += NGW) {
        const f32x4* xr = (const f32x4*)(X.in(0) + (size_t)m * D) + X.lane; f32x4 v[8]; float s = 0.f;
#pragma unroll
        for (int j = 0; j < 8; ++j) { v[j] = xr[64 * j]; s += (v[j].x * v[j].x + v[j].y * v[j].y) + (v[j].z * v[j].z + v[j].w * v[j].w); }
        s = wave_sum(s); if (X.lane < 32) ss0[(size_t)m * 32 + X.lane] = X.lane == 0 ? s : 0.f;
        v2u* o8 = (v2u*)(xb + (size_t)m * D) + X.lane;
#pragma unroll
        for (int j = 0; j < 8; ++j) { v2u w; w.x = pk2(v[j].x, v[j].y); w.y = pk2(v[j].z, v[j].w); o8[64 * j] = w; }
    }
    const int gt = X.bid * NTHR + X.tid, NGT = X.G * NTHR;
    float* rc = (float*)(X.ws + WS_ROPE); float* rs = rc + SEQ * 32;
    for (int i = gt; i < SEQ * 32; i += NGT) { const int pos = i >> 5, f = i & 31; double inv = 1.0; for (int e = 0; e < f; ++e) inv *= 0.7498942093324558; const float ang = (float)pos * (float)inv; float s, c; sincos_d((double)ang, s, c); rc[i] = c; rs[i] = s; }
    float* LB = (float*)(X.ws + WS_TAB); float* BT = LB + 2 * 4 * 768;
    for (int i = gt; i < 2 * 768; i += NGT) { const int dir = i / 768, c = i % 768; const float* src = dir ? X.in(8) : X.in(7);
        const float a0 = src[c], a1 = src[768 + c], a2 = src[2 * 768 + c], a3 = src[3 * 768 + c]; const float mx = fmaxf(fmaxf(a0, a1), fmaxf(a2, a3));
        const float e0 = __expf(a0 - mx), e1 = __expf(a1 - mx), e2 = __expf(a2 - mx), e3 = __expf(a3 - mx); const float inv = 1.0f / (e0 + e1 + e2 + e3);
        float* o = LB + dir * 4 * 768 + c; o[0] = 0.f; o[768] = e1 * inv; o[2 * 768] = (e1 + e2) * inv; o[3 * 768] = (e1 + e2 + e3) * inv; }
    for (int i = gt; i < 3 * 4 * 132; i += NGT) { const int g = i / (4 * 132), sl = (i / 132) % 4, rr = i % 132; const int dil = g == 0 ? 1 : (g == 1 ? 4 : 16);
        BT[i] = rr < 129 ? 1.4426950408889634f * X.in(13)[t5_bucket((rr - 64) * dil) * 12 + g * 4 + sl] : 0.f; }
}

template <int NC> struct RawRegs { v4u w[NC / 64]; };
template <int NC> __device__ __forceinline__ void raw_load(const Ctx& X, const bf16* H, size_t m0, int col, RawRegs<NC>& R) {
#pragma unroll
    for (int p = 0; p < NC / 64; ++p) { const int idx = X.tid + NTHR * p, r = idx / (NC / 8), c8 = idx % (NC / 8); R.w[p] = *(const v4u*)hptr(H, m0 + r, col + 8 * c8); }
}
template <int NC> __device__ __forceinline__ void raw_store(const Ctx& X, lptr dst, const RawRegs<NC>& R) {
#pragma unroll
    for (int p = 0; p < NC / 64; ++p) { const int idx = X.tid + NTHR * p; *(LAS v4u*)(dst + idx * 16) = R.w[p]; }
}
__device__ __forceinline__ void vt_store(const Ctx& X, lptr VT, const RawRegs<128>& R) {
#pragma unroll
    for (int p = 0; p < 2; ++p) { const int idx = X.tid + NTHR * p, r = idx >> 4, c8 = idx & 15; const v4u w = R.w[p];
        LAS unsigned short* d = (LAS unsigned short*)(VT + (8 * c8) * 144 + (r ^ (8 * (c8 & 7))) * 2);
        d[0] = (unsigned short)w.x; d[72] = (unsigned short)(w.x >> 16); d[144] = (unsigned short)w.y; d[216] = (unsigned short)(w.y >> 16);
        d[288] = (unsigned short)w.z; d[360] = (unsigned short)(w.z >> 16); d[432] = (unsigned short)w.w; d[504] = (unsigned short)(w.w >> 16); }
}
__device__ __forceinline__ bf16x8 vtfrag(lptr VT, int row, int stride_b, int kel) { return *(const LAS bf16x8*)(VT + row * stride_b + (kel ^ (8 * ((row >> 3) & 7))) * 2); }
typedef float f32x2v __attribute__((ext_vector_type(2)));
__device__ __forceinline__ f32x2v bfpair(unsigned w) { f32x2v r; r.x = __uint_as_float(w << 16); r.y = __uint_as_float(w & 0xffff0000u); return r; }
__device__ __forceinline__ f32x2v rcp2(f32x2v v) { f32x2v r; r.x = __builtin_amdgcn_rcpf(v.x); r.y = __builtin_amdgcn_rcpf(v.y); return r; }
template <int DIR, bool NEEDQ>
__device__ __forceinline__ void gla_prep(lptr rawz, lptr rawq, f32x2v lb, LAS float* seg, int kp, int rg, f32x2v (&c)[8], f32x2v (&qv)[8], f32x2v (&kv)[8]) {
    f32x2v run = (f32x2v){1.f, 1.f}; const f32x2v oml = 1.0f - lb;
#pragma unroll
    for (int i = 0; i < 8; ++i) { const int ii = DIR ? 7 - i : i; const int r = 8 * rg + ii;
        const f32x2v z = bfpair(*(const LAS unsigned*)(rawz + (r * 128 + 2 * kp) * 2)); f32x2v e; e.x = __expf(-z.x); e.y = __expf(-z.y);
        const f32x2v f = lb + oml * rcp2(e + 1.0f); run = run * f; kv[ii] = 1.0f - f; c[ii] = run;
        if (NEEDQ) qv[ii] = bfpair(*(const LAS unsigned*)(rawq + (r * 128 + 2 * kp) * 2)); }
    *(LAS f32x2v*)(seg + rg * 128 + 2 * kp) = run;
}
#define SEGT(j) (*(const LAS f32x2v*)(seg + ((DIR) ? 7 - (j) : (j)) * 128 + 2 * kp))

constexpr int L1_VT = 0, L1_KC = 128 * 144, L1_SEG = 2 * 128 * 144, L1_RAW = L1_SEG + 4096, L1_END = L1_RAW + 32768;
template <int DK, bool RET, int DIR>
__device__ __forceinline__ void gla_local_dir(const Ctx& X, int chain, int n, f32x2v lb, bf16* St, float* dd) {
    static_assert(DK == 128 && !RET, "HGRN2 only (retention has its own path)");
    const lptr VT = X.lds + L1_VT, KC = X.lds + L1_KC; LAS float* seg = (LAS float*)(X.lds + L1_SEG);
    const lptr rawz = X.lds + L1_RAW + (DIR ? 16384 : 0);
    int t_ = X.tid; asm volatile("" : "+v"(t_));
    const int kp = t_ & 63, rg = __builtin_amdgcn_readfirstlane(t_ >> 6);
    f32x2v c[8], qv[8], kv[8];
    gla_prep<DIR, false>(rawz, rawz, lb, seg, kp, rg, c, qv, kv);
    BAR_LDS();
    {
        const int sg = DIR ? 7 - rg : rg;
        f32x2v base = (f32x2v){1.f, 1.f}, all = (f32x2v){1.f, 1.f};
#pragma unroll
        for (int j = 0; j < 8; ++j) { const f32x2v T = SEGT(j); all = all * T; if (j >= sg) base = base * T; }
        f32x2v e[8];
#pragma unroll
        for (int ii = 0; ii < 8; ++ii) { f32x2v cc = c[ii]; cc.x = fmaxf(cc.x, 1e-37f); cc.y = fmaxf(cc.y, 1e-37f); e[ii] = kv[ii] * base * rcp2(cc); }
        v4u w0, w1;
        w0.x = pk2(e[0].x, e[1].x); w0.y = pk2(e[2].x, e[3].x); w0.z = pk2(e[4].x, e[5].x); w0.w = pk2(e[6].x, e[7].x);
        w1.x = pk2(e[0].y, e[1].y); w1.y = pk2(e[2].y, e[3].y); w1.z = pk2(e[4].y, e[5].y); w1.w = pk2(e[6].y, e[7].y);
        *(LAS v4u*)(KC + (2 * kp) * 144 + rg * 16) = w0; *(LAS v4u*)(KC + (2 * kp + 1) * 144 + rg * 16) = w1;
        if (rg == 0) *(f32x2v*)(dd + ((size_t)chain * NCH + n) * DK + 2 * kp) = all;
    }
    BAR_LDS();
    {
        const int fr = X.lane & 15, fq = X.lane >> 4; const int rt = X.wave; constexpr int NCT = 8;
        f32x4 acc[NCT];
#pragma unroll
        for (int t = 0; t < NCT; ++t) acc[t] = (f32x4){0.f, 0.f, 0.f, 0.f};
#pragma unroll
        for (int ks = 0; ks < 2; ++ks) { const bf16x8 a = ldsfrag(KC, 16 * rt + fr, 144, 32 * ks + 8 * fq);
#pragma unroll
            for (int t = 0; t < NCT; ++t) { const bf16x8 bb = vtfrag(VT, 16 * t + fr, 144, 32 * ks + 8 * fq); acc[t] = MFMA16(a, bb, acc[t]); } }
        bf16* Sp = St + ((size_t)chain * NCH + n) * 128 * DK;
        const lptr UT = X.lds + L1_END;
#pragma unroll
        for (int t = 0; t < NCT; ++t) { v2u w; w.x = pk2(acc[t][0], acc[t][1]); w.y = pk2(acc[t][2], acc[t][3]); *(LAS v2u*)(UT + (16 * t + fr) * 272 + (16 * rt + 4 * fq) * 2) = w; }
        BAR_LDS();
#pragma unroll
        for (int p = 0; p < 4; ++p) { const int idx = X.tid + NTHR * p, row = idx >> 4, c8 = idx & 15; *(v4u*)(Sp + (size_t)row * DK + 8 * c8) = *(const LAS v4u*)(UT + row * 272 + c8 * 16); }
    }
    BAR_LDS();
}
template <bool RET> struct LocRegs { RawRegs<128> rv, rzf, rzb; RawRegs<64> rq, rk; f32x4 c4, s4; };
template <bool RET> __device__ __forceinline__ void loc_load(const Ctx& X, const bf16* H, int r, LocRegs<RET>& R) {
    const int b = r / 768, head = (r / 128) % 6, n = r % 128; const size_t m0 = (size_t)(b * SEQ + n * CH);
    raw_load<128>(X, H, m0, (RET ? C_RV : C_HGV) + head * 128, R.rv);
    if (!RET) { raw_load<128>(X, H, m0, C_ZF + head * 128, R.rzf); raw_load<128>(X, H, m0, C_ZB + head * 128, R.rzb); }
    else { raw_load<64>(X, H, m0, C_RQ + head * 64, R.rq); raw_load<64>(X, H, m0, C_RK + head * 64, R.rk);
        const float* rc = (const float*)(X.ws + WS_ROPE) + (size_t)n * CH * 32; R.c4 = *(const f32x4*)(rc + X.tid * 4); R.s4 = *(const f32x4*)(rc + SEQ * 32 + X.tid * 4); }
}
template <int DK, bool RET>
__device__ __forceinline__ void gla_local_item(const Ctx& X, bf16* H, int l, int r, LocRegs<RET>& R, bool has_next) {
    static_assert(DK == 128 && !RET, "HGRN2 only (retention has its own path)");
    const int b = r / 768, head = (r / 128) % 6, n = r % 128;
    const float* LB = (const float*)(X.ws + WS_TAB);
    bf16* St = (bf16*)(X.ws + WS_SHG); float* dd = (float*)(X.ws + WS_DHG);
    const int kp = X.tid & 63;
    f32x2v lb0 = *(const f32x2v*)(LB + (0 * 4 + l) * 768 + head * 128 + 2 * kp), lb1 = *(const f32x2v*)(LB + (1 * 4 + l) * 768 + head * 128 + 2 * kp);
    vt_store(X, X.lds + L1_VT, R.rv); raw_store<128>(X, X.lds + L1_RAW, R.rzf); raw_store<128>(X, X.lds + L1_RAW + 16384, R.rzb);
    asm volatile("" : "+v"(lb0), "+v"(lb1)); __builtin_amdgcn_sched_barrier(0);
    if (has_next) loc_load<RET>(X, H, r + X.G, R);
    __builtin_amdgcn_sched_barrier(0);
    BAR_LDS();
    const int chain = (b * 6 + head) * 2;
    gla_local_dir<DK, RET, 0>(X, chain, n, lb0, St, dd);
    gla_local_dir<DK, RET, 1>(X, chain + 1, n, lb1, St, dd);
}

template <int DK, bool RET> struct L3 { static constexpr int SQ = (DK + 8) * 2, Q0 = 0, Q1 = 64 * SQ, KD = 96 * SQ, KH = 160 * SQ, VT = 192 * SQ, AM = VT + 128 * 144, SEG = AM + 64 * 144, RED = SEG + 4096, RAW = RED + 1024,
    ST = RAW + 32768, END = ST + 128 * 272; };
static_assert(L3<128, false>::END <= PH_BYTES && L1_END <= PH_BYTES, "mixer LDS maps");
template <int DK, bool RET, int DIR>
__device__ __forceinline__ void gla_out_dir(const Ctx& X, int chain, int n, f32x2v lb, const bf16* St, f32x4 (&o)[4], const bf16* H, size_t m0, int zbcol) {
    static_assert(DK == 128 && !RET, "HGRN2 only (retention has its own path)");
    typedef L3<DK, RET> L; constexpr int SQ = L::SQ;
    const lptr Q0 = X.lds + L::Q0, Q1 = X.lds + L::Q1, KD = X.lds + L::KD, KH = X.lds + L::KH, VT = X.lds + L::VT, AM = X.lds + L::AM; LAS float* seg = (LAS float*)(X.lds + L::SEG);
    const lptr rawz = X.lds + L::RAW, rawq = X.lds + L::RAW + 16384, ST = X.lds + L::ST;
    int t_ = X.tid; asm volatile("" : "+v"(t_));
    const int kp = t_ & 63, rg = __builtin_amdgcn_readfirstlane(t_ >> 6);
    const int fr = X.lane & 15, fq = X.lane >> 4;
    const int tb = X.wave & 3, vh = X.wave >> 2;
    SP_BEGIN()
    const bf16* Sp = St + ((size_t)chain * NCH + n) * 128 * DK;
    v4u sr[4];
#pragma unroll
    for (int p = 0; p < 4; ++p) { const int idx = X.tid + NTHR * p; sr[p] = *(const v4u*)(Sp + (size_t)idx * 8); }
    {
        f32x2v c[8], qv[8], kv[8];
        gla_prep<DIR, true>(rawz, rawq, lb, seg, kp, rg, c, qv, kv);
        BAR_LDS(); SP_END(21);
#pragma unroll
        for (int p = 0; p < 4; ++p) { const int idx = X.tid + NTHR * p; *(LAS v4u*)(ST + (idx >> 4) * 272 + (idx & 15) * 16) = sr[p]; }
        {
            const int sg = DIR ? 7 - rg : rg, ss = sg >> 2, hq = sg & 3;
            const f32x2v T0 = SEGT(0), T1 = SEGT(1), T2 = SEGT(2), T3 = SEGT(3), sub0 = (T0 * T1) * (T2 * T3);
            f32x2v pq = (f32x2v){1.f, 1.f};
#pragma unroll
            for (int j = 0; j < 3; ++j) if (j < hq) pq = pq * SEGT(4 * ss + j);
#pragma unroll
            for (int ii = 0; ii < 8; ++ii) { const int r = 8 * rg + ii; f32x2v cp = c[ii] * pq;
                const f32x2v q0 = qv[ii] * cp; cp.x = fmaxf(cp.x, 1e-37f); cp.y = fmaxf(cp.y, 1e-37f); const f32x2v kd = kv[ii] * rcp2(cp);
                *(LAS unsigned*)(KD + r * SQ + kp * 4) = pk2(kd.x, kd.y);
                *(LAS unsigned*)(Q0 + r * SQ + kp * 4) = pk2(q0.x, q0.y);
                if (ss) { const f32x2v q1 = q0 * sub0; *(LAS unsigned*)(Q1 + (DIR ? r : r - 32) * SQ + kp * 4) = pk2(q1.x, q1.y); }
                else { const f32x2v kh = kd * sub0; *(LAS unsigned*)(KH + (DIR ? r - 32 : r) * SQ + kp * 4) = pk2(kh.x, kh.y); }
                if (ii & 1) __builtin_amdgcn_sched_barrier(0); }
        }
    }
    BAR_LDS(); SP_END(22);
    RawRegs<128> zbr; if (!RET && DIR == 0) raw_load<128>(X, H, m0, zbcol, zbr);
#pragma unroll
    for (int bi = 0; bi < 2; ++bi) { const int blk = 2 * X.wave + bi, I = blk >> 2, J = blk & 3; const int sI = DIR ? 3 - I : I, sJ = DIR ? 3 - J : J;
        v2u w; w.x = 0u; w.y = 0u;
        if (sJ <= sI) { const bool same = (sI >> 1) == (sJ >> 1); const lptr KS = same ? KD : KH; const int krow = same ? 16 * J + fr : (DIR ? 16 * J + fr - 32 : 16 * J + fr);
            f32x4 acc = (f32x4){0.f, 0.f, 0.f, 0.f};
#pragma unroll
            for (int ks = 0; ks < DK / 32; ++ks) { const bf16x8 a = ldsfrag(KS, krow, SQ, 32 * ks + 8 * fq); const bf16x8 bb = ldsfrag(Q0, 16 * I + fr, SQ, 32 * ks + 8 * fq); acc = MFMA16(a, bb, acc); }
            if (sI == sJ) {
#pragma unroll
                for (int j = 0; j < 4; ++j) { const int jl = 4 * fq + j; const bool keep = DIR ? (jl >= fr) : (jl <= fr); if (!keep) acc[j] = 0.f; } }
            w.x = pk2(acc[0], acc[1]); w.y = pk2(acc[2], acc[3]); }
        *(LAS v2u*)(AM + (16 * I + fr) * 144 + (16 * J + 4 * fq) * 2) = w; }
    BAR_LDS(); SP_END(23);
    {
        const int stb = DIR ? 3 - tb : tb; const int r = 16 * tb + fr;
#pragma unroll
        for (int ks = 0; ks < 2; ++ks) { const bf16x8 bb = ldsfrag(AM, r, 144, 32 * ks + 8 * fq);
#pragma unroll
            for (int vt = 0; vt < 4; ++vt) { const bf16x8 a = vtfrag(VT, 64 * vh + 16 * vt + fr, 144, 32 * ks + 8 * fq); o[vt] = MFMA16(a, bb, o[vt]); } }
        const lptr QI = (stb >> 1) ? Q1 : Q0; const int qrow = (stb >> 1) ? (DIR ? r : r - 32) : r;
#pragma unroll
        for (int ks = 0; ks < DK / 32; ++ks) { const bf16x8 bb = ldsfrag(QI, qrow, SQ, 32 * ks + 8 * fq);
#pragma unroll
            for (int vt = 0; vt < 4; ++vt) { const bf16x8 a = ldsfrag(ST, 64 * vh + 16 * vt + fr, 272, 32 * ks + 8 * fq); o[vt] = MFMA16(a, bb, o[vt]); } }
    }
    if (!RET && DIR == 0) raw_store<128>(X, X.lds + L::RAW, zbr);
    BAR_LDS(); SP_END(24);
}
template <bool RET> struct OutRegs { RawRegs<128> rv, rzf, rzb, rq; RawRegs<64> rq6, rk6; v2u gw[4]; };
template <bool RET> __device__ __forceinline__ void out_load(const Ctx& X, const bf16* H, int r, OutRegs<RET>& R) {
    const int b = r / 768, head = (r / 128) % 6, n = r % 128; const size_t m0 = (size_t)(b * SEQ + n * CH);
    const int fr = X.lane & 15, fq = X.lane >> 4, tb = X.wave & 3, vh = X.wave >> 2; const size_t m = m0 + 16 * tb + fr; const int gcol = (RET ? C_RG : C_HGG) + head * 128;
    raw_load<128>(X, H, m0, (RET ? C_RV : C_HGV) + head * 128, R.rv);
    if (!RET) { raw_load<128>(X, H, m0, C_ZF + head * 128, R.rzf); raw_load<128>(X, H, m0, C_HGQ + head * 128, R.rq); }
    else { raw_load<64>(X, H, m0, C_RQ + head * 64, R.rq6); raw_load<64>(X, H, m0, C_RK + head * 64, R.rk6); }
#pragma unroll
    for (int t = 0; t < 4; ++t) if (RET) R.gw[t] = *(const v2u*)hptr(H, m, gcol + 64 * vh + 16 * t + 4 * fq);
}
template <int DK, bool RET>
__device__ __forceinline__ void gla_out_item(const Ctx& X, const bf16* H, bf16* Y, int l, int r, OutRegs<RET>& R, bool has_next) {
    typedef L3<DK, RET> L;
    const int b = r / 768, head = (r / 128) % 6, n = r % 128;
    const float* LB = (const float*)(X.ws + WS_TAB);
    const bf16* St = (const bf16*)(X.ws + (RET ? WS_SRT : WS_SHG));
    const int fr = X.lane & 15, fq = X.lane >> 4, tb = X.wave & 3, vh = X.wave >> 2;
    const size_t m = (size_t)(b * SEQ + n * CH + 16 * tb + fr);
    const int ycol = (RET ? 768 : 0) + head * 128;
    SP_BEGIN()
    const int kp = X.tid & 63; f32x2v lb0 = (f32x2v){0.f, 0.f}, lb1 = lb0;
    v2u gw[4];
    if (!RET) {
        lb0 = *(const f32x2v*)(LB + (0 * 4 + l) * 768 + head * 128 + 2 * kp); lb1 = *(const f32x2v*)(LB + (1 * 4 + l) * 768 + head * 128 + 2 * kp);
        vt_store(X, X.lds + L::VT, R.rv); raw_store<128>(X, X.lds + L::RAW, R.rzf); raw_store<128>(X, X.lds + L::RAW + 16384, R.rq);
    } else {
        vt_store(X, X.lds + L::VT, R.rv); raw_store<64>(X, X.lds + L::RAW, R.rq6); raw_store<64>(X, X.lds + L::RAW + 8192, R.rk6);
    }
    asm volatile("" : "+v"(lb0), "+v"(lb1)); __builtin_amdgcn_sched_barrier(0);
    if (has_next) out_load<RET>(X, H, r + X.G, R);
    __builtin_amdgcn_sched_barrier(0);
    BAR_LDS(); SP_END(20);
    const int chain = (b * 6 + head) * 2;
    f32x4 o[4];
#pragma unroll
    for (int t = 0; t < 4; ++t) o[t] = (f32x4){0.f, 0.f, 0.f, 0.f};
    const size_t m0 = (size_t)(b * SEQ + n * CH);
    gla_out_dir<DK, RET, 0>(X, chain, n, lb0, St, o, H, m0, C_ZB + head * 128);
#pragma unroll
    for (int t = 0; t < 4; ++t) gw[t] = *(const v2u*)hptr(H, m, C_HGG + head * 128 + 64 * vh + 16 * t + 4 * fq);
    gla_out_dir<DK, RET, 1>(X, chain + 1, n, lb1, St, o, H, m0, 0);
    LAS float* red = (LAS float*)(X.lds + L::RED);
    float mu = 0.f;
    if (RET) {
        float s = 0.f;
#pragma unroll
        for (int t = 0; t < 4; ++t) s += (o[t][0] + o[t][1]) + (o[t][2] + o[t][3]);
        s += __shfl_xor(s, 16); s += __shfl_xor(s, 32);
        if (fq == 0) red[128 + X.wave * 16 + fr] = s;
        BAR_LDS();
        mu = (red[128 + X.wave * 16 + fr] + red[128 + (X.wave ^ 4) * 16 + fr]) * (1.0f / 128.0f);
    }
    float s2 = 0.f;
#pragma unroll
    for (int t = 0; t < 4; ++t)
#pragma unroll
        for (int j = 0; j < 4; ++j) { const float dlt = o[t][j] - mu; s2 += dlt * dlt; }
    s2 += __shfl_xor(s2, 16); s2 += __shfl_xor(s2, 32);
    if (fq == 0) red[X.wave * 16 + fr] = s2;
    BAR_LDS();
    const float rstd = __builtin_amdgcn_rsqf((red[X.wave * 16 + fr] + red[(X.wave ^ 4) * 16 + fr]) * (1.0f / 128.0f) + EPS);
    const float* gn = X.in(RET ? 10 : 9) + l * 768 + head * 128;
#pragma unroll
    for (int t = 0; t < 4; ++t) { const int v = 64 * vh + 16 * t + 4 * fq; const f32x4 g4 = *(const f32x4*)(gn + v);
        const float g0 = bf2f(gw[t].x & 0xffffu), g1 = bf2f(gw[t].x >> 16), g2 = bf2f(gw[t].y & 0xffffu), g3 = bf2f(gw[t].y >> 16);
        const float y0 = (o[t][0] - mu) * rstd * g4.x * (g0 * __builtin_amdgcn_rcpf(1.0f + __expf(-g0))), y1 = (o[t][1] - mu) * rstd * g4.y * (g1 * __builtin_amdgcn_rcpf(1.0f + __expf(-g1)));
        const float y2 = (o[t][2] - mu) * rstd * g4.z * (g2 * __builtin_amdgcn_rcpf(1.0f + __expf(-g2))), y3 = (o[t][3] - mu) * rstd * g4.w * (g3 * __builtin_amdgcn_rcpf(1.0f + __expf(-g3)));
        v2u w; w.x = pk2(y0, y1); w.y = pk2(y2, y3); *(LAS v2u*)(X.lds + L::Q0 + (16 * tb + fr) * 272 + v * 2) = w; }
    BAR_LDS();
    { const size_t mrow = (size_t)(b * SEQ + n * CH); int t_ = X.tid; asm volatile("" : "+v"(t_));
#pragma unroll
        for (int p = 0; p < 2; ++p) { const int idx = t_ + NTHR * p, row = idx >> 4, c8 = idx & 15; *(v4u*)(Y + (mrow + row) * D + ycol + 8 * c8) = *(const LAS v4u*)(X.lds + L::Q0 + row * 272 + c8 * 16); } }
    BAR_LDS();
}

constexpr int RCH = 128, RNCH = SEQ / RCH;
constexpr int R1_VT = 0, R1_KC0 = 128 * 144, R1_KC1 = R1_KC0 + 64 * 144, R1_RAW = R1_KC1 + 64 * 144, R1_END = R1_RAW + 32768;
__device__ __forceinline__ void ret_local_item(const Ctx& X, bf16* H, int it, LocRegs<true>& R, bool has_next) {
    const int b = it / 384, head = (it / 64) % 6, n = it % 64;
    bf16* St = (bf16*)(X.ws + WS_SRT); float* dd = (float*)(X.ws + WS_DRT);
    const lptr VT = X.lds + R1_VT, KC0 = X.lds + R1_KC0, KC1 = X.lds + R1_KC1, rawq = X.lds + R1_RAW, rawk = X.lds + R1_RAW + 8192; LAS float* cs = (LAS float*)(X.lds + R1_RAW + 16384); LAS float* sn = (LAS float*)(X.lds + R1_RAW + 24576);
    const float l2f = __log2f(1.0f - exp2f(-5.0f - (float)head)), l2b = __log2f(1.0f - exp2f(-5.0f - (float)(5 - head)));
    const int chain = (b * 6 + head) * 2;
    const int fr = X.lane & 15, fq = X.lane >> 4, rt = X.wave & 3, ct0 = (X.wave >> 2) * 4;
    const int k = X.tid & 63, rq = X.tid >> 6, k2 = k & 31; const bool active = X.tid < 256;
    f32x4 accf[4], accb[4];
#pragma unroll
    for (int t = 0; t < 4; ++t) { accf[t] = (f32x4){0.f, 0.f, 0.f, 0.f}; accb[t] = accf[t]; }
#pragma unroll 1
    for (int h = 0; h < 2; ++h) {
        const int r = 2 * it + h; const size_t m0 = (size_t)(b * SEQ + (2 * n + h) * 64);
        vt_store(X, VT, R.rv); raw_store<64>(X, rawq, R.rq); raw_store<64>(X, rawk, R.rk); *(LAS f32x4*)(cs + X.tid * 4) = R.c4; *(LAS f32x4*)(sn + X.tid * 4) = R.s4;
        __builtin_amdgcn_sched_barrier(0);
        { const int nr = h == 0 ? r + 1 : 2 * (it + X.G); if (h == 0 || has_next) loc_load<true>(X, H, nr, R); }
        __builtin_amdgcn_sched_barrier(0);
        BAR_LDS();
        float qr[16], kr[16];
        if (active) {
#pragma unroll
            for (int ii = 0; ii < 16; ++ii) { const int rr = 16 * rq + ii; const float c_ = cs[rr * 32 + k2], s_ = sn[rr * 32 + k2];
                const float q1 = bf2f(*(const LAS unsigned short*)(rawq + (rr * 64 + k2) * 2)), q2 = bf2f(*(const LAS unsigned short*)(rawq + (rr * 64 + 32 + k2) * 2));
                const float k1 = bf2f(*(const LAS unsigned short*)(rawk + (rr * 64 + k2) * 2)), k2v = bf2f(*(const LAS unsigned short*)(rawk + (rr * 64 + 32 + k2) * 2));
                qr[ii] = (k < 32) ? (q1 * c_ - q2 * s_) : (q1 * s_ + q2 * c_); kr[ii] = 0.125f * ((k < 32) ? (k1 * c_ - k2v * s_) : (k1 * s_ + k2v * c_)); } }
        BAR_LDS();
        if (active) {
            float ef[16], eb[16];
#pragma unroll
            for (int ii = 0; ii < 16; ++ii) { const int rr = 16 * rq + ii, tt = 64 * h + rr; *(LAS unsigned short*)(rawq + (rr * 64 + k) * 2) = f2bf(qr[ii]); *(LAS unsigned short*)(rawk + (rr * 64 + k) * 2) = f2bf(kr[ii]);
                ef[ii] = kr[ii] * __builtin_amdgcn_exp2f((float)(RCH - 1 - tt) * l2f); eb[ii] = kr[ii] * __builtin_amdgcn_exp2f((float)tt * l2b); }
            v4u w0, w1;
            w0.x = pk2(ef[0], ef[1]); w0.y = pk2(ef[2], ef[3]); w0.z = pk2(ef[4], ef[5]); w0.w = pk2(ef[6], ef[7]); w1.x = pk2(ef[8], ef[9]); w1.y = pk2(ef[10], ef[11]); w1.z = pk2(ef[12], ef[13]); w1.w = pk2(ef[14], ef[15]);
            *(LAS v4u*)(KC0 + k * 144 + rq * 32) = w0; *(LAS v4u*)(KC0 + k * 144 + rq * 32 + 16) = w1;
            w0.x = pk2(eb[0], eb[1]); w0.y = pk2(eb[2], eb[3]); w0.z = pk2(eb[4], eb[5]); w0.w = pk2(eb[6], eb[7]); w1.x = pk2(eb[8], eb[9]); w1.y = pk2(eb[10], eb[11]); w1.z = pk2(eb[12], eb[13]); w1.w = pk2(eb[14], eb[15]);
            *(LAS v4u*)(KC1 + k * 144 + rq * 32) = w0; *(LAS v4u*)(KC1 + k * 144 + rq * 32 + 16) = w1;
        }
        BAR_LDS();
        { const int rr = X.tid >> 3, c8 = X.tid & 7; *(v4u*)hptr(H, m0 + rr, C_RQ + head * 64 + 8 * c8) = *(const LAS v4u*)(rawq + X.tid * 16); *(v4u*)hptr(H, m0 + rr, C_RK + head * 64 + 8 * c8) = *(const LAS v4u*)(rawk + X.tid * 16); }
#pragma unroll
        for (int ks = 0; ks < 2; ++ks) { const bf16x8 af = ldsfrag(KC0, 16 * rt + fr, 144, 32 * ks + 8 * fq), ab = ldsfrag(KC1, 16 * rt + fr, 144, 32 * ks + 8 * fq);
#pragma unroll
            for (int t = 0; t < 4; ++t) { const bf16x8 bb = vtfrag(VT, 16 * (ct0 + t) + fr, 144, 32 * ks + 8 * fq); accf[t] = MFMA16(af, bb, accf[t]); accb[t] = MFMA16(ab, bb, accb[t]); } }
        BAR_LDS();
    }
#pragma unroll
    for (int t = 0; t < 4; ++t) { v2u w; w.x = pk2(accf[t][0], accf[t][1]); w.y = pk2(accf[t][2], accf[t][3]); *(LAS v2u*)(X.lds + R1_END + (16 * (ct0 + t) + fr) * 144 + (16 * rt + 4 * fq) * 2) = w;
        w.x = pk2(accb[t][0], accb[t][1]); w.y = pk2(accb[t][2], accb[t][3]); *(LAS v2u*)(X.lds + R1_END + 128 * 144 + (16 * (ct0 + t) + fr) * 144 + (16 * rt + 4 * fq) * 2) = w; }
    if (X.tid < 64) { dd[((size_t)chain * RNCH + n) * 64 + X.tid] = __builtin_amdgcn_exp2f((float)RCH * l2f); dd[((size_t)(chain + 1) * RNCH + n) * 64 + X.tid] = __builtin_amdgcn_exp2f((float)RCH * l2b); }
    BAR_LDS();
#pragma unroll
    for (int dir = 0; dir < 2; ++dir) { bf16* Sp = St + ((size_t)(chain + dir) * RNCH + n) * 128 * 64; const lptr UT = X.lds + R1_END + dir * 128 * 144;
#pragma unroll
        for (int p = 0; p < 2; ++p) { const int idx = X.tid + NTHR * p, row = idx >> 3, c8 = idx & 7; *(v4u*)(Sp + (size_t)row * 64 + 8 * c8) = *(const LAS v4u*)(UT + row * 144 + c8 * 16); } }
    BAR_LDS();
}
struct RetOutRegs { v4u q[2], k[2], v[4]; };
__device__ __forceinline__ void ret_out_load(const Ctx& X, const bf16* H, int it, RetOutRegs& R) {
    const int b = it / 384, head = (it / 64) % 6, n = it % 64; const size_t m0 = (size_t)(b * SEQ + n * RCH);
    const int fr = X.lane & 15, fq = X.lane >> 4, tbq = X.wave & 3, vh = X.wave >> 2;
#pragma unroll
    for (int p = 0; p < 2; ++p) { const int idx = X.tid + NTHR * p, row = idx >> 3, c8 = idx & 7; R.q[p] = *(const v4u*)hptr(H, m0 + row, C_RQ + head * 64 + 8 * c8); R.k[p] = *(const v4u*)hptr(H, m0 + row, C_RK + head * 64 + 8 * c8); }
#pragma unroll
    for (int p = 0; p < 4; ++p) { const int idx = X.tid + NTHR * p, row = idx >> 4, c8 = idx & 15; R.v[p] = *(const v4u*)hptr(H, m0 + row, C_RV + head * 128 + 8 * c8); }
}
constexpr int R3_Q = 0, R3_K = 128 * 144, R3_VT = 2 * 128 * 144, R3_AM = R3_VT + 128 * 272, R3_RED = R3_AM + 128 * 272, R3_END = R3_RED + 4096;
static_assert(R3_END <= PH_BYTES && R1_END + 2 * 128 * 144 <= PH_BYTES, "retention LDS maps");
__device__ __forceinline__ void ret_out_item(const Ctx& X, const bf16* H, bf16* Y, int l, int it, RetOutRegs& R, bool has_next) {
    const int b = it / 384, head = (it / 64) % 6, n = it % 64; const size_t m0 = (size_t)(b * SEQ + n * RCH);
    const bf16* St = (const bf16*)(X.ws + WS_SRT);
    const lptr Q = X.lds + R3_Q, K = X.lds + R3_K, VT = X.lds + R3_VT, AM = X.lds + R3_AM; LAS float* red = (LAS float*)(X.lds + R3_RED);
    const int fr = X.lane & 15, fq = X.lane >> 4, tbq = X.wave & 3, vh = X.wave >> 2; const int ycol = 768 + head * 128;
    const float l2f = __log2f(1.0f - exp2f(-5.0f - (float)head)), l2b = __log2f(1.0f - exp2f(-5.0f - (float)(5 - head)));
    const int chain = (b * 6 + head) * 2;
#pragma unroll
    for (int p = 0; p < 2; ++p) { const int idx = X.tid + NTHR * p, row = idx >> 3, c8 = idx & 7; *(LAS v4u*)(Q + row * 144 + c8 * 16) = R.q[p]; *(LAS v4u*)(K + row * 144 + c8 * 16) = R.k[p]; }
#pragma unroll
    for (int p = 0; p < 4; ++p) { const int idx = X.tid + NTHR * p, row = idx >> 4, c8 = idx & 15; const v4u w = R.v[p];
        LAS unsigned short* d = (LAS unsigned short*)(VT + (8 * c8) * 272 + (row ^ (8 * (c8 & 7))) * 2);
        d[0] = (unsigned short)w.x; d[136] = (unsigned short)(w.x >> 16); d[272] = (unsigned short)w.y; d[408] = (unsigned short)(w.y >> 16);
        d[544] = (unsigned short)w.z; d[680] = (unsigned short)(w.z >> 16); d[816] = (unsigned short)w.w; d[952] = (unsigned short)(w.w >> 16); }
    __builtin_amdgcn_sched_barrier(0);
    if (has_next) ret_out_load(X, H, it + X.G, R);
    bf16x8 sff[2][4], sfb[2][4];
    { const bf16* Sf = St + ((size_t)chain * RNCH + n) * 128 * 64; const bf16* Sb = St + ((size_t)(chain + 1) * RNCH + n) * 128 * 64;
#pragma unroll
        for (int ks = 0; ks < 2; ++ks)
#pragma unroll
            for (int vt = 0; vt < 4; ++vt) { const size_t o_ = (size_t)(64 * vh + 16 * vt + fr) * 64 + 32 * ks + 8 * fq; sff[ks][vt] = *(const bf16x8*)(Sf + o_); sfb[ks][vt] = *(const bf16x8*)(Sb + o_); } }
    __builtin_amdgcn_sched_barrier(0);
    BAR_LDS();
#pragma unroll 1
    for (int J = 0; J < 8; ++J) { const int I = X.wave;
        f32x4 acc = (f32x4){0.f, 0.f, 0.f, 0.f};
#pragma unroll
        for (int ks = 0; ks < 2; ++ks) { const bf16x8 a = ldsfrag(K, 16 * J + fr, 144, 32 * ks + 8 * fq); const bf16x8 bb = ldsfrag(Q, 16 * I + fr, 144, 32 * ks + 8 * fq); acc = MFMA16(a, bb, acc); }
#pragma unroll
        for (int j = 0; j < 4; ++j) { const int d = (16 * I + fr) - (16 * J + 4 * fq + j); const float dec = d > 0 ? __builtin_amdgcn_exp2f((float)d * l2f) : (d < 0 ? __builtin_amdgcn_exp2f((float)(-d) * l2b) : 2.0f); acc[j] *= dec; }
        v2u w; w.x = pk2(acc[0], acc[1]); w.y = pk2(acc[2], acc[3]); *(LAS v2u*)(AM + (16 * I + fr) * 272 + (16 * J + 4 * fq) * 2) = w; }
    BAR_LDS();
    const float* gn = X.in(10) + l * 768 + head * 128;
    v2u gw[2][4];
#pragma unroll
    for (int ps = 0; ps < 2; ++ps)
#pragma unroll
        for (int t = 0; t < 4; ++t) gw[ps][t] = *(const v2u*)hptr(H, m0 + 16 * (tbq + 4 * ps) + fr, C_RG + head * 128 + 64 * vh + 16 * t + 4 * fq);
#pragma unroll
    for (int ps = 0; ps < 2; ++ps) { const int tok = 16 * (tbq + 4 * ps) + fr; f32x4 o[4];
#pragma unroll
        for (int t = 0; t < 4; ++t) o[t] = (f32x4){0.f, 0.f, 0.f, 0.f};
#pragma unroll
        for (int ks = 0; ks < 4; ++ks) { const bf16x8 bb = ldsfrag(AM, tok, 272, 32 * ks + 8 * fq);
#pragma unroll
            for (int vt = 0; vt < 4; ++vt) { const bf16x8 a = vtfrag(VT, 64 * vh + 16 * vt + fr, 272, 32 * ks + 8 * fq); o[vt] = MFMA16(a, bb, o[vt]); } }
        const bf16x8 bq0 = ldsfrag(Q, tok, 144, 8 * fq), bq1 = ldsfrag(Q, tok, 144, 32 + 8 * fq);
        const float cf = __builtin_amdgcn_exp2f((float)(tok + 1) * l2f), cb = __builtin_amdgcn_exp2f((float)(RCH - tok) * l2b);
        {
            f32x4 tf[4];
#pragma unroll
            for (int vt = 0; vt < 4; ++vt) { tf[vt] = MFMA16(sff[0][vt], bq0, ((f32x4){0.f, 0.f, 0.f, 0.f})); tf[vt] = MFMA16(sff[1][vt], bq1, tf[vt]); }
#pragma unroll
            for (int t = 0; t < 4; ++t) o[t] = o[t] + tf[t] * cf;
#pragma unroll
            for (int vt = 0; vt < 4; ++vt) { tf[vt] = MFMA16(sfb[0][vt], bq0, ((f32x4){0.f, 0.f, 0.f, 0.f})); tf[vt] = MFMA16(sfb[1][vt], bq1, tf[vt]); }
#pragma unroll
            for (int t = 0; t < 4; ++t) o[t] = o[t] + tf[t] * cb;
        }
        float s_ = 0.f;
#pragma unroll
        for (int t = 0; t < 4; ++t) s_ += (o[t][0] + o[t][1]) + (o[t][2] + o[t][3]);
        s_ += __shfl_xor(s_, 16); s_ += __shfl_xor(s_, 32);
        if (fq == 0) red[512 + (ps * 8 + X.wave) * 16 + fr] = s_;
        BAR_LDS();
        const float mu = (red[512 + (ps * 8 + X.wave) * 16 + fr] + red[512 + (ps * 8 + (X.wave ^ 4)) * 16 + fr]) * (1.0f / 128.0f); float s2 = 0.f;
#pragma unroll
        for (int t = 0; t < 4; ++t)
#pragma unroll
            for (int j = 0; j < 4; ++j) { const float dlt = o[t][j] - mu; s2 += dlt * dlt; }
        s2 += __shfl_xor(s2, 16); s2 += __shfl_xor(s2, 32);
        if (fq == 0) red[(ps * 8 + X.wave) * 16 + fr] = s2;
        BAR_LDS();
        const float rstd = __builtin_amdgcn_rsqf((red[(ps * 8 + X.wave) * 16 + fr] + red[(ps * 8 + (X.wave ^ 4)) * 16 + fr]) * (1.0f / 128.0f) + EPS);
#pragma unroll
        for (int t = 0; t < 4; ++t) { const int v = 64 * vh + 16 * t + 4 * fq; const f32x4 g4 = *(const f32x4*)(gn + v);
            const float g0 = bf2f(gw[ps][t].x & 0xffffu), g1 = bf2f(gw[ps][t].x >> 16), g2 = bf2f(gw[ps][t].y & 0xffffu), g3 = bf2f(gw[ps][t].y >> 16);
            const float y0 = (o[t][0] - mu) * rstd * g4.x * (g0 * __builtin_amdgcn_rcpf(1.0f + __expf(-g0))), y1 = (o[t][1] - mu) * rstd * g4.y * (g1 * __builtin_amdgcn_rcpf(1.0f + __expf(-g1)));
            const float y2 = (o[t][2] - mu) * rstd * g4.z * (g2 * __builtin_amdgcn_rcpf(1.0f + __expf(-g2))), y3 = (o[t][3] - mu) * rstd * g4.w * (g3 * __builtin_amdgcn_rcpf(1.0f + __expf(-g3)));
            v2u w; w.x = pk2(y0, y1); w.y = pk2(y2, y3); *(LAS v2u*)(AM + tok * 272 + v * 2) = w; } }
    BAR_LDS();
#pragma unroll
    for (int p = 0; p < 4; ++p) { const int idx = X.tid + NTHR * p, row = idx >> 4, c8 = idx & 15; *(v4u*)(Y + (m0 + row) * D + ycol + 8 * c8) = *(const LAS v4u*)(AM + row * 272 + c8 * 16); }
    BAR_LDS();
}

struct ScanBatch { v4u u[4]; f32x4 d0[4], d1[4]; };
__device__ __forceinline__ void scan_load(ScanBatch& B, const bf16* p, const float* dp, int cstride, int dstride, int dir, int s0, int nch) {
#pragma unroll
    for (int j = 0; j < 4; ++j) { const int n = dir ? nch - 1 - (s0 + j) : s0 + j; B.u[j] = *(const v4u*)(p + (size_t)n * cstride); B.d0[j] = *(const f32x4*)(dp + (size_t)n * dstride); B.d1[j] = *(const f32x4*)(dp + (size_t)n * dstride + 4); }
}
__device__ __forceinline__ void scan_step(const ScanBatch& B, float (&S)[8], bf16* p, int cstride, int dir, int s0, int nch) {
#pragma unroll
    for (int j = 0; j < 4; ++j) { const int n = dir ? nch - 1 - (s0 + j) : s0 + j;
        v4u w; w.x = pk2(S[0], S[1]); w.y = pk2(S[2], S[3]); w.z = pk2(S[4], S[5]); w.w = pk2(S[6], S[7]); *(v4u*)(p + (size_t)n * cstride) = w;
        S[0] = B.d0[j].x * S[0] + bf2f(B.u[j].x & 0xffffu); S[1] = B.d0[j].y * S[1] + bf2f(B.u[j].x >> 16); S[2] = B.d0[j].z * S[2] + bf2f(B.u[j].y & 0xffffu); S[3] = B.d0[j].w * S[3] + bf2f(B.u[j].y >> 16);
        S[4] = B.d1[j].x * S[4] + bf2f(B.u[j].z & 0xffffu); S[5] = B.d1[j].y * S[5] + bf2f(B.u[j].z >> 16); S[6] = B.d1[j].z * S[6] + bf2f(B.u[j].w & 0xffffu); S[7] = B.d1[j].w * S[7] + bf2f(B.u[j].w >> 16); }
}
__device__ __forceinline__ void scan_phase(const Ctx& X) {
    constexpr int T_HG = 24 * 2048, T_RT = 24 * 1024;
    for (int task = X.bid * NTHR + X.tid; task < T_HG + T_RT; task += X.G * NTHR) {
        bf16* p; const float* dp; int cstride, dstride, dir, nch;
        if (task < T_HG) { const int chain = task / 2048, e = task % 2048; p = (bf16*)(X.ws + WS_SHG) + (size_t)chain * NCH * 16384 + e * 8; dp = (const float*)(X.ws + WS_DHG) + (size_t)chain * NCH * 128 + (e & 15) * 8; cstride = 16384; dstride = 128; dir = chain & 1; nch = NCH; }
        else { const int t2 = task - T_HG, chain = t2 / 1024, e = t2 % 1024; p = (bf16*)(X.ws + WS_SRT) + (size_t)chain * RNCH * 8192 + e * 8; dp = (const float*)(X.ws + WS_DRT) + (size_t)chain * RNCH * 64 + (e & 7) * 8; cstride = 8192; dstride = 64; dir = chain & 1; nch = RNCH; }
        float S[8];
#pragma unroll
        for (int i = 0; i < 8; ++i) S[i] = 0.f;
        ScanBatch A, B;
        scan_load(A, p, dp, cstride, dstride, dir, 0, nch);
        for (int s0 = 0; s0 < nch; s0 += 8) {
            scan_load(B, p, dp, cstride, dstride, dir, s0 + 4, nch);
            scan_step(A, S, p, cstride, dir, s0, nch);
            if (s0 + 8 < nch) scan_load(A, p, dp, cstride, dstride, dir, s0 + 8, nch);
            scan_step(B, S, p, cstride, dir, s0 + 4, nch);
        }
    }
}

constexpr int DA_KN = 0, DA_VT = 192 * 272, DA_P = DA_VT + 128 * 400, DA_BIAS = DA_P + 64 * 400, DA_MX = DA_BIAS + 1024, DA_LX = DA_MX + 512, DA_END = DA_LX + 512;
static_assert(DA_END <= PH_BYTES, "dilated-attention LDS map");
struct DaBlk { v4u kw[2], vw[2]; };
struct DaRun { int b, g, slot, dil, rho, nb0, nbper, qcol; };
__device__ __forceinline__ DaRun da_decode(int run) {
    DaRun I; I.b = run / 384; const int rem = run % 384; I.g = rem / 128; const int rem2 = rem % 128; I.slot = rem2 / 32; const int rb = rem2 % 32;
    I.dil = I.g == 0 ? 1 : (I.g == 1 ? 4 : 16); I.nbper = 128 / I.dil; const int rpr = I.nbper / 4; I.rho = rb / rpr; I.nb0 = 4 * (rb % rpr); I.qcol = C_DIL + (3 * I.g) * 512 + I.slot * 128; return I;
}
__device__ __forceinline__ void da_blk_load(const Ctx& X, const bf16* H, const DaRun& I, int kb, DaBlk& R) {
    const bool ok = kb >= 0 && kb < I.nbper; const size_t mb = (size_t)I.b * SEQ; const int kcol = I.qcol + 512, vcol = I.qcol + 1024;
#pragma unroll
    for (int p = 0; p < 2; ++p) { const int r = (X.tid >> 4) + 32 * p, c8 = X.tid & 15; R.kw[p] = (v4u){0u, 0u, 0u, 0u}; R.vw[p] = (v4u){0u, 0u, 0u, 0u};
        if (ok) { const size_t mr = mb + (size_t)(I.rho * (SEQ / I.dil) + 64 * kb + r); R.kw[p] = *(const v4u*)hptr(H, mr, kcol + 8 * c8); R.vw[p] = *(const v4u*)hptr(H, mr, vcol + 8 * c8); } }
}
__device__ __forceinline__ void da_blk_stage(const Ctx& X, const float* kg, int kb, const DaBlk& R) {
    const lptr KN = X.lds + DA_KN, VT = X.lds + DA_VT; const int slot = ((kb % 3) + 3) % 3;
#pragma unroll
    for (int p = 0; p < 2; ++p) { const int row = slot * 64 + (X.tid >> 4) + 32 * p, c8 = X.tid & 15; const v4u kw = R.kw[p], vw = R.vw[p];
        float f[8]; f[0] = bf2f(kw.x & 0xffffu); f[1] = bf2f(kw.x >> 16); f[2] = bf2f(kw.y & 0xffffu); f[3] = bf2f(kw.y >> 16); f[4] = bf2f(kw.z & 0xffffu); f[5] = bf2f(kw.z >> 16); f[6] = bf2f(kw.w & 0xffffu); f[7] = bf2f(kw.w >> 16);
        float s = 0.f;
#pragma unroll
        for (int e = 0; e < 8; ++e) s += f[e] * f[e];
        s += __shfl_xor(s, 1); s += __shfl_xor(s, 2); s += __shfl_xor(s, 4); s += __shfl_xor(s, 8);
        const float sc = __builtin_amdgcn_rsqf(s * (1.0f / 128.0f) + EPS); const f32x4 g0 = *(const f32x4*)(kg + 8 * c8), g1 = *(const f32x4*)(kg + 8 * c8 + 4);
        v4u o; o.x = pk2(f[0] * sc * g0.x, f[1] * sc * g0.y); o.y = pk2(f[2] * sc * g0.z, f[3] * sc * g0.w); o.z = pk2(f[4] * sc * g1.x, f[5] * sc * g1.y); o.w = pk2(f[6] * sc * g1.z, f[7] * sc * g1.w);
        *(LAS v4u*)(KN + row * 272 + c8 * 16) = o;
        LAS unsigned short* d = (LAS unsigned short*)(VT + (8 * c8) * 400 + (row ^ (8 * (c8 & 7))) * 2);
        d[0] = (unsigned short)vw.x; d[200] = (unsigned short)(vw.x >> 16); d[400] = (unsigned short)vw.y; d[600] = (unsigned short)(vw.y >> 16);
        d[800] = (unsigned short)vw.z; d[1000] = (unsigned short)(vw.z >> 16); d[1200] = (unsigned short)vw.w; d[1400] = (unsigned short)(vw.w >> 16); }
}
__device__ __forceinline__ void da_q_load(const Ctx& X, const bf16* H, const DaRun& I, int nb, v4u (&qw)[4]) {
    const int fr = X.lane & 15, fq = X.lane >> 4, qb = X.wave & 3; const size_t m = (size_t)I.b * SEQ + (size_t)(I.rho * (SEQ / I.dil) + 64 * nb + 16 * qb + fr);
#pragma unroll
    for (int ks = 0; ks < 4; ++ks) qw[ks] = *(const v4u*)hptr(H, m, I.qcol + 32 * ks + 8 * fq);
}
__device__ __forceinline__ void dil_run(const Ctx& X, bf16* H, int l, int run) {
    const DaRun I = da_decode(run); const int b = I.b, g = I.g, slot = I.slot, dil = I.dil, rho = I.rho, qcol = I.qcol, Ls = SEQ / I.dil;
    const lptr KN = X.lds + DA_KN, VT = X.lds + DA_VT, P = X.lds + DA_P; LAS float* bias = (LAS float*)(X.lds + DA_BIAS); LAS float* mx = (LAS float*)(X.lds + DA_MX); LAS float* lx = (LAS float*)(X.lds + DA_LX);
    const float* qg = X.in(11) + l * 128; const float* kg = X.in(12) + l * 128; asm volatile("" : "+s"(qg), "+s"(kg));
    const int fr = X.lane & 15, fq = X.lane >> 4, qb = X.wave & 3, kh = X.wave >> 2; const int qi = 16 * qb + fr;
    SP_BEGIN()
    {
        DaBlk B0, B1, B2; da_blk_load(X, H, I, I.nb0 - 1, B0); da_blk_load(X, H, I, I.nb0, B1); da_blk_load(X, H, I, I.nb0 + 1, B2);
        if (X.tid < 256) bias[X.tid] = (X.tid >= 63 && X.tid <= 191) ? ((const float*)(X.ws + WS_TAB) + 2 * 4 * 768)[(g * 4 + slot) * 132 + X.tid - 63] : -1e30f;
        da_blk_stage(X, kg, I.nb0 - 1, B0); da_blk_stage(X, kg, I.nb0, B1); da_blk_stage(X, kg, I.nb0 + 1, B2);
    }
    v4u qw_[4]; da_q_load(X, H, I, I.nb0, qw_);
    for (int i = 0; i < 4; ++i) {
        const int nb = I.nb0 + i; const size_t qtok = (size_t)((64 * nb + qi) * dil + rho);
        bf16x8 qf[4];
        {
            float s = 0.f;
#pragma unroll
            for (int ks = 0; ks < 4; ++ks) { const v4u qw = qw_[ks];
                const float a0 = bf2f(qw.x & 0xffffu), a1 = bf2f(qw.x >> 16), a2 = bf2f(qw.y & 0xffffu), a3 = bf2f(qw.y >> 16), a4 = bf2f(qw.z & 0xffffu), a5 = bf2f(qw.z >> 16), a6 = bf2f(qw.w & 0xffffu), a7 = bf2f(qw.w >> 16);
                s += (a0 * a0 + a1 * a1) + (a2 * a2 + a3 * a3) + (a4 * a4 + a5 * a5) + (a6 * a6 + a7 * a7); }
            s += __shfl_xor(s, 16); s += __shfl_xor(s, 32);
            const float sc = (0.08838834764831845f * 1.4426950408889634f) * __builtin_amdgcn_rsqf(s * (1.0f / 128.0f) + EPS);
#pragma unroll
            for (int ks = 0; ks < 4; ++ks) { const v4u qw = qw_[ks]; const f32x4 g0 = *(const f32x4*)(qg + 32 * ks + 8 * fq), g1 = *(const f32x4*)(qg + 32 * ks + 8 * fq + 4);
                v4u o; o.x = pk2(bf2f(qw.x & 0xffffu) * sc * g0.x, bf2f(qw.x >> 16) * sc * g0.y); o.y = pk2(bf2f(qw.y & 0xffffu) * sc * g0.z, bf2f(qw.y >> 16) * sc * g0.w);
                o.z = pk2(bf2f(qw.z & 0xffffu) * sc * g1.x, bf2f(qw.z >> 16) * sc * g1.y); o.w = pk2(bf2f(qw.w & 0xffffu) * sc * g1.z, bf2f(qw.w >> 16) * sc * g1.w);
                qf[ks] = __builtin_bit_cast(bf16x8, o); }
        }
        asm volatile("" : "+v"(qf[0]), "+v"(qf[1]), "+v"(qf[2]), "+v"(qf[3]));
        __builtin_amdgcn_sched_barrier(0);
        DaBlk Bn; if (i < 3) { da_blk_load(X, H, I, nb + 2, Bn); da_q_load(X, H, I, nb + 1, qw_); }
        __builtin_amdgcn_sched_barrier(0);
        BAR_LDS(); SP_END(16);
        f32x4 sc[6]; float mloc = -1e30f;
        const LAS float* tb = bias + (96 * kh + 4 * fq - qi + 63);
        const bool edge_lo = nb == 0, edge_hi = nb == I.nbper - 1;
#pragma unroll
        for (int t = 0; t < 6; ++t) { f32x4 acc = (f32x4){0.f, 0.f, 0.f, 0.f}; const int rrow = (64 * nb + 128 + 96 * kh + 16 * t) % 192;
#pragma unroll
            for (int ks = 0; ks < 4; ++ks) { const bf16x8 a = ldsfrag(KN, rrow + fr, 272, 32 * ks + 8 * fq); acc = MFMA16(a, qf[ks], acc); }
#pragma unroll
            for (int j = 0; j < 4; ++j) acc[j] += tb[16 * t + j];
            if (edge_lo || edge_hi) {
#pragma unroll
                for (int j = 0; j < 4; ++j) { const int kj = 64 * nb - 64 + 96 * kh + 16 * t + 4 * fq + j; if (kj < 0 || kj >= Ls) acc[j] = -1e30f; } }
            mloc = fmaxf(fmaxf(mloc, fmaxf(acc[0], acc[1])), fmaxf(acc[2], acc[3]));
            sc[t] = acc; }
        mloc = fmaxf(mloc, __shfl_xor(mloc, 16)); mloc = fmaxf(mloc, __shfl_xor(mloc, 32));
        if (fq == 0) mx[kh * 64 + qi] = mloc;
        BAR_LDS(); SP_END(17);
        const float mrow = fmaxf(mx[qi], mx[64 + qi]); float lloc = 0.f;
#pragma unroll
        for (int t = 0; t < 6; ++t) { float p[4];
#pragma unroll
            for (int j = 0; j < 4; ++j) { p[j] = __builtin_amdgcn_exp2f(sc[t][j] - mrow); lloc += p[j]; }
            v2u w; w.x = pk2(p[0], p[1]); w.y = pk2(p[2], p[3]); *(LAS v2u*)(P + qi * 400 + (96 * kh + 16 * t + 4 * fq) * 2) = w; }
        lloc += __shfl_xor(lloc, 16); lloc += __shfl_xor(lloc, 32);
        if (fq == 0) lx[kh * 64 + qi] = lloc;
        BAR_LDS(); SP_END(18);
        const int dh = kh; const float lrow = lx[qi] + lx[64 + qi]; const float inv = __builtin_amdgcn_rcpf(lrow);
        f32x4 oo[4];
#pragma unroll
        for (int t = 0; t < 4; ++t) oo[t] = (f32x4){0.f, 0.f, 0.f, 0.f};
#pragma unroll
        for (int ks = 0; ks < 6; ++ks) { const bf16x8 bb = ldsfrag(P, qi, 400, 32 * ks + 8 * fq); const int rcol = (64 * nb + 128 + 32 * ks) % 192;
#pragma unroll
            for (int t = 0; t < 4; ++t) { const bf16x8 a = vtfrag(VT, 64 * dh + 16 * t + fr, 400, rcol + 8 * fq); oo[t] = MFMA16(a, bb, oo[t]); } }
        BAR_LDS();
#pragma unroll
        for (int t = 0; t < 4; ++t) { v2u w; w.x = pk2(oo[t][0] * inv, oo[t][1] * inv); w.y = pk2(oo[t][2] * inv, oo[t][3] * inv); *(LAS v2u*)(P + qi * 272 + (64 * dh + 16 * t + 4 * fq) * 2) = w; }
        if (dh == 0 && fq == 0) ((float*)(X.ws + WS_LSE))[((size_t)g * M + (size_t)b * SEQ + qtok) * 4 + slot] = 0.6931471805599453f * (mrow + __log2f(lrow));
        BAR_LDS(); SP_END(19);
#pragma unroll
        for (int p = 0; p < 2; ++p) { const int idx = X.tid + NTHR * p, row = idx >> 4, c8 = idx & 15; *(v4u*)hptr(H, (size_t)b * SEQ + (size_t)(rho * Ls + 64 * nb + row), qcol + 8 * c8) = *(const LAS v4u*)(P + row * 272 + c8 * 16); }
        if (i < 3) da_blk_stage(X, kg, nb + 2, Bn);
    }
    BAR_LDS();
}
__device__ __forceinline__ void dil_merge_item(const Ctx& X, const bf16* H, bf16* Y, int it) {
    const float* LSE = (const float*)(X.ws + WS_LSE);
#pragma unroll
    for (int p = 0; p < 8; ++p) { const int idx = X.tid + NTHR * p; const int tk = idx >> 6, slot = (idx >> 4) & 3, c8 = idx & 15; const size_t m = (size_t)it * 64 + tk;
        const float l0 = LSE[(0 * (size_t)M + m) * 4 + slot], l1 = LSE[(1 * (size_t)M + m) * 4 + slot], l2 = LSE[(2 * (size_t)M + m) * 4 + slot]; const float mxl = fmaxf(l0, fmaxf(l1, l2));
        const float e0 = __expf(l0 - mxl), e1 = __expf(l1 - mxl), e2 = __expf(l2 - mxl), inv = __builtin_amdgcn_rcpf(e0 + e1 + e2); const float w[3] = {e0 * inv, e1 * inv, e2 * inv};
        float acc[8];
#pragma unroll
        for (int e = 0; e < 8; ++e) acc[e] = 0.f;
#pragma unroll
        for (int g = 0; g < 3; ++g) { const int sh = 2 * g, t = (int)(m & 8191); const size_t pm = (m & ~(size_t)8191) + (size_t)(((t & ((1 << sh) - 1)) << (13 - sh)) + (t >> sh));
            const v4u ow = *(const v4u*)hptr(H, pm, C_DIL + (3 * g) * 512 + slot * 128 + 8 * c8);
            acc[0] += w[g] * bf2f(ow.x & 0xffffu); acc[1] += w[g] * bf2f(ow.x >> 16); acc[2] += w[g] * bf2f(ow.y & 0xffffu); acc[3] += w[g] * bf2f(ow.y >> 16);
            acc[4] += w[g] * bf2f(ow.z & 0xffffu); acc[5] += w[g] * bf2f(ow.z >> 16); acc[6] += w[g] * bf2f(ow.w & 0xffffu); acc[7] += w[g] * bf2f(ow.w >> 16); }
        v4u o; o.x = pk2(acc[0], acc[1]); o.y = pk2(acc[2], acc[3]); o.z = pk2(acc[4], acc[5]); o.w = pk2(acc[6], acc[7]);
        *(v4u*)(Y + m * D + 1536 + slot * 128 + 8 * c8) = o; }
}

#ifndef MK_N_LAUNCHES
#define MK_N_LAUNCHES 1
#endif
__global__ void __launch_bounds__(NTHR, 2) mega_fwd(Args args) {
    extern __shared__ __attribute__((aligned(16))) unsigned char lds_raw[];
    const lptr lds = (lptr)lds_raw;
    volatile LAS unsigned* MISC = (volatile LAS unsigned*)(lds + MISC_OFF);
    for (int u = threadIdx.x; u < (LDS_BYTES - LDSCTL_OFF) / 4; u += NTHR) ((LAS unsigned*)(lds + LDSCTL_OFF))[u] = 0u;
    __syncthreads();
    XcdBarrier bar; bar.bar = (unsigned*)(args.ws + WS_CTL) + CW_BAR; bar.x = 0; bar.st = nullptr;
    if (MK_N_LAUNCHES == 1) bar = xcd_barrier_post((unsigned*)(args.ws + WS_CTL) + CW_BAR, MISC + 8);
    const int lo = args.ph_lo, hi = args.ph_hi;
#ifndef PROBE_K
#define PROBE_K 1
#endif
#define PB_BEGIN(bit) unsigned long long pt0_ = 0; if (PROBE_MASK & (1 << (bit))) pt0_ = __builtin_amdgcn_s_memrealtime();
#define PB_END(bit) if ((PROBE_MASK & (1 << 15)) && ((226 >> (bit)) & 1)) { const unsigned long long t1_ = __builtin_amdgcn_s_memrealtime(); while (__builtin_amdgcn_s_memrealtime() - t1_ < 10000ull) __builtin_amdgcn_s_sleep(8); } \
    if (PROBE_MASK & (1 << (bit))) { const unsigned long long t1_ = __builtin_amdgcn_s_memrealtime(), dt_ = (t1_ - pt0_) * PROBE_K; while (__builtin_amdgcn_s_memrealtime() - t1_ < dt_) __builtin_amdgcn_s_sleep(8); }
#define IN(k) (lo <= (k) && (k) < hi)
#define SEAM(k) do { if (IN(k) && IN((k) + 1)) { xcd_barrier(bar); if (PROBE_MASK & (1 << 14)) xcd_barrier(bar); } } while (0)
#define PHASE_CTX() const Ctx X = mkctx(lds); bf16* const XB = (bf16*)(X.ws + WS_XB); bf16* const Y = (bf16*)(X.ws + WS_Y); bf16* const H = (bf16*)(X.ws + WS_H); float* const ss_mix = (float*)(X.ws + WS_PART); \
        float* const ss_mix_next = ss_mix; float* const ss_mlp = ss_mix + (size_t)M * 32; (void)XB; (void)Y; (void)H; (void)ss_mix; (void)ss_mix_next; (void)ss_mlp;

    #ifndef NO_PRO
    if (IN(0)) { PB_BEGIN(0) const Ctx X = mkctx(lds); prologue(X); PB_END(0) }
#endif
    SEAM(0);
    for (int l = 0; l < DEPTH; ++l) {
        const int pb = 1 + 7 * l;
#if !defined(NO_GEMM) && !defined(NO_GA)
        if (IN(pb + 0)) { PB_BEGIN(1) PHASE_CTX(); pg8::Gemm g{XB, (const bf16*)(X.ws + WS_WIN) + (size_t)l * INW * D, M, INW, D}; pg8::StaticOrder S; S.init(M, INW, X.G, X.bid);
            pg8::EpiScaleBf16<0, true, true> E{H, M, ss_mix, (LAS float*)(X.lds + 131072)}; pg8::gemm_phase<pg8::EpiScaleBf16<0, true, true>, pg8::StaticOrder, true, true>(X.lds, g, S, E);
            if (X.G == 256 && X.bid >= 128 && l + 1 < DEPTH) {
                LAS float* scr = (LAS float*)(X.lds + X.wave * TR_SCR);
                for (int r = (X.bid - 128) * NWAVES + X.wave; r < TAILQ; r += 128 * NWAVES) convert_item(X, l + 1, r, scr); }
            PB_END(1) }
#endif
        SEAM(pb + 0);
#ifndef NO_MIX1
        if (IN(pb + 1)) { PB_BEGIN(2)
#ifndef NO_DA
            { PB_BEGIN(8) PHASE_CTX(); const int vcu = (X.G % 8 == 0) ? (X.bid % 8) * (X.G / 8) + X.bid / 8 : X.bid;
              for (int run = vcu; run < 768; run += X.G) dil_run(X, H, l, run); PB_END(8) }
#endif
#ifndef NO_HG1
            { PB_BEGIN(9) PHASE_CTX(); LocRegs<false> R; loc_load<false>(X, H, X.bid, R); for (int r = X.bid; r < 1536; r += X.G) gla_local_item<128, false>(X, H, l, r, R, r + X.G < 1536); PB_END(9) }
#endif
#ifndef NO_RT1
            { PB_BEGIN(10) PHASE_CTX(); LocRegs<true> R; loc_load<true>(X, H, 2 * X.bid, R); for (int it = X.bid; it < 768; it += X.G) ret_local_item(X, H, it, R, it + X.G < 768); PB_END(10) }
#endif
        PB_END(2) }
#endif
        SEAM(pb + 1);
#ifndef NO_SCAN
        if (IN(pb + 2)) { PB_BEGIN(3) const Ctx X = mkctx(lds); scan_phase(X); PB_END(3) }
#endif
#ifndef NO_DM
        if (IN(pb + 2)) { PHASE_CTX(); constexpr int SCAN_WG = (24 * 2048 + 24 * 1024) / NTHR;
            if (X.G > SCAN_WG + 16) { for (int it = X.bid - SCAN_WG; it >= 0 && it < 256; it += X.G - SCAN_WG) dil_merge_item(X, H, Y, it); }
            else { for (int it = X.bid; it < 256; it += X.G) dil_merge_item(X, H, Y, it); } }
#endif
        SEAM(pb + 2);
#ifndef NO_MIX2
        if (IN(pb + 3)) { PB_BEGIN(4)
#ifndef NO_HG2
            { PB_BEGIN(11) PHASE_CTX(); OutRegs<false> R; out_load<false>(X, H, X.bid, R); for (int r = X.bid; r < 1536; r += X.G) gla_out_item<128, false>(X, H, Y, l, r, R, r + X.G < 1536); PB_END(11) }
#endif
#ifndef NO_RT2
            { PB_BEGIN(12) PHASE_CTX(); RetOutRegs R; ret_out_load(X, H, X.bid, R); for (int it = X.bid; it < 768; it += X.G) ret_out_item(X, H, Y, l, it, R, it + X.G < 768); PB_END(12) }
#endif
        PB_END(4) }
#endif
        SEAM(pb + 3);
#if !defined(NO_GEMM) && !defined(NO_GE)
        if (IN(pb + 4)) { PB_BEGIN(5) PHASE_CTX(); pg8::Gemm g{Y, (const bf16*)(X.ws + WS_WOUT) + (size_t)l * D * D, M, D, D}; pg8::StaticOrder S; S.init(M, D, X.G, X.bid);
            pg8::EpiResid<false> E{XB, nullptr, ss_mlp}; pg8::gemm_phase<pg8::EpiResid<false>, pg8::StaticOrder, true, true>(X.lds, g, S, E); PB_END(5) }
#endif
        SEAM(pb + 4);
#if !defined(NO_GEMM) && !defined(NO_GF)
        if (IN(pb + 5)) { PB_BEGIN(6) PHASE_CTX(); pg8::Gemm g{XB, (const bf16*)(X.ws + WS_WUP) + (size_t)l * FF * D, M, FF, D}; pg8::StaticOrder S; S.init(M, FF, X.G, X.bid);
            pg8::EpiScaleBf16<1> E{H, FF, ss_mlp, (LAS float*)(X.lds + 131072)}; pg8::gemm_phase<pg8::EpiScaleBf16<1>, pg8::StaticOrder, true, true>(X.lds, g, S, E); PB_END(6) }
#endif
        SEAM(pb + 5);
#if !defined(NO_GEMM) && !defined(NO_GG)
        if (IN(pb + 6)) { PB_BEGIN(7) PHASE_CTX(); pg8::Gemm g{H, (const bf16*)(X.ws + WS_WDN) + (size_t)l * D * FF, M, D, FF}; pg8::StaticOrder S; S.init(M, D, X.G, X.bid);
            if (l < DEPTH - 1) { pg8::EpiResid<false> E{XB, nullptr, ss_mix_next}; pg8::gemm_phase<pg8::EpiResid<false>, pg8::StaticOrder, true, true>(X.lds, g, S, E); }
            else { pg8::EpiResid<true> E{XB, X.out(), nullptr}; pg8::gemm_phase<pg8::EpiResid<true>, pg8::StaticOrder, true, true>(X.lds, g, S, E); }
            PB_END(7) }
#endif
        SEAM(pb + 6);
    }
#undef IN
#undef SEAM
}

extern "C" void kernel_launch(void* const* d_in, const int* in_sizes, int n_in, void* d_out, int out_size, void* d_ws, size_t ws_size, hipStream_t stream) {
    static int grid = 0;
    if (grid == 0) {
        if (n_in != 14 || in_sizes[0] != M * D || out_size != M * D || ws_size < WS_END) { fprintf(stderr, "kernel_launch: unexpected problem (n_in %d, in0 %d, out %d, ws %zu < %zu); nothing launched\n", n_in, n_in > 0 ? in_sizes[0] : -1, out_size, ws_size, (size_t)WS_END); grid = -1; return; }
        int dev = 0, cus = 0, per_cu = 0;
        if (hipGetDevice(&dev) != hipSuccess || hipDeviceGetAttribute(&cus, hipDeviceAttributeMultiprocessorCount, dev) != hipSuccess) { grid = -1; return; }
        if (hipFuncSetAttribute((const void*)mega_fwd, hipFuncAttributeMaxDynamicSharedMemorySize, LDS_BYTES) != hipSuccess) { fprintf(stderr, "kernel_launch: hipFuncSetAttribute failed\n"); grid = -1; return; }
        if (hipOccupancyMaxActiveBlocksPerMultiprocessor(&per_cu, (const void*)mega_fwd, NTHR, LDS_BYTES) != hipSuccess || per_cu < 1) fprintf(stderr, "kernel_launch: occupancy query reports %d workgroups per CU\n", per_cu);
        (void)hipGetLastError();
        grid = cus;
    }
    if (grid < 0) return;
    (void)hipMemsetAsync((char*)d_ws + WS_CTL, 0, CTL_ZERO_BYTES, stream);
    Args a{};
    for (int i = 0; i < 14; ++i) a.in[i] = (const float*)d_in[i];
    a.out = (float*)d_out; a.ws = (unsigned char*)d_ws;
    if (MK_N_LAUNCHES == 1) { a.ph_lo = 0; a.ph_hi = NPHASE; hipLaunchKernelGGL(mega_fwd, dim3(grid), dim3(NTHR), LDS_BYTES, stream, a); }
    else for (int p = 0; p < NPHASE; ++p) { a.ph_lo = p; a.ph_hi = p + 1; hipLaunchKernelGGL(mega_fwd, dim3(grid), dim3(NTHR), LDS_BYTES, stream, a); }
}
```

```cpp
#include <hip/hip_runtime.h>
#include <cstdio>
#include <cstdint>
namespace pg8 {
#define PG8_LAS __attribute__((address_space(3)))
typedef unsigned short bf16_t;
typedef short bf16x8 __attribute__((ext_vector_type(8)));
typedef float f32x4 __attribute__((ext_vector_type(4)));
typedef unsigned u32x4 __attribute__((ext_vector_type(4)));
constexpr int BM = 256, BK = 64, HALF = 128, HTB = HALF * BK * 2  , STAGE_BYTES = 8 * HTB, NXCD = 8, WGM = 4;

__host__ __device__ __forceinline__ int lds_byte(int r, int c) { const int st = (r >> 4) * 2 + (c >> 5), rr = r & 15, cc = c & 31, ob = rr * 64 + cc * 2; return st * 1024 + (ob ^ (((ob >> 9) & 1) << 5)); }
__host__ __device__ __forceinline__ void stage_rc(int b, int& R, int& C) { const int st = b / 1024, sb = b % 1024, swz = sb ^ (((sb >> 9) & 1) << 5); R = (st >> 1) * 16 + swz / 64; C = (st & 1) * 32 + (swz % 64) / 2; }
__host__ __device__ __forceinline__ int perm32(int rho) { const int n = rho >> 4, i = rho & 15; return 8 * (i >> 2) + 4 * n + (i & 3); }

struct Unit { int pm, pn; };
struct Gemm { const bf16_t* A; const bf16_t* Bt; int M, N, K; };

struct StaticOrder {
    int nM, nN, nwg, G, c;
    __host__ __device__ void init(int M, int N, int G_, int c_) { nM = M / BM; nN = N / BM; nwg = nM * nN; G = G_; c = c_; }
    __host__ __device__ bool next(int i, Unit& u) const {
        const long L = (long)i * G + c; if (L >= nwg) return false;
        int wgid = (int)L; { const int q = nwg / NXCD, r = nwg % NXCD, xcd = wgid % NXCD, off = wgid / NXCD; wgid = (xcd < r ? xcd * (q + 1) : r * (q + 1) + (xcd - r) * q) + off; }
        const int nig = WGM * nN, gid = wgid / nig, fm = gid * WGM, gsz = (nM - fm) < WGM ? (nM - fm) : WGM;
        u.pm = fm + ((wgid % nig) % gsz); u.pn = (wgid % nig) / gsz; return true;
    }
    __device__ __forceinline__ void a_ready(const Unit&) const {}
    __device__ __forceinline__ void done(const Unit&) const {}
};

typedef float f32x2 __attribute__((ext_vector_type(2))); typedef __bf16 bf16x2_t __attribute__((ext_vector_type(2)));
__device__ __forceinline__ unsigned cvt_pk_bf16(float lo, float hi) { f32x2 v = {lo, hi}; bf16x2_t b = __builtin_convertvector(v, bf16x2_t); return __builtin_bit_cast(unsigned, b); }

template <int ACT, bool BLK = false, bool PERMROWS = false> struct EpiScaleBf16 {
    static constexpr bool PERM = true, AFTER_DRAIN = false, HAS_PREP = true;
    bf16_t* O; int ldc; const float* ss; PG8_LAS float* rtab;
    __device__ __forceinline__ void prep(const Unit& u, int tid, int buf) const {
        if (tid < BM) { const float* p = ss + (size_t)(u.pm * BM + tid) * 32; float sq = 0.f;
#pragma unroll
            for (int i = 0; i < 8; ++i) { const f32x4 v = *(const f32x4*)(p + 4 * i); sq += (v[0] + v[1]) + (v[2] + v[3]); }
            rtab[buf * BM + tid] = __builtin_amdgcn_rsqf(sq * (1.0f / 2048.0f) + 1e-6f); }
    }
    __device__ __forceinline__ void operator()(const f32x4 (&acc)[2][2][4][2], const Unit& u, int wr, int wc, int fr, int fq, int buf) const {
        const int row0 = u.pm * BM + wr * 64 + fr; const int col0 = u.pn * BM + wc * 32 + 8 * fq;
#pragma unroll
        for (int ai = 0; ai < 2; ++ai)
#pragma unroll
            for (int m = 0; m < 4; ++m) { const int row = row0 + ai * HALF + m * 16;
                const float sc = rtab[buf * BM + wr * 64 + fr + ai * HALF + m * 16];
                int prow = row;
                if (PERMROWS && u.pn >= 24) { const int sh = 2 * ((u.pn - 24) / 6), t = row & 8191; prow = (row & ~8191) + ((t & ((1 << sh) - 1)) << (13 - sh)) + (t >> sh); }
                bf16_t* rowp = BLK ? O + ((size_t)(2 * u.pn) * ldc + prow) * 128 + wc * 32 + 8 * fq : O + (size_t)row * ldc + col0;
#pragma unroll
                for (int bj = 0; bj < 2; ++bj) { f32x4 v0 = acc[ai][bj][m][0] * sc, v1 = acc[ai][bj][m][1] * sc;
                    if (ACT == 1) {
#pragma unroll
                        for (int e = 0; e < 4; ++e) { float a = v0[e] > 0.f ? v0[e] : 0.f; v0[e] = a * a; float b = v1[e] > 0.f ? v1[e] : 0.f; v1[e] = b * b; } }
                    u32x4 w; w.x = cvt_pk_bf16(v0[0], v0[1]); w.y = cvt_pk_bf16(v0[2], v0[3]); w.z = cvt_pk_bf16(v1[0], v1[1]); w.w = cvt_pk_bf16(v1[2], v1[3]);
                    *(u32x4*)(rowp + (BLK ? (size_t)bj * ldc * 128 : (size_t)bj * HALF)) = w; } }
    }
};
template <bool FINAL> struct EpiResid {
    static constexpr bool PERM = true, AFTER_DRAIN = false, HAS_PREP = false;
    bf16_t* xb; float* out; float* ssn;
    __device__ __forceinline__ void operator()(const f32x4 (&acc)[2][2][4][2], const Unit& u, int wr, int wc, int fr, int fq) const {
        const int col0 = u.pn * BM + wc * 32 + 8 * fq;
#pragma unroll
        for (int ai = 0; ai < 2; ++ai) {
            u32x4 xr[4][2];
#pragma unroll
            for (int m = 0; m < 4; ++m)
#pragma unroll
                for (int bj = 0; bj < 2; ++bj) xr[m][bj] = *(const u32x4*)(xb + (size_t)(u.pm * BM + ai * HALF + wr * 64 + m * 16 + fr) * 2048 + col0 + bj * HALF);
#pragma unroll
            for (int m = 0; m < 4; ++m) { const int row = u.pm * BM + ai * HALF + wr * 64 + m * 16 + fr; const size_t off = (size_t)row * 2048 + col0; float sq = 0.f;
#pragma unroll
                for (int bj = 0; bj < 2; ++bj) { const size_t o2 = off + bj * HALF; const u32x4 xw = xr[m][bj];
                    f32x4 x0, x1; x0[0] = __uint_as_float(xw.x << 16); x0[1] = __uint_as_float(xw.x & 0xffff0000u); x0[2] = __uint_as_float(xw.y << 16); x0[3] = __uint_as_float(xw.y & 0xffff0000u);
                    x1[0] = __uint_as_float(xw.z << 16); x1[1] = __uint_as_float(xw.z & 0xffff0000u); x1[2] = __uint_as_float(xw.w << 16); x1[3] = __uint_as_float(xw.w & 0xffff0000u);
                    x0 = x0 + acc[ai][bj][m][0]; x1 = x1 + acc[ai][bj][m][1];
                    if (FINAL) { *(f32x4*)(out + o2) = x0; *(f32x4*)(out + o2 + 4) = x1; }
                    else { u32x4 w; w.x = cvt_pk_bf16(x0[0], x0[1]); w.y = cvt_pk_bf16(x0[2], x0[3]); w.z = cvt_pk_bf16(x1[0], x1[1]); w.w = cvt_pk_bf16(x1[2], x1[3]); *(u32x4*)(xb + o2) = w; }
                    sq += ((x0[0] * x0[0] + x0[1] * x0[1]) + (x0[2] * x0[2] + x0[3] * x0[3])) + ((x1[0] * x1[0] + x1[1] * x1[1]) + (x1[2] * x1[2] + x1[3] * x1[3])); }
                sq += __shfl_xor(sq, 16); sq += __shfl_xor(sq, 32);
                if (!FINAL && fq == 0) ssn[(size_t)row * 32 + u.pn * 4 + wc] = sq; }
        }
    }
};
template <class Epi, class Sched, bool ALIGN_EPI = false, bool SP2 = false>
__device__ __forceinline__ void gemm_phase(PG8_LAS unsigned char* lds, const Gemm g, const Sched& S, const Epi& E) {
    int tid_ = threadIdx.x; asm volatile("" : "+v"(tid_));
    const int tid = tid_, wid = __builtin_amdgcn_readfirstlane(tid >> 6), lane = tid & 63, wr = wid >> 2, wc = wid & 3, fr = lane & 15, fq = lane >> 4;
    const int K = g.K, nt = K / BK;
    unsigned voffA[2], voffB[2];
#pragma unroll
    for (int i = 0; i < 2; ++i) { int R, C; stage_rc(tid * 16 + i * 8192, R, C); const int Rb = Epi::PERM ? ((R & ~31) + perm32(R & 31)) : R;
        voffA[i] = (unsigned)(R * K + C) * 2u; voffB[i] = (unsigned)(Rb * K + C) * 2u; }
    const size_t kstep = (size_t)(BK * 2);
    const size_t hstep = (size_t)HALF * K * 2;
    const size_t tstep = 2 * hstep;
    const unsigned ldsw = (unsigned)wid * 1024u;
    const int aoff = lds_byte(wr * 64 + fr, fq * 8), boff = lds_byte(wc * 32 + fr, fq * 8);
#define PG8_SA(b, h) (((b) * 2 + (h)) * HTB)
#define PG8_SB(b, h) ((4 + (b) * 2 + (h)) * HTB)
#define PG8_STAGE(bufoff, gbase, voff) do { _Pragma("unroll") for (int _i = 0; _i < 2; ++_i) \
        __builtin_amdgcn_global_load_lds((const unsigned*)((const char*)(gbase) + (voff)[_i]), (PG8_LAS unsigned*)(lds + (bufoff) + ldsw + _i * 8192), 16, 0, 0); } while (0)
#define PG8_LDA(dst, b, h) do { _Pragma("unroll") for (int m = 0; m < 4; ++m) _Pragma("unroll") for (int k = 0; k < 2; ++k) dst[m][k] = *(const PG8_LAS bf16x8*)(lds + PG8_SA(b, h) + aoff + m * 2048 + k * 1024); } while (0)
#define PG8_LDB(dst, b, h) do { _Pragma("unroll") for (int n = 0; n < 2; ++n) _Pragma("unroll") for (int k = 0; k < 2; ++k) dst[n][k] = *(const PG8_LAS bf16x8*)(lds + PG8_SB(b, h) + boff + n * 2048 + k * 1024); } while (0)
#define PG8_MMA(ai, bj, At, Bt) do { __builtin_amdgcn_s_setprio(1); _Pragma("unroll") for (int m = 0; m < 4; ++m) _Pragma("unroll") for (int n = 0; n < 2; ++n) _Pragma("unroll") for (int k = 0; k < 2; ++k) \
        acc[ai][bj][m][n] = __builtin_amdgcn_mfma_f32_16x16x32_bf16(Bt[n][k], At[m][k], acc[ai][bj][m][n], 0, 0, 0); __builtin_amdgcn_s_setprio(0); } while (0)
#define PG8_WAIT_V(n) asm volatile("s_waitcnt vmcnt(" #n ")" ::: "memory")
#define PG8_WAIT_L(n) asm volatile("s_waitcnt lgkmcnt(" #n ")" ::: "memory")
#define PG8_BAR __builtin_amdgcn_s_barrier()
#define PG8_SCHED __builtin_amdgcn_sched_barrier(0)
    Unit cur, nxt; int ui = 0;
    if (!S.next(0, cur)) return;
    f32x4 acc[2][2][4][2];
#pragma unroll
    for (int a = 0; a < 2; ++a)
#pragma unroll
        for (int b = 0; b < 2; ++b)
#pragma unroll
            for (int m = 0; m < 4; ++m)
#pragma unroll
                for (int n = 0; n < 2; ++n) acc[a][b][m][n] = (f32x4){0.f, 0.f, 0.f, 0.f};
    bf16x8 At[4][2], B0[2][2], B1[2][2];
    const char* cA = (const char*)g.A + (size_t)cur.pm * tstep; const char* cB = (const char*)g.Bt + (size_t)cur.pn * tstep;
    S.a_ready(cur);
    int prep_pm = cur.pm, prep_gen = 0; if constexpr (Epi::HAS_PREP) E.prep(cur, tid, 0);
    if constexpr (SP2) {
        PG8_STAGE(PG8_SB(0, 0), cB, voffB); PG8_STAGE(PG8_SB(0, 1), cB + hstep, voffB); PG8_STAGE(PG8_SA(0, 0), cA, voffA); PG8_STAGE(PG8_SA(0, 1), cA + hstep, voffA);
        if (wr == 1) PG8_BAR;
        PG8_WAIT_V(2); PG8_BAR;
        PG8_STAGE(PG8_SB(1, 0), cB + kstep, voffB); PG8_STAGE(PG8_SA(1, 0), cA + kstep, voffA); PG8_STAGE(PG8_SB(1, 1), cB + hstep + kstep, voffB);
        PG8_WAIT_V(6); PG8_BAR;
    } else {
        PG8_STAGE(PG8_SB(0, 0), cB, voffB); PG8_STAGE(PG8_SA(0, 0), cA, voffA); PG8_STAGE(PG8_SB(0, 1), cB + hstep, voffB); PG8_STAGE(PG8_SA(0, 1), cA + hstep, voffA);
        if (wr == 1) PG8_BAR;
        PG8_WAIT_V(4); PG8_BAR;
        PG8_STAGE(PG8_SB(1, 0), cB + kstep, voffB); PG8_STAGE(PG8_SA(1, 0), cA + kstep, voffA); PG8_STAGE(PG8_SB(1, 1), cB + hstep + kstep, voffB);
        PG8_WAIT_V(6); PG8_BAR;
    }
    for (;;) {
        const bool has_next = S.next(ui + 1, nxt);
        const char* nA = has_next ? (const char*)g.A + (size_t)nxt.pm * tstep : cA; const char* nB = has_next ? (const char*)g.Bt + (size_t)nxt.pn * tstep : cB;
        for (int t = 0; t < nt; t += 2) {
            const bool last = (t == nt - 2);
            const char* a1 = cA + (size_t)(t + 1) * kstep;
            const char* a2 = last ? nA : cA + (size_t)(t + 2) * kstep; const char* b2 = last ? nB : cB + (size_t)(t + 2) * kstep;
            const char* a3 = a2 + kstep; const char* b3 = b2 + kstep;
            if (last && has_next) S.a_ready(nxt);
            if constexpr (SP2) {
            PG8_LDB(B0, 0, 0); PG8_LDB(B1, 0, 1); PG8_SCHED; PG8_LDA(At, 0, 0); PG8_STAGE(PG8_SA(1, 1), a1 + hstep, voffA);
            PG8_WAIT_V(8); PG8_WAIT_L(0); PG8_BAR; PG8_MMA(0, 0, At, B0); PG8_MMA(0, 1, At, B1); PG8_BAR; PG8_SCHED;
            PG8_LDA(At, 0, 1); PG8_STAGE(PG8_SB(0, 0), b2, voffB); PG8_STAGE(PG8_SB(0, 1), b2 + hstep, voffB); PG8_STAGE(PG8_SA(0, 0), a2, voffA);
            PG8_WAIT_V(8); PG8_WAIT_L(0); PG8_BAR; PG8_MMA(1, 0, At, B0); PG8_MMA(1, 1, At, B1); PG8_BAR; PG8_SCHED;
            PG8_LDB(B0, 1, 0); PG8_LDB(B1, 1, 1); PG8_SCHED; PG8_LDA(At, 1, 0); PG8_STAGE(PG8_SA(0, 1), a2 + hstep, voffA);
            PG8_WAIT_V(8); PG8_WAIT_L(0); PG8_BAR; PG8_MMA(0, 0, At, B0); PG8_MMA(0, 1, At, B1); PG8_BAR; PG8_SCHED;
            PG8_LDA(At, 1, 1); PG8_STAGE(PG8_SB(1, 0), b3, voffB); PG8_STAGE(PG8_SB(1, 1), b3 + hstep, voffB); PG8_STAGE(PG8_SA(1, 0), a3, voffA);
            PG8_WAIT_V(8); PG8_WAIT_L(0); PG8_BAR; PG8_MMA(1, 0, At, B0); PG8_MMA(1, 1, At, B1); PG8_BAR; PG8_SCHED;
            } else {
            PG8_LDB(B0, 0, 0); PG8_SCHED; PG8_LDA(At, 0, 0); PG8_STAGE(PG8_SA(1, 1), a1 + hstep, voffA);
            PG8_WAIT_L(8); PG8_BAR; PG8_WAIT_L(0); PG8_MMA(0, 0, At, B0); PG8_BAR; PG8_SCHED;
            PG8_LDB(B1, 0, 1); PG8_STAGE(PG8_SB(0, 0), b2, voffB);
            PG8_BAR; PG8_WAIT_L(0); PG8_MMA(0, 1, At, B1); PG8_BAR;
            PG8_LDA(At, 0, 1); PG8_STAGE(PG8_SA(0, 0), a2, voffA);
            PG8_BAR; PG8_WAIT_L(0); PG8_MMA(1, 0, At, B0); PG8_BAR; PG8_SCHED;
            PG8_STAGE(PG8_SB(0, 1), b2 + hstep, voffB);
            PG8_WAIT_V(6); PG8_BAR; PG8_MMA(1, 1, At, B1); PG8_BAR;
            PG8_LDB(B0, 1, 0); PG8_SCHED; PG8_LDA(At, 1, 0); PG8_STAGE(PG8_SA(0, 1), a2 + hstep, voffA);
            PG8_WAIT_L(8); PG8_BAR; PG8_WAIT_L(0); PG8_MMA(0, 0, At, B0); PG8_BAR; PG8_SCHED;
            PG8_LDB(B1, 1, 1); PG8_STAGE(PG8_SB(1, 0), b3, voffB);
            PG8_BAR; PG8_WAIT_L(0); PG8_MMA(0, 1, At, B1); PG8_BAR;
            PG8_LDA(At, 1, 1); PG8_STAGE(PG8_SA(1, 0), a3, voffA);
            PG8_BAR; PG8_WAIT_L(0); PG8_MMA(1, 0, At, B0); PG8_BAR; PG8_SCHED;
            PG8_STAGE(PG8_SB(1, 1), b3 + hstep, voffB);
            PG8_WAIT_V(6); PG8_BAR; PG8_MMA(1, 1, At, B1); PG8_BAR;
            }
        }
        if constexpr (ALIGN_EPI) { if (wr == 0) PG8_BAR; }
        if constexpr (!Epi::AFTER_DRAIN) { if constexpr (Epi::HAS_PREP) E(acc, cur, wr, wc, fr, fq, prep_gen & 1); else E(acc, cur, wr, wc, fr, fq); S.done(cur); }
        if (!has_next) break;
#pragma unroll
        for (int a = 0; a < 2; ++a)
#pragma unroll
            for (int b = 0; b < 2; ++b)
#pragma unroll
                for (int m = 0; m < 4; ++m)
#pragma unroll
                    for (int n = 0; n < 2; ++n) acc[a][b][m][n] = (f32x4){0.f, 0.f, 0.f, 0.f};
        cur = nxt; cA = nA; cB = nB; ++ui;
        if constexpr (Epi::HAS_PREP) { if (cur.pm != prep_pm) { ++prep_gen; E.prep(cur, tid, prep_gen & 1); prep_pm = cur.pm; } }
        if constexpr (ALIGN_EPI) { if (wr == 1) PG8_BAR; }
    }
    PG8_WAIT_V(0);
    if constexpr (!ALIGN_EPI) { if (wr == 0) PG8_BAR; }
    PG8_BAR;
    if constexpr (Epi::AFTER_DRAIN) { E.fused(acc, cur, wr, wc, fr, fq, lds, wid, lane); S.done(cur); }
#undef PG8_SA
#undef PG8_SB
#undef PG8_STAGE
#undef PG8_LDA
#undef PG8_LDB
#undef PG8_MMA
#undef PG8_WAIT_V
#undef PG8_WAIT_L
#undef PG8_BAR
#undef PG8_SCHED
}
}
constexpr int NWAVES = 8, NTHR = 512;
constexpr int BATCH = 2, SEQ = 8192, M = BATCH * SEQ, D = 2048, DEPTH = 4, INW = 10752, FF = 8192;
constexpr int C_HGQ = 0, C_HGV = 768, C_ZF = 1536, C_ZB = 2304, C_HGG = 3072, C_RQ = 3840, C_RK = 4224, C_RV = 4608, C_RG = 5376, C_DIL = 6144;
constexpr int CH = 64, NCH = SEQ / CH;
constexpr float EPS = 1e-6f;
constexpr int NPHASE = 1 + 7 * DEPTH;

constexpr size_t MiB = 1u << 20;
constexpr size_t WS_CTL = 0, CTL_ZERO_BYTES = 1 * MiB;
constexpr size_t WS_PART = 10 * MiB;
constexpr size_t WS_ROPE = 2 * MiB;
constexpr size_t WS_TAB = 4 * MiB;
constexpr size_t WS_LSE = 5 * MiB;
constexpr size_t WS_DHG = 6 * MiB;
constexpr size_t WS_DRT = 8 * MiB;
constexpr size_t WS_WIN = 16 * MiB, WS_WOUT = 184 * MiB, WS_WUP = 216 * MiB, WS_WDN = 344 * MiB;
constexpr size_t WS_XB = 472 * MiB;
constexpr size_t WS_Y = 536 * MiB;
constexpr size_t WS_H = 600 * MiB;
constexpr size_t WS_SHG = 936 * MiB;
constexpr size_t WS_SRT = 1032 * MiB;
constexpr size_t WS_END = 1080 * MiB;
constexpr int CW_BAR = 4096;

constexpr int PH_BYTES = 155648;
constexpr int LDSCTL_OFF = PH_BYTES, MISC_OFF = LDSCTL_OFF + 320;
constexpr int LDS_BYTES = PH_BYTES + 1024;

#define GAS __attribute__((address_space(1)))
#define LAS __attribute__((address_space(3)))
typedef unsigned short bf16;
typedef unsigned v4u __attribute__((ext_vector_type(4)));
typedef unsigned v2u __attribute__((ext_vector_type(2)));
typedef float f32x4 __attribute__((ext_vector_type(4)));
typedef short bf16x8 __attribute__((ext_vector_type(8)));
typedef LAS unsigned char* lptr;
#define LDS_WAIT() asm volatile("s_waitcnt lgkmcnt(0)" ::: "memory")
#define VM_WAIT() asm volatile("s_waitcnt vmcnt(0)" ::: "memory")
#ifndef PROBE_MASK
#define PROBE_MASK 0
#endif
#define SP_BEGIN() unsigned long long sp0_ = 0; if (PROBE_MASK >> 16) sp0_ = __builtin_amdgcn_s_memrealtime();
#define SP_END(bit) do { if (PROBE_MASK >> 16) { const unsigned long long t1_ = __builtin_amdgcn_s_memrealtime(); if (PROBE_MASK & (1 << (bit))) { const unsigned long long dt_ = t1_ - sp0_; while (__builtin_amdgcn_s_memrealtime() - t1_ < dt_) __builtin_amdgcn_s_sleep(2); } sp0_ = __builtin_amdgcn_s_memrealtime(); } } while (0)
#define BAR_LDS() do { asm volatile("s_waitcnt lgkmcnt(0)" ::: "memory"); __builtin_amdgcn_s_barrier(); asm volatile("" ::: "memory"); } while (0)
__device__ __forceinline__ float bf2f(unsigned h) { return __uint_as_float(h << 16); }
__device__ __forceinline__ unsigned pk2(float lo, float hi) { return pg8::cvt_pk_bf16(lo, hi); }
typedef float f32x2v __attribute__((ext_vector_type(2)));
__device__ __forceinline__ float clamp8(float x) { return __builtin_amdgcn_fmed3f(x, -240.f, 240.f); }
__device__ __forceinline__ unsigned pk4f8(float a, float b, float c, float d) { int w = __builtin_amdgcn_cvt_pk_fp8_f32(clamp8(a), clamp8(b), 0, false); return (unsigned)__builtin_amdgcn_cvt_pk_fp8_f32(clamp8(c), clamp8(d), w, true); }
__device__ __forceinline__ f32x2v f8lo(unsigned w) { return __builtin_amdgcn_cvt_pk_f32_fp8((int)w, false); }
__device__ __forceinline__ f32x2v f8hi(unsigned w) { return __builtin_amdgcn_cvt_pk_f32_fp8((int)w, true); }
__device__ __forceinline__ unsigned short f2bf(float f) { return (unsigned short)(pk2(f, 0.f) & 0xffffu); }
__device__ __forceinline__ bf16x8 ldsfrag(lptr base, int row, int stride_b, int kel) { return *(const LAS bf16x8*)(base + row * stride_b + kel * 2); }
#define MFMA16(a, b, c) __builtin_amdgcn_mfma_f32_16x16x32_bf16((a), (b), (c), 0, 0, 0)
template <class T> __device__ __forceinline__ T* hptr(T* H, size_t m, int col) { return H + ((size_t)(col >> 7) * M + m) * 128 + (col & 127); }
__device__ __forceinline__ float wave_sum(float v) {
#pragma unroll
    for (int o = 1; o < 64; o <<= 1) v += __shfl_xor(v, o);
    return v;
}
typedef GAS unsigned gu32;
#define XB_TMO      128
#define XB_XCNT(j)  (256  + 64 * (j))
#define XB_XSUB(j)  (1280 + 64 * (j))
#define XB_XGEN(j)  (2304 + 64 * (j))
#define XB_TOP      3328
#define XB_TOPGEN   3392
#define XCD_BAR_WORDS 3456
#define XB_SPIN_CAP (1u << 18)

__device__ __forceinline__ unsigned xb_ld(unsigned* p)              { return __hip_atomic_load(p, __ATOMIC_RELAXED, __HIP_MEMORY_SCOPE_AGENT); }
__device__ __forceinline__ unsigned xb_add(unsigned* p, unsigned v) { return __hip_atomic_fetch_add(p, v, __ATOMIC_RELAXED, __HIP_MEMORY_SCOPE_AGENT); }
__device__ __forceinline__ unsigned xb_xcc_id() { return (unsigned)__builtin_amdgcn_s_getreg((3 << 11) | 20) & 0xFu; }
#define XB_SPIN(cond, bar) do { unsigned _sp = 0; while (cond) { __builtin_amdgcn_s_sleep(1); \
    if ((++_sp & 255u) == 0u) { if (xb_ld(&(bar)[XB_TMO])) break; if (_sp > XB_SPIN_CAP) { atomicAdd(&(bar)[XB_TMO], 1u); break; } } } } while (0)

struct XcdBarrier {
    unsigned* bar; unsigned x;
    volatile LAS unsigned* st;
};

__device__ __forceinline__ XcdBarrier xcd_barrier_post(unsigned* bar, volatile LAS unsigned* st) {
    XcdBarrier b; b.bar = bar; b.x = xb_xcc_id(); b.st = st;
    if (threadIdx.x == 0) (void)xb_add(&bar[XB_XCNT(b.x)], 1u);
    return b;
}
__device__ __forceinline__ void xcd_barrier_complete(unsigned* bar, unsigned x, unsigned& nloc, unsigned& nx) {
    const unsigned G = gridDim.x * gridDim.y * gridDim.z;
    unsigned sum, cnt, mine, sp = 0u;
    for (;;) {
        sum = 0u; cnt = 0u; mine = 0u;
#pragma unroll
        for (unsigned j = 0; j < 16; ++j) { const unsigned c = xb_ld(&bar[XB_XCNT(j)]); sum += c; cnt += (c > 0u) ? 1u : 0u; mine = (j == x) ? c : mine; }
        if (sum == G) break;
        __builtin_amdgcn_s_sleep(1);
        if ((++sp & 255u) == 0u) { if (xb_ld(&bar[XB_TMO])) break; if (sp > XB_SPIN_CAP) { atomicAdd(&bar[XB_TMO], 1u); break; } }
    }
    nloc = mine > 0u ? mine : 1u; nx = cnt > 0u ? cnt : 1u;
}

__device__ __forceinline__ void xcd_barrier(const XcdBarrier& b) {
    asm volatile("s_waitcnt vmcnt(0)" ::: "memory");
    __syncthreads();
    if (threadIdx.x == 0) {
        unsigned* bar = b.bar;
        __builtin_amdgcn_s_waitcnt(0);
        unsigned nloc = b.st[0], nx = b.st[1];
        if (nloc == 0u) { xcd_barrier_complete(bar, b.x, nloc, nx); b.st[0] = nloc; b.st[1] = nx; }
        const unsigned old = xb_add(&bar[XB_XSUB(b.x)], 1u);
        const unsigned gen = old / nloc;
        if (old + 1u == (gen + 1u) * nloc) {
            __builtin_amdgcn_fence(__ATOMIC_RELEASE, "agent");
            asm volatile("s_waitcnt vmcnt(0)" ::: "memory");
            const unsigned og = xb_add(&bar[XB_TOP], 1u);
            const unsigned tg = og / nx;
            if (og + 1u == (tg + 1u) * nx) xb_add(&bar[XB_TOPGEN], 1u);
            else XB_SPIN(xb_ld(&bar[XB_TOPGEN]) == tg, bar);
            __builtin_amdgcn_fence(__ATOMIC_ACQUIRE, "agent");
            xb_add(&bar[XB_XGEN(b.x)], 1u);
            asm volatile("s_waitcnt vmcnt(0)" ::: "memory");
        } else {
            XB_SPIN(xb_ld(&bar[XB_XGEN(b.x)]) == gen, bar);
            __builtin_amdgcn_fence(__ATOMIC_ACQUIRE, "agent");
            asm volatile("s_waitcnt vmcnt(0)" ::: "memory");
        }
    }
    __syncthreads();
}
constexpr int TR_SCR = 64 * 65 * 4;
__device__ __forceinline__ void transpose_item(const float* W, const float* g, int K, int N, bf16* WT, LAS float* scr, int item, int lane) {
    const int nblk = N / 64, kb = item / nblk, nb = item % nblk, k0 = 64 * kb, n0 = 64 * nb;
    const int n4 = lane & 15, kr = lane >> 4;
    f32x4 w[16];
    const float gl = g ? g[k0 + lane] : 1.f;
#pragma unroll
    for (int i = 0; i < 16; ++i) w[i] = *(const f32x4*)(W + (size_t)(k0 + 4 * i + kr) * N + n0 + 4 * n4);
    if (g) {
#pragma unroll
        for (int i = 0; i < 16; ++i) w[i] = w[i] * __shfl(gl, 4 * i + kr); }
#pragma unroll
    for (int i = 0; i < 16; ++i) { LAS float* d = scr + (4 * i + kr) * 65 + 4 * n4; d[0] = w[i].x; d[1] = w[i].y; d[2] = w[i].z; d[3] = w[i].w; }
    LDS_WAIT(); asm volatile("" ::: "memory");
    const int c = lane & 7;
#pragma unroll
    for (int j = 0; j < 8; ++j) { const int n = (lane >> 3) + 8 * j; const LAS float* s = scr + (8 * c) * 65 + n;
        v4u o; o.x = pk2(s[0 * 65], s[1 * 65]); o.y = pk2(s[2 * 65], s[3 * 65]); o.z = pk2(s[4 * 65], s[5 * 65]); o.w = pk2(s[6 * 65], s[7 * 65]);
        *(v4u*)(WT + (size_t)(n0 + n) * K + k0 + 8 * c) = o; }
    LDS_WAIT(); asm volatile("" ::: "memory");
}
__device__ __forceinline__ void sincos_d(double a, float& s, float& c) {
    const double kq = __builtin_rint(a * 0.6366197723675814); const double r = a - kq * 1.5707963267948966; const int q = ((int)kq) & 3; const double r2 = r * r;
    double sp = 1.0 / 6227020800.0; sp = sp * r2 - 1.0 / 39916800.0; sp = sp * r2 + 1.0 / 362880.0; sp = sp * r2 - 1.0 / 5040.0; sp = sp * r2 + 1.0 / 120.0; sp = sp * r2 - 1.0 / 6.0; sp = sp * r2 + 1.0; sp *= r;
    double cp = -1.0 / 87178291200.0; cp = cp * r2 + 1.0 / 479001600.0; cp = cp * r2 - 1.0 / 3628800.0; cp = cp * r2 + 1.0 / 40320.0; cp = cp * r2 - 1.0 / 720.0; cp = cp * r2 + 1.0 / 24.0; cp = cp * r2 - 0.5; cp = cp * r2 + 1.0;
    const double ss = (q == 0) ? sp : (q == 1) ? cp : (q == 2) ? -sp : -cp; const double cc = (q == 0) ? cp : (q == 1) ? -sp : (q == 2) ? -cp : sp;
    s = (float)ss; c = (float)cc;
}
__device__ __forceinline__ int t5_bucket(int rel) {
    const int n = rel < 0 ? -rel : rel; int b;
    if (n < 8) b = n; else { b = 8 + (n >= 15) + (n >= 27) + (n >= 50) + (n >= 91) + (n >= 166) + (n >= 305) + (n >= 559); }
    return b + (rel > 0 ? 16 : 0);
}

struct Args { const float* in[14]; float* out; unsigned char* ws; int ph_lo, ph_hi; };
typedef const __attribute__((address_space(4))) Args* kargp;
struct Ctx {
    lptr lds; int tid, lane, wave, G, bid; kargp ka; unsigned char* ws;
    __device__ __forceinline__ const float* in(int i) const { return ka->in[i]; }
    __device__ __forceinline__ float* out() const { return ka->out; }
};
__device__ __forceinline__ Ctx mkctx(lptr lds) {
    Ctx X; int tid = threadIdx.x; asm volatile("" : "+v"(tid));
    kargp ka = (kargp)__builtin_amdgcn_kernarg_segment_ptr(); asm volatile("" : "+s"(ka));
    X.lds = lds; X.tid = tid; X.lane = tid & 63; X.wave = __builtin_amdgcn_readfirstlane(tid >> 6); X.G = gridDim.x; X.bid = blockIdx.x; X.ka = ka; X.ws = ka->ws; return X;
}

constexpr int I_IN = (D / 64) * (INW / 64), I_OUT = (D / 64) * (D / 64), I_UP = (D / 64) * (FF / 64), I_DN = (FF / 64) * (D / 64), I_L = I_IN + I_OUT + I_UP + I_DN;
constexpr int TAILQ = 8192;
__device__ __forceinline__ void convert_item(const Ctx& X, int l, int r, LAS float* scr) {
    if (r < I_IN) { transpose_item(X.in(1) + (size_t)l * D * INW, X.in(5) + l * D, D, INW, (bf16*)(X.ws + WS_WIN) + (size_t)l * INW * D, scr, r, X.lane); return; } r -= I_IN;
    if (r < I_OUT) { transpose_item(X.in(2) + (size_t)l * D * D, nullptr, D, D, (bf16*)(X.ws + WS_WOUT) + (size_t)l * D * D, scr, r, X.lane); return; } r -= I_OUT;
    if (r < I_UP) { transpose_item(X.in(3) + (size_t)l * D * FF, X.in(6) + l * D, D, FF, (bf16*)(X.ws + WS_WUP) + (size_t)l * FF * D, scr, r, X.lane); return; } r -= I_UP;
    transpose_item(X.in(4) + (size_t)l * FF * D, nullptr, FF, D, (bf16*)(X.ws + WS_WDN) + (size_t)l * D * FF, scr, r, X.lane);
}
__device__ __forceinline__ void prologue(const Ctx& X) {
    const int gw = X.bid * NWAVES + X.wave, NGW = X.G * NWAVES;
    LAS float* scr = (LAS float*)(X.lds + X.wave * TR_SCR);
    static_assert(8 * TR_SCR <= PH_BYTES, "transpose scratch");
    const int tq = X.G == 256 ? TAILQ : 0, per = I_L - tq;
    for (int it = gw; it < DEPTH * per; it += NGW) convert_item(X, it / per, it % per, scr);
    float* ss0 = (float*)(X.ws + WS_PART); bf16* xb = (bf16*)(X.ws + WS_XB);
    for (int m = gw; m < M; m += NGW) {
        const f32x4* xr = (const f32x4*)(X.in(0) + (size_t)m * D) + X.lane; f32x4 v[8]; float s = 0.f;
#pragma unroll
        for (int j = 0; j < 8; ++j) { v[j] = xr[64 * j]; s += (v[j].x * v[j].x + v[j].y * v[j].y) + (v[j].z * v[j].z + v[j].w * v[j].w); }
        s = wave_sum(s); if (X.lane < 32) ss0[(size_t)m * 32 + X.lane] = X.lane == 0 ? s : 0.f;
        v2u* o8 = (v2u*)(xb + (size_t)m * D) + X.lane;
#pragma unroll
        for (int j = 0; j < 8; ++j) { v2u w; w.x = pk2(v[j].x, v[j].y); w.y = pk2(v[j].z, v[j].w); o8[64 * j] = w; }
    }
    const int gt = X.bid * NTHR + X.tid, NGT = X.G * NTHR;
    float* rc = (float*)(X.ws + WS_ROPE); float* rs = rc + SEQ * 32;
    for (int i = gt; i < SEQ * 32; i += NGT) { const int pos = i >> 5, f = i & 31; double inv = 1.0; for (int e = 0; e < f; ++e) inv *= 0.7498942093324558; const float ang = (float)pos * (float)inv; float s, c; sincos_d((double)ang, s, c); rc[i] = c; rs[i] = s; }
    float* LB = (float*)(X.ws + WS_TAB); float* BT = LB + 2 * 4 * 768;
    for (int i = gt; i < 2 * 768; i += NGT) { const int dir = i / 768, c = i % 768; const float* src = dir ? X.in(8) : X.in(7);
        const float a0 = src[c], a1 = src[768 + c], a2 = src[2 * 768 + c], a3 = src[3 * 768 + c]; const float mx = fmaxf(fmaxf(a0, a1), fmaxf(a2, a3));
        const float e0 = __expf(a0 - mx), e1 = __expf(a1 - mx), e2 = __expf(a2 - mx), e3 = __expf(a3 - mx); const float inv = 1.0f / (e0 + e1 + e2 + e3);
        float* o = LB + dir * 4 * 768 + c; o[0] = 0.f; o[768] = e1 * inv; o[2 * 768] = (e1 + e2) * inv; o[3 * 768] = (e1 + e2 + e3) * inv; }
    for (int i = gt; i < 3 * 4 * 132; i += NGT) { const int g = i / (4 * 132), sl = (i / 132) % 4, rr = i % 132; const int dil = g == 0 ? 1 : (g == 1 ? 4 : 16);
        BT[i] = rr < 129 ? 1.4426950408889634f * X.in(13)[t5_bucket((rr - 64) * dil) * 12 + g * 4 + sl] : 0.f; }
    float* DB = BT + 3 * 4 * 132;
    for (int l2 = gt; l2 < DEPTH; l2 += NGT) { float gq = 0.f, gk = 0.f, bm = 0.f;
        for (int e = 0; e < 128; ++e) { gq = fmaxf(gq, fabsf(X.in(11)[l2 * 128 + e])); gk = fmaxf(gk, fabsf(X.in(12)[l2 * 128 + e])); }
        for (int e = 0; e < 32 * 12; ++e) bm = fmaxf(bm, X.in(13)[e]);
        DB[l2] = 1.01f * 16.322f * gq * gk + 1.4426950408889634f * bm; }
}

template <int NC> struct RawRegs { v4u w[NC / 64]; };
template <int NC> __device__ __forceinline__ void raw_load(const Ctx& X, const bf16* H, size_t m0, int col, RawRegs<NC>& R) {
#pragma unroll
    for (int p = 0; p < NC / 64; ++p) { const int idx = X.tid + NTHR * p, r = idx / (NC / 8), c8 = idx % (NC / 8); R.w[p] = *(const v4u*)hptr(H, m0 + r, col + 8 * c8); }
}
template <int NC> __device__ __forceinline__ void raw_store(const Ctx& X, lptr dst, const RawRegs<NC>& R) {
#pragma unroll
    for (int p = 0; p < NC / 64; ++p) { const int idx = X.tid + NTHR * p; *(LAS v4u*)(dst + idx * 16) = R.w[p]; }
}
__device__ __forceinline__ void vt_store(const Ctx& X, lptr VT, const RawRegs<128>& R) {
#pragma unroll
    for (int p = 0; p < 2; ++p) { const int idx = X.tid + NTHR * p, r = idx >> 4, c8 = idx & 15; const v4u w = R.w[p];
        LAS unsigned short* d = (LAS unsigned short*)(VT + (8 * c8) * 144 + (r ^ (8 * (c8 & 7))) * 2);
        d[0] = (unsigned short)w.x; d[72] = (unsigned short)(w.x >> 16); d[144] = (unsigned short)w.y; d[216] = (unsigned short)(w.y >> 16);
        d[288] = (unsigned short)w.z; d[360] = (unsigned short)(w.z >> 16); d[432] = (unsigned short)w.w; d[504] = (unsigned short)(w.w >> 16); }
}
__device__ __forceinline__ bf16x8 vtfrag(lptr VT, int row, int stride_b, int kel) { return *(const LAS bf16x8*)(VT + row * stride_b + (kel ^ (8 * ((row >> 3) & 7))) * 2); }
__device__ __forceinline__ f32x2v bfpair(unsigned w) { f32x2v r; r.x = __uint_as_float(w << 16); r.y = __uint_as_float(w & 0xffff0000u); return r; }
__device__ __forceinline__ f32x2v rcp2(f32x2v v) { f32x2v r; r.x = __builtin_amdgcn_rcpf(v.x); r.y = __builtin_amdgcn_rcpf(v.y); return r; }
template <int DIR, bool NEEDQ>
__device__ __forceinline__ void gla_prep(lptr rawz, lptr rawq, f32x2v lb, LAS float* seg, int kp, int rg, f32x2v (&c)[8], f32x2v (&qv)[8], f32x2v (&kv)[8]) {
    f32x2v run = (f32x2v){1.f, 1.f}; const f32x2v oml = 1.0f - lb;
#pragma unroll
    for (int i = 0; i < 8; ++i) { const int ii = DIR ? 7 - i : i; const int r = 8 * rg + ii;
        const f32x2v z = bfpair(*(const LAS unsigned*)(rawz + (r * 128 + 2 * kp) * 2)); f32x2v e; e.x = __expf(-z.x); e.y = __expf(-z.y);
        const f32x2v f = lb + oml * rcp2(e + 1.0f); run = run * f; kv[ii] = 1.0f - f; c[ii] = run;
        if (NEEDQ) qv[ii] = bfpair(*(const LAS unsigned*)(rawq + (r * 128 + 2 * kp) * 2)); }
    *(LAS f32x2v*)(seg + rg * 128 + 2 * kp) = run;
}
#define SEGT(j) (*(const LAS f32x2v*)(seg + ((DIR) ? 7 - (j) : (j)) * 128 + 2 * kp))

constexpr int L1_VT = 0, L1_KC = 128 * 144, L1_SEG = 2 * 128 * 144, L1_RAW = L1_SEG + 4096, L1_END = L1_RAW + 32768;
template <int DK, bool RET, int DIR>
__device__ __forceinline__ void gla_local_dir(const Ctx& X, int chain, int n, f32x2v lb, unsigned char* St, float* dd) {
    static_assert(DK == 128 && !RET, "HGRN2 only (retention has its own path)");
    const lptr VT = X.lds + L1_VT, KC = X.lds + L1_KC; LAS float* seg = (LAS float*)(X.lds + L1_SEG);
    const lptr rawz = X.lds + L1_RAW + (DIR ? 16384 : 0);
    int t_ = X.tid; asm volatile("" : "+v"(t_));
    const int kp = t_ & 63, rg = __builtin_amdgcn_readfirstlane(t_ >> 6);
    f32x2v c[8], qv[8], kv[8];
    gla_prep<DIR, false>(rawz, rawz, lb, seg, kp, rg, c, qv, kv);
    BAR_LDS();
    {
        const int sg = DIR ? 7 - rg : rg;
        f32x2v base = (f32x2v){1.f, 1.f}, all = (f32x2v){1.f, 1.f};
#pragma unroll
        for (int j = 0; j < 8; ++j) { const f32x2v T = SEGT(j); all = all * T; if (j >= sg) base = base * T; }
        f32x2v e[8];
#pragma unroll
        for (int ii = 0; ii < 8; ++ii) { f32x2v cc = c[ii]; cc.x = fmaxf(cc.x, 1e-37f); cc.y = fmaxf(cc.y, 1e-37f); e[ii] = kv[ii] * base * rcp2(cc); }
        v4u w0, w1;
        w0.x = pk2(e[0].x, e[1].x); w0.y = pk2(e[2].x, e[3].x); w0.z = pk2(e[4].x, e[5].x); w0.w = pk2(e[6].x, e[7].x);
        w1.x = pk2(e[0].y, e[1].y); w1.y = pk2(e[2].y, e[3].y); w1.z = pk2(e[4].y, e[5].y); w1.w = pk2(e[6].y, e[7].y);
        *(LAS v4u*)(KC + (2 * kp) * 144 + rg * 16) = w0; *(LAS v4u*)(KC + (2 * kp + 1) * 144 + rg * 16) = w1;
        if (rg == 0) *(f32x2v*)(dd + ((size_t)chain * NCH + n) * DK + 2 * kp) = all;
    }
    BAR_LDS();
    {
        const int fr = X.lane & 15, fq = X.lane >> 4; const int rt = X.wave; constexpr int NCT = 8;
        f32x4 acc[NCT];
#pragma unroll
        for (int t = 0; t < NCT; ++t) acc[t] = (f32x4){0.f, 0.f, 0.f, 0.f};
#pragma unroll
        for (int ks = 0; ks < 2; ++ks) { const bf16x8 a = ldsfrag(KC, 16 * rt + fr, 144, 32 * ks + 8 * fq);
#pragma unroll
            for (int t = 0; t < NCT; ++t) { const bf16x8 bb = vtfrag(VT, 16 * t + fr, 144, 32 * ks + 8 * fq); acc[t] = MFMA16(a, bb, acc[t]); } }
        unsigned char* Sp = St + ((size_t)chain * NCH + n) * 128 * DK;
        const lptr UT = X.lds + L1_END;
#pragma unroll
        for (int t = 0; t < NCT; ++t) *(LAS unsigned*)(UT + (16 * t + fr) * 144 + 16 * rt + 4 * fq) = pk4f8(acc[t][0], acc[t][1], acc[t][2], acc[t][3]);
        BAR_LDS();
#pragma unroll
        for (int p = 0; p < 2; ++p) { const int idx = X.tid + NTHR * p, row = idx >> 3, c16 = idx & 7; *(v4u*)(Sp + (size_t)row * DK + 16 * c16) = *(const LAS v4u*)(UT + row * 144 + c16 * 16); }
    }
    BAR_LDS();
}
template <bool RET> struct LocRegs { RawRegs<128> rv, rzf, rzb; RawRegs<64> rq, rk; f32x4 c4, s4; };
template <bool RET> __device__ __forceinline__ void loc_load(const Ctx& X, const bf16* H, int r, LocRegs<RET>& R) {
    const int b = r / 768, head = (r / 128) % 6, n = r % 128; const size_t m0 = (size_t)(b * SEQ + n * CH);
    raw_load<128>(X, H, m0, (RET ? C_RV : C_HGV) + head * 128, R.rv);
    if (!RET) { raw_load<128>(X, H, m0, C_ZF + head * 128, R.rzf); raw_load<128>(X, H, m0, C_ZB + head * 128, R.rzb); }
    else { raw_load<64>(X, H, m0, C_RQ + head * 64, R.rq); raw_load<64>(X, H, m0, C_RK + head * 64, R.rk);
        const float* rc = (const float*)(X.ws + WS_ROPE) + (size_t)n * CH * 32; R.c4 = *(const f32x4*)(rc + X.tid * 4); R.s4 = *(const f32x4*)(rc + SEQ * 32 + X.tid * 4); }
}
template <int DK, bool RET>
__device__ __forceinline__ void gla_local_item(const Ctx& X, bf16* H, int l, int r, LocRegs<RET>& R, bool has_next) {
    static_assert(DK == 128 && !RET, "HGRN2 only (retention has its own path)");
    const int b = r / 768, head = (r / 128) % 6, n = r % 128;
    const float* LB = (const float*)(X.ws + WS_TAB);
    unsigned char* St = (unsigned char*)(X.ws + WS_SHG); float* dd = (float*)(X.ws + WS_DHG);
    const int kp = X.tid & 63;
    f32x2v lb0 = *(const f32x2v*)(LB + (0 * 4 + l) * 768 + head * 128 + 2 * kp), lb1 = *(const f32x2v*)(LB + (1 * 4 + l) * 768 + head * 128 + 2 * kp);
    vt_store(X, X.lds + L1_VT, R.rv); raw_store<128>(X, X.lds + L1_RAW, R.rzf); raw_store<128>(X, X.lds + L1_RAW + 16384, R.rzb);
    asm volatile("" : "+v"(lb0), "+v"(lb1)); __builtin_amdgcn_sched_barrier(0);
    if (has_next) loc_load<RET>(X, H, r + X.G, R);
    __builtin_amdgcn_sched_barrier(0);
    BAR_LDS();
    const int chain = (b * 6 + head) * 2;
    gla_local_dir<DK, RET, 0>(X, chain, n, lb0, St, dd);
    gla_local_dir<DK, RET, 1>(X, chain + 1, n, lb1, St, dd);
}

template <int DK, bool RET> struct L3 { static constexpr int SQ = (DK + 8) * 2, Q0 = 0, Q1 = 64 * SQ, KD = 96 * SQ, KH = 160 * SQ, VT = 192 * SQ, AM = VT + 128 * 144, SEG = AM + 64 * 144, RED = SEG + 4096, RAW = RED + 1024,
    ST = RAW + 32768, END = ST + 128 * 272; };
static_assert(L3<128, false>::END <= PH_BYTES && L1_END <= PH_BYTES, "mixer LDS maps");
template <int DK, bool RET, int DIR>
__device__ __forceinline__ void gla_out_dir(const Ctx& X, int chain, int n, f32x2v lb, const unsigned char* St, f32x4 (&o)[4], const bf16* H, size_t m0, int zbcol) {
    static_assert(DK == 128 && !RET, "HGRN2 only (retention has its own path)");
    typedef L3<DK, RET> L; constexpr int SQ = L::SQ;
    const lptr Q0 = X.lds + L::Q0, Q1 = X.lds + L::Q1, KD = X.lds + L::KD, KH = X.lds + L::KH, VT = X.lds + L::VT, AM = X.lds + L::AM; LAS float* seg = (LAS float*)(X.lds + L::SEG);
    const lptr rawz = X.lds + L::RAW, rawq = X.lds + L::RAW + 16384, ST = X.lds + L::ST;
    int t_ = X.tid; asm volatile("" : "+v"(t_));
    const int kp = t_ & 63, rg = __builtin_amdgcn_readfirstlane(t_ >> 6);
    const int fr = X.lane & 15, fq = X.lane >> 4;
    const int tb = X.wave & 3, vh = X.wave >> 2;
    SP_BEGIN()
    const unsigned char* Sp = St + ((size_t)chain * NCH + n) * 128 * DK;
    v4u sr[2];
#pragma unroll
    for (int p = 0; p < 2; ++p) { const int idx = X.tid + NTHR * p; sr[p] = *(const v4u*)(Sp + (size_t)idx * 16); }
    {
        f32x2v c[8], qv[8], kv[8];
        gla_prep<DIR, true>(rawz, rawq, lb, seg, kp, rg, c, qv, kv);
        BAR_LDS(); SP_END(21);
#pragma unroll
        for (int p = 0; p < 2; ++p) { const int idx = X.tid + NTHR * p; const lptr d = ST + (idx >> 3) * 272 + (idx & 7) * 32;
            v4u a, b; f32x2v f;
            f = f8lo(sr[p].x); a.x = pk2(f.x, f.y); f = f8hi(sr[p].x); a.y = pk2(f.x, f.y); f = f8lo(sr[p].y); a.z = pk2(f.x, f.y); f = f8hi(sr[p].y); a.w = pk2(f.x, f.y);
            f = f8lo(sr[p].z); b.x = pk2(f.x, f.y); f = f8hi(sr[p].z); b.y = pk2(f.x, f.y); f = f8lo(sr[p].w); b.z = pk2(f.x, f.y); f = f8hi(sr[p].w); b.w = pk2(f.x, f.y);
            *(LAS v4u*)d = a; *(LAS v4u*)(d + 16) = b; }
        {
            const int sg = DIR ? 7 - rg : rg, ss = sg >> 2, hq = sg & 3;
            const f32x2v T0 = SEGT(0), T1 = SEGT(1), T2 = SEGT(2), T3 = SEGT(3), sub0 = (T0 * T1) * (T2 * T3);
            f32x2v pq = (f32x2v){1.f, 1.f};
#pragma unroll
            for (int j = 0; j < 3; ++j) if (j < hq) pq = pq * SEGT(4 * ss + j);
#pragma unroll
            for (int ii = 0; ii < 8; ++ii) { const int r = 8 * rg + ii; f32x2v cp = c[ii] * pq;
                const f32x2v q0 = qv[ii] * cp; cp.x = fmaxf(cp.x, 1e-37f); cp.y = fmaxf(cp.y, 1e-37f); const f32x2v kd = kv[ii] * rcp2(cp);
                *(LAS unsigned*)(KD + r * SQ + kp * 4) = pk2(kd.x, kd.y);
                *(LAS unsigned*)(Q0 + r * SQ + kp * 4) = pk2(q0.x, q0.y);
                if (ss) { const f32x2v q1 = q0 * sub0; *(LAS unsigned*)(Q1 + (DIR ? r : r - 32) * SQ + kp * 4) = pk2(q1.x, q1.y); }
                else { const f32x2v kh = kd * sub0; *(LAS unsigned*)(KH + (DIR ? r - 32 : r) * SQ + kp * 4) = pk2(kh.x, kh.y); }
                if (ii & 1) __builtin_amdgcn_sched_barrier(0); }
        }
    }
    BAR_LDS(); SP_END(22);
    RawRegs<128> zbr; if (!RET && DIR == 0) raw_load<128>(X, H, m0, zbcol, zbr);
#pragma unroll
    for (int bi = 0; bi < 2; ++bi) { const int blk = 2 * X.wave + bi, I = blk >> 2, J = blk & 3; const int sI = DIR ? 3 - I : I, sJ = DIR ? 3 - J : J;
        v2u w; w.x = 0u; w.y = 0u;
        if (sJ <= sI) { const bool same = (sI >> 1) == (sJ >> 1); const lptr KS = same ? KD : KH; const int krow = same ? 16 * J + fr : (DIR ? 16 * J + fr - 32 : 16 * J + fr);
            f32x4 acc = (f32x4){0.f, 0.f, 0.f, 0.f};
#pragma unroll
            for (int ks = 0; ks < DK / 32; ++ks) { const bf16x8 a = ldsfrag(KS, krow, SQ, 32 * ks + 8 * fq); const bf16x8 bb = ldsfrag(Q0, 16 * I + fr, SQ, 32 * ks + 8 * fq); acc = MFMA16(a, bb, acc); }
            if (sI == sJ) {
#pragma unroll
                for (int j = 0; j < 4; ++j) { const int jl = 4 * fq + j; const bool keep = DIR ? (jl >= fr) : (jl <= fr); if (!keep) acc[j] = 0.f; } }
            w.x = pk2(acc[0], acc[1]); w.y = pk2(acc[2], acc[3]); }
        *(LAS v2u*)(AM + (16 * I + fr) * 144 + (16 * J + 4 * fq) * 2) = w; }
    BAR_LDS(); SP_END(23);
    {
        const int stb = DIR ? 3 - tb : tb; const int r = 16 * tb + fr;
#pragma unroll
        for (int ks = 0; ks < 2; ++ks) { const bf16x8 bb = ldsfrag(AM, r, 144, 32 * ks + 8 * fq);
#pragma unroll
            for (int vt = 0; vt < 4; ++vt) { const bf16x8 a = vtfrag(VT, 64 * vh + 16 * vt + fr, 144, 32 * ks + 8 * fq); o[vt] = MFMA16(a, bb, o[vt]); } }
        const lptr QI = (stb >> 1) ? Q1 : Q0; const int qrow = (stb >> 1) ? (DIR ? r : r - 32) : r;
#pragma unroll
        for (int ks = 0; ks < DK / 32; ++ks) { const bf16x8 bb = ldsfrag(QI, qrow, SQ, 32 * ks + 8 * fq);
#pragma unroll
            for (int vt = 0; vt < 4; ++vt) { const bf16x8 a = ldsfrag(ST, 64 * vh + 16 * vt + fr, 272, 32 * ks + 8 * fq); o[vt] = MFMA16(a, bb, o[vt]); } }
    }
    if (!RET && DIR == 0) raw_store<128>(X, X.lds + L::RAW, zbr);
    BAR_LDS(); SP_END(24);
}
template <bool RET> struct OutRegs { RawRegs<128> rv, rzf, rzb, rq; RawRegs<64> rq6, rk6; v2u gw[4]; };
template <bool RET> __device__ __forceinline__ void out_load(const Ctx& X, const bf16* H, int r, OutRegs<RET>& R) {
    const int b = r / 768, head = (r / 128) % 6, n = r % 128; const size_t m0 = (size_t)(b * SEQ + n * CH);
    const int fr = X.lane & 15, fq = X.lane >> 4, tb = X.wave & 3, vh = X.wave >> 2; const size_t m = m0 + 16 * tb + fr; const int gcol = (RET ? C_RG : C_HGG) + head * 128;
    raw_load<128>(X, H, m0, (RET ? C_RV : C_HGV) + head * 128, R.rv);
    if (!RET) { raw_load<128>(X, H, m0, C_ZF + head * 128, R.rzf); raw_load<128>(X, H, m0, C_HGQ + head * 128, R.rq); }
    else { raw_load<64>(X, H, m0, C_RQ + head * 64, R.rq6); raw_load<64>(X, H, m0, C_RK + head * 64, R.rk6); }
#pragma unroll
    for (int t = 0; t < 4; ++t) if (RET) R.gw[t] = *(const v2u*)hptr(H, m, gcol + 64 * vh + 16 * t + 4 * fq);
}
template <int DK, bool RET>
__device__ __forceinline__ void gla_out_item(const Ctx& X, const bf16* H, bf16* Y, int l, int r, OutRegs<RET>& R, bool has_next) {
    typedef L3<DK, RET> L;
    const int b = r / 768, head = (r / 128) % 6, n = r % 128;
    const float* LB = (const float*)(X.ws + WS_TAB);
    const unsigned char* St = (const unsigned char*)(X.ws + WS_SHG);
    const int fr = X.lane & 15, fq = X.lane >> 4, tb = X.wave & 3, vh = X.wave >> 2;
    const size_t m = (size_t)(b * SEQ + n * CH + 16 * tb + fr);
    const int ycol = (RET ? 768 : 0) + head * 128;
    SP_BEGIN()
    const int kp = X.tid & 63; f32x2v lb0 = (f32x2v){0.f, 0.f}, lb1 = lb0;
    v2u gw[4];
    if (!RET) {
        lb0 = *(const f32x2v*)(LB + (0 * 4 + l) * 768 + head * 128 + 2 * kp); lb1 = *(const f32x2v*)(LB + (1 * 4 + l) * 768 + head * 128 + 2 * kp);
        vt_store(X, X.lds + L::VT, R.rv); raw_store<128>(X, X.lds + L::RAW, R.rzf); raw_store<128>(X, X.lds + L::RAW + 16384, R.rq);
    } else {
        vt_store(X, X.lds + L::VT, R.rv); raw_store<64>(X, X.lds + L::RAW, R.rq6); raw_store<64>(X, X.lds + L::RAW + 8192, R.rk6);
    }
    asm volatile("" : "+v"(lb0), "+v"(lb1)); __builtin_amdgcn_sched_barrier(0);
    if (has_next) out_load<RET>(X, H, r + X.G, R);
    __builtin_amdgcn_sched_barrier(0);
    BAR_LDS(); SP_END(20);
    const int chain = (b * 6 + head) * 2;
    f32x4 o[4];
#pragma unroll
    for (int t = 0; t < 4; ++t) o[t] = (f32x4){0.f, 0.f, 0.f, 0.f};
    const size_t m0 = (size_t)(b * SEQ + n * CH);
    gla_out_dir<DK, RET, 0>(X, chain, n, lb0, St, o, H, m0, C_ZB + head * 128);
#pragma unroll
    for (int t = 0; t < 4; ++t) gw[t] = *(const v2u*)hptr(H, m, C_HGG + head * 128 + 64 * vh + 16 * t + 4 * fq);
    gla_out_dir<DK, RET, 1>(X, chain + 1, n, lb1, St, o, H, m0, 0);
    LAS float* red = (LAS float*)(X.lds + L::RED);
    float mu = 0.f;
    if (RET) {
        float s = 0.f;
#pragma unroll
        for (int t = 0; t < 4; ++t) s += (o[t][0] + o[t][1]) + (o[t][2] + o[t][3]);
        s += __shfl_xor(s, 16); s += __shfl_xor(s, 32);
        if (fq == 0) red[128 + X.wave * 16 + fr] = s;
        BAR_LDS();
        mu = (red[128 + X.wave * 16 + fr] + red[128 + (X.wave ^ 4) * 16 + fr]) * (1.0f / 128.0f);
    }
    float s2 = 0.f;
#pragma unroll
    for (int t = 0; t < 4; ++t)
#pragma unroll
        for (int j = 0; j < 4; ++j) { const float dlt = o[t][j] - mu; s2 += dlt * dlt; }
    s2 += __shfl_xor(s2, 16); s2 += __shfl_xor(s2, 32);
    if (fq == 0) red[X.wave * 16 + fr] = s2;
    BAR_LDS();
    const float rstd = __builtin_amdgcn_rsqf((red[X.wave * 16 + fr] + red[(X.wave ^ 4) * 16 + fr]) * (1.0f / 128.0f) + EPS);
    const float* gn = X.in(RET ? 10 : 9) + l * 768 + head * 128;
#pragma unroll
    for (int t = 0; t < 4; ++t) { const int v = 64 * vh + 16 * t + 4 * fq; const f32x4 g4 = *(const f32x4*)(gn + v);
        const float g0 = bf2f(gw[t].x & 0xffffu), g1 = bf2f(gw[t].x >> 16), g2 = bf2f(gw[t].y & 0xffffu), g3 = bf2f(gw[t].y >> 16);
        const float y0 = (o[t][0] - mu) * rstd * g4.x * (g0 * __builtin_amdgcn_rcpf(1.0f + __expf(-g0))), y1 = (o[t][1] - mu) * rstd * g4.y * (g1 * __builtin_amdgcn_rcpf(1.0f + __expf(-g1)));
        const float y2 = (o[t][2] - mu) * rstd * g4.z * (g2 * __builtin_amdgcn_rcpf(1.0f + __expf(-g2))), y3 = (o[t][3] - mu) * rstd * g4.w * (g3 * __builtin_amdgcn_rcpf(1.0f + __expf(-g3)));
        v2u w; w.x = pk2(y0, y1); w.y = pk2(y2, y3); *(LAS v2u*)(X.lds + L::Q0 + (16 * tb + fr) * 272 + v * 2) = w; }
    BAR_LDS();
    { const size_t mrow = (size_t)(b * SEQ + n * CH); int t_ = X.tid; asm volatile("" : "+v"(t_));
#pragma unroll
        for (int p = 0; p < 2; ++p) { const int idx = t_ + NTHR * p, row = idx >> 4, c8 = idx & 15; *(v4u*)(Y + (mrow + row) * D + ycol + 8 * c8) = *(const LAS v4u*)(X.lds + L::Q0 + row * 272 + c8 * 16); } }
    BAR_LDS();
}

constexpr int RCH = 128, RNCH = SEQ / RCH;
constexpr int R1_VT = 0, R1_KC0 = 128 * 144, R1_KC1 = R1_KC0 + 64 * 144, R1_RAW = R1_KC1 + 64 * 144, R1_END = R1_RAW + 32768;
__device__ __forceinline__ void ret_local_item(const Ctx& X, bf16* H, int it, LocRegs<true>& R, bool has_next) {
    const int b = it / 384, head = (it / 64) % 6, n = it % 64;
    bf16* St = (bf16*)(X.ws + WS_SRT); float* dd = (float*)(X.ws + WS_DRT);
    const lptr VT = X.lds + R1_VT, KC0 = X.lds + R1_KC0, KC1 = X.lds + R1_KC1, rawq = X.lds + R1_RAW, rawk = X.lds + R1_RAW + 8192; LAS float* cs = (LAS float*)(X.lds + R1_RAW + 16384); LAS float* sn = (LAS float*)(X.lds + R1_RAW + 24576);
    const float l2f = __log2f(1.0f - exp2f(-5.0f - (float)head)), l2b = __log2f(1.0f - exp2f(-5.0f - (float)(5 - head)));
    const int chain = (b * 6 + head) * 2;
    const int fr = X.lane & 15, fq = X.lane >> 4, rt = X.wave & 3, ct0 = (X.wave >> 2) * 4;
    const int k = X.tid & 63, rq = X.tid >> 6, k2 = k & 31; const bool active = X.tid < 256;
    f32x4 accf[4], accb[4];
#pragma unroll
    for (int t = 0; t < 4; ++t) { accf[t] = (f32x4){0.f, 0.f, 0.f, 0.f}; accb[t] = accf[t]; }
#pragma unroll 1
    for (int h = 0; h < 2; ++h) {
        const int r = 2 * it + h; const size_t m0 = (size_t)(b * SEQ + (2 * n + h) * 64);
        vt_store(X, VT, R.rv); raw_store<64>(X, rawq, R.rq); raw_store<64>(X, rawk, R.rk); *(LAS f32x4*)(cs + X.tid * 4) = R.c4; *(LAS f32x4*)(sn + X.tid * 4) = R.s4;
        __builtin_amdgcn_sched_barrier(0);
        { const int nr = h == 0 ? r + 1 : 2 * (it + X.G); if (h == 0 || has_next) loc_load<true>(X, H, nr, R); }
        __builtin_amdgcn_sched_barrier(0);
        BAR_LDS();
        float qr[16], kr[16];
        if (active) {
#pragma unroll
            for (int ii = 0; ii < 16; ++ii) { const int rr = 16 * rq + ii; const float c_ = cs[rr * 32 + k2], s_ = sn[rr * 32 + k2];
                const float q1 = bf2f(*(const LAS unsigned short*)(rawq + (rr * 64 + k2) * 2)), q2 = bf2f(*(const LAS unsigned short*)(rawq + (rr * 64 + 32 + k2) * 2));
                const float k1 = bf2f(*(const LAS unsigned short*)(rawk + (rr * 64 + k2) * 2)), k2v = bf2f(*(const LAS unsigned short*)(rawk + (rr * 64 + 32 + k2) * 2));
                qr[ii] = (k < 32) ? (q1 * c_ - q2 * s_) : (q1 * s_ + q2 * c_); kr[ii] = 0.125f * ((k < 32) ? (k1 * c_ - k2v * s_) : (k1 * s_ + k2v * c_)); } }
        BAR_LDS();
        if (active) {
            float ef[16], eb[16];
#pragma unroll
            for (int ii = 0; ii < 16; ++ii) { const int rr = 16 * rq + ii, tt = 64 * h + rr; *(LAS unsigned short*)(rawq + (rr * 64 + k) * 2) = f2bf(qr[ii]); *(LAS unsigned short*)(rawk + (rr * 64 + k) * 2) = f2bf(kr[ii]);
                ef[ii] = kr[ii] * __builtin_amdgcn_exp2f((float)(RCH - 1 - tt) * l2f); eb[ii] = kr[ii] * __builtin_amdgcn_exp2f((float)tt * l2b); }
            v4u w0, w1;
            w0.x = pk2(ef[0], ef[1]); w0.y = pk2(ef[2], ef[3]); w0.z = pk2(ef[4], ef[5]); w0.w = pk2(ef[6], ef[7]); w1.x = pk2(ef[8], ef[9]); w1.y = pk2(ef[10], ef[11]); w1.z = pk2(ef[12], ef[13]); w1.w = pk2(ef[14], ef[15]);
            *(LAS v4u*)(KC0 + k * 144 + rq * 32) = w0; *(LAS v4u*)(KC0 + k * 144 + rq * 32 + 16) = w1;
            w0.x = pk2(eb[0], eb[1]); w0.y = pk2(eb[2], eb[3]); w0.z = pk2(eb[4], eb[5]); w0.w = pk2(eb[6], eb[7]); w1.x = pk2(eb[8], eb[9]); w1.y = pk2(eb[10], eb[11]); w1.z = pk2(eb[12], eb[13]); w1.w = pk2(eb[14], eb[15]);
            *(LAS v4u*)(KC1 + k * 144 + rq * 32) = w0; *(LAS v4u*)(KC1 + k * 144 + rq * 32 + 16) = w1;
        }
        BAR_LDS();
        { const int rr = X.tid >> 3, c8 = X.tid & 7; *(v4u*)hptr(H, m0 + rr, C_RQ + head * 64 + 8 * c8) = *(const LAS v4u*)(rawq + X.tid * 16); *(v4u*)hptr(H, m0 + rr, C_RK + head * 64 + 8 * c8) = *(const LAS v4u*)(rawk + X.tid * 16); }
#pragma unroll
        for (int ks = 0; ks < 2; ++ks) { const bf16x8 af = ldsfrag(KC0, 16 * rt + fr, 144, 32 * ks + 8 * fq), ab = ldsfrag(KC1, 16 * rt + fr, 144, 32 * ks + 8 * fq);
#pragma unroll
            for (int t = 0; t < 4; ++t) { const bf16x8 bb = vtfrag(VT, 16 * (ct0 + t) + fr, 144, 32 * ks + 8 * fq); accf[t] = MFMA16(af, bb, accf[t]); accb[t] = MFMA16(ab, bb, accb[t]); } }
        BAR_LDS();
    }
#pragma unroll
    for (int t = 0; t < 4; ++t) { v2u w; w.x = pk2(accf[t][0], accf[t][1]); w.y = pk2(accf[t][2], accf[t][3]); *(LAS v2u*)(X.lds + R1_END + (16 * (ct0 + t) + fr) * 144 + (16 * rt + 4 * fq) * 2) = w;
        w.x = pk2(accb[t][0], accb[t][1]); w.y = pk2(accb[t][2], accb[t][3]); *(LAS v2u*)(X.lds + R1_END + 128 * 144 + (16 * (ct0 + t) + fr) * 144 + (16 * rt + 4 * fq) * 2) = w; }
    if (X.tid < 64) { dd[((size_t)chain * RNCH + n) * 64 + X.tid] = __builtin_amdgcn_exp2f((float)RCH * l2f); dd[((size_t)(chain + 1) * RNCH + n) * 64 + X.tid] = __builtin_amdgcn_exp2f((float)RCH * l2b); }
    BAR_LDS();
#pragma unroll
    for (int dir = 0; dir < 2; ++dir) { bf16* Sp = St + ((size_t)(chain + dir) * RNCH + n) * 128 * 64; const lptr UT = X.lds + R1_END + dir * 128 * 144;
#pragma unroll
        for (int p = 0; p < 2; ++p) { const int idx = X.tid + NTHR * p, row = idx >> 3, c8 = idx & 7; *(v4u*)(Sp + (size_t)row * 64 + 8 * c8) = *(const LAS v4u*)(UT + row * 144 + c8 * 16); } }
    BAR_LDS();
}
struct RetOutRegs { v4u q[2], k[2], v[4]; };
__device__ __forceinline__ void ret_out_load(const Ctx& X, const bf16* H, int it, RetOutRegs& R) {
    const int b = it / 384, head = (it / 64) % 6, n = it % 64; const size_t m0 = (size_t)(b * SEQ + n * RCH);
    const int fr = X.lane & 15, fq = X.lane >> 4, tbq = X.wave & 3, vh = X.wave >> 2;
#pragma unroll
    for (int p = 0; p < 2; ++p) { const int idx = X.tid + NTHR * p, row = idx >> 3, c8 = idx & 7; R.q[p] = *(const v4u*)hptr(H, m0 + row, C_RQ + head * 64 + 8 * c8); R.k[p] = *(const v4u*)hptr(H, m0 + row, C_RK + head * 64 + 8 * c8); }
#pragma unroll
    for (int p = 0; p < 4; ++p) { const int idx = X.tid + NTHR * p, row = idx >> 4, c8 = idx & 15; R.v[p] = *(const v4u*)hptr(H, m0 + row, C_RV + head * 128 + 8 * c8); }
}
constexpr int R3_Q = 0, R3_K = 128 * 144, R3_VT = 2 * 128 * 144, R3_AM = R3_VT + 128 * 272, R3_RED = R3_AM + 128 * 272, R3_END = R3_RED + 4096;
static_assert(R3_END <= PH_BYTES && R1_END + 2 * 128 * 144 <= PH_BYTES, "retention LDS maps");
__device__ __forceinline__ void ret_out_item(const Ctx& X, const bf16* H, bf16* Y, int l, int it, RetOutRegs& R, bool has_next) {
    const int b = it / 384, head = (it / 64) % 6, n = it % 64; const size_t m0 = (size_t)(b * SEQ + n * RCH);
    const bf16* St = (const bf16*)(X.ws + WS_SRT);
    const lptr Q = X.lds + R3_Q, K = X.lds + R3_K, VT = X.lds + R3_VT, AM = X.lds + R3_AM; LAS float* red = (LAS float*)(X.lds + R3_RED);
    const int fr = X.lane & 15, fq = X.lane >> 4, tbq = X.wave & 3, vh = X.wave >> 2; const int ycol = 768 + head * 128;
    const float l2f = __log2f(1.0f - exp2f(-5.0f - (float)head)), l2b = __log2f(1.0f - exp2f(-5.0f - (float)(5 - head)));
    const int chain = (b * 6 + head) * 2;
#pragma unroll
    for (int p = 0; p < 2; ++p) { const int idx = X.tid + NTHR * p, row = idx >> 3, c8 = idx & 7; *(LAS v4u*)(Q + row * 144 + c8 * 16) = R.q[p]; *(LAS v4u*)(K + row * 144 + c8 * 16) = R.k[p]; }
#pragma unroll
    for (int p = 0; p < 4; ++p) { const int idx = X.tid + NTHR * p, row = idx >> 4, c8 = idx & 15; const v4u w = R.v[p];
        LAS unsigned short* d = (LAS unsigned short*)(VT + (8 * c8) * 272 + (row ^ (8 * (c8 & 7))) * 2);
        d[0] = (unsigned short)w.x; d[136] = (unsigned short)(w.x >> 16); d[272] = (unsigned short)w.y; d[408] = (unsigned short)(w.y >> 16);
        d[544] = (unsigned short)w.z; d[680] = (unsigned short)(w.z >> 16); d[816] = (unsigned short)w.w; d[952] = (unsigned short)(w.w >> 16); }
    __builtin_amdgcn_sched_barrier(0);
    if (has_next) ret_out_load(X, H, it + X.G, R);
    bf16x8 sff[2][4], sfb[2][4];
    { const bf16* Sf = St + ((size_t)chain * RNCH + n) * 128 * 64; const bf16* Sb = St + ((size_t)(chain + 1) * RNCH + n) * 128 * 64;
#pragma unroll
        for (int ks = 0; ks < 2; ++ks)
#pragma unroll
            for (int vt = 0; vt < 4; ++vt) { const size_t o_ = (size_t)(64 * vh + 16 * vt + fr) * 64 + 32 * ks + 8 * fq; sff[ks][vt] = *(const bf16x8*)(Sf + o_); sfb[ks][vt] = *(const bf16x8*)(Sb + o_); } }
    __builtin_amdgcn_sched_barrier(0);
    BAR_LDS();
#pragma unroll 1
    for (int J = 0; J < 8; ++J) { const int I = X.wave;
        f32x4 acc = (f32x4){0.f, 0.f, 0.f, 0.f};
#pragma unroll
        for (int ks = 0; ks < 2; ++ks) { const bf16x8 a = ldsfrag(K, 16 * J + fr, 144, 32 * ks + 8 * fq); const bf16x8 bb = ldsfrag(Q, 16 * I + fr, 144, 32 * ks + 8 * fq); acc = MFMA16(a, bb, acc); }
#pragma unroll
        for (int j = 0; j < 4; ++j) { const int d = (16 * I + fr) - (16 * J + 4 * fq + j); const float dec = d > 0 ? __builtin_amdgcn_exp2f((float)d * l2f) : (d < 0 ? __builtin_amdgcn_exp2f((float)(-d) * l2b) : 2.0f); acc[j] *= dec; }
        v2u w; w.x = pk2(acc[0], acc[1]); w.y = pk2(acc[2], acc[3]); *(LAS v2u*)(AM + (16 * I + fr) * 272 + (16 * J + 4 * fq) * 2) = w; }
    BAR_LDS();
    const float* gn = X.in(10) + l * 768 + head * 128;
    v2u gw[2][4];
#pragma unroll
    for (int ps = 0; ps < 2; ++ps)
#pragma unroll
        for (int t = 0; t < 4; ++t) gw[ps][t] = *(const v2u*)hptr(H, m0 + 16 * (tbq + 4 * ps) + fr, C_RG + head * 128 + 64 * vh + 16 * t + 4 * fq);
#pragma unroll
    for (int ps = 0; ps < 2; ++ps) { const int tok = 16 * (tbq + 4 * ps) + fr; f32x4 o[4];
#pragma unroll
        for (int t = 0; t < 4; ++t) o[t] = (f32x4){0.f, 0.f, 0.f, 0.f};
#pragma unroll
        for (int ks = 0; ks < 4; ++ks) { const bf16x8 bb = ldsfrag(AM, tok, 272, 32 * ks + 8 * fq);
#pragma unroll
            for (int vt = 0; vt < 4; ++vt) { const bf16x8 a = vtfrag(VT, 64 * vh + 16 * vt + fr, 272, 32 * ks + 8 * fq); o[vt] = MFMA16(a, bb, o[vt]); } }
        const bf16x8 bq0 = ldsfrag(Q, tok, 144, 8 * fq), bq1 = ldsfrag(Q, tok, 144, 32 + 8 * fq);
        const float cf = __builtin_amdgcn_exp2f((float)(tok + 1) * l2f), cb = __builtin_amdgcn_exp2f((float)(RCH - tok) * l2b);
        {
            f32x4 tf[4];
#pragma unroll
            for (int vt = 0; vt < 4; ++vt) { tf[vt] = MFMA16(sff[0][vt], bq0, ((f32x4){0.f, 0.f, 0.f, 0.f})); tf[vt] = MFMA16(sff[1][vt], bq1, tf[vt]); }
#pragma unroll
            for (int t = 0; t < 4; ++t) o[t] = o[t] + tf[t] * cf;
#pragma unroll
            for (int vt = 0; vt < 4; ++vt) { tf[vt] = MFMA16(sfb[0][vt], bq0, ((f32x4){0.f, 0.f, 0.f, 0.f})); tf[vt] = MFMA16(sfb[1][vt], bq1, tf[vt]); }
#pragma unroll
            for (int t = 0; t < 4; ++t) o[t] = o[t] + tf[t] * cb;
        }
        float s_ = 0.f;
#pragma unroll
        for (int t = 0; t < 4; ++t) s_ += (o[t][0] + o[t][1]) + (o[t][2] + o[t][3]);
        s_ += __shfl_xor(s_, 16); s_ += __shfl_xor(s_, 32);
        if (fq == 0) red[512 + (ps * 8 + X.wave) * 16 + fr] = s_;
        BAR_LDS();
        const float mu = (red[512 + (ps * 8 + X.wave) * 16 + fr] + red[512 + (ps * 8 + (X.wave ^ 4)) * 16 + fr]) * (1.0f / 128.0f); float s2 = 0.f;
#pragma unroll
        for (int t = 0; t < 4; ++t)
#pragma unroll
            for (int j = 0; j < 4; ++j) { const float dlt = o[t][j] - mu; s2 += dlt * dlt; }
        s2 += __shfl_xor(s2, 16); s2 += __shfl_xor(s2, 32);
        if (fq == 0) red[(ps * 8 + X.wave) * 16 + fr] = s2;
        BAR_LDS();
        const float rstd = __builtin_amdgcn_rsqf((red[(ps * 8 + X.wave) * 16 + fr] + red[(ps * 8 + (X.wave ^ 4)) * 16 + fr]) * (1.0f / 128.0f) + EPS);
#pragma unroll
        for (int t = 0; t < 4; ++t) { const int v = 64 * vh + 16 * t + 4 * fq; const f32x4 g4 = *(const f32x4*)(gn + v);
            const float g0 = bf2f(gw[ps][t].x & 0xffffu), g1 = bf2f(gw[ps][t].x >> 16), g2 = bf2f(gw[ps][t].y & 0xffffu), g3 = bf2f(gw[ps][t].y >> 16);
            const float y0 = (o[t][0] - mu) * rstd * g4.x * (g0 * __builtin_amdgcn_rcpf(1.0f + __expf(-g0))), y1 = (o[t][1] - mu) * rstd * g4.y * (g1 * __builtin_amdgcn_rcpf(1.0f + __expf(-g1)));
            const float y2 = (o[t][2] - mu) * rstd * g4.z * (g2 * __builtin_amdgcn_rcpf(1.0f + __expf(-g2))), y3 = (o[t][3] - mu) * rstd * g4.w * (g3 * __builtin_amdgcn_rcpf(1.0f + __expf(-g3)));
            v2u w; w.x = pk2(y0, y1); w.y = pk2(y2, y3); *(LAS v2u*)(AM + tok * 272 + v * 2) = w; } }
    BAR_LDS();
#pragma unroll
    for (int p = 0; p < 4; ++p) { const int idx = X.tid + NTHR * p, row = idx >> 4, c8 = idx & 15; *(v4u*)(Y + (m0 + row) * D + ycol + 8 * c8) = *(const LAS v4u*)(AM + row * 272 + c8 * 16); }
    BAR_LDS();
}

template <bool F8> struct ScanVec { typedef v4u T; };
template <> struct ScanVec<true> { typedef v2u T; };
template <int KW, int NC, bool F8, bool LOAD> __device__ __forceinline__ void scan_oct(lptr DT, unsigned char* p, int dir, int koff, int s0, typename ScanVec<F8>::T (&u)[8], float (&S)[8]) {
    typedef typename ScanVec<F8>::T V; constexpr int CS = 128 * KW * (F8 ? 1 : 2);
#pragma unroll
    for (int j = 0; j < 8; ++j) { const int s = s0 + j, n = dir ? NC - 1 - s : s;
        const f32x4 d0 = *(const LAS f32x4*)(DT + (n * KW + koff) * 4), d1 = *(const LAS f32x4*)(DT + (n * KW + koff) * 4 + 16);
        V uu = u[j]; asm volatile("" : "+v"(uu));
        float f[8];
        if constexpr (F8) { *(V*)(p + (size_t)n * CS) = (V){pk4f8(S[0], S[1], S[2], S[3]), pk4f8(S[4], S[5], S[6], S[7])};
            const f32x2v a = f8lo(uu.x), b = f8hi(uu.x), c = f8lo(uu.y), d = f8hi(uu.y); f[0] = a.x; f[1] = a.y; f[2] = b.x; f[3] = b.y; f[4] = c.x; f[5] = c.y; f[6] = d.x; f[7] = d.y; }
        else { V w; w.x = pk2(S[0], S[1]); w.y = pk2(S[2], S[3]); w.z = pk2(S[4], S[5]); w.w = pk2(S[6], S[7]); *(V*)(p + (size_t)n * CS) = w;
            f[0] = bf2f(uu.x & 0xffffu); f[1] = bf2f(uu.x >> 16); f[2] = bf2f(uu.y & 0xffffu); f[3] = bf2f(uu.y >> 16); f[4] = bf2f(uu.z & 0xffffu); f[5] = bf2f(uu.z >> 16); f[6] = bf2f(uu.w & 0xffffu); f[7] = bf2f(uu.w >> 16); }
        S[0] = d0.x * S[0] + f[0]; S[1] = d0.y * S[1] + f[1]; S[2] = d0.z * S[2] + f[2]; S[3] = d0.w * S[3] + f[3];
        S[4] = d1.x * S[4] + f[4]; S[5] = d1.y * S[5] + f[5]; S[6] = d1.z * S[6] + f[6]; S[7] = d1.w * S[7] + f[7];
        asm volatile("" ::: "memory"); __builtin_amdgcn_sched_barrier(0);
        if (LOAD) u[j] = *(const V*)(p + (size_t)(dir ? n - 8 : n + 8) * CS);
        asm volatile("" ::: "memory"); __builtin_amdgcn_sched_barrier(0); }
}
template <int KW, int NC, bool F8> __device__ __forceinline__ void scan_chain(const Ctx& X, unsigned char* p, const float* dp, int dir, int koff) {
    typedef typename ScanVec<F8>::T V; constexpr int CS = 128 * KW * (F8 ? 1 : 2); const lptr DT = X.lds;
    V u[8];
#pragma unroll
    for (int j = 0; j < 8; ++j) u[j] = *(const V*)(p + (size_t)(dir ? NC - 1 - j : j) * CS);
    BAR_LDS();
#pragma unroll
    for (int i = 0; i < NC * KW / 4 / NTHR; ++i) *(LAS f32x4*)(DT + (X.tid + NTHR * i) * 16) = *(const f32x4*)(dp + (size_t)(X.tid + NTHR * i) * 4);
    BAR_LDS();
    float S[8];
#pragma unroll
    for (int i = 0; i < 8; ++i) S[i] = 0.f;
#pragma unroll 1
    for (int s0 = 0; s0 < NC - 8; s0 += 8) scan_oct<KW, NC, F8, true>(DT, p, dir, koff, s0, u, S);
    scan_oct<KW, NC, F8, false>(DT, p, dir, koff, NC - 8, u, S);
}
constexpr int SCAN_WHG = 24 * 4, SCAN_WRT = 24 * 2, SCAN_WG = SCAN_WHG + SCAN_WRT;
__device__ __forceinline__ void scan_phase(const Ctx& X) {
    for (int w = X.bid; w < SCAN_WG; w += X.G) {
        if (w < SCAN_WHG) { const int chain = w >> 2, e = (w & 3) * NTHR + X.tid;
            scan_chain<128, NCH, true>(X, X.ws + WS_SHG + (size_t)chain * NCH * 16384 + e * 8, (const float*)(X.ws + WS_DHG) + (size_t)chain * NCH * 128, chain & 1, (e & 15) * 8); }
        else { const int w2 = w - SCAN_WHG, chain = w2 >> 1, e = (w2 & 1) * NTHR + X.tid;
            scan_chain<64, RNCH, false>(X, X.ws + WS_SRT + ((size_t)chain * RNCH * 8192 + e * 8) * 2, (const float*)(X.ws + WS_DRT) + (size_t)chain * RNCH * 64, chain & 1, (e & 7) * 8); }
    }
}

constexpr int DA_KN = 0, DA_VT = 192 * 272, DA_P = DA_VT + 128 * 400, DA_BIAS = DA_P + 64 * 400, DA_MX = DA_BIAS + 1024, DA_LX = DA_MX + 1024, DA_END = DA_LX + 1024;
static_assert(DA_END <= PH_BYTES, "dilated-attention LDS map");
struct DaBlk { v4u kw[2], vw[2]; };
struct DaRun { int b, g, slot, dil, rho, nb0, dn, nbper, qcol; };
__device__ __forceinline__ DaRun da_decode(int run) {
    DaRun I; I.b = run / 384; const int rem = run % 384; I.g = rem / 128; const int rem2 = rem % 128; I.slot = rem2 / 32; const int rb = rem2 % 32;
    I.dil = I.g == 0 ? 1 : (I.g == 1 ? 4 : 16); I.nbper = 128 / I.dil; const int rpr = I.nbper / 4; I.rho = rb / rpr; const int rr = rb % rpr; I.dn = (rr & 1) ? -1 : 1; I.nb0 = 4 * rr + ((rr & 1) ? 3 : 0); I.qcol = C_DIL + (3 * I.g) * 512 + I.slot * 128; return I;
}
__device__ __forceinline__ void da_blk_load(const Ctx& X, const bf16* H, const DaRun& I, int kb, DaBlk& R) {
    const bool ok = kb >= 0 && kb < I.nbper; const size_t mb = (size_t)I.b * SEQ; const int kcol = I.qcol + 512, vcol = I.qcol + 1024;
#pragma unroll
    for (int p = 0; p < 2; ++p) { const int r = (X.tid >> 4) + 32 * p, c8 = X.tid & 15; R.kw[p] = (v4u){0u, 0u, 0u, 0u}; R.vw[p] = (v4u){0u, 0u, 0u, 0u};
        if (ok) { const size_t mr = mb + (size_t)(I.rho * (SEQ / I.dil) + 64 * kb + r); R.kw[p] = *(const v4u*)hptr(H, mr, kcol + 8 * c8); R.vw[p] = *(const v4u*)hptr(H, mr, vcol + 8 * c8); } }
}
__device__ __forceinline__ void da_blk_stage(const Ctx& X, const f32x4 g0, const f32x4 g1, int kb, const DaBlk& R) {
    const lptr KN = X.lds + DA_KN, VT = X.lds + DA_VT; const int slot = ((kb % 3) + 3) % 3;
#pragma unroll
    for (int p = 0; p < 2; ++p) { const int row = slot * 64 + (X.tid >> 4) + 32 * p, c8 = X.tid & 15; const v4u kw = R.kw[p], vw = R.vw[p];
        float f[8]; f[0] = bf2f(kw.x & 0xffffu); f[1] = bf2f(kw.x >> 16); f[2] = bf2f(kw.y & 0xffffu); f[3] = bf2f(kw.y >> 16); f[4] = bf2f(kw.z & 0xffffu); f[5] = bf2f(kw.z >> 16); f[6] = bf2f(kw.w & 0xffffu); f[7] = bf2f(kw.w >> 16);
        float s = 0.f;
#pragma unroll
        for (int e = 0; e < 8; ++e) s += f[e] * f[e];
        s += __shfl_xor(s, 1); s += __shfl_xor(s, 2); s += __shfl_xor(s, 4); s += __shfl_xor(s, 8);
        const float sc = __builtin_amdgcn_rsqf(s * (1.0f / 128.0f) + EPS);
        v4u o; o.x = pk2(f[0] * sc * g0.x, f[1] * sc * g0.y); o.y = pk2(f[2] * sc * g0.z, f[3] * sc * g0.w); o.z = pk2(f[4] * sc * g1.x, f[5] * sc * g1.y); o.w = pk2(f[6] * sc * g1.z, f[7] * sc * g1.w);
        *(LAS v4u*)(KN + row * 272 + c8 * 16) = o;
        LAS unsigned short* d = (LAS unsigned short*)(VT + (8 * c8) * 400 + (row ^ (8 * (c8 & 7))) * 2);
        d[0] = (unsigned short)vw.x; d[200] = (unsigned short)(vw.x >> 16); d[400] = (unsigned short)vw.y; d[600] = (unsigned short)(vw.y >> 16);
        d[800] = (unsigned short)vw.z; d[1000] = (unsigned short)(vw.z >> 16); d[1200] = (unsigned short)vw.w; d[1400] = (unsigned short)(vw.w >> 16); }
}
__device__ __forceinline__ void da_q_load(const Ctx& X, const bf16* H, const DaRun& I, int nb, v4u (&qw)[2][4]) {
    const int fr = X.lane & 15, fq = X.lane >> 4, qh = X.wave & 1;
#pragma unroll
    for (int u = 0; u < 2; ++u) { const size_t m = (size_t)I.b * SEQ + (size_t)(I.rho * (SEQ / I.dil) + 64 * nb + 32 * qh + 16 * u + fr);
#pragma unroll
        for (int ks = 0; ks < 4; ++ks) qw[u][ks] = *(const v4u*)hptr(H, m, I.qcol + 32 * ks + 8 * fq); }
}
__device__ __forceinline__ void dil_run(const Ctx& X, bf16* H, int l, int run) {
    const DaRun I = da_decode(run); const int b = I.b, g = I.g, slot = I.slot, dil = I.dil, rho = I.rho, qcol = I.qcol, Ls = SEQ / I.dil;
    const lptr KN = X.lds + DA_KN, VT = X.lds + DA_VT, P = X.lds + DA_P; LAS float* bias = (LAS float*)(X.lds + DA_BIAS); LAS float* mx = (LAS float*)(X.lds + DA_MX); LAS float* lx = (LAS float*)(X.lds + DA_LX);
    const float* qg = X.in(11) + l * 128; const float* kg = X.in(12) + l * 128; asm volatile("" : "+s"(qg), "+s"(kg));
    const f32x4 kg0 = *(const f32x4*)(kg + 8 * (X.tid & 15)), kg1 = *(const f32x4*)(kg + 8 * (X.tid & 15) + 4);
    LAS float* qgl = mx;
    if (X.tid < 128) qgl[X.tid] = qg[X.tid];
    const int fr = X.lane & 15, fq = X.lane >> 4, qb = X.wave & 3, kh = X.wave >> 2; const int qi = 16 * qb + fr;
    const float mshift = ((const float*)(X.ws + WS_TAB) + 2 * 4 * 768 + 3 * 4 * 132)[l];
    SP_BEGIN()
    {
        DaBlk B0, B1, B2; da_blk_load(X, H, I, I.nb0 - 1, B0); da_blk_load(X, H, I, I.nb0, B1); da_blk_load(X, H, I, I.nb0 + 1, B2);
        if (X.tid < 256) bias[X.tid] = (X.tid >= 63 && X.tid <= 191) ? ((const float*)(X.ws + WS_TAB) + 2 * 4 * 768)[(g * 4 + slot) * 132 + X.tid - 63] - mshift : -1e30f;
        da_blk_stage(X, kg0, kg1, I.nb0 - 1, B0); da_blk_stage(X, kg0, kg1, I.nb0, B1); da_blk_stage(X, kg0, kg1, I.nb0 + 1, B2);
    }
    v4u qw_[2][4]; da_q_load(X, H, I, I.nb0, qw_);
    BAR_LDS();
    const int qh = X.wave & 1, kq = X.wave >> 1;
    for (int i = 0; i < 4; ++i) {
        const int nb = I.nb0 + I.dn * i; const size_t qtok = (size_t)((64 * nb + qi) * dil + rho);
        bf16x8 qf[2][4];
#pragma unroll
        for (int u = 0; u < 2; ++u) {
            float s = 0.f;
#pragma unroll
            for (int ks = 0; ks < 4; ++ks) { const v4u qw = qw_[u][ks];
                const float a0 = bf2f(qw.x & 0xffffu), a1 = bf2f(qw.x >> 16), a2 = bf2f(qw.y & 0xffffu), a3 = bf2f(qw.y >> 16), a4 = bf2f(qw.z & 0xffffu), a5 = bf2f(qw.z >> 16), a6 = bf2f(qw.w & 0xffffu), a7 = bf2f(qw.w >> 16);
                s += (a0 * a0 + a1 * a1) + (a2 * a2 + a3 * a3) + (a4 * a4 + a5 * a5) + (a6 * a6 + a7 * a7); }
            s += __shfl_xor(s, 16); s += __shfl_xor(s, 32);
            const float sc = (0.08838834764831845f * 1.4426950408889634f) * __builtin_amdgcn_rsqf(s * (1.0f / 128.0f) + EPS);
#pragma unroll
            for (int ks = 0; ks < 4; ++ks) { const v4u qw = qw_[u][ks]; const f32x4 g0 = *(const LAS f32x4*)(qgl + 32 * ks + 8 * fq), g1 = *(const LAS f32x4*)(qgl + 32 * ks + 8 * fq + 4);
                v4u o; o.x = pk2(bf2f(qw.x & 0xffffu) * sc * g0.x, bf2f(qw.x >> 16) * sc * g0.y); o.y = pk2(bf2f(qw.y & 0xffffu) * sc * g0.z, bf2f(qw.y >> 16) * sc * g0.w);
                o.z = pk2(bf2f(qw.z & 0xffffu) * sc * g1.x, bf2f(qw.z >> 16) * sc * g1.y); o.w = pk2(bf2f(qw.w & 0xffffu) * sc * g1.z, bf2f(qw.w >> 16) * sc * g1.w);
                qf[u][ks] = __builtin_bit_cast(bf16x8, o); }
        }
        asm volatile("" : "+v"(qf[0][0]), "+v"(qf[0][1]), "+v"(qf[0][2]), "+v"(qf[0][3]), "+v"(qf[1][0]), "+v"(qf[1][1]), "+v"(qf[1][2]), "+v"(qf[1][3]));
        __builtin_amdgcn_sched_barrier(0);
        DaBlk Bn; if (i < 3) { da_blk_load(X, H, I, nb + 2 * I.dn, Bn); da_q_load(X, H, I, nb + I.dn, qw_); }
        __builtin_amdgcn_sched_barrier(0);
        BAR_LDS(); SP_END(16);
        float lloc[2] = {0.f, 0.f};
        const LAS float* tb = bias + (48 * kq + 4 * fq - (32 * qh + fr) + 63);
        const bool edge_lo = nb == 0, edge_hi = nb == I.nbper - 1;
#pragma unroll
        for (int t = 0; t < 3; ++t) { f32x4 acc[2] = {(f32x4){0.f, 0.f, 0.f, 0.f}, (f32x4){0.f, 0.f, 0.f, 0.f}}; const int rrow = (64 * nb + 128 + 48 * kq + 16 * t) % 192;
#pragma unroll
            for (int ks = 0; ks < 4; ++ks) { const bf16x8 a = ldsfrag(KN, rrow + fr, 272, 32 * ks + 8 * fq); acc[0] = MFMA16(a, qf[0][ks], acc[0]); acc[1] = MFMA16(a, qf[1][ks], acc[1]); }
#pragma unroll
            for (int u = 0; u < 2; ++u) { float p[4];
#pragma unroll
                for (int j = 0; j < 4; ++j) acc[u][j] += tb[16 * t + j - 16 * u];
                if (edge_lo || edge_hi) {
#pragma unroll
                    for (int j = 0; j < 4; ++j) { const int kj = 64 * nb - 64 + 48 * kq + 16 * t + 4 * fq + j; if (kj < 0 || kj >= Ls) acc[u][j] = -1e30f; } }
#pragma unroll
                for (int j = 0; j < 4; ++j) { p[j] = __builtin_amdgcn_exp2f(acc[u][j]); lloc[u] += p[j]; }
                v2u w; w.x = pk2(p[0], p[1]); w.y = pk2(p[2], p[3]); *(LAS v2u*)(P + (32 * qh + 16 * u + fr) * 400 + (48 * kq + 16 * t + 4 * fq) * 2) = w; } }
        SP_END(17);
#pragma unroll
        for (int u = 0; u < 2; ++u) { lloc[u] += __shfl_xor(lloc[u], 16); lloc[u] += __shfl_xor(lloc[u], 32); if (fq == 0) lx[kq * 64 + 32 * qh + 16 * u + fr] = lloc[u]; }
        BAR_LDS(); SP_END(18);
        const int dh = kh; const float lrow = (lx[qi] + lx[64 + qi]) + (lx[128 + qi] + lx[192 + qi]); const float inv = __builtin_amdgcn_rcpf(lrow);
        f32x4 oo[4];
#pragma unroll
        for (int t = 0; t < 4; ++t) oo[t] = (f32x4){0.f, 0.f, 0.f, 0.f};
#pragma unroll
        for (int ks = 0; ks < 6; ++ks) { const bf16x8 bb = ldsfrag(P, qi, 400, 32 * ks + 8 * fq); const int rcol = (64 * nb + 128 + 32 * ks) % 192;
#pragma unroll
            for (int t = 0; t < 4; ++t) { const bf16x8 a = vtfrag(VT, 64 * dh + 16 * t + fr, 400, rcol + 8 * fq); oo[t] = MFMA16(a, bb, oo[t]); } }
        BAR_LDS();
#pragma unroll
        for (int t = 0; t < 4; ++t) { v2u w; w.x = pk2(oo[t][0] * inv, oo[t][1] * inv); w.y = pk2(oo[t][2] * inv, oo[t][3] * inv); *(LAS v2u*)(P + qi * 272 + (64 * dh + 16 * t + 4 * fq) * 2) = w; }
        if (dh == 0 && fq == 0) ((float*)(X.ws + WS_LSE))[((size_t)g * M + (size_t)b * SEQ + qtok) * 4 + slot] = 0.6931471805599453f * (mshift + __log2f(lrow));
        BAR_LDS(); SP_END(19);
#pragma unroll
        for (int p = 0; p < 2; ++p) { const int idx = X.tid + NTHR * p, row = idx >> 4, c8 = idx & 15; *(v4u*)hptr(H, (size_t)b * SEQ + (size_t)(rho * Ls + 64 * nb + row), qcol + 8 * c8) = *(const LAS v4u*)(P + row * 272 + c8 * 16); }
        if (i < 3) da_blk_stage(X, kg0, kg1, nb + 2 * I.dn, Bn);
    }
    BAR_LDS();
}
__device__ __forceinline__ void dil_merge_units(const Ctx& X, const bf16* H, bf16* Y, int u0, int u1) {
    const float* LSE = (const float*)(X.ws + WS_LSE);
    for (int ub = u0; ub < u1; ub += 4)
#pragma unroll
    for (int p = 0; p < 4; ++p) { const int un = min(ub + p, u1 - 1); const int slot = (X.tid >> 4) & 3, c8 = X.tid & 15; const size_t m = (size_t)un * 8 + (X.tid >> 6);
        const float l0 = LSE[(0 * (size_t)M + m) * 4 + slot], l1 = LSE[(1 * (size_t)M + m) * 4 + slot], l2 = LSE[(2 * (size_t)M + m) * 4 + slot]; const float mxl = fmaxf(l0, fmaxf(l1, l2));
        const float e0 = __expf(l0 - mxl), e1 = __expf(l1 - mxl), e2 = __expf(l2 - mxl), inv = __builtin_amdgcn_rcpf(e0 + e1 + e2); const float w[3] = {e0 * inv, e1 * inv, e2 * inv};
        float acc[8];
#pragma unroll
        for (int e = 0; e < 8; ++e) acc[e] = 0.f;
#pragma unroll
        for (int g = 0; g < 3; ++g) { const int sh = 2 * g, t = (int)(m & 8191); const size_t pm = (m & ~(size_t)8191) + (size_t)(((t & ((1 << sh) - 1)) << (13 - sh)) + (t >> sh));
            const v4u ow = *(const v4u*)hptr(H, pm, C_DIL + (3 * g) * 512 + slot * 128 + 8 * c8);
            acc[0] += w[g] * bf2f(ow.x & 0xffffu); acc[1] += w[g] * bf2f(ow.x >> 16); acc[2] += w[g] * bf2f(ow.y & 0xffffu); acc[3] += w[g] * bf2f(ow.y >> 16);
            acc[4] += w[g] * bf2f(ow.z & 0xffffu); acc[5] += w[g] * bf2f(ow.z >> 16); acc[6] += w[g] * bf2f(ow.w & 0xffffu); acc[7] += w[g] * bf2f(ow.w >> 16); }
        v4u o; o.x = pk2(acc[0], acc[1]); o.y = pk2(acc[2], acc[3]); o.z = pk2(acc[4], acc[5]); o.w = pk2(acc[6], acc[7]);
        *(v4u*)(Y + m * D + 1536 + slot * 128 + 8 * c8) = o; }
}

#ifndef MK_N_LAUNCHES
#define MK_N_LAUNCHES 1
#endif
__global__ void __launch_bounds__(NTHR, 2) mega_fwd(Args args) {
    extern __shared__ __attribute__((aligned(16))) unsigned char lds_raw[];
    const lptr lds = (lptr)lds_raw;
    volatile LAS unsigned* MISC = (volatile LAS unsigned*)(lds + MISC_OFF);
    for (int u = threadIdx.x; u < (LDS_BYTES - LDSCTL_OFF) / 4; u += NTHR) ((LAS unsigned*)(lds + LDSCTL_OFF))[u] = 0u;
    __syncthreads();
    XcdBarrier bar; bar.bar = (unsigned*)(args.ws + WS_CTL) + CW_BAR; bar.x = 0; bar.st = nullptr;
    if (MK_N_LAUNCHES == 1) bar = xcd_barrier_post((unsigned*)(args.ws + WS_CTL) + CW_BAR, MISC + 8);
    const int lo = args.ph_lo, hi = args.ph_hi;
#ifndef PROBE_K
#define PROBE_K 1
#endif
#define PB_BEGIN(bit) unsigned long long pt0_ = 0; if (PROBE_MASK & (1 << (bit))) pt0_ = __builtin_amdgcn_s_memrealtime();
#define PB_END(bit) if ((PROBE_MASK & (1 << 15)) && ((226 >> (bit)) & 1)) { const unsigned long long t1_ = __builtin_amdgcn_s_memrealtime(); while (__builtin_amdgcn_s_memrealtime() - t1_ < 10000ull) __builtin_amdgcn_s_sleep(8); } \
    if (PROBE_MASK & (1 << (bit))) { const unsigned long long t1_ = __builtin_amdgcn_s_memrealtime(), dt_ = (t1_ - pt0_) * PROBE_K; while (__builtin_amdgcn_s_memrealtime() - t1_ < dt_) __builtin_amdgcn_s_sleep(8); }
#define IN(k) (lo <= (k) && (k) < hi)
#define SEAM(k) do { if (IN(k) && IN((k) + 1)) { xcd_barrier(bar); if (PROBE_MASK & (1 << 14)) xcd_barrier(bar); } } while (0)
#define PHASE_CTX() const Ctx X = mkctx(lds); bf16* const XB = (bf16*)(X.ws + WS_XB); bf16* const Y = (bf16*)(X.ws + WS_Y); bf16* const H = (bf16*)(X.ws + WS_H); float* const ss_mix = (float*)(X.ws + WS_PART); \
        float* const ss_mix_next = ss_mix; float* const ss_mlp = ss_mix + (size_t)M * 32; (void)XB; (void)Y; (void)H; (void)ss_mix; (void)ss_mix_next; (void)ss_mlp;

    #ifndef NO_PRO
    if (IN(0)) { PB_BEGIN(0) const Ctx X = mkctx(lds); prologue(X); PB_END(0) }
#endif
    SEAM(0);
    for (int l = 0; l < DEPTH; ++l) {
        const int pb = 1 + 7 * l;
#if !defined(NO_GEMM) && !defined(NO_GA)
        if (IN(pb + 0)) { PB_BEGIN(1) PHASE_CTX(); pg8::Gemm g{XB, (const bf16*)(X.ws + WS_WIN) + (size_t)l * INW * D, M, INW, D}; pg8::StaticOrder S; S.init(M, INW, X.G, X.bid);
            pg8::EpiScaleBf16<0, true, true> E{H, M, ss_mix, (LAS float*)(X.lds + 131072)}; pg8::gemm_phase<pg8::EpiScaleBf16<0, true, true>, pg8::StaticOrder, true, true>(X.lds, g, S, E);
            if (X.G == 256 && X.bid >= 128) {
                LAS float* scr = (LAS float*)(X.lds + X.wave * TR_SCR);
                for (int r = I_L - TAILQ + (X.bid - 128) * NWAVES + X.wave; r < I_L; r += 128 * NWAVES) convert_item(X, l, r, scr); }
            PB_END(1) }
#endif
        SEAM(pb + 0);
#ifndef NO_MIX1
        if (IN(pb + 1)) { PB_BEGIN(2)
#ifndef NO_DA
            { PB_BEGIN(8) PHASE_CTX(); const int vcu = (X.G % 8 == 0) ? (X.bid % 8) * (X.G / 8) + X.bid / 8 : X.bid;
              for (int run = vcu; run < 768; run += X.G) dil_run(X, H, l, run); PB_END(8) }
#endif
#ifndef NO_HG1
            { PB_BEGIN(9) PHASE_CTX(); LocRegs<false> R; loc_load<false>(X, H, X.bid, R); for (int r = X.bid; r < 1536; r += X.G) gla_local_item<128, false>(X, H, l, r, R, r + X.G < 1536); PB_END(9) }
#endif
#ifndef NO_RT1
            { PB_BEGIN(10) PHASE_CTX(); LocRegs<true> R; loc_load<true>(X, H, 2 * X.bid, R); for (int it = X.bid; it < 768; it += X.G) ret_local_item(X, H, it, R, it + X.G < 768); PB_END(10) }
#endif
        PB_END(2) }
#endif
        SEAM(pb + 1);
#ifndef NO_SCAN
        if (IN(pb + 2)) { PB_BEGIN(3) const Ctx X = mkctx(lds); scan_phase(X); PB_END(3) }
#endif
#ifndef NO_DM
        if (IN(pb + 2)) { PHASE_CTX();
            constexpr int NU = M / 8;
            if (X.G > SCAN_WG + 16) { const int nw = X.G - SCAN_WG, i = X.bid - SCAN_WG; if (i >= 0) dil_merge_units(X, H, Y, (int)((long long)i * NU / nw), (int)((long long)(i + 1) * NU / nw)); }
            else dil_merge_units(X, H, Y, (int)((long long)X.bid * NU / X.G), (int)((long long)(X.bid + 1) * NU / X.G)); }
#endif
        SEAM(pb + 2);
#ifndef NO_MIX2
        if (IN(pb + 3)) { PB_BEGIN(4)
#ifndef NO_HG2
            { PB_BEGIN(11) PHASE_CTX(); OutRegs<false> R; out_load<false>(X, H, X.bid, R); for (int r = X.bid; r < 1536; r += X.G) gla_out_item<128, false>(X, H, Y, l, r, R, r + X.G < 1536); PB_END(11) }
#endif
#ifndef NO_RT2
            { PB_BEGIN(12) PHASE_CTX(); RetOutRegs R; ret_out_load(X, H, X.bid, R); for (int it = X.bid; it < 768; it += X.G) ret_out_item(X, H, Y, l, it, R, it + X.G < 768); PB_END(12) }
#endif
        PB_END(4) }
#endif
        SEAM(pb + 3);
#if !defined(NO_GEMM) && !defined(NO_GE)
        if (IN(pb + 4)) { PB_BEGIN(5) PHASE_CTX(); pg8::Gemm g{Y, (const bf16*)(X.ws + WS_WOUT) + (size_t)l * D * D, M, D, D}; pg8::StaticOrder S; S.init(M, D, X.G, X.bid);
            pg8::EpiResid<false> E{XB, nullptr, ss_mlp}; pg8::gemm_phase<pg8::EpiResid<false>, pg8::StaticOrder, true, true>(X.lds, g, S, E); PB_END(5) }
#endif
        SEAM(pb + 4);
#if !defined(NO_GEMM) && !defined(NO_GF)
        if (IN(pb + 5)) { PB_BEGIN(6) PHASE_CTX(); pg8::Gemm g{XB, (const bf16*)(X.ws + WS_WUP) + (size_t)l * FF * D, M, FF, D}; pg8::StaticOrder S; S.init(M, FF, X.G, X.bid);
            pg8::EpiScaleBf16<1> E{H, FF, ss_mlp, (LAS float*)(X.lds + 131072)}; pg8::gemm_phase<pg8::EpiScaleBf16<1>, pg8::StaticOrder, true, true>(X.lds, g, S, E); PB_END(6) }
#endif
        SEAM(pb + 5);
#if !defined(NO_GEMM) && !defined(NO_GG)
        if (IN(pb + 6)) { PB_BEGIN(7) PHASE_CTX(); pg8::Gemm g{H, (const bf16*)(X.ws + WS_WDN) + (size_t)l * D * FF, M, D, FF}; pg8::StaticOrder S; S.init(M, D, X.G, X.bid);
            if (l < DEPTH - 1) { pg8::EpiResid<false> E{XB, nullptr, ss_mix_next}; pg8::gemm_phase<pg8::EpiResid<false>, pg8::StaticOrder, true, true>(X.lds, g, S, E); }
            else { pg8::EpiResid<true> E{XB, X.out(), nullptr}; pg8::gemm_phase<pg8::EpiResid<true>, pg8::StaticOrder, true, true>(X.lds, g, S, E); }
            PB_END(7) }
#endif
        SEAM(pb + 6);
    }
#undef IN
#undef SEAM
}

extern "C" void kernel_launch(void* const* d_in, const int* in_sizes, int n_in, void* d_out, int out_size, void* d_ws, size_t ws_size, hipStream_t stream) {
    static int grid = 0;
    if (grid == 0) {
        if (n_in != 14 || in_sizes[0] != M * D || out_size != M * D || ws_size < WS_END) { fprintf(stderr, "kernel_launch: unexpected problem (n_in %d, in0 %d, out %d, ws %zu < %zu); nothing launched\n", n_in, n_in > 0 ? in_sizes[0] : -1, out_size, ws_size, (size_t)WS_END); grid = -1; return; }
        int dev = 0, cus = 0, per_cu = 0;
        if (hipGetDevice(&dev) != hipSuccess || hipDeviceGetAttribute(&cus, hipDeviceAttributeMultiprocessorCount, dev) != hipSuccess) { grid = -1; return; }
        if (hipFuncSetAttribute((const void*)mega_fwd, hipFuncAttributeMaxDynamicSharedMemorySize, LDS_BYTES) != hipSuccess) { fprintf(stderr, "kernel_launch: hipFuncSetAttribute failed\n"); grid = -1; return; }
        if (hipOccupancyMaxActiveBlocksPerMultiprocessor(&per_cu, (const void*)mega_fwd, NTHR, LDS_BYTES) != hipSuccess || per_cu < 1) fprintf(stderr, "kernel_launch: occupancy query reports %d workgroups per CU\n", per_cu);
        (void)hipGetLastError();
        grid = cus;
    }
    if (grid < 0) return;
    (void)hipMemsetAsync((char*)d_ws + WS_CTL, 0, CTL_ZERO_BYTES, stream);
    Args a{};
    for (int i = 0; i < 14; ++i) a.in[i] = (const float*)d_in[i];
    a.out = (float*)d_out; a.ws = (unsigned char*)d_ws;
    if (MK_N_LAUNCHES == 1) { a.ph_lo = 0; a.ph_hi = NPHASE; hipLaunchKernelGGL(mega_fwd, dim3(grid), dim3(NTHR), LDS_BYTES, stream, a); }
    else for (int p = 0; p < NPHASE; ++p) { a.ph_lo = p; a.ph_hi = p + 1; hipLaunchKernelGGL(mega_fwd, dim3(grid), dim3(NTHR), LDS_BYTES, stream, a); }
}
```
